# Optimizing an MI355X kernel written in HIP

```python
import math
import jax, jax.numpy as jnp
from jax import lax
import numpy as np

D_MODEL = 1024
BATCH = 8
SEQ = 2048
DEPTH = 2

MIX_W = 256
N_BRANCH = 4
CONV_A = 3
SC_HEADS = 4
POOL_WINDOWS = (2, 4, 8, 16)
POOL_GROUPS = len(POOL_WINDOWS)
POOL_GC = MIX_W // POOL_GROUPS
S5_GROUP_CH = 16
S5_GROUPS = MIX_W // S5_GROUP_CH
S5_STATE = 64
S5_EIG_CLIP = -1e-4
LRU_HEADS = 4
LRU_HD = MIX_W // LRU_HEADS
LRU_CONV = 4
LRU_C = 8.0
COLS_A = 3 * MIX_W
COLS_B = MIX_W
COLS_C = MIX_W
COLS_D = 2 * MIX_W
IN_COLS = COLS_A + COLS_B + COLS_C + COLS_D
N_GROUPS = 4
EXP_PER_GROUP = 8
N_EXPERTS = N_GROUPS * EXP_PER_GROUP
TOP_K = 2
D_EXPERT = 512
MOE_BLOCK = 128
EPS = 1e-6

kernel_name = "hybrid_gated_conv_pool_s5_rglru_hmoe"


def rms_norm(x, g):
    x32 = x.astype(jnp.float32)
    y = x32 * lax.rsqrt(jnp.mean(x32 * x32, axis=-1, keepdims=True) + EPS) * g.astype(jnp.float32)
    return y.astype(x.dtype)


def causal_dwconv(u, w):
    k_taps = w.shape[0]
    s = u.shape[1]
    up = jnp.pad(u, ((0, 0), (k_taps - 1, 0), (0, 0)))
    y = up[:, 0:s] * w[0]
    for k in range(1, k_taps):
        y = y + up[:, k:k + s] * w[k]
    return y


def linear_scan(a, b):
    def op(c1, c2):
        a1, b1 = c1
        a2, b2 = c2
        return a1 * a2, a2 * b1 + b2
    _, h = lax.associative_scan(op, (a, b), axis=1)
    return h


def short_conv_mixer(bg, cg, xv, conv_w):
    return bg * causal_dwconv(cg * xv, conv_w)


def pool_mixer(u, pool_w, pool_b, pool_scale):
    bn, s, _ = u.shape
    u32 = u.astype(jnp.float32)
    cs = jnp.cumsum(u32, axis=1)
    t = jnp.arange(s)
    outs = []
    for gi, w in enumerate(POOL_WINDOWS):
        c = cs[..., gi * POOL_GC:(gi + 1) * POOL_GC]
        prev = jnp.pad(c, ((0, 0), (w, 0), (0, 0)))[:, :s]
        cnt = jnp.minimum(t + 1, w).astype(jnp.float32)[None, :, None]
        outs.append((c - prev) / cnt)
    pooled = jnp.concatenate(outs, axis=-1) - u32
    pg = pooled.reshape(bn, s, POOL_GROUPS, POOL_GC)
    y = jnp.einsum('bsgc,gcd->bsgd', pg, pool_w.astype(jnp.float32)) + pool_b.astype(jnp.float32)
    return (y.reshape(bn, s, MIX_W) * pool_scale.astype(jnp.float32)).astype(u.dtype)


def s5_mixer(u, lam_re, lam_im, log_step, b_re, b_im, c_re, c_im, d, glu_w, glu_b):
    bn, s, _ = u.shape
    u32 = u.astype(jnp.float32)
    ug = u32.reshape(bn, s, S5_GROUPS, S5_GROUP_CH)
    lam = lax.complex(jnp.minimum(lam_re.astype(jnp.float32), S5_EIG_CLIP), lam_im.astype(jnp.float32))
    step = jnp.exp(log_step.astype(jnp.float32))[:, None]
    a_bar = jnp.exp(lam * step)
    coef = (a_bar - 1.0) / lam
    b_bar = coef[..., None] * lax.complex(b_re.astype(jnp.float32), b_im.astype(jnp.float32))
    bu = lax.complex(jnp.einsum('bsgh,gph->bsgp', ug, jnp.real(b_bar)),
                     jnp.einsum('bsgh,gph->bsgp', ug, jnp.imag(b_bar)))
    h = linear_scan(jnp.broadcast_to(a_bar, bu.shape), bu)
    y = (jnp.einsum('bsgp,ghp->bsgh', jnp.real(h), c_re.astype(jnp.float32))
         - jnp.einsum('bsgp,ghp->bsgh', jnp.imag(h), c_im.astype(jnp.float32)))
    y = y.reshape(bn, s, MIX_W) + d.astype(jnp.float32) * u32
    y = jax.nn.gelu(y)
    y = y * jax.nn.sigmoid(y @ glu_w.astype(jnp.float32) + glu_b.astype(jnp.float32))
    return y.astype(u.dtype)


def rglru_mixer(xb, gate_in, conv_w, conv_b, wa, ba, wx, bx, lam):
    bn, s, _ = xb.shape
    xc = (causal_dwconv(xb, conv_w) + conv_b).astype(jnp.float32)
    xh = xc.reshape(bn, s, LRU_HEADS, LRU_HD)
    r = jax.nn.sigmoid(jnp.einsum('bshc,hcd->bshd', xh, wa.astype(jnp.float32)) + ba.astype(jnp.float32)).reshape(bn, s, MIX_W)
    i = jax.nn.sigmoid(jnp.einsum('bshc,hcd->bshd', xh, wx.astype(jnp.float32)) + bx.astype(jnp.float32)).reshape(bn, s, MIX_W)
    log_a = -LRU_C * r * jax.nn.softplus(-lam.astype(jnp.float32))
    a = jnp.exp(log_a)
    mult = jnp.sqrt(-jnp.expm1(2.0 * log_a))
    h = linear_scan(a, mult * (i * xc))
    return (h * jax.nn.gelu(gate_in.astype(jnp.float32))).astype(xb.dtype)


def hybrid_mixer(xn, w_in, conv_a_w, pool_w, pool_b, pool_scale,
                 s5_lambda_re, s5_lambda_im, s5_log_step, s5_b_re, s5_b_im, s5_c_re, s5_c_im, s5_d, s5_glu_w, s5_glu_b,
                 lru_conv_w, lru_conv_b, lru_wa, lru_ba, lru_wx, lru_bx, lru_lambda,
                 merge_gate_w, merge_gate_b, branch_w, w_out):
    bn, s, d = xn.shape
    proj = xn @ w_in
    o0 = 0
    a_b = proj[..., o0:o0 + MIX_W]; a_c = proj[..., o0 + MIX_W:o0 + 2 * MIX_W]; a_x = proj[..., o0 + 2 * MIX_W:o0 + 3 * MIX_W]
    o1 = COLS_A
    p_u = proj[..., o1:o1 + COLS_B]
    o2 = o1 + COLS_B
    s_u = proj[..., o2:o2 + COLS_C]
    o3 = o2 + COLS_C
    l_x = proj[..., o3:o3 + MIX_W]; l_g = proj[..., o3 + MIX_W:o3 + 2 * MIX_W]

    ya = short_conv_mixer(a_b, a_c, a_x, conv_a_w)
    yb = pool_mixer(p_u, pool_w, pool_b, pool_scale)
    yc = s5_mixer(s_u, s5_lambda_re, s5_lambda_im, s5_log_step, s5_b_re, s5_b_im, s5_c_re, s5_c_im, s5_d, s5_glu_w, s5_glu_b)
    yd = rglru_mixer(l_x, l_g, lru_conv_w, lru_conv_b, lru_wa, lru_ba, lru_wx, lru_bx, lru_lambda)

    ys = jnp.stack([ya, yb, yc, yd], axis=2)
    branch = jnp.einsum('bskw,kwd->bskd', ys, branch_w)
    gates = jax.nn.sigmoid(xn @ merge_gate_w + merge_gate_b).reshape(bn, s, N_BRANCH, d)
    merged = jnp.sum(gates * branch, axis=2)
    return merged @ w_out


def hier_moe(xn, rg_w, rg_b, re_w, re_b, w1, w3, w2):
    bn, s, d = xn.shape
    x = xn.reshape(-1, d)
    t_tok = x.shape[0]
    x32 = x.astype(jnp.float32)
    g_prob = jax.nn.softmax(x32 @ rg_w.astype(jnp.float32) + rg_b.astype(jnp.float32), axis=-1)
    g_val, g_idx = lax.top_k(g_prob, 1)
    e_logits = (x32 @ re_w.astype(jnp.float32) + re_b.astype(jnp.float32)).reshape(t_tok, N_GROUPS, EXP_PER_GROUP)
    sel = jnp.take_along_axis(e_logits, g_idx[:, :, None], axis=1)[:, 0]
    e_val, e_idx = lax.top_k(sel, TOP_K)
    weights = jax.nn.softmax(e_val, axis=-1) * g_val
    expert_ids = g_idx * EXP_PER_GROUP + e_idx

    tk = t_tok * TOP_K
    flat_e = expert_ids.reshape(-1).astype(jnp.int32)
    flat_w = weights.reshape(-1)
    flat_tok = jnp.repeat(jnp.arange(t_tok, dtype=jnp.int32), TOP_K)
    order = jnp.argsort(flat_e)
    se = flat_e[order]
    counts = jnp.bincount(flat_e, length=N_EXPERTS)
    padded = ((counts + MOE_BLOCK - 1) // MOE_BLOCK) * MOE_BLOCK
    pad_end = jnp.cumsum(padded)
    pad_start = pad_end - padded
    start = jnp.cumsum(counts) - counts
    rank = jnp.arange(tk, dtype=jnp.int32) - start[se]
    dest = pad_start[se] + rank
    n_rows = (-(-tk // MOE_BLOCK)) * MOE_BLOCK + N_EXPERTS * MOE_BLOCK
    n_blocks = n_rows // MOE_BLOCK
    buf_tok = jnp.zeros((n_rows,), jnp.int32).at[dest].set(flat_tok[order])
    buf_w = jnp.zeros((n_rows,), jnp.float32).at[dest].set(flat_w[order])
    block_e = jnp.minimum(jnp.searchsorted(pad_end, jnp.arange(n_blocks) * MOE_BLOCK, side='right'), N_EXPERTS - 1)
    xs = x[buf_tok].reshape(n_blocks, MOE_BLOCK, d)

    def expert_block(args):
        xb, e = args
        h = jax.nn.silu(xb @ w1[e]) * (xb @ w3[e])
        return h @ w2[e]

    ys = lax.map(expert_block, (xs, block_e)).reshape(n_rows, d).astype(jnp.float32) * buf_w[:, None]
    out = jnp.zeros((t_tok, d), jnp.float32).at[buf_tok].add(ys)
    return out.reshape(bn, s, d).astype(xn.dtype)


def setup_inputs(seed: int = 0) -> dict:
    key = jax.random.key(seed)
    ks = iter(jax.random.split(key, 64))
    L, D, W = DEPTH, D_MODEL, MIX_W

    def nrm(shape, scale):
        return jax.random.normal(next(ks), shape, jnp.float32) * scale

    def unif(shape, lo, hi):
        return jax.random.uniform(next(ks), shape, jnp.float32, lo, hi)

    x = nrm((BATCH, SEQ, D), 1.0)
    norm1_g = 1.0 + nrm((L, D), 0.02)
    w_in = nrm((L, D, IN_COLS), D ** -0.5)
    conv_a_w = nrm((L, CONV_A, W), CONV_A ** -0.5)
    pool_w = nrm((L, POOL_GROUPS, POOL_GC, POOL_GC), POOL_GC ** -0.5)
    pool_b = nrm((L, POOL_GROUPS, POOL_GC), 0.01)
    pool_scale = 1.0 + nrm((L, W), 0.02)
    s5_lambda_re = -0.5 + nrm((L, S5_GROUPS, S5_STATE), 0.01)
    s5_lambda_im = math.pi * jnp.broadcast_to(jnp.arange(S5_STATE, dtype=jnp.float32), (L, S5_GROUPS, S5_STATE)) + nrm((L, S5_GROUPS, S5_STATE), 0.01)
    s5_log_step = unif((L, S5_GROUPS), math.log(1e-3), math.log(1e-1))
    s5_b_re = nrm((L, S5_GROUPS, S5_STATE, S5_GROUP_CH), (2.0 * S5_GROUP_CH) ** -0.5)
    s5_b_im = nrm((L, S5_GROUPS, S5_STATE, S5_GROUP_CH), (2.0 * S5_GROUP_CH) ** -0.5)
    s5_c_re = nrm((L, S5_GROUPS, S5_GROUP_CH, S5_STATE), 0.5)
    s5_c_im = nrm((L, S5_GROUPS, S5_GROUP_CH, S5_STATE), 0.5)
    s5_d = nrm((L, W), 0.5)
    s5_glu_w = nrm((L, W, W), W ** -0.5)
    s5_glu_b = nrm((L, W), 0.01)
    lru_conv_w = nrm((L, LRU_CONV, W), LRU_CONV ** -0.5)
    lru_conv_b = nrm((L, W), 0.01)
    lru_wa = nrm((L, LRU_HEADS, LRU_HD, LRU_HD), LRU_HD ** -0.5)
    lru_ba = nrm((L, LRU_HEADS, LRU_HD), 0.01)
    lru_wx = nrm((L, LRU_HEADS, LRU_HD, LRU_HD), LRU_HD ** -0.5)
    lru_bx = nrm((L, LRU_HEADS, LRU_HD), 0.01)
    a0 = unif((L, W), 0.9, 0.999) ** (1.0 / LRU_C)
    lru_lambda = jnp.log(a0) - jnp.log1p(-a0)
    merge_gate_w = nrm((L, D, N_BRANCH * D), D ** -0.5)
    merge_gate_b = nrm((L, N_BRANCH * D), 0.01)
    branch_w = nrm((L, N_BRANCH, W, D), W ** -0.5)
    w_out = nrm((L, D, D), D ** -0.5)
    norm2_g = 1.0 + nrm((L, D), 0.02)
    router_group_w = nrm((L, D, N_GROUPS), D ** -0.5)
    router_group_b = nrm((L, N_GROUPS), 0.01)
    router_expert_w = nrm((L, D, N_EXPERTS), D ** -0.5)
    router_expert_b = nrm((L, N_EXPERTS), 0.01)
    expert_w1 = nrm((L, N_EXPERTS, D, D_EXPERT), D ** -0.5)
    expert_w3 = nrm((L, N_EXPERTS, D, D_EXPERT), D ** -0.5)
    expert_w2 = nrm((L, N_EXPERTS, D_EXPERT, D), D_EXPERT ** -0.5)
    final_norm_g = 1.0 + nrm((D,), 0.02)
    return {
        "x": x, "norm1_g": norm1_g, "w_in": w_in, "conv_a_w": conv_a_w,
        "pool_w": pool_w, "pool_b": pool_b, "pool_scale": pool_scale,
        "s5_lambda_re": s5_lambda_re, "s5_lambda_im": s5_lambda_im, "s5_log_step": s5_log_step,
        "s5_b_re": s5_b_re, "s5_b_im": s5_b_im, "s5_c_re": s5_c_re, "s5_c_im": s5_c_im,
        "s5_d": s5_d, "s5_glu_w": s5_glu_w, "s5_glu_b": s5_glu_b,
        "lru_conv_w": lru_conv_w, "lru_conv_b": lru_conv_b, "lru_wa": lru_wa, "lru_ba": lru_ba,
        "lru_wx": lru_wx, "lru_bx": lru_bx, "lru_lambda": lru_lambda,
        "merge_gate_w": merge_gate_w, "merge_gate_b": merge_gate_b, "branch_w": branch_w, "w_out": w_out,
        "norm2_g": norm2_g, "router_group_w": router_group_w, "router_group_b": router_group_b,
        "router_expert_w": router_expert_w, "router_expert_b": router_expert_b,
        "expert_w1": expert_w1, "expert_w3": expert_w3, "expert_w2": expert_w2,
        "final_norm_g": final_norm_g,
    }


def reference(x, norm1_g, w_in, conv_a_w, pool_w, pool_b, pool_scale,
              s5_lambda_re, s5_lambda_im, s5_log_step, s5_b_re, s5_b_im, s5_c_re, s5_c_im,
              s5_d, s5_glu_w, s5_glu_b, lru_conv_w, lru_conv_b, lru_wa, lru_ba, lru_wx, lru_bx, lru_lambda,
              merge_gate_w, merge_gate_b, branch_w, w_out, norm2_g,
              router_group_w, router_group_b, router_expert_w, router_expert_b,
              expert_w1, expert_w3, expert_w2, final_norm_g):
    h = x
    for l in range(DEPTH):
        xn = rms_norm(h, norm1_g[l])
        h = h + hybrid_mixer(xn, w_in[l], conv_a_w[l], pool_w[l], pool_b[l], pool_scale[l],
                             s5_lambda_re[l], s5_lambda_im[l], s5_log_step[l], s5_b_re[l], s5_b_im[l],
                             s5_c_re[l], s5_c_im[l], s5_d[l], s5_glu_w[l], s5_glu_b[l],
                             lru_conv_w[l], lru_conv_b[l], lru_wa[l], lru_ba[l], lru_wx[l], lru_bx[l], lru_lambda[l],
                             merge_gate_w[l], merge_gate_b[l], branch_w[l], w_out[l])
        xn = rms_norm(h, norm2_g[l])
        h = h + hier_moe(xn, router_group_w[l], router_group_b[l], router_expert_w[l], router_expert_b[l],
                         expert_w1[l], expert_w3[l], expert_w2[l])
    return rms_norm(h, final_norm_g)
```

```cpp
#include <hip/hip_runtime.h>
#include <cstdint>
#include <cstdio>

namespace {
constexpr int D = 1024, BATCH = 8, SEQ = 2048, DEPTH = 2, T = BATCH * SEQ;
constexpr int W = 256, IN_COLS = 1792;
constexpr int NEXP = 32, DEXP = 512;
constexpr int CHUNK = 64, NCHUNK = SEQ / CHUNK;
constexpr int CAP = 16384;
constexpr int MAXBLK = 160;
constexpr float EPS = 1e-6f;

typedef unsigned short bf16_t;
typedef float f32x4 __attribute__((ext_vector_type(4)));

__device__ __forceinline__ float bf2f(bf16_t b) { return __uint_as_float(((unsigned)b) << 16); }
__device__ __forceinline__ bf16_t f2bf(float f) { unsigned u = __float_as_uint(f); u += 0x7fffu + ((u >> 16) & 1u); return (bf16_t)(u >> 16); }
__device__ __forceinline__ float sigmoidf_(float x) { return 1.0f / (1.0f + __expf(-x)); }
__device__ __forceinline__ float gelu_tanh(float x) {
    const float z = 0.7978845608028654f * (x + 0.044715f * x * x * x);
    const float t = 1.0f - 2.0f / (__expf(2.0f * z) + 1.0f);
    return 0.5f * x * (1.0f + t);
}

constexpr size_t MiB = 1u << 20;
constexpr size_t WS_CTL = 0;
constexpr size_t WS_TAB = 1 * MiB;
constexpr size_t WS_H = 4 * MiB;
constexpr size_t WS_XN = 68 * MiB;
constexpr size_t WS_PROJ = 100 * MiB;
constexpr size_t WS_YS = 156 * MiB;
constexpr size_t WS_R1 = 188 * MiB;
constexpr size_t WS_HBUF = WS_R1;
constexpr size_t WS_YMOE = WS_R1 + 48 * MiB;
constexpr size_t WS_MERGED = 316 * MiB;
constexpr size_t WS_S5ST = 348 * MiB;
constexpr size_t WS_LRUA = 350 * MiB;
constexpr size_t WS_LRUH = 366 * MiB;
constexpr size_t WS_LRUS = 382 * MiB;
constexpr size_t WS_BUFTS = 383 * MiB;
constexpr size_t WS_BUFW = 385 * MiB;
constexpr size_t WS_END = 387 * MiB;

constexpr int CW_CNT = 64;
constexpr int CW_PLAN = 256;

constexpr int TB_A = 0;
constexpr int TB_A64 = 2048;
constexpr int TB_BRE = 4096;
constexpr int TB_BIM = 4096 + 16384;
constexpr int TB_NLOG = 4096 + 32768;
constexpr int TB_RW = 4096 + 32768 + 256;

struct Ptrs {
    const float* in[37];
    float* out;
    unsigned char* ws;
};

__global__ void k_prep(Ptrs P) {
    const int l = blockIdx.y;
    float* tab = (float*)(P.ws + WS_TAB + (size_t)l * MiB);
    const int gid = blockIdx.x * blockDim.x + threadIdx.x;
    if (gid < 1024) {
        const int g = gid >> 6;
        const double lre = fmin((double)P.in[7][l * 1024 + gid], -1e-4);
        const double lim = (double)P.in[8][l * 1024 + gid];
        const double step = exp((double)P.in[9][l * 16 + g]);
        const double er = exp(lre * step), ar = er * cos(lim * step), ai = er * sin(lim * step);
        const double e64 = exp(lre * step * 64.0), a64r = e64 * cos(lim * step * 64.0), a64i = e64 * sin(lim * step * 64.0);
        const double nr = ar - 1.0, ni = ai, den = lre * lre + lim * lim;
        const double cr = (nr * lre + ni * lim) / den, ci = (ni * lre - nr * lim) / den;
        tab[TB_A + 2 * gid] = (float)ar; tab[TB_A + 2 * gid + 1] = (float)ai;
        tab[TB_A64 + 2 * gid] = (float)a64r; tab[TB_A64 + 2 * gid + 1] = (float)a64i;
        for (int h = 0; h < 16; ++h) {
            const double br = (double)P.in[10][((size_t)l * 1024 + gid) * 16 + h], bi = (double)P.in[11][((size_t)l * 1024 + gid) * 16 + h];
            tab[TB_BRE + gid * 16 + h] = (float)(cr * br - ci * bi);
            tab[TB_BIM + gid * 16 + h] = (float)(cr * bi + ci * br);
        }
    }
    if (gid < 256) {
        const double lam = (double)P.in[23][l * 256 + gid];
        tab[TB_NLOG + gid] = (float)(-8.0 * log1p(exp(-lam)));
    }
    if (gid < 36 * 1024) {
        const int o = gid >> 10, k = gid & 1023;
        tab[TB_RW + gid] = (o < 4) ? P.in[29][((size_t)l * 1024 + k) * 4 + o] : P.in[31][((size_t)l * 1024 + k) * 32 + (o - 4)];
    }
}

__global__ void __launch_bounds__(256) k_norm(const float* hin, const bf16_t* y, const float* g, float* hout, bf16_t* xn, float* out) {
    const int lane = threadIdx.x & 63, m = blockIdx.x * 4 + (threadIdx.x >> 6);
    f32x4 v[4]; float s = 0.f;
#pragma unroll
    for (int j = 0; j < 4; ++j) {
        const int col = 4 * lane + 256 * j;
        v[j] = *(const f32x4*)(hin + (size_t)m * D + col);
        if (y) {
            const uint2 a = *(const uint2*)(y + ((size_t)m * 2 + 0) * D + col), b = *(const uint2*)(y + ((size_t)m * 2 + 1) * D + col);
            v[j].x += __uint_as_float(a.x << 16) + __uint_as_float(b.x << 16);
            v[j].y += __uint_as_float(a.x & 0xffff0000u) + __uint_as_float(b.x & 0xffff0000u);
            v[j].z += __uint_as_float(a.y << 16) + __uint_as_float(b.y << 16);
            v[j].w += __uint_as_float(a.y & 0xffff0000u) + __uint_as_float(b.y & 0xffff0000u);
        }
        s += v[j].x * v[j].x + v[j].y * v[j].y + v[j].z * v[j].z + v[j].w * v[j].w;
    }
#pragma unroll
    for (int o = 1; o < 64; o <<= 1) s += __shfl_xor(s, o);
    const float rstd = rsqrtf(s * (1.0f / D) + EPS);
#pragma unroll
    for (int j = 0; j < 4; ++j) {
        const int col = 4 * lane + 256 * j;
        if (hout) *(f32x4*)(hout + (size_t)m * D + col) = v[j];
        const f32x4 gg = *(const f32x4*)(g + col);
        const f32x4 o = v[j] * rstd * gg;
        if (xn) { uint2 w; w.x = (unsigned)f2bf(o.x) | ((unsigned)f2bf(o.y) << 16); w.y = (unsigned)f2bf(o.z) | ((unsigned)f2bf(o.w) << 16); *(uint2*)(xn + (size_t)m * D + col) = w; }
        if (out) *(f32x4*)(out + (size_t)m * D + col) = o;
    }
}

template <class P>
__global__ void __launch_bounds__(256) k_gemm_naive(P p) {
    __shared__ float As[16][65];
    __shared__ float Bs[16][65];
    const int tile_n = blockIdx.x, tile_m = blockIdx.y;
    if (!p.active(tile_m)) return;
    const int row0 = tile_m * 64, col0 = tile_n * 64;
    const int tid = threadIdx.x, tx = tid & 15, ty = tid >> 4;
    float acc[4][4];
#pragma unroll
    for (int i = 0; i < 4; ++i)
#pragma unroll
        for (int j = 0; j < 4; ++j) acc[i][j] = 0.f;
    for (int k0 = 0; k0 < P::K; k0 += 16) {
#pragma unroll
        for (int i = 0; i < 4; ++i) { const int e = tid + i * 256; const int r = e >> 4, kk = e & 15; As[kk][r] = p.a(row0 + r, k0 + kk, col0); }
#pragma unroll
        for (int i = 0; i < 4; ++i) { const int e = tid + i * 256; const int kk = e >> 6, c = e & 63; Bs[kk][c] = p.b(k0 + kk, col0 + c, row0); }
        __syncthreads();
#pragma unroll
        for (int kk = 0; kk < 16; ++kk) {
            float av[4], bv[4];
#pragma unroll
            for (int i = 0; i < 4; ++i) { av[i] = As[kk][ty * 4 + i]; bv[i] = Bs[kk][tx * 4 + i]; }
#pragma unroll
            for (int i = 0; i < 4; ++i)
#pragma unroll
                for (int j = 0; j < 4; ++j) acc[i][j] += av[i] * bv[j];
        }
        __syncthreads();
    }
#pragma unroll
    for (int i = 0; i < 4; ++i) p.epi(row0 + ty * 4 + i, col0 + tx * 4, acc[i]);
}

struct PProj {
    static constexpr int K = 1024;
    const bf16_t* xn; const float* w; bf16_t* proj;
    __device__ bool active(int) const { return true; }
    __device__ float a(int row, int k, int) const { return bf2f(xn[(size_t)row * D + k]); }
    __device__ float b(int k, int col, int) const { return w[(size_t)k * IN_COLS + col]; }
    __device__ void epi(int row, int col, const float* acc) const {
        uint2 w2; w2.x = (unsigned)f2bf(acc[0]) | ((unsigned)f2bf(acc[1]) << 16); w2.y = (unsigned)f2bf(acc[2]) | ((unsigned)f2bf(acc[3]) << 16);
        *(uint2*)(proj + (size_t)row * IN_COLS + col) = w2;
    }
};
struct PBranch {
    static constexpr int K = 256;
    const bf16_t* ys; const float* w; bf16_t* br;
    __device__ bool active(int) const { return true; }
    __device__ float a(int row, int k, int col0) const { return bf2f(ys[(size_t)row * 1024 + (col0 >> 10) * 256 + k]); }
    __device__ float b(int k, int col, int) const { const int k4 = col >> 10, d = col & 1023; return w[((size_t)k4 * 256 + k) * 1024 + d]; }
    __device__ void epi(int row, int col, const float* acc) const {
        const int k4 = col >> 10, d = col & 1023;
        uint2 w2; w2.x = (unsigned)f2bf(acc[0]) | ((unsigned)f2bf(acc[1]) << 16); w2.y = (unsigned)f2bf(acc[2]) | ((unsigned)f2bf(acc[3]) << 16);
        *(uint2*)(br + (((size_t)row * 256 + (d >> 2)) * 4 + k4) * 4) = w2;
    }
};
struct PGate {
    static constexpr int K = 1024;
    const bf16_t* xn; const float* w; const float* bias; const bf16_t* br; bf16_t* merged;
    __device__ bool active(int) const { return true; }
    __device__ float a(int row, int k, int) const { return bf2f(xn[(size_t)row * D + k]); }
    __device__ float b(int k, int col, int) const { const int d = col >> 2, k4 = col & 3; return w[(size_t)k * 4096 + k4 * 1024 + d]; }
    __device__ void epi(int row, int col, const float* acc) const {
        const int d = col >> 2; float m = 0.f;
#pragma unroll
        for (int k4 = 0; k4 < 4; ++k4) {
            const float gt = sigmoidf_(acc[k4] + bias[k4 * 1024 + d]);
            m += gt * bf2f(br[(((size_t)row * 256 + (d >> 2)) * 4 + k4) * 4 + (d & 3)]);
        }
        merged[(size_t)row * D + d] = f2bf(m);
    }
};
struct POut {
    static constexpr int K = 1024;
    const bf16_t* mg; const float* w; float* h;
    __device__ bool active(int) const { return true; }
    __device__ float a(int row, int k, int) const { return bf2f(mg[(size_t)row * D + k]); }
    __device__ float b(int k, int col, int) const { return w[(size_t)k * D + col]; }
    __device__ void epi(int row, int col, const float* acc) const {
        f32x4* p = (f32x4*)(h + (size_t)row * D + col); f32x4 v = *p; v.x += acc[0]; v.y += acc[1]; v.z += acc[2]; v.w += acc[3]; *p = v;
    }
};
struct PMoe1 {
    static constexpr int K = 1024;
    const bf16_t* xn; const float* w1; const float* w3; bf16_t* hbuf; const unsigned* plan; const unsigned* cnt; const int* buf_ts;
    __device__ bool active(int tile_m) const { return (unsigned)(tile_m >> 2) < plan[0]; }
    __device__ int tokslot(int prow) const {
        const int blk = prow >> 8; const int e = plan[1 + blk], lb = plan[1 + MAXBLK + blk]; const int pos = lb * 256 + (prow & 255);
        return pos < (int)cnt[e] ? buf_ts[e * CAP + pos] : -1;
    }
    __device__ float a(int prow, int k, int) const { const int ts = tokslot(prow); return ts < 0 ? 0.f : bf2f(xn[(size_t)(ts >> 1) * D + k]); }
    __device__ float b(int k, int col, int row0) const { const int e = plan[1 + (row0 >> 8)]; const int hid = col >> 1; const float* w = (col & 1) ? w3 : w1; return w[((size_t)e * 1024 + k) * DEXP + hid]; }
    __device__ void epi(int prow, int col, const float* acc) const {
        const int hid = col >> 1;
        const float h0 = acc[0] * sigmoidf_(acc[0]) * acc[1], h1 = acc[2] * sigmoidf_(acc[2]) * acc[3];
        *(unsigned*)(hbuf + (size_t)prow * DEXP + hid) = (unsigned)f2bf(h0) | ((unsigned)f2bf(h1) << 16);
    }
};
struct PMoe2 {
    static constexpr int K = 512;
    const bf16_t* hbuf; const float* w2; bf16_t* ymoe; const unsigned* plan; const unsigned* cnt; const int* buf_ts; const float* buf_w;
    __device__ bool active(int tile_m) const { return (unsigned)(tile_m >> 2) < plan[0]; }
    __device__ float a(int prow, int k, int) const { return bf2f(hbuf[(size_t)prow * DEXP + k]); }
    __device__ float b(int k, int col, int row0) const { const int e = plan[1 + (row0 >> 8)]; return w2[((size_t)e * DEXP + k) * D + col]; }
    __device__ void epi(int prow, int col, const float* acc) const {
        const int blk = prow >> 8; const int e = plan[1 + blk], lb = plan[1 + MAXBLK + blk]; const int pos = lb * 256 + (prow & 255);
        if (pos >= (int)cnt[e]) return;
        const int ts = buf_ts[e * CAP + pos]; const float wt = buf_w[e * CAP + pos];
        uint2 w; w.x = (unsigned)f2bf(wt * acc[0]) | ((unsigned)f2bf(wt * acc[1]) << 16); w.y = (unsigned)f2bf(wt * acc[2]) | ((unsigned)f2bf(wt * acc[3]) << 16);
        *(uint2*)(ymoe + (size_t)ts * D + col) = w;
    }
};

struct MixArgs {
    const bf16_t* proj; bf16_t* ys; const float* tab;
    float2* s5st; float* lruA; float* lruH; float2* lruS;
    const float *conv_a_w, *pool_w, *pool_b, *pool_scale, *c_re, *c_im, *s5_d, *glu_w, *glu_b, *lconv_w, *lconv_b, *wa, *ba, *wx, *bx;
};

__global__ void __launch_bounds__(512) k_mix_b1(MixArgs A) {
    extern __shared__ __attribute__((aligned(16))) unsigned char smem[];
    float* buf = (float*)smem;
    float2* ex = (float2*)(smem + 65536);
    const int tid = threadIdx.x, b = blockIdx.x >> 5, c = blockIdx.x & 31;
    const size_t t0 = (size_t)b * SEQ + c * CHUNK;
    const float* tab = A.tab;
    for (int e = tid; e < 64 * 256; e += 512) { const int s = e >> 8, ch = e & 255; buf[e] = bf2f(A.proj[(t0 + s) * IN_COLS + 1024 + ch]); }
    __syncthreads();
    {
        const int g = tid >> 5, p0 = (tid & 31) * 2;
        float bre[2][16], bim[2][16], ar[2], ai[2], hr[2] = {0.f, 0.f}, hi[2] = {0.f, 0.f};
#pragma unroll
        for (int q = 0; q < 2; ++q) {
            const int si = g * 64 + p0 + q;
            ar[q] = tab[TB_A + 2 * si]; ai[q] = tab[TB_A + 2 * si + 1];
#pragma unroll
            for (int h = 0; h < 16; ++h) { bre[q][h] = tab[TB_BRE + si * 16 + h]; bim[q][h] = tab[TB_BIM + si * 16 + h]; }
        }
        for (int s = 0; s < 64; ++s) {
            float u[16];
#pragma unroll
            for (int h = 0; h < 16; ++h) u[h] = buf[s * 256 + g * 16 + h];
#pragma unroll
            for (int q = 0; q < 2; ++q) {
                float xr = 0.f, xi = 0.f;
#pragma unroll
                for (int h = 0; h < 16; ++h) { xr += bre[q][h] * u[h]; xi += bim[q][h] * u[h]; }
                const float nr = ar[q] * hr[q] - ai[q] * hi[q] + xr, ni = ar[q] * hi[q] + ai[q] * hr[q] + xi;
                hr[q] = nr; hi[q] = ni;
            }
        }
#pragma unroll
        for (int q = 0; q < 2; ++q) A.s5st[((size_t)b * NCHUNK + c) * 1024 + g * 64 + p0 + q] = make_float2(hr[q], hi[q]);
    }
    __syncthreads();
    const int col = tid & 255, half = tid >> 8;
    {
        const float w0 = A.lconv_w[0 * 256 + col], w1 = A.lconv_w[1 * 256 + col], w2 = A.lconv_w[2 * 256 + col], w3 = A.lconv_w[3 * 256 + col], cb = A.lconv_b[col];
        const int tl0 = half * 32;
        float xm3, xm2, xm1;
        {
            const int pos = c * CHUNK + tl0;
            xm3 = (pos - 3 >= 0) ? bf2f(A.proj[(t0 + tl0 - 3) * IN_COLS + 1280 + col]) : 0.f;
            xm2 = (pos - 2 >= 0) ? bf2f(A.proj[(t0 + tl0 - 2) * IN_COLS + 1280 + col]) : 0.f;
            xm1 = (pos - 1 >= 0) ? bf2f(A.proj[(t0 + tl0 - 1) * IN_COLS + 1280 + col]) : 0.f;
        }
        for (int i = 0; i < 32; ++i) {
            const float x0 = bf2f(A.proj[(t0 + tl0 + i) * IN_COLS + 1280 + col]);
            buf[(tl0 + i) * 256 + col] = w0 * xm3 + w1 * xm2 + w2 * xm1 + w3 * x0 + cb;
            xm3 = xm2; xm2 = xm1; xm1 = x0;
        }
    }
    __syncthreads();
    {
        const int hh = col >> 6, dc = col & 63, tl0 = half * 32;
        float accr[32], acci[32];
#pragma unroll
        for (int i = 0; i < 32; ++i) { accr[i] = 0.f; acci[i] = 0.f; }
        for (int kk = 0; kk < 64; ++kk) {
            const float wav = A.wa[((size_t)hh * 64 + kk) * 64 + dc], wxv = A.wx[((size_t)hh * 64 + kk) * 64 + dc];
#pragma unroll
            for (int i = 0; i < 32; ++i) { const float x = buf[(tl0 + i) * 256 + hh * 64 + kk]; accr[i] += x * wav; acci[i] += x * wxv; }
        }
        const float bav = A.ba[col], bxv = A.bx[col], nlog = tab[TB_NLOG + col];
        float Ac = 1.f, hl = 0.f;
#pragma unroll
        for (int i = 0; i < 32; ++i) {
            const float r = sigmoidf_(accr[i] + bav), ig = sigmoidf_(acci[i] + bxv);
            const float la = nlog * r, a = __expf(la), mult = sqrtf(fmaxf(-expm1f(2.0f * la), 0.f));
            const float bv = mult * ig * buf[(tl0 + i) * 256 + col];
            hl = a * hl + bv; Ac = Ac * a;
            accr[i] = Ac; acci[i] = hl;
        }
        if (half == 0) ex[col] = make_float2(Ac, hl);
        __syncthreads();
        if (half == 1) {
            const float2 pv = ex[col];
#pragma unroll
            for (int i = 0; i < 32; ++i) { acci[i] += accr[i] * pv.y; accr[i] *= pv.x; }
            A.lruS[((size_t)b * NCHUNK + c) * 256 + col] = make_float2(accr[31], acci[31]);
        }
#pragma unroll
        for (int i = 0; i < 32; ++i) { A.lruA[(t0 + tl0 + i) * 256 + col] = accr[i]; A.lruH[(t0 + tl0 + i) * 256 + col] = acci[i]; }
    }
}

__global__ void __launch_bounds__(512) k_mix_b2(MixArgs A) {
    extern __shared__ __attribute__((aligned(16))) unsigned char smem[];
    float* ybuf = (float*)smem;
    bf16_t* su = (bf16_t*)(smem + 65536);
    float2* hs = (float2*)(smem + 65536 + 32768);
    const int tid = threadIdx.x, b = blockIdx.x >> 5, c = blockIdx.x & 31;
    const size_t t0 = (size_t)b * SEQ + c * CHUNK;
    const float* tab = A.tab;
    const int col = tid & 255, half = tid >> 8, tl0 = half * 32;

    {
        const float w0 = A.conv_a_w[0 * 256 + col], w1 = A.conv_a_w[1 * 256 + col], w2 = A.conv_a_w[2 * 256 + col];
        const int pos = c * CHUNK + tl0;
        float vm2 = 0.f, vm1 = 0.f;
        if (pos - 2 >= 0) vm2 = bf2f(A.proj[(t0 + tl0 - 2) * IN_COLS + 256 + col]) * bf2f(A.proj[(t0 + tl0 - 2) * IN_COLS + 512 + col]);
        if (pos - 1 >= 0) vm1 = bf2f(A.proj[(t0 + tl0 - 1) * IN_COLS + 256 + col]) * bf2f(A.proj[(t0 + tl0 - 1) * IN_COLS + 512 + col]);
        for (int i = 0; i < 32; ++i) {
            const size_t r = (t0 + tl0 + i) * IN_COLS;
            const float bg = bf2f(A.proj[r + col]), v0 = bf2f(A.proj[r + 256 + col]) * bf2f(A.proj[r + 512 + col]);
            A.ys[(t0 + tl0 + i) * 1024 + col] = f2bf(bg * (w0 * vm2 + w1 * vm1 + w2 * v0));
            vm2 = vm1; vm1 = v0;
        }
    }
    {
        const int gi = col >> 6, win = 2 << gi;
        for (int i = 0; i < 32; ++i) {
            const int tl = tl0 + i, pos = c * CHUNK + tl;
            const int cnt = (pos + 1 < win) ? pos + 1 : win;
            float s = 0.f;
            for (int j = 0; j < cnt; ++j) s += bf2f(A.proj[(t0 + tl - j) * IN_COLS + 768 + col]);
            const float u = bf2f(A.proj[(t0 + tl) * IN_COLS + 768 + col]);
            ybuf[tl * 256 + col] = s / (float)cnt - u;
        }
        __syncthreads();
        const int dc = col & 63;
        float acc[32];
#pragma unroll
        for (int i = 0; i < 32; ++i) acc[i] = 0.f;
        for (int cc = 0; cc < 64; ++cc) {
            const float wv = A.pool_w[((size_t)gi * 64 + cc) * 64 + dc];
#pragma unroll
            for (int i = 0; i < 32; ++i) acc[i] += ybuf[(tl0 + i) * 256 + gi * 64 + cc] * wv;
        }
        const float pb = A.pool_b[col], ps = A.pool_scale[col];
#pragma unroll
        for (int i = 0; i < 32; ++i) A.ys[(t0 + tl0 + i) * 1024 + 256 + col] = f2bf((acc[i] + pb) * ps);
        __syncthreads();
    }
    {
        float hin = 0.f;
        for (int j = 0; j < c; ++j) { const float2 sv = A.lruS[((size_t)b * NCHUNK + j) * 256 + col]; hin = sv.x * hin + sv.y; }
        for (int i = 0; i < 32; ++i) {
            const size_t t = t0 + tl0 + i;
            const float h = A.lruH[t * 256 + col] + A.lruA[t * 256 + col] * hin;
            const float gt = gelu_tanh(bf2f(A.proj[t * IN_COLS + 1536 + col]));
            A.ys[t * 1024 + 768 + col] = f2bf(h * gt);
        }
    }
    for (int e = tid; e < 64 * 256; e += 512) { const int s = e >> 8, ch = e & 255; su[e] = A.proj[(t0 + s) * IN_COLS + 1024 + ch]; }
    {
        const int g = tid >> 5, p0 = (tid & 31) * 2;
        float bre[2][16], bim[2][16], ar[2], ai[2], hr[2] = {0.f, 0.f}, hi[2] = {0.f, 0.f};
#pragma unroll
        for (int q = 0; q < 2; ++q) {
            const int si = g * 64 + p0 + q;
            ar[q] = tab[TB_A + 2 * si]; ai[q] = tab[TB_A + 2 * si + 1];
            const float a64r = tab[TB_A64 + 2 * si], a64i = tab[TB_A64 + 2 * si + 1];
            for (int j = 0; j < c; ++j) {
                const float2 sv = A.s5st[((size_t)b * NCHUNK + j) * 1024 + si];
                const float nr = a64r * hr[q] - a64i * hi[q] + sv.x, ni = a64r * hi[q] + a64i * hr[q] + sv.y;
                hr[q] = nr; hi[q] = ni;
            }
#pragma unroll
            for (int h = 0; h < 16; ++h) { bre[q][h] = tab[TB_BRE + si * 16 + h]; bim[q][h] = tab[TB_BIM + si * 16 + h]; }
        }
        const int g2 = tid >> 5, cc = (tid >> 1) & 15, hp = tid & 1;
        float cre[32], cim[32];
#pragma unroll
        for (int p = 0; p < 32; ++p) { cre[p] = A.c_re[((size_t)g2 * 16 + cc) * 64 + hp * 32 + p]; cim[p] = A.c_im[((size_t)g2 * 16 + cc) * 64 + hp * 32 + p]; }
        __syncthreads();
        for (int s4 = 0; s4 < 64; s4 += 4) {
#pragma unroll
            for (int tt = 0; tt < 4; ++tt) {
                const int s = s4 + tt;
                float u[16];
#pragma unroll
                for (int h = 0; h < 16; ++h) u[h] = bf2f(su[s * 256 + g * 16 + h]);
#pragma unroll
                for (int q = 0; q < 2; ++q) {
                    float xr = 0.f, xi = 0.f;
#pragma unroll
                    for (int h = 0; h < 16; ++h) { xr += bre[q][h] * u[h]; xi += bim[q][h] * u[h]; }
                    const float nr = ar[q] * hr[q] - ai[q] * hi[q] + xr, ni = ar[q] * hi[q] + ai[q] * hr[q] + xi;
                    hr[q] = nr; hi[q] = ni;
                    hs[tt * 1024 + g * 64 + p0 + q] = make_float2(nr, ni);
                }
            }
            __syncthreads();
#pragma unroll
            for (int tt = 0; tt < 4; ++tt) {
                float part = 0.f;
#pragma unroll
                for (int p = 0; p < 32; ++p) { const float2 hv = hs[tt * 1024 + g2 * 64 + hp * 32 + p]; part += cre[p] * hv.x - cim[p] * hv.y; }
                part += __shfl_xor(part, 1);
                if (hp == 0) ybuf[(s4 + tt) * 256 + g2 * 16 + cc] = part;
            }
            __syncthreads();
        }
    }
    {
        const float dv = A.s5_d[col];
        for (int i = 0; i < 32; ++i) { const int tl = tl0 + i; ybuf[tl * 256 + col] = gelu_tanh(ybuf[tl * 256 + col] + dv * bf2f(su[tl * 256 + col])); }
    }
    __syncthreads();
    {
        float acc[32];
#pragma unroll
        for (int i = 0; i < 32; ++i) acc[i] = 0.f;
        for (int k = 0; k < 256; ++k) {
            const float wv = A.glu_w[(size_t)k * 256 + col];
#pragma unroll
            for (int i = 0; i < 32; ++i) acc[i] += ybuf[(tl0 + i) * 256 + k] * wv;
        }
        const float gb = A.glu_b[col];
#pragma unroll
        for (int i = 0; i < 32; ++i) A.ys[(t0 + tl0 + i) * 1024 + 512 + col] = f2bf(ybuf[(tl0 + i) * 256 + col] * sigmoidf_(acc[i] + gb));
    }
}

__global__ void __launch_bounds__(256) k_router(const float* h, const float* g2, const float* tab, const float* rgb, const float* reb,
                                                bf16_t* xn, unsigned* cnt, int* buf_ts, float* buf_w) {
    __shared__ float lg[4][4][40];
    const int lane = threadIdx.x & 63, wv = threadIdx.x >> 6;
    const int m0 = (blockIdx.x * 4 + wv) * 4;
    f32x4 v[4][4];
#pragma unroll
    for (int tk = 0; tk < 4; ++tk) {
        float s = 0.f;
#pragma unroll
        for (int j = 0; j < 4; ++j) { v[tk][j] = *(const f32x4*)(h + (size_t)(m0 + tk) * D + 4 * lane + 256 * j); s += v[tk][j].x * v[tk][j].x + v[tk][j].y * v[tk][j].y + v[tk][j].z * v[tk][j].z + v[tk][j].w * v[tk][j].w; }
#pragma unroll
        for (int o = 1; o < 64; o <<= 1) s += __shfl_xor(s, o);
        const float rstd = rsqrtf(s * (1.0f / D) + EPS);
#pragma unroll
        for (int j = 0; j < 4; ++j) {
            const int col = 4 * lane + 256 * j;
            const f32x4 gg = *(const f32x4*)(g2 + col);
            v[tk][j] = v[tk][j] * rstd * gg;
            uint2 w; w.x = (unsigned)f2bf(v[tk][j].x) | ((unsigned)f2bf(v[tk][j].y) << 16); w.y = (unsigned)f2bf(v[tk][j].z) | ((unsigned)f2bf(v[tk][j].w) << 16);
            *(uint2*)(xn + (size_t)(m0 + tk) * D + col) = w;
        }
    }
    const float* rw = tab + TB_RW;
    for (int o = 0; o < 36; ++o) {
        f32x4 wr[4];
#pragma unroll
        for (int j = 0; j < 4; ++j) wr[j] = *(const f32x4*)(rw + (size_t)o * 1024 + 4 * lane + 256 * j);
#pragma unroll
        for (int tk = 0; tk < 4; ++tk) {
            float s = 0.f;
#pragma unroll
            for (int j = 0; j < 4; ++j) s += v[tk][j].x * wr[j].x + v[tk][j].y * wr[j].y + v[tk][j].z * wr[j].z + v[tk][j].w * wr[j].w;
#pragma unroll
            for (int q = 1; q < 64; q <<= 1) s += __shfl_xor(s, q);
            if (lane == 0) lg[wv][tk][o] = s;
        }
    }
    __syncthreads();
    if (lane < 4) {
        const int tk = lane, m = m0 + tk;
        float gl[4], mx = -1e30f; int gi = 0;
#pragma unroll
        for (int i = 0; i < 4; ++i) { gl[i] = lg[wv][tk][i] + rgb[i]; if (gl[i] > mx) { mx = gl[i]; gi = i; } }
        float den = 0.f;
#pragma unroll
        for (int i = 0; i < 4; ++i) den += __expf(gl[i] - mx);
        const float gval = 1.0f / den;
        float el[8]; float v1 = -1e30f; int i1 = 0;
#pragma unroll
        for (int i = 0; i < 8; ++i) { el[i] = lg[wv][tk][4 + gi * 8 + i] + reb[gi * 8 + i]; if (el[i] > v1) { v1 = el[i]; i1 = i; } }
        float v2 = -1e30f; int i2 = 0;
#pragma unroll
        for (int i = 0; i < 8; ++i) if (i != i1 && el[i] > v2) { v2 = el[i]; i2 = i; }
        const float e2 = __expf(v2 - v1), w1 = gval / (1.0f + e2), w2 = gval * e2 / (1.0f + e2);
        const int ex1 = gi * 8 + i1, ex2 = gi * 8 + i2;
        const unsigned r1 = atomicAdd(&cnt[ex1], 1u), r2 = atomicAdd(&cnt[ex2], 1u);
        buf_ts[ex1 * CAP + r1] = m * 2 + 0; buf_w[ex1 * CAP + r1] = w1;
        buf_ts[ex2 * CAP + r2] = m * 2 + 1; buf_w[ex2 * CAP + r2] = w2;
    }
}

__global__ void k_plan(const unsigned* cnt, unsigned* plan) {
    if (threadIdx.x == 0) {
        unsigned nb = 0;
        for (int e = 0; e < NEXP; ++e) { const unsigned n = (cnt[e] + 255u) >> 8; for (unsigned j = 0; j < n && nb < (unsigned)MAXBLK; ++j) { plan[1 + nb] = e; plan[1 + MAXBLK + nb] = j; ++nb; } }
        plan[0] = nb;
    }
}
}

extern "C" void kernel_launch(void* const* d_in, const int* in_sizes, int n_in, void* d_out, int out_size, void* d_ws, size_t ws_size, hipStream_t stream) {
    static bool init = false;
    if (!init) {
        init = true;
        hipFuncSetAttribute((const void*)k_mix_b1, hipFuncAttributeMaxDynamicSharedMemorySize, 65536 + 2048);
        hipFuncSetAttribute((const void*)k_mix_b2, hipFuncAttributeMaxDynamicSharedMemorySize, 65536 + 32768 + 32768);
    }
    if (n_in != 37 || ws_size < WS_END) { fprintf(stderr, "kernel_launch: unexpected n_in %d or ws %zu\n", n_in, ws_size); return; }
    Ptrs P{};
    for (int i = 0; i < 37; ++i) P.in[i] = (const float*)d_in[i];
    P.out = (float*)d_out; P.ws = (unsigned char*)d_ws;
    unsigned char* ws = (unsigned char*)d_ws;
    hipMemsetAsync(ws + WS_CTL, 0, 1 * MiB, stream);
    unsigned* ctl = (unsigned*)(ws + WS_CTL);
    float* h = (float*)(ws + WS_H); bf16_t* xn = (bf16_t*)(ws + WS_XN); bf16_t* proj = (bf16_t*)(ws + WS_PROJ); bf16_t* ys = (bf16_t*)(ws + WS_YS);
    bf16_t* br = (bf16_t*)(ws + WS_R1); bf16_t* hbuf = (bf16_t*)(ws + WS_HBUF); bf16_t* ymoe = (bf16_t*)(ws + WS_YMOE); bf16_t* merged = (bf16_t*)(ws + WS_MERGED);
    int* buf_ts = (int*)(ws + WS_BUFTS); float* buf_w = (float*)(ws + WS_BUFW);

    k_prep<<<dim3(144, DEPTH), 256, 0, stream>>>(P);
    for (int l = 0; l < DEPTH; ++l) {
        const float* tab = (const float*)(ws + WS_TAB + (size_t)l * MiB);
        if (l == 0) k_norm<<<T / 4, 256, 0, stream>>>(P.in[0], nullptr, P.in[1] + (size_t)l * D, h, xn, nullptr);
        else k_norm<<<T / 4, 256, 0, stream>>>(h, ymoe, P.in[1] + (size_t)l * D, h, xn, nullptr);
        { PProj p{xn, P.in[2] + (size_t)l * D * IN_COLS, proj}; k_gemm_naive<PProj><<<dim3(IN_COLS / 64, T / 64), 256, 0, stream>>>(p); }
        MixArgs A{};
        A.proj = proj; A.ys = ys; A.tab = tab; A.s5st = (float2*)(ws + WS_S5ST); A.lruA = (float*)(ws + WS_LRUA); A.lruH = (float*)(ws + WS_LRUH); A.lruS = (float2*)(ws + WS_LRUS);
        A.conv_a_w = P.in[3] + (size_t)l * 3 * W; A.pool_w = P.in[4] + (size_t)l * 4 * 64 * 64; A.pool_b = P.in[5] + (size_t)l * W; A.pool_scale = P.in[6] + (size_t)l * W;
        A.c_re = P.in[12] + (size_t)l * 16 * 16 * 64; A.c_im = P.in[13] + (size_t)l * 16 * 16 * 64; A.s5_d = P.in[14] + (size_t)l * W; A.glu_w = P.in[15] + (size_t)l * W * W; A.glu_b = P.in[16] + (size_t)l * W;
        A.lconv_w = P.in[17] + (size_t)l * 4 * W; A.lconv_b = P.in[18] + (size_t)l * W; A.wa = P.in[19] + (size_t)l * 4 * 64 * 64; A.ba = P.in[20] + (size_t)l * W; A.wx = P.in[21] + (size_t)l * 4 * 64 * 64; A.bx = P.in[22] + (size_t)l * W;
        k_mix_b1<<<BATCH * NCHUNK, 512, 65536 + 2048, stream>>>(A);
        k_mix_b2<<<BATCH * NCHUNK, 512, 65536 + 32768 + 32768, stream>>>(A);
        { PBranch p{ys, P.in[26] + (size_t)l * 4 * W * D, br}; k_gemm_naive<PBranch><<<dim3(4096 / 64, T / 64), 256, 0, stream>>>(p); }
        { PGate p{xn, P.in[24] + (size_t)l * D * 4096, P.in[25] + (size_t)l * 4096, br, merged}; k_gemm_naive<PGate><<<dim3(4096 / 64, T / 64), 256, 0, stream>>>(p); }
        { POut p{merged, P.in[27] + (size_t)l * D * D, h}; k_gemm_naive<POut><<<dim3(D / 64, T / 64), 256, 0, stream>>>(p); }
        unsigned* cnt = ctl + CW_CNT + 64 * l; unsigned* plan = ctl + CW_PLAN + 512 * l;
        k_router<<<T / 16, 256, 0, stream>>>(h, P.in[28] + (size_t)l * D, tab, P.in[30] + (size_t)l * 4, P.in[32] + (size_t)l * 32, xn, cnt, buf_ts, buf_w);
        k_plan<<<1, 64, 0, stream>>>(cnt, plan);
        { PMoe1 p{xn, P.in[33] + (size_t)l * NEXP * D * DEXP, P.in[34] + (size_t)l * NEXP * D * DEXP, hbuf, plan, cnt, buf_ts}; k_gemm_naive<PMoe1><<<dim3(1024 / 64, MAXBLK * 4), 256, 0, stream>>>(p); }
        { PMoe2 p{hbuf, P.in[35] + (size_t)l * NEXP * DEXP * D, ymoe, plan, cnt, buf_ts, buf_w}; k_gemm_naive<PMoe2><<<dim3(D / 64, MAXBLK * 4), 256, 0, stream>>>(p); }
    }
    k_norm<<<T / 4, 256, 0, stream>>>(h, ymoe, P.in[36], nullptr, nullptr, (float*)d_out);
}
```

```cpp
#include <hip/hip_runtime.h>
#include <cstdint>
#include <cstdio>

#ifndef MK_N_LAUNCHES
#define MK_N_LAUNCHES 1
#endif

namespace pg8 {
#define PG8_LAS __attribute__((address_space(3)))
typedef unsigned short bf16_t;
typedef short bf16x8 __attribute__((ext_vector_type(8)));
typedef float f32x4 __attribute__((ext_vector_type(4)));
typedef unsigned u32x4 __attribute__((ext_vector_type(4)));
typedef unsigned u32x2 __attribute__((ext_vector_type(2)));
constexpr int BM = 256, BK = 64, HALF = 128, HTB = HALF * BK * 2, STAGE_BYTES = 8 * HTB, NXCD = 8, WGM = 8;

__host__ __device__ __forceinline__ int lds_byte(int r, int c) { const int st = (r >> 4) * 2 + (c >> 5), rr = r & 15, cc = c & 31, ob = rr * 64 + cc * 2; return st * 1024 + (ob ^ (((ob >> 9) & 1) << 5)); }
__host__ __device__ __forceinline__ void stage_rc(int b, int& R, int& C) { const int st = b / 1024, sb = b % 1024, swz = sb ^ (((sb >> 9) & 1) << 5); R = (st >> 1) * 16 + swz / 64; C = (st & 1) * 32 + (swz % 64) / 2; }
__host__ __device__ __forceinline__ int perm32(int rho) { const int n = rho >> 4, i = rho & 15; return 8 * (i >> 2) + 4 * n + (i & 3); }

struct Unit { int pm, pn; };

struct StaticOrder {
    int nM, nN, nwg, G, c;
    __host__ __device__ void init(int M, int N, int G_, int c_) { nM = M / BM; nN = N / BM; nwg = nM * nN; G = G_; c = c_; }
    __host__ __device__ bool next(int i, Unit& u) const {
        const long L = (long)i * G + c; if (L >= nwg) return false;
        int wgid = (int)L; { const int q = nwg / NXCD, r = nwg % NXCD, xcd = wgid % NXCD, off = wgid / NXCD; wgid = (xcd < r ? xcd * (q + 1) : r * (q + 1) + (xcd - r) * q) + off; }
        const int nig = WGM * nN, gid = wgid / nig, fm = gid * WGM, gsz = (nM - fm) < WGM ? (nM - fm) : WGM;
        u.pm = fm + ((wgid % nig) % gsz); u.pn = (wgid % nig) / gsz; return true;
    }
};

__device__ __forceinline__ unsigned cvt_pk_bf16(float lo, float hi) { unsigned r; asm volatile("v_cvt_pk_bf16_f32 %0, %1, %2" : "=v"(r) : "v"(lo), "v"(hi)); return r; }

template <class Epi, class Sched, bool ALIGN_EPI, bool SP2>
__device__ __forceinline__ void gemm_phase(PG8_LAS unsigned char* lds, const int tid, const int K, const Sched& S, const Epi& E) {
    const int wid = __builtin_amdgcn_readfirstlane(tid >> 6), lane = tid & 63, wr = wid >> 2, wc = wid & 3, fr = lane & 15, fq = lane >> 4;
    const int nt = K / BK;
    unsigned voffB[2]; int RA[2], CA[2];
#pragma unroll
    for (int i = 0; i < 2; ++i) { int R, C; stage_rc(tid * 16 + i * 8192, R, C); const int Rb = Epi::PERM ? ((R & ~31) + perm32(R & 31)) : R;
        voffB[i] = (unsigned)(Rb * K + C) * 2u; RA[i] = R; CA[i] = C; }
    const size_t kstep = (size_t)(BK * 2);
    const size_t hstepB = (size_t)HALF * K * 2;
    const unsigned ldsw = (unsigned)wid * 1024u;
    const int aoff = lds_byte(wr * 64 + fr, fq * 8), boff = lds_byte(wc * 32 + fr, fq * 8);
#define PG8_SA(b, h) (((b) * 2 + (h)) * HTB)
#define PG8_SB(b, h) ((4 + (b) * 2 + (h)) * HTB)
#define PG8_STAGE(bufoff, gbase, voff) do { _Pragma("unroll") for (int _i = 0; _i < 2; ++_i) \
        __builtin_amdgcn_global_load_lds((const unsigned*)((const char*)(gbase) + (voff)[_i]), (PG8_LAS unsigned*)(lds + (bufoff) + ldsw + _i * 8192), 16, 0, 0); } while (0)
#define PG8_LDA(dst, b, h) do { _Pragma("unroll") for (int m = 0; m < 4; ++m) _Pragma("unroll") for (int k = 0; k < 2; ++k) dst[m][k] = *(const PG8_LAS bf16x8*)(lds + PG8_SA(b, h) + aoff + m * 2048 + k * 1024); } while (0)
#define PG8_LDB(dst, b, h) do { _Pragma("unroll") for (int n = 0; n < 2; ++n) _Pragma("unroll") for (int k = 0; k < 2; ++k) dst[n][k] = *(const PG8_LAS bf16x8*)(lds + PG8_SB(b, h) + boff + n * 2048 + k * 1024); } while (0)
#define PG8_MMA(ai, bj, At, Bt) do { __builtin_amdgcn_s_setprio(1); _Pragma("unroll") for (int m = 0; m < 4; ++m) _Pragma("unroll") for (int n = 0; n < 2; ++n) _Pragma("unroll") for (int k = 0; k < 2; ++k) \
        acc[ai][bj][m][n] = __builtin_amdgcn_mfma_f32_16x16x32_bf16(Bt[n][k], At[m][k], acc[ai][bj][m][n], 0, 0, 0); __builtin_amdgcn_s_setprio(0); } while (0)
#define PG8_WAIT_V(n) asm volatile("s_waitcnt vmcnt(" #n ")" ::: "memory")
#define PG8_WAIT_L(n) asm volatile("s_waitcnt lgkmcnt(" #n ")" ::: "memory")
#define PG8_BAR __builtin_amdgcn_s_barrier()
#define PG8_SCHED __builtin_amdgcn_sched_barrier(0)
    Unit cur, nxt; int ui = 0;
    if (!S.next(0, cur)) return;
    bool has_next = S.next(1, nxt);
    unsigned offC[2][2], offN[2][2];
#pragma unroll
    for (int h = 0; h < 2; ++h)
#pragma unroll
        for (int i = 0; i < 2; ++i) {
            if constexpr (Sched::GATHER) { offC[h][i] = S.gather_off(cur, h * HALF + RA[i]) + (unsigned)CA[i] * 2u; offN[h][i] = has_next ? S.gather_off(nxt, h * HALF + RA[i]) + (unsigned)CA[i] * 2u : offC[h][i]; }
            else { offC[h][i] = (unsigned)((h * HALF + RA[i]) * S.lda + CA[i]) * 2u; offN[h][i] = offC[h][i]; }
        }
    f32x4 acc[2][2][4][2];
#pragma unroll
    for (int a = 0; a < 2; ++a)
#pragma unroll
        for (int b = 0; b < 2; ++b)
#pragma unroll
            for (int m = 0; m < 4; ++m)
#pragma unroll
                for (int n = 0; n < 2; ++n) acc[a][b][m][n] = (f32x4){0.f, 0.f, 0.f, 0.f};
    bf16x8 At[4][2], B0[2][2], B1[2][2];
    const char* cA = S.a_base(cur); const char* cB = S.b_base(cur);
    if constexpr (SP2) {
        PG8_STAGE(PG8_SB(0, 0), cB, voffB); PG8_STAGE(PG8_SB(0, 1), cB + hstepB, voffB); PG8_STAGE(PG8_SA(0, 0), cA, offC[0]); PG8_STAGE(PG8_SA(0, 1), cA, offC[1]);
        if (wr == 1) PG8_BAR;
        PG8_WAIT_V(2); PG8_BAR;
        PG8_STAGE(PG8_SB(1, 0), cB + kstep, voffB); PG8_STAGE(PG8_SA(1, 0), cA + kstep, offC[0]); PG8_STAGE(PG8_SB(1, 1), cB + hstepB + kstep, voffB);
        PG8_WAIT_V(6); PG8_BAR;
    } else {
        PG8_STAGE(PG8_SB(0, 0), cB, voffB); PG8_STAGE(PG8_SA(0, 0), cA, offC[0]); PG8_STAGE(PG8_SB(0, 1), cB + hstepB, voffB); PG8_STAGE(PG8_SA(0, 1), cA, offC[1]);
        if (wr == 1) PG8_BAR;
        PG8_WAIT_V(4); PG8_BAR;
        PG8_STAGE(PG8_SB(1, 0), cB + kstep, voffB); PG8_STAGE(PG8_SA(1, 0), cA + kstep, offC[0]); PG8_STAGE(PG8_SB(1, 1), cB + hstepB + kstep, voffB);
        PG8_WAIT_V(6); PG8_BAR;
    }
    for (;;) {
        const char* nA = has_next ? S.a_base(nxt) : cA; const char* nB = has_next ? S.b_base(nxt) : cB;
#pragma unroll 1
        for (int t = 0; t < nt; t += 2) {
            const bool last = (t == nt - 2);
            const char* a1 = cA + (size_t)(t + 1) * kstep;
            const char* a2 = last ? nA : cA + (size_t)(t + 2) * kstep; const char* b2 = last ? nB : cB + (size_t)(t + 2) * kstep;
            const char* a3 = a2 + kstep; const char* b3 = b2 + kstep;
            unsigned o2[2][2];
#pragma unroll
            for (int h = 0; h < 2; ++h)
#pragma unroll
                for (int i = 0; i < 2; ++i) o2[h][i] = (Sched::GATHER && last) ? offN[h][i] : offC[h][i];
            if constexpr (SP2) {
            PG8_LDB(B0, 0, 0); PG8_LDB(B1, 0, 1); PG8_SCHED; PG8_LDA(At, 0, 0); PG8_STAGE(PG8_SA(1, 1), a1, offC[1]);
            PG8_WAIT_V(8); PG8_WAIT_L(0); PG8_BAR; PG8_MMA(0, 0, At, B0); PG8_MMA(0, 1, At, B1); PG8_BAR; PG8_SCHED;
            PG8_LDA(At, 0, 1); PG8_STAGE(PG8_SB(0, 0), b2, voffB); PG8_STAGE(PG8_SB(0, 1), b2 + hstepB, voffB); PG8_STAGE(PG8_SA(0, 0), a2, o2[0]);
            PG8_WAIT_V(8); PG8_WAIT_L(0); PG8_BAR; PG8_MMA(1, 0, At, B0); PG8_MMA(1, 1, At, B1); PG8_BAR; PG8_SCHED;
            PG8_LDB(B0, 1, 0); PG8_LDB(B1, 1, 1); PG8_SCHED; PG8_LDA(At, 1, 0); PG8_STAGE(PG8_SA(0, 1), a2, o2[1]);
            PG8_WAIT_V(8); PG8_WAIT_L(0); PG8_BAR; PG8_MMA(0, 0, At, B0); PG8_MMA(0, 1, At, B1); PG8_BAR; PG8_SCHED;
            PG8_LDA(At, 1, 1); PG8_STAGE(PG8_SB(1, 0), b3, voffB); PG8_STAGE(PG8_SB(1, 1), b3 + hstepB, voffB); PG8_STAGE(PG8_SA(1, 0), a3, o2[0]);
            PG8_WAIT_V(8); PG8_WAIT_L(0); PG8_BAR; PG8_MMA(1, 0, At, B0); PG8_MMA(1, 1, At, B1); PG8_BAR; PG8_SCHED;
            } else {
            PG8_LDB(B0, 0, 0); PG8_SCHED; PG8_LDA(At, 0, 0); PG8_STAGE(PG8_SA(1, 1), a1, offC[1]);
            PG8_WAIT_L(8); PG8_BAR; PG8_WAIT_L(0); PG8_MMA(0, 0, At, B0); PG8_BAR; PG8_SCHED;
            PG8_LDB(B1, 0, 1); PG8_STAGE(PG8_SB(0, 0), b2, voffB);
            PG8_BAR; PG8_WAIT_L(0); PG8_MMA(0, 1, At, B1); PG8_BAR;
            PG8_LDA(At, 0, 1); PG8_STAGE(PG8_SA(0, 0), a2, o2[0]);
            PG8_BAR; PG8_WAIT_L(0); PG8_MMA(1, 0, At, B0); PG8_BAR; PG8_SCHED;
            PG8_STAGE(PG8_SB(0, 1), b2 + hstepB, voffB);
            PG8_WAIT_V(6); PG8_BAR; PG8_MMA(1, 1, At, B1); PG8_BAR;
            PG8_LDB(B0, 1, 0); PG8_SCHED; PG8_LDA(At, 1, 0); PG8_STAGE(PG8_SA(0, 1), a2, o2[1]);
            PG8_WAIT_L(8); PG8_BAR; PG8_WAIT_L(0); PG8_MMA(0, 0, At, B0); PG8_BAR; PG8_SCHED;
            PG8_LDB(B1, 1, 1); PG8_STAGE(PG8_SB(1, 0), b3, voffB);
            PG8_BAR; PG8_WAIT_L(0); PG8_MMA(0, 1, At, B1); PG8_BAR;
            PG8_LDA(At, 1, 1); PG8_STAGE(PG8_SA(1, 0), a3, o2[0]);
            PG8_BAR; PG8_WAIT_L(0); PG8_MMA(1, 0, At, B0); PG8_BAR; PG8_SCHED;
            PG8_STAGE(PG8_SB(1, 1), b3 + hstepB, voffB);
            PG8_WAIT_V(6); PG8_BAR; PG8_MMA(1, 1, At, B1); PG8_BAR;
            }
        }
        if constexpr (ALIGN_EPI) { if (wr == 0) PG8_BAR; }
        Unit nn; bool has_nn = false;
        if constexpr (Sched::GATHER) {
            has_nn = has_next && S.next(ui + 2, nn);
#pragma unroll
            for (int h = 0; h < 2; ++h)
#pragma unroll
                for (int i = 0; i < 2; ++i) { int R_, C_; stage_rc(tid * 16 + i * 8192, R_, C_); offC[h][i] = offN[h][i]; if (has_nn) offN[h][i] = S.gather_off(nn, h * HALF + R_) + (unsigned)C_ * 2u; }
        }
        E(acc, cur, wr, wc, fr, fq);
        if (!has_next) break;
#pragma unroll
        for (int a = 0; a < 2; ++a)
#pragma unroll
            for (int b = 0; b < 2; ++b)
#pragma unroll
                for (int m = 0; m < 4; ++m)
#pragma unroll
                    for (int n = 0; n < 2; ++n) acc[a][b][m][n] = (f32x4){0.f, 0.f, 0.f, 0.f};
        cur = nxt; cA = nA; cB = nB; ++ui;
        if constexpr (Sched::GATHER) { has_next = has_nn; nxt = nn; }
        else { has_next = S.next(ui + 1, nxt); }
        if constexpr (ALIGN_EPI) { if (wr == 1) PG8_BAR; }
    }
    PG8_WAIT_V(0);
    if constexpr (!ALIGN_EPI) { if (wr == 0) PG8_BAR; }
    PG8_BAR;
#undef PG8_SA
#undef PG8_SB
#undef PG8_STAGE
#undef PG8_LDA
#undef PG8_LDB
#undef PG8_MMA
#undef PG8_WAIT_V
#undef PG8_WAIT_L
#undef PG8_BAR
#undef PG8_SCHED
}
}

namespace {
constexpr int NWAVES = 8;
constexpr int N_LAUNCHES = MK_N_LAUNCHES;
constexpr int D = 1024, BATCH = 8, SEQ = 2048, DEPTH = 2, T = BATCH * SEQ;
constexpr int W = 256, IN_COLS = 1792;
constexpr int NEXP = 32, DEXP = 512;
constexpr int CHUNK = 64, NCHUNK = SEQ / CHUNK;
constexpr int CAP = 16384;
constexpr int MAXBLK = 160;
constexpr float EPS = 1e-6f;
constexpr int PH_PER_LAYER = 10, N_PHASES = 1 + PH_PER_LAYER * DEPTH;

typedef unsigned short bf16_t;
typedef float f32x4 __attribute__((ext_vector_type(4)));
typedef unsigned v4u __attribute__((ext_vector_type(4)));
#define GAS __attribute__((address_space(1)))
#define LAS __attribute__((address_space(3)))
typedef GAS unsigned gu32;
#define RLX_AGENT __ATOMIC_RELAXED, __HIP_MEMORY_SCOPE_AGENT
#define LDS_WAIT() asm volatile("s_waitcnt lgkmcnt(0)" ::: "memory")

__device__ __forceinline__ float bf2f(bf16_t b) { return __uint_as_float(((unsigned)b) << 16); }
__device__ __forceinline__ unsigned f2bfu(float f) { unsigned u = __float_as_uint(f); return (u + 0x7fffu + ((u >> 16) & 1u)) >> 16; }
__device__ __forceinline__ bf16_t f2bf(float f) { return (bf16_t)f2bfu(f); }
__device__ __forceinline__ unsigned pk2(float lo, float hi) { return f2bfu(lo) | (f2bfu(hi) << 16); }
__device__ __forceinline__ float sigmoidf_(float x) { return 1.0f / (1.0f + __expf(-x)); }
__device__ __forceinline__ float gelu_tanh(float x) {
    const float z = 0.7978845608028654f * (x + 0.044715f * x * x * x);
    const float t = 1.0f - 2.0f / (__expf(2.0f * z) + 1.0f);
    return 0.5f * x * (1.0f + t);
}

constexpr size_t MiB = 1u << 20;
constexpr size_t WS_CTL = 0;
constexpr size_t WS_TAB = 1 * MiB;
constexpr size_t WS_H = 4 * MiB;
constexpr size_t WS_XN = 68 * MiB;
constexpr size_t WS_PROJ = 100 * MiB;
constexpr size_t WS_MERGED = WS_PROJ;
constexpr size_t WS_YS = 156 * MiB;
constexpr size_t WS_R1 = 188 * MiB;
constexpr size_t WS_HBUF = WS_R1;
constexpr size_t WS_YMOE = WS_R1 + 48 * MiB;
constexpr size_t WS_S5ST = 316 * MiB;
constexpr size_t WS_LRUA = 318 * MiB;
constexpr size_t WS_LRUH = 334 * MiB;
constexpr size_t WS_LRUS = 350 * MiB;
constexpr size_t WS_BUFTS = 351 * MiB;
constexpr size_t WS_BUFW = 353 * MiB;
constexpr size_t WS_WMIX = 356 * MiB;
constexpr size_t WMIX_IN = 0, WMIX_MG = (size_t)1792 * 1024 * 2, WMIX_BR = WMIX_MG + (size_t)4096 * 1024 * 2, WMIX_OUT = WMIX_BR + (size_t)4096 * 256 * 2, WMIX_STRIDE = 16 * MiB;
static_assert(WMIX_OUT + (size_t)1024 * 1024 * 2 <= WMIX_STRIDE, "mixer weights");
constexpr size_t WS_WEXP = 388 * MiB;
constexpr size_t WEXP_W2 = 64 * MiB;
constexpr size_t WS_END = 484 * MiB;

constexpr int CW_CNT = 64;
constexpr int CW_BAR = 4096;

constexpr int TB_A = 0, TB_A64 = 2048, TB_BRE = 4096, TB_BIM = 4096 + 16384, TB_NLOG = 4096 + 32768, TB_RW = 4096 + 32768 + 256;

constexpr int RING_BYTES = 131072;
constexpr int LDSCTL_OFF = RING_BYTES, MISC_OFF = LDSCTL_OFF + 320;
constexpr int PLAN_OFF = MISC_OFF + 128;
constexpr int LDS_BYTES = 147456;
static_assert(PLAN_OFF + 4 * 360 <= LDS_BYTES, "LDS map");

#define XB_TMO      128
#define XB_XCNT(j)  (256  + 64 * (j))
#define XB_XSUB(j)  (1280 + 64 * (j))
#define XB_XGEN(j)  (2304 + 64 * (j))
#define XB_TOP      3328
#define XB_TOPGEN   3392
#define XCD_BAR_WORDS 3456
#define XB_SPIN_CAP (1u << 18)
__device__ __forceinline__ unsigned xb_ld(unsigned* p)              { return __hip_atomic_load(p, __ATOMIC_RELAXED, __HIP_MEMORY_SCOPE_AGENT); }
__device__ __forceinline__ unsigned xb_add(unsigned* p, unsigned v) { return __hip_atomic_fetch_add(p, v, __ATOMIC_RELAXED, __HIP_MEMORY_SCOPE_AGENT); }
__device__ __forceinline__ unsigned xb_xcc_id() { return (unsigned)__builtin_amdgcn_s_getreg((3 << 11) | 20) & 0xFu; }
#define XB_SPIN(cond, bar) do { unsigned _sp = 0; while (cond) { __builtin_amdgcn_s_sleep(1); \
    if ((++_sp & 255u) == 0u) { if (xb_ld(&(bar)[XB_TMO])) break; if (_sp > XB_SPIN_CAP) { atomicAdd(&(bar)[XB_TMO], 1u); break; } } } } while (0)
struct XcdBarrier { unsigned* bar; unsigned x; volatile LAS unsigned* st; };
__device__ __forceinline__ XcdBarrier xcd_barrier_post(unsigned* bar, volatile LAS unsigned* st) {
    XcdBarrier b; b.bar = bar; b.x = xb_xcc_id(); b.st = st;
    if (threadIdx.x == 0) (void)xb_add(&bar[XB_XCNT(b.x)], 1u);
    return b;
}
__device__ __forceinline__ void xcd_barrier_complete(unsigned* bar, unsigned x, unsigned& nloc, unsigned& nx) {
    const unsigned G = gridDim.x * gridDim.y * gridDim.z;
    unsigned sum, cnt, mine, sp = 0u;
    for (;;) {
        sum = 0u; cnt = 0u; mine = 0u;
#pragma unroll
        for (unsigned j = 0; j < 16; ++j) { const unsigned c = xb_ld(&bar[XB_XCNT(j)]); sum += c; cnt += (c > 0u) ? 1u : 0u; mine = (j == x) ? c : mine; }
        if (sum == G) break;
        __builtin_amdgcn_s_sleep(1);
        if ((++sp & 255u) == 0u) { if (xb_ld(&bar[XB_TMO])) break; if (sp > XB_SPIN_CAP) { atomicAdd(&bar[XB_TMO], 1u); break; } }
    }
    nloc = mine > 0u ? mine : 1u; nx = cnt > 0u ? cnt : 1u;
}
__device__ __forceinline__ void xcd_barrier(const XcdBarrier& b) {
    asm volatile("s_waitcnt vmcnt(0)" ::: "memory");
    __syncthreads();
    if (threadIdx.x == 0) {
        unsigned* bar = b.bar;
        __builtin_amdgcn_s_waitcnt(0);
        unsigned nloc = b.st[0], nx = b.st[1];
        if (nloc == 0u) { xcd_barrier_complete(bar, b.x, nloc, nx); b.st[0] = nloc; b.st[1] = nx; }
        const unsigned old = xb_add(&bar[XB_XSUB(b.x)], 1u);
        const unsigned gen = old / nloc;
        if (old + 1u == (gen + 1u) * nloc) {
            __builtin_amdgcn_fence(__ATOMIC_RELEASE, "agent");
            asm volatile("s_waitcnt vmcnt(0)" ::: "memory");
            const unsigned og = xb_add(&bar[XB_TOP], 1u);
            const unsigned tg = og / nx;
            if (og + 1u == (tg + 1u) * nx) xb_add(&bar[XB_TOPGEN], 1u);
            else XB_SPIN(xb_ld(&bar[XB_TOPGEN]) == tg, bar);
            __builtin_amdgcn_fence(__ATOMIC_ACQUIRE, "agent");
            xb_add(&bar[XB_XGEN(b.x)], 1u);
            asm volatile("s_waitcnt vmcnt(0)" ::: "memory");
        } else {
            XB_SPIN(xb_ld(&bar[XB_XGEN(b.x)]) == gen, bar);
            __builtin_amdgcn_fence(__ATOMIC_ACQUIRE, "agent");
            asm volatile("s_waitcnt vmcnt(0)" ::: "memory");
        }
    }
    __syncthreads();
}

struct Args { const float* in[37]; float* out; unsigned char* ws; int ph_lo, ph_hi; };

struct Frame {
    LAS unsigned char* lds;
    unsigned char* smem;
    volatile LAS unsigned* MISC;
    unsigned* ctl;
    int tid, lane, wave, vcu, G;
    unsigned char* ws;
};

struct MapNat { int off; __device__ __forceinline__ int operator()(int n) const { return off + n; } };
struct MapGate { __device__ __forceinline__ int operator()(int s) const {
    const int k4 = s >> 10, d = s & 1023, pn = d >> 6, dd = d & 63;
    return pn * 256 + 128 * (k4 >> 1) + 32 * (dd >> 4) + 16 * (k4 & 1) + 4 * ((dd >> 2) & 3) + (dd & 3); } };
struct MapMoe13 { int which; __device__ __forceinline__ int operator()(int hid) const {
    const int pn = hid >> 7, r = hid & 127;
    return pn * 256 + 128 * (r >> 6) + 32 * ((r >> 4) & 3) + 16 * which + 4 * ((r >> 2) & 3) + (r & 3); } };

template <class RowMap>
__device__ __forceinline__ void transpose_item(const float* W, int K, int N, bf16_t* WT, LAS float* scr, int item, int lane, const RowMap rm) {
    const int nblk = N / 32, kb = item / nblk, nb = item % nblk, k0 = 64 * kb, n0 = 32 * nb;
#pragma unroll 8
    for (int i = 0; i < 32; ++i) { const int kk = 2 * i + (lane >> 5); scr[kk * 33 + (lane & 31)] = W[(size_t)(k0 + kk) * N + n0 + (lane & 31)]; }
    LDS_WAIT(); asm volatile("" ::: "memory");
    const int c = lane & 7;
#pragma unroll
    for (int j = 0; j < 4; ++j) { const int n = (lane >> 3) + 8 * j; const LAS float* s = scr + (8 * c) * 33 + n;
        v4u o; o.x = pk2(s[0 * 33], s[1 * 33]); o.y = pk2(s[2 * 33], s[3 * 33]); o.z = pk2(s[4 * 33], s[5 * 33]); o.w = pk2(s[6 * 33], s[7 * 33]);
        *(GAS v4u*)(WT + (size_t)rm(n0 + n) * K + k0 + 8 * c) = o; }
    LDS_WAIT(); asm volatile("" ::: "memory");
}

__device__ __forceinline__ void conv_mixer_weights(Frame& F, const Args& a) {
    LAS float* scr = (LAS float*)(F.lds + F.wave * 16384);
    const int gw = F.vcu * NWAVES + F.wave, NGW = F.G * NWAVES;
    constexpr int I_IN = 16 * 56, I_MG = 16 * 128, I_BR = 4 * 32, I_OUT = 16 * 32, PER_L = I_IN + I_MG + 4 * I_BR + I_OUT;
    for (int it = gw; it < DEPTH * PER_L; it += NGW) {
        const int l = it / PER_L; int r = it % PER_L;
        unsigned char* wb = F.ws + WS_WMIX + (size_t)l * WMIX_STRIDE;
        if (r < I_IN) { transpose_item(a.in[2] + (size_t)l * D * IN_COLS, D, IN_COLS, (bf16_t*)(wb + WMIX_IN), scr, r, F.lane, MapNat{0}); continue; } r -= I_IN;
        if (r < I_MG) { transpose_item(a.in[24] + (size_t)l * D * 4096, D, 4096, (bf16_t*)(wb + WMIX_MG), scr, r, F.lane, MapGate{}); continue; } r -= I_MG;
        if (r < 4 * I_BR) { const int k4 = r / I_BR; transpose_item(a.in[26] + ((size_t)l * 4 + k4) * W * D, W, D, (bf16_t*)(wb + WMIX_BR), scr, r % I_BR, F.lane, MapNat{k4 * 1024}); continue; } r -= 4 * I_BR;
        transpose_item(a.in[27] + (size_t)l * D * D, D, D, (bf16_t*)(wb + WMIX_OUT), scr, r, F.lane, MapNat{0});
    }
}
__device__ __forceinline__ void conv_expert_weights(Frame& F, const Args& a, int l) {
    LAS float* scr = (LAS float*)(F.lds + F.wave * 16384);
    const int gw = F.vcu * NWAVES + F.wave, NGW = F.G * NWAVES;
    constexpr int I_13 = 16 * 16, I_2 = 8 * 32, PER_E = 2 * I_13 + I_2;
    for (int it = gw; it < NEXP * PER_E; it += NGW) {
        const int e = it / PER_E; int r = it % PER_E;
        bf16_t* w13 = (bf16_t*)(F.ws + WS_WEXP) + (size_t)e * 1024 * 1024;
        bf16_t* w2t = (bf16_t*)(F.ws + WS_WEXP + WEXP_W2) + (size_t)e * 1024 * 512;
        if (r < I_13) { transpose_item(a.in[33] + ((size_t)l * NEXP + e) * D * DEXP, D, DEXP, w13, scr, r, F.lane, MapMoe13{0}); continue; } r -= I_13;
        if (r < I_13) { transpose_item(a.in[34] + ((size_t)l * NEXP + e) * D * DEXP, D, DEXP, w13, scr, r, F.lane, MapMoe13{1}); continue; } r -= I_13;
        transpose_item(a.in[35] + ((size_t)l * NEXP + e) * DEXP * D, DEXP, D, w2t, scr, r, F.lane, MapNat{0});
    }
}
__device__ __forceinline__ void prep_tables(Frame& F, const Args& a) {
    for (int idx = F.vcu * 512 + F.tid; idx < DEPTH * 36864; idx += F.G * 512) {
        const int l = idx / 36864, gid = idx % 36864;
        float* tab = (float*)(F.ws + WS_TAB + (size_t)l * MiB);
        if (gid < 1024) {
            const int g = gid >> 6;
            const double lre = fmin((double)a.in[7][l * 1024 + gid], -1e-4);
            const double lim = (double)a.in[8][l * 1024 + gid];
            const double step = exp((double)a.in[9][l * 16 + g]);
            const double er = exp(lre * step), ar = er * cos(lim * step), ai = er * sin(lim * step);
            const double e64 = exp(lre * step * 64.0), a64r = e64 * cos(lim * step * 64.0), a64i = e64 * sin(lim * step * 64.0);
            const double nr = ar - 1.0, ni = ai, den = lre * lre + lim * lim;
            const double cr = (nr * lre + ni * lim) / den, ci = (ni * lre - nr * lim) / den;
            tab[TB_A + 2 * gid] = (float)ar; tab[TB_A + 2 * gid + 1] = (float)ai;
            tab[TB_A64 + 2 * gid] = (float)a64r; tab[TB_A64 + 2 * gid + 1] = (float)a64i;
            for (int h = 0; h < 16; ++h) {
                const double br = (double)a.in[10][((size_t)l * 1024 + gid) * 16 + h], bi = (double)a.in[11][((size_t)l * 1024 + gid) * 16 + h];
                tab[TB_BRE + gid * 16 + h] = (float)(cr * br - ci * bi);
                tab[TB_BIM + gid * 16 + h] = (float)(cr * bi + ci * br);
            }
        }
        if (gid < 256) { const double lam = (double)a.in[23][l * 256 + gid]; tab[TB_NLOG + gid] = (float)(-8.0 * log1p(exp(-lam))); }
        { const int o = gid >> 10, k = gid & 1023;
          tab[TB_RW + gid] = (o < 4) ? a.in[29][((size_t)l * 1024 + k) * 4 + o] : a.in[31][((size_t)l * 1024 + k) * 32 + (o - 4)]; }
    }
}

__device__ __forceinline__ void norm_phase(Frame& F, const float* hin, const bf16_t* y, const float* g, float* hout, bf16_t* xn, float* out) {
    const int gw = F.vcu * NWAVES + F.wave, NGW = F.G * NWAVES, lane = F.lane;
    for (int m = gw; m < T; m += NGW) {
        f32x4 v[4]; float s = 0.f;
#pragma unroll
        for (int j = 0; j < 4; ++j) {
            const int col = 4 * lane + 256 * j;
            v[j] = *(const f32x4*)(hin + (size_t)m * D + col);
            if (y) {
                const uint2 a = *(const uint2*)(y + ((size_t)m * 2 + 0) * D + col), b = *(const uint2*)(y + ((size_t)m * 2 + 1) * D + col);
                v[j].x += __uint_as_float(a.x << 16) + __uint_as_float(b.x << 16);
                v[j].y += __uint_as_float(a.x & 0xffff0000u) + __uint_as_float(b.x & 0xffff0000u);
                v[j].z += __uint_as_float(a.y << 16) + __uint_as_float(b.y << 16);
                v[j].w += __uint_as_float(a.y & 0xffff0000u) + __uint_as_float(b.y & 0xffff0000u);
            }
            s += v[j].x * v[j].x + v[j].y * v[j].y + v[j].z * v[j].z + v[j].w * v[j].w;
        }
#pragma unroll
        for (int o = 1; o < 64; o <<= 1) s += __shfl_xor(s, o);
        const float rstd = rsqrtf(s * (1.0f / D) + EPS);
#pragma unroll
        for (int j = 0; j < 4; ++j) {
            const int col = 4 * lane + 256 * j;
            if (hout) *(f32x4*)(hout + (size_t)m * D + col) = v[j];
            const f32x4 gg = *(const f32x4*)(g + col);
            const f32x4 o = v[j] * rstd * gg;
            if (xn) { uint2 w; w.x = pk2(o.x, o.y); w.y = pk2(o.z, o.w); *(uint2*)(xn + (size_t)m * D + col) = w; }
            if (out) *(f32x4*)(out + (size_t)m * D + col) = o;
        }
    }
}

struct MixArgs {
    const bf16_t* proj; bf16_t* ys; const float* tab;
    float2* s5st; float* lruA; float* lruH; float2* lruS;
    const float *conv_a_w, *pool_w, *pool_b, *pool_scale, *c_re, *c_im, *s5_d, *glu_w, *glu_b, *lconv_w, *lconv_b, *wa, *ba, *wx, *bx;
};

__device__ __forceinline__ void mix_b1_unit(const MixArgs& A, unsigned char* smem, int unit, int tid) {
    float* buf = (float*)smem;
    float2* ex = (float2*)(smem + 65536);
    const int b = unit >> 5, c = unit & 31;
    const size_t t0 = (size_t)b * SEQ + c * CHUNK;
    const float* tab = A.tab;
    for (int e = tid; e < 64 * 256; e += 512) { const int s = e >> 8, ch = e & 255; buf[e] = bf2f(A.proj[(t0 + s) * IN_COLS + 1024 + ch]); }
    __syncthreads();
    {
        const int g = tid >> 5, p0 = (tid & 31) * 2;
        float bre[2][16], bim[2][16], ar[2], ai[2], hr[2] = {0.f, 0.f}, hi[2] = {0.f, 0.f};
#pragma unroll
        for (int q = 0; q < 2; ++q) {
            const int si = g * 64 + p0 + q;
            ar[q] = tab[TB_A + 2 * si]; ai[q] = tab[TB_A + 2 * si + 1];
#pragma unroll
            for (int h = 0; h < 16; ++h) { bre[q][h] = tab[TB_BRE + si * 16 + h]; bim[q][h] = tab[TB_BIM + si * 16 + h]; }
        }
        for (int s = 0; s < 64; ++s) {
            float u[16];
#pragma unroll
            for (int h = 0; h < 16; ++h) u[h] = buf[s * 256 + g * 16 + h];
#pragma unroll
            for (int q = 0; q < 2; ++q) {
                float xr = 0.f, xi = 0.f;
#pragma unroll
                for (int h = 0; h < 16; ++h) { xr += bre[q][h] * u[h]; xi += bim[q][h] * u[h]; }
                const float nr = ar[q] * hr[q] - ai[q] * hi[q] + xr, ni = ar[q] * hi[q] + ai[q] * hr[q] + xi;
                hr[q] = nr; hi[q] = ni;
            }
        }
#pragma unroll
        for (int q = 0; q < 2; ++q) A.s5st[((size_t)b * NCHUNK + c) * 1024 + g * 64 + p0 + q] = make_float2(hr[q], hi[q]);
    }
    __syncthreads();
    const int col = tid & 255, half = tid >> 8;
    {
        const float w0 = A.lconv_w[0 * 256 + col], w1 = A.lconv_w[1 * 256 + col], w2 = A.lconv_w[2 * 256 + col], w3 = A.lconv_w[3 * 256 + col], cb = A.lconv_b[col];
        const int tl0 = half * 32;
        float xm3, xm2, xm1;
        {
            const int pos = c * CHUNK + tl0;
            xm3 = (pos - 3 >= 0) ? bf2f(A.proj[(t0 + tl0 - 3) * IN_COLS + 1280 + col]) : 0.f;
            xm2 = (pos - 2 >= 0) ? bf2f(A.proj[(t0 + tl0 - 2) * IN_COLS + 1280 + col]) : 0.f;
            xm1 = (pos - 1 >= 0) ? bf2f(A.proj[(t0 + tl0 - 1) * IN_COLS + 1280 + col]) : 0.f;
        }
        for (int i = 0; i < 32; ++i) {
            const float x0 = bf2f(A.proj[(t0 + tl0 + i) * IN_COLS + 1280 + col]);
            buf[(tl0 + i) * 256 + col] = w0 * xm3 + w1 * xm2 + w2 * xm1 + w3 * x0 + cb;
            xm3 = xm2; xm2 = xm1; xm1 = x0;
        }
    }
    __syncthreads();
    {
        const int hh = col >> 6, dc = col & 63, tl0 = half * 32;
        float accr[32], acci[32];
#pragma unroll
        for (int i = 0; i < 32; ++i) { accr[i] = 0.f; acci[i] = 0.f; }
        for (int kk = 0; kk < 64; ++kk) {
            const float wav = A.wa[((size_t)hh * 64 + kk) * 64 + dc], wxv = A.wx[((size_t)hh * 64 + kk) * 64 + dc];
#pragma unroll
            for (int i = 0; i < 32; ++i) { const float x = buf[(tl0 + i) * 256 + hh * 64 + kk]; accr[i] += x * wav; acci[i] += x * wxv; }
        }
        const float bav = A.ba[col], bxv = A.bx[col], nlog = tab[TB_NLOG + col];
        float Ac = 1.f, hl = 0.f;
#pragma unroll
        for (int i = 0; i < 32; ++i) {
            const float r = sigmoidf_(accr[i] + bav), ig = sigmoidf_(acci[i] + bxv);
            const float la = nlog * r, a = __expf(la), mult = sqrtf(fmaxf(-expm1f(2.0f * la), 0.f));
            const float bv = mult * ig * buf[(tl0 + i) * 256 + col];
            hl = a * hl + bv; Ac = Ac * a;
            accr[i] = Ac; acci[i] = hl;
        }
        if (half == 0) ex[col] = make_float2(Ac, hl);
        __syncthreads();
        if (half == 1) {
            const float2 pv = ex[col];
#pragma unroll
            for (int i = 0; i < 32; ++i) { acci[i] += accr[i] * pv.y; accr[i] *= pv.x; }
            A.lruS[((size_t)b * NCHUNK + c) * 256 + col] = make_float2(accr[31], acci[31]);
        }
#pragma unroll
        for (int i = 0; i < 32; ++i) { A.lruA[(t0 + tl0 + i) * 256 + col] = accr[i]; A.lruH[(t0 + tl0 + i) * 256 + col] = acci[i]; }
    }
    __syncthreads();
}

__device__ __forceinline__ void mix_b2_unit(const MixArgs& A, unsigned char* smem, int unit, int tid) {
    float* ybuf = (float*)smem;
    bf16_t* su = (bf16_t*)(smem + 65536);
    float2* hs = (float2*)(smem + 65536 + 32768);
    const int b = unit >> 5, c = unit & 31;
    const size_t t0 = (size_t)b * SEQ + c * CHUNK;
    const float* tab = A.tab;
    const int col = tid & 255, half = tid >> 8, tl0 = half * 32;
    {
        const float w0 = A.conv_a_w[0 * 256 + col], w1 = A.conv_a_w[1 * 256 + col], w2 = A.conv_a_w[2 * 256 + col];
        const int pos = c * CHUNK + tl0;
        float vm2 = 0.f, vm1 = 0.f;
        if (pos - 2 >= 0) vm2 = bf2f(A.proj[(t0 + tl0 - 2) * IN_COLS + 256 + col]) * bf2f(A.proj[(t0 + tl0 - 2) * IN_COLS + 512 + col]);
        if (pos - 1 >= 0) vm1 = bf2f(A.proj[(t0 + tl0 - 1) * IN_COLS + 256 + col]) * bf2f(A.proj[(t0 + tl0 - 1) * IN_COLS + 512 + col]);
        for (int i = 0; i < 32; ++i) {
            const size_t r = (t0 + tl0 + i) * IN_COLS;
            const float bg = bf2f(A.proj[r + col]), v0 = bf2f(A.proj[r + 256 + col]) * bf2f(A.proj[r + 512 + col]);
            A.ys[(t0 + tl0 + i) * 1024 + col] = f2bf(bg * (w0 * vm2 + w1 * vm1 + w2 * v0));
            vm2 = vm1; vm1 = v0;
        }
    }
    {
        const int gi = col >> 6, win = 2 << gi;
        for (int i = 0; i < 32; ++i) {
            const int tl = tl0 + i, pos = c * CHUNK + tl;
            const int cnt = (pos + 1 < win) ? pos + 1 : win;
            float s = 0.f;
            for (int j = 0; j < cnt; ++j) s += bf2f(A.proj[(t0 + tl - j) * IN_COLS + 768 + col]);
            const float u = bf2f(A.proj[(t0 + tl) * IN_COLS + 768 + col]);
            ybuf[tl * 256 + col] = s / (float)cnt - u;
        }
        __syncthreads();
        const int dc = col & 63;
        float acc[32];
#pragma unroll
        for (int i = 0; i < 32; ++i) acc[i] = 0.f;
        for (int cc = 0; cc < 64; ++cc) {
            const float wv = A.pool_w[((size_t)gi * 64 + cc) * 64 + dc];
#pragma unroll
            for (int i = 0; i < 32; ++i) acc[i] += ybuf[(tl0 + i) * 256 + gi * 64 + cc] * wv;
        }
        const float pb = A.pool_b[col], ps = A.pool_scale[col];
#pragma unroll
        for (int i = 0; i < 32; ++i) A.ys[(t0 + tl0 + i) * 1024 + 256 + col] = f2bf((acc[i] + pb) * ps);
        __syncthreads();
    }
    {
        float hin = 0.f;
        for (int j = 0; j < c; ++j) { const float2 sv = A.lruS[((size_t)b * NCHUNK + j) * 256 + col]; hin = sv.x * hin + sv.y; }
        for (int i = 0; i < 32; ++i) {
            const size_t t = t0 + tl0 + i;
            const float h = A.lruH[t * 256 + col] + A.lruA[t * 256 + col] * hin;
            const float gt = gelu_tanh(bf2f(A.proj[t * IN_COLS + 1536 + col]));
            A.ys[t * 1024 + 768 + col] = f2bf(h * gt);
        }
    }
    for (int e = tid; e < 64 * 256; e += 512) { const int s = e >> 8, ch = e & 255; su[e] = A.proj[(t0 + s) * IN_COLS + 1024 + ch]; }
    {
        const int g = tid >> 5, p0 = (tid & 31) * 2;
        float bre[2][16], bim[2][16], ar[2], ai[2], hr[2] = {0.f, 0.f}, hi[2] = {0.f, 0.f};
#pragma unroll
        for (int q = 0; q < 2; ++q) {
            const int si = g * 64 + p0 + q;
            ar[q] = tab[TB_A + 2 * si]; ai[q] = tab[TB_A + 2 * si + 1];
            const float a64r = tab[TB_A64 + 2 * si], a64i = tab[TB_A64 + 2 * si + 1];
            for (int j = 0; j < c; ++j) {
                const float2 sv = A.s5st[((size_t)b * NCHUNK + j) * 1024 + si];
                const float nr = a64r * hr[q] - a64i * hi[q] + sv.x, ni = a64r * hi[q] + a64i * hr[q] + sv.y;
                hr[q] = nr; hi[q] = ni;
            }
#pragma unroll
            for (int h = 0; h < 16; ++h) { bre[q][h] = tab[TB_BRE + si * 16 + h]; bim[q][h] = tab[TB_BIM + si * 16 + h]; }
        }
        const int g2 = tid >> 5, cc = (tid >> 1) & 15, hp = tid & 1;
        unsigned cpk[32];
#pragma unroll
        for (int p = 0; p < 32; ++p) cpk[p] = pk2(A.c_re[((size_t)g2 * 16 + cc) * 64 + hp * 32 + p], A.c_im[((size_t)g2 * 16 + cc) * 64 + hp * 32 + p]);
        __syncthreads();
        for (int s4 = 0; s4 < 64; s4 += 4) {
#pragma unroll 1
            for (int tt = 0; tt < 4; ++tt) {
                const int s = s4 + tt;
                float u[16];
#pragma unroll
                for (int h = 0; h < 16; ++h) u[h] = bf2f(su[s * 256 + g * 16 + h]);
#pragma unroll
                for (int q = 0; q < 2; ++q) {
                    float xr = 0.f, xi = 0.f;
#pragma unroll
                    for (int h = 0; h < 16; ++h) { xr += bre[q][h] * u[h]; xi += bim[q][h] * u[h]; }
                    const float nr = ar[q] * hr[q] - ai[q] * hi[q] + xr, ni = ar[q] * hi[q] + ai[q] * hr[q] + xi;
                    hr[q] = nr; hi[q] = ni;
                    hs[tt * 1024 + g * 64 + p0 + q] = make_float2(nr, ni);
                }
            }
            __syncthreads();
#pragma unroll 1
            for (int tt = 0; tt < 4; ++tt) {
                float part = 0.f;
#pragma unroll
                for (int p = 0; p < 32; ++p) { const float2 hv = hs[tt * 1024 + g2 * 64 + hp * 32 + p]; part += __uint_as_float(cpk[p] << 16) * hv.x - __uint_as_float(cpk[p] & 0xffff0000u) * hv.y; }
                part += __shfl_xor(part, 1);
                if (hp == 0) ybuf[(s4 + tt) * 256 + g2 * 16 + cc] = part;
            }
            __syncthreads();
        }
    }
    {
        const float dv = A.s5_d[col];
        for (int i = 0; i < 32; ++i) { const int tl = tl0 + i; ybuf[tl * 256 + col] = gelu_tanh(ybuf[tl * 256 + col] + dv * bf2f(su[tl * 256 + col])); }
    }
    __syncthreads();
    {
        float acc[32];
#pragma unroll
        for (int i = 0; i < 32; ++i) acc[i] = 0.f;
        for (int k = 0; k < 256; ++k) {
            const float wv = A.glu_w[(size_t)k * 256 + col];
#pragma unroll
            for (int i = 0; i < 32; ++i) acc[i] += ybuf[(tl0 + i) * 256 + k] * wv;
        }
        const float gb = A.glu_b[col];
#pragma unroll
        for (int i = 0; i < 32; ++i) A.ys[(t0 + tl0 + i) * 1024 + 512 + col] = f2bf(ybuf[(tl0 + i) * 256 + col] * sigmoidf_(acc[i] + gb));
    }
    __syncthreads();
}

__device__ __forceinline__ void router_phase(Frame& F, const float* h, const float* g2, const float* tab, const float* rgb, const float* reb,
                                             bf16_t* xn, unsigned* cnt, int* buf_ts, float* buf_w) {
    float* lg = (float*)(F.smem + F.wave * 1024);
    const int lane = F.lane;
    const int gw = F.vcu * NWAVES + F.wave, NGW = F.G * NWAVES;
    const float* rw = tab + TB_RW;
    for (int q4 = gw; q4 < T / 4; q4 += NGW) {
        const int m0 = q4 * 4;
        f32x4 v[4][4];
#pragma unroll
        for (int tk = 0; tk < 4; ++tk) {
            float s = 0.f;
#pragma unroll
            for (int j = 0; j < 4; ++j) { v[tk][j] = *(const f32x4*)(h + (size_t)(m0 + tk) * D + 4 * lane + 256 * j); s += v[tk][j].x * v[tk][j].x + v[tk][j].y * v[tk][j].y + v[tk][j].z * v[tk][j].z + v[tk][j].w * v[tk][j].w; }
#pragma unroll
            for (int o = 1; o < 64; o <<= 1) s += __shfl_xor(s, o);
            const float rstd = rsqrtf(s * (1.0f / D) + EPS);
#pragma unroll
            for (int j = 0; j < 4; ++j) {
                const int col = 4 * lane + 256 * j;
                const f32x4 gg = *(const f32x4*)(g2 + col);
                v[tk][j] = v[tk][j] * rstd * gg;
                uint2 w; w.x = pk2(v[tk][j].x, v[tk][j].y); w.y = pk2(v[tk][j].z, v[tk][j].w);
                *(uint2*)(xn + (size_t)(m0 + tk) * D + col) = w;
            }
        }
        for (int o = 0; o < 36; ++o) {
            f32x4 wr[4];
#pragma unroll
            for (int j = 0; j < 4; ++j) wr[j] = *(const f32x4*)(rw + (size_t)o * 1024 + 4 * lane + 256 * j);
#pragma unroll
            for (int tk = 0; tk < 4; ++tk) {
                float s = 0.f;
#pragma unroll
                for (int j = 0; j < 4; ++j) s += v[tk][j].x * wr[j].x + v[tk][j].y * wr[j].y + v[tk][j].z * wr[j].z + v[tk][j].w * wr[j].w;
#pragma unroll
                for (int q = 1; q < 64; q <<= 1) s += __shfl_xor(s, q);
                if (lane == 0) lg[tk * 40 + o] = s;
            }
        }
        LDS_WAIT(); asm volatile("" ::: "memory");
        if (lane < 4) {
            const int tk = lane, m = m0 + tk;
            float gl[4], mx = -1e30f; int gi = 0;
#pragma unroll
            for (int i = 0; i < 4; ++i) { gl[i] = lg[tk * 40 + i] + rgb[i]; if (gl[i] > mx) { mx = gl[i]; gi = i; } }
            float den = 0.f;
#pragma unroll
            for (int i = 0; i < 4; ++i) den += __expf(gl[i] - mx);
            const float gval = 1.0f / den;
            float v1 = -1e30f, v2 = -1e30f; int i1 = 0, i2 = 0;
            for (int i = 0; i < 8; ++i) { const float el = lg[tk * 40 + 4 + gi * 8 + i] + reb[gi * 8 + i]; if (el > v1) { v2 = v1; i2 = i1; v1 = el; i1 = i; } else if (el > v2) { v2 = el; i2 = i; } }
            const float e2 = __expf(v2 - v1), w1 = gval / (1.0f + e2), w2 = gval * e2 / (1.0f + e2);
            const int ex1 = gi * 8 + i1, ex2 = gi * 8 + i2;
            const unsigned r1 = atomicAdd(&cnt[ex1], 1u), r2 = atomicAdd(&cnt[ex2], 1u);
            buf_ts[ex1 * CAP + r1] = m * 2 + 0; buf_w[ex1 * CAP + r1] = w1;
            buf_ts[ex2 * CAP + r2] = m * 2 + 1; buf_w[ex2 * CAP + r2] = w2;
        }
        LDS_WAIT(); asm volatile("" ::: "memory");
    }
}

__device__ __forceinline__ void build_plan(Frame& F, const unsigned* cnt) {
    LAS int* plan = (LAS int*)(F.lds + PLAN_OFF);
    if (F.tid == 0) {
        int nb = 0;
        for (int e = 0; e < NEXP; ++e) { const int ce = (int)__hip_atomic_load(cnt + e, RLX_AGENT); plan[321 + e] = ce; const int n = (ce + 255) >> 8; for (int j = 0; j < n && nb < MAXBLK; ++j) { plan[1 + nb] = e; plan[1 + MAXBLK + nb] = j; ++nb; } }
        plan[0] = nb;
    }
    __syncthreads();
}

struct DenseSched {
    static constexpr bool GATHER = false;
    pg8::StaticOrder ord; const char* A; const char* Bt; int lda, K; int a_sh, a_cs;
    __device__ __forceinline__ bool next(int i, pg8::Unit& u) const { return ord.next(i, u); }
    __device__ __forceinline__ const char* a_base(const pg8::Unit& u) const { return A + (size_t)u.pm * 256 * lda * 2 + (size_t)((u.pn >> a_sh) * a_cs); }
    __device__ __forceinline__ const char* b_base(const pg8::Unit& u) const { return Bt + (size_t)u.pn * 256 * K * 2; }
    __device__ __forceinline__ unsigned gather_off(const pg8::Unit&, int) const { return 0u; }
};
struct Moe1Sched {
    static constexpr bool GATHER = true;
    const char* xn; const char* w13; const LAS int* plan; const int* buf_ts; int G, c, lda;
    __device__ __forceinline__ bool next(int i, pg8::Unit& u) const { const int L = i * G + c; if (L >= 4 * plan[0]) return false; u.pm = L >> 2; u.pn = L & 3; return true; }
    __device__ __forceinline__ const char* a_base(const pg8::Unit&) const { return xn; }
    __device__ __forceinline__ const char* b_base(const pg8::Unit& u) const { return w13 + (size_t)plan[1 + u.pm] * (1024 * 1024 * 2) + (size_t)u.pn * (256 * 1024 * 2); }
    __device__ __forceinline__ unsigned gather_off(const pg8::Unit& u, int r) const {
        const int e = plan[1 + u.pm], lb = plan[1 + MAXBLK + u.pm], ce = plan[321 + e];
        int pos = lb * 256 + r; pos = pos < ce ? pos : ce - 1;
        return (unsigned)(buf_ts[e * CAP + pos] >> 1) * (unsigned)(D * 2);
    }
};
struct Moe2Sched {
    static constexpr bool GATHER = false;
    const char* hbuf; const char* w2t; const LAS int* plan; int G, c, lda;
    __device__ __forceinline__ bool next(int i, pg8::Unit& u) const { const int L = i * G + c; if (L >= 4 * plan[0]) return false; u.pm = L >> 2; u.pn = L & 3; return true; }
    __device__ __forceinline__ const char* a_base(const pg8::Unit& u) const { return hbuf + (size_t)u.pm * 256 * DEXP * 2; }
    __device__ __forceinline__ const char* b_base(const pg8::Unit& u) const { return w2t + (size_t)plan[1 + u.pm] * (1024 * 512 * 2) + (size_t)u.pn * (256 * 512 * 2); }
    __device__ __forceinline__ unsigned gather_off(const pg8::Unit&, int) const { return 0u; }
};

using pg8::f32x4; using pg8::u32x4; using pg8::u32x2; using pg8::cvt_pk_bf16; using pg8::Unit; using pg8::HALF; using pg8::BM;
struct EpiStoreBf16 {
    static constexpr bool PERM = true;
    bf16_t* O; int ldc;
    __device__ __forceinline__ void operator()(const f32x4 (&acc)[2][2][4][2], const Unit& u, int wr, int wc, int fr, int fq) const {
        const int row0 = u.pm * BM + wr * 64 + fr, col0 = u.pn * BM + wc * 32 + 8 * fq;
#pragma unroll
        for (int ai = 0; ai < 2; ++ai)
#pragma unroll
            for (int m = 0; m < 4; ++m) { bf16_t* rowp = O + (size_t)(row0 + ai * HALF + m * 16) * ldc + col0;
#pragma unroll
                for (int bj = 0; bj < 2; ++bj) { const f32x4 v0 = acc[ai][bj][m][0], v1 = acc[ai][bj][m][1];
                    u32x4 w; w.x = cvt_pk_bf16(v0[0], v0[1]); w.y = cvt_pk_bf16(v0[2], v0[3]); w.z = cvt_pk_bf16(v1[0], v1[1]); w.w = cvt_pk_bf16(v1[2], v1[3]);
                    *(u32x4*)(rowp + bj * HALF) = w; } }
    }
};
struct EpiGateMerge {
    static constexpr bool PERM = false;
    const float* bias; const bf16_t* br; bf16_t* merged;
    __device__ __forceinline__ void operator()(const f32x4 (&acc)[2][2][4][2], const Unit& u, int wr, int wc, int fr, int fq) const {
        const int row0 = u.pm * BM + wr * 64 + fr, d0 = u.pn * 64 + wc * 16 + 4 * fq;
        f32x4 bv[4];
#pragma unroll
        for (int k4 = 0; k4 < 4; ++k4) bv[k4] = *(const f32x4*)(bias + k4 * 1024 + d0);
#pragma unroll
        for (int ai = 0; ai < 2; ++ai)
#pragma unroll
            for (int m = 0; m < 4; ++m) {
                const size_t row = (size_t)(row0 + ai * HALF + m * 16);
                f32x4 s = (f32x4){0.f, 0.f, 0.f, 0.f};
#pragma unroll
                for (int k4 = 0; k4 < 4; ++k4) {
                    const u32x2 b2 = *(const u32x2*)(br + row * 4096 + k4 * 1024 + d0);
                    const f32x4 a = acc[ai][k4 >> 1][m][k4 & 1] + bv[k4];
                    s[0] += sigmoidf_(a[0]) * __uint_as_float(b2.x << 16);
                    s[1] += sigmoidf_(a[1]) * __uint_as_float(b2.x & 0xffff0000u);
                    s[2] += sigmoidf_(a[2]) * __uint_as_float(b2.y << 16);
                    s[3] += sigmoidf_(a[3]) * __uint_as_float(b2.y & 0xffff0000u);
                }
                u32x2 w; w.x = cvt_pk_bf16(s[0], s[1]); w.y = cvt_pk_bf16(s[2], s[3]);
                *(u32x2*)(merged + row * D + d0) = w;
            }
    }
};
struct EpiAddF32 {
    static constexpr bool PERM = false;
    float* h;
    __device__ __forceinline__ void operator()(const f32x4 (&acc)[2][2][4][2], const Unit& u, int wr, int wc, int fr, int fq) const {
        const int row0 = u.pm * BM + wr * 64 + fr, col0 = u.pn * BM + wc * 32 + 4 * fq;
#pragma unroll
        for (int ai = 0; ai < 2; ++ai)
#pragma unroll
            for (int m = 0; m < 4; ++m) { float* rowp = h + (size_t)(row0 + ai * HALF + m * 16) * D + col0;
#pragma unroll
                for (int bj = 0; bj < 2; ++bj)
#pragma unroll
                    for (int n = 0; n < 2; ++n) { f32x4* p = (f32x4*)(rowp + bj * HALF + n * 16); *p = *p + acc[ai][bj][m][n]; } }
    }
};
struct EpiMoe1 {
    static constexpr bool PERM = false;
    bf16_t* hbuf;
    __device__ __forceinline__ void operator()(const f32x4 (&acc)[2][2][4][2], const Unit& u, int wr, int wc, int fr, int fq) const {
        const int row0 = u.pm * BM + wr * 64 + fr, h0 = u.pn * 128 + wc * 16 + 4 * fq;
#pragma unroll
        for (int ai = 0; ai < 2; ++ai)
#pragma unroll
            for (int m = 0; m < 4; ++m) { bf16_t* rowp = hbuf + (size_t)(row0 + ai * HALF + m * 16) * DEXP + h0;
#pragma unroll
                for (int bj = 0; bj < 2; ++bj) { const f32x4 a1 = acc[ai][bj][m][0], a3 = acc[ai][bj][m][1];
                    u32x2 w; w.x = cvt_pk_bf16(a1[0] * sigmoidf_(a1[0]) * a3[0], a1[1] * sigmoidf_(a1[1]) * a3[1]); w.y = cvt_pk_bf16(a1[2] * sigmoidf_(a1[2]) * a3[2], a1[3] * sigmoidf_(a1[3]) * a3[3]);
                    *(u32x2*)(rowp + bj * 64) = w; } }
    }
};
struct EpiMoe2 {
    static constexpr bool PERM = true;
    bf16_t* ymoe; const LAS int* plan; const int* buf_ts; const float* buf_w;
    __device__ __forceinline__ void operator()(const f32x4 (&acc)[2][2][4][2], const Unit& u, int wr, int wc, int fr, int fq) const {
        const int e = plan[1 + u.pm], lb = plan[1 + MAXBLK + u.pm], ce = plan[321 + e];
        const int col0 = u.pn * BM + wc * 32 + 8 * fq;
#pragma unroll
        for (int ai = 0; ai < 2; ++ai)
#pragma unroll
            for (int m = 0; m < 4; ++m) {
                const int pos = lb * 256 + ai * HALF + wr * 64 + m * 16 + fr;
                if (pos < ce) {
                    const int ts = buf_ts[e * CAP + pos]; const float wt = buf_w[e * CAP + pos];
                    bf16_t* rowp = ymoe + (size_t)ts * D + col0;
#pragma unroll
                    for (int bj = 0; bj < 2; ++bj) { const f32x4 v0 = acc[ai][bj][m][0] * wt, v1 = acc[ai][bj][m][1] * wt;
                        u32x4 w; w.x = cvt_pk_bf16(v0[0], v0[1]); w.y = cvt_pk_bf16(v0[2], v0[3]); w.z = cvt_pk_bf16(v1[0], v1[1]); w.w = cvt_pk_bf16(v1[2], v1[3]);
                        *(u32x4*)(rowp + bj * HALF) = w; }
                }
            }
    }
};

__device__ __forceinline__ void make_mix_args(MixArgs& A, const Args& args, unsigned char* ws, int l) {
    A.proj = (const bf16_t*)(ws + WS_PROJ); A.ys = (bf16_t*)(ws + WS_YS); A.tab = (const float*)(ws + WS_TAB + (size_t)l * MiB);
    A.s5st = (float2*)(ws + WS_S5ST); A.lruA = (float*)(ws + WS_LRUA); A.lruH = (float*)(ws + WS_LRUH); A.lruS = (float2*)(ws + WS_LRUS);
    A.conv_a_w = args.in[3] + (size_t)l * 3 * W; A.pool_w = args.in[4] + (size_t)l * 4 * 64 * 64; A.pool_b = args.in[5] + (size_t)l * W; A.pool_scale = args.in[6] + (size_t)l * W;
    A.c_re = args.in[12] + (size_t)l * 16 * 16 * 64; A.c_im = args.in[13] + (size_t)l * 16 * 16 * 64; A.s5_d = args.in[14] + (size_t)l * W; A.glu_w = args.in[15] + (size_t)l * W * W; A.glu_b = args.in[16] + (size_t)l * W;
    A.lconv_w = args.in[17] + (size_t)l * 4 * W; A.lconv_b = args.in[18] + (size_t)l * W; A.wa = args.in[19] + (size_t)l * 4 * 64 * 64; A.ba = args.in[20] + (size_t)l * W; A.wx = args.in[21] + (size_t)l * 4 * 64 * 64; A.bx = args.in[22] + (size_t)l * W;
}

__global__ void __launch_bounds__(NWAVES * 64, 2) mk_fwd(Args args) {
    extern __shared__ __attribute__((aligned(16))) unsigned char lds[];
    Frame F;
    F.lds = (LAS unsigned char*)lds; F.smem = lds;
    F.MISC = (volatile LAS unsigned*)(F.lds + MISC_OFF);
    F.tid = threadIdx.x; F.lane = F.tid & 63; F.wave = __builtin_amdgcn_readfirstlane(F.tid >> 6);
    F.G = gridDim.x; { const int bx = blockIdx.x; F.vcu = (F.G % 8 == 0) ? (bx % 8) * (F.G / 8) + bx / 8 : bx; }
    F.ws = args.ws; F.ctl = (unsigned*)(args.ws + WS_CTL);
    unsigned char* ws = args.ws;
    for (int u = F.tid; u < (LDS_BYTES - LDSCTL_OFF) / 4; u += NWAVES * 64) ((LAS unsigned*)(F.lds + LDSCTL_OFF))[u] = 0u;
    __syncthreads();
    XcdBarrier bar; bar.bar = F.ctl + CW_BAR; bar.x = 0; bar.st = nullptr;
    if (N_LAUNCHES == 1) bar = xcd_barrier_post(F.ctl + CW_BAR, F.MISC + 8);
    const int lo = args.ph_lo, hi = args.ph_hi;
    float* h = (float*)(ws + WS_H); bf16_t* xn = (bf16_t*)(ws + WS_XN); bf16_t* proj = (bf16_t*)(ws + WS_PROJ); bf16_t* ys = (bf16_t*)(ws + WS_YS);
    bf16_t* br = (bf16_t*)(ws + WS_R1); bf16_t* hbuf = (bf16_t*)(ws + WS_HBUF); bf16_t* ymoe = (bf16_t*)(ws + WS_YMOE); bf16_t* merged = (bf16_t*)(ws + WS_MERGED);
    int* buf_ts = (int*)(ws + WS_BUFTS); float* buf_w = (float*)(ws + WS_BUFW);

#ifndef KIND_MASK
#define KIND_MASK 0x7ff
#endif
#define PH_BEGIN(k, kind) if (lo <= (k) && (k) < hi && ((KIND_MASK >> (kind)) & 1)) { \
        { int t_ = threadIdx.x; asm volatile("" : "+v"(t_)); F.tid = t_; F.lane = t_ & 63; F.wave = __builtin_amdgcn_readfirstlane(t_ >> 6); }
#define PH_END(k) if ((k) + 1 < hi) xcd_barrier(bar); }

    PH_BEGIN(0, 0)
        prep_tables(F, args);
        conv_mixer_weights(F, args);
        conv_expert_weights(F, args, 0);
        norm_phase(F, args.in[0], nullptr, args.in[1], h, xn, nullptr);
    PH_END(0)

#define LAYER(l) { \
    const int pb = 1 + PH_PER_LAYER * (l); \
    const float* tab = (const float*)(ws + WS_TAB + (size_t)(l) * MiB); \
    const unsigned char* wmix = ws + WS_WMIX + (size_t)(l) * WMIX_STRIDE; \
    unsigned* cnt = F.ctl + CW_CNT + 64 * (l); \
    PH_BEGIN(pb + 0, 1)   \
        DenseSched S; S.ord.init(T, IN_COLS, F.G, (int)blockIdx.x); S.A = (const char*)xn; S.Bt = (const char*)(wmix + WMIX_IN); S.lda = D; S.K = D; S.a_sh = 0; S.a_cs = 0; \
        EpiStoreBf16 E{proj, IN_COLS}; \
        pg8::gemm_phase<EpiStoreBf16, DenseSched, true, true>(F.lds, F.tid, D, S, E); \
    PH_END(pb + 0) \
    PH_BEGIN(pb + 1, 2)   \
        MixArgs A; make_mix_args(A, args, ws, (l)); \
        for (int u = blockIdx.x; u < BATCH * NCHUNK; u += F.G) { int t_ = F.tid; asm volatile("" : "+v"(t_)); mix_b1_unit(A, F.smem, u, t_); } \
    PH_END(pb + 1) \
    PH_BEGIN(pb + 2, 3)   \
        MixArgs A; make_mix_args(A, args, ws, (l)); \
        for (int u = blockIdx.x; u < BATCH * NCHUNK; u += F.G) { int t_ = F.tid; asm volatile("" : "+v"(t_)); mix_b2_unit(A, F.smem, u, t_); } \
    PH_END(pb + 2) \
    PH_BEGIN(pb + 3, 4)   \
        DenseSched S; S.ord.init(T, 4096, F.G, (int)blockIdx.x); S.A = (const char*)ys; S.Bt = (const char*)(wmix + WMIX_BR); S.lda = 1024; S.K = 256; S.a_sh = 2; S.a_cs = 512; \
        EpiStoreBf16 E{br, 4096}; \
        pg8::gemm_phase<EpiStoreBf16, DenseSched, true, true>(F.lds, F.tid, 256, S, E); \
    PH_END(pb + 3) \
    PH_BEGIN(pb + 4, 5)   \
        DenseSched S; S.ord.init(T, 4096, F.G, (int)blockIdx.x); S.A = (const char*)xn; S.Bt = (const char*)(wmix + WMIX_MG); S.lda = D; S.K = D; S.a_sh = 0; S.a_cs = 0; \
        EpiGateMerge E{args.in[25] + (size_t)(l) * 4096, br, merged}; \
        pg8::gemm_phase<EpiGateMerge, DenseSched, true, true>(F.lds, F.tid, D, S, E); \
    PH_END(pb + 4) \
    PH_BEGIN(pb + 5, 6)   \
        DenseSched S; S.ord.init(T, D, F.G, (int)blockIdx.x); S.A = (const char*)merged; S.Bt = (const char*)(wmix + WMIX_OUT); S.lda = D; S.K = D; S.a_sh = 0; S.a_cs = 0; \
        EpiAddF32 E{h}; \
        pg8::gemm_phase<EpiAddF32, DenseSched, true, true>(F.lds, F.tid, D, S, E); \
    PH_END(pb + 5) \
    PH_BEGIN(pb + 6, 7)   \
        router_phase(F, h, args.in[28] + (size_t)(l) * D, tab, args.in[30] + (size_t)(l) * 4, args.in[32] + (size_t)(l) * 32, xn, cnt, buf_ts, buf_w); \
    PH_END(pb + 6) \
    PH_BEGIN(pb + 7, 8)   \
        build_plan(F, cnt); \
        Moe1Sched S{(const char*)xn, (const char*)(ws + WS_WEXP), (const LAS int*)(F.lds + PLAN_OFF), buf_ts, F.G, F.vcu, D}; \
        EpiMoe1 E{hbuf}; \
        pg8::gemm_phase<EpiMoe1, Moe1Sched, true, true>(F.lds, F.tid, D, S, E); \
    PH_END(pb + 7) \
    PH_BEGIN(pb + 8, 9)   \
        build_plan(F, cnt); \
        Moe2Sched S{(const char*)hbuf, (const char*)(ws + WS_WEXP + WEXP_W2), (const LAS int*)(F.lds + PLAN_OFF), F.G, F.vcu, DEXP}; \
        EpiMoe2 E{ymoe, (const LAS int*)(F.lds + PLAN_OFF), buf_ts, buf_w}; \
        pg8::gemm_phase<EpiMoe2, Moe2Sched, true, true>(F.lds, F.tid, DEXP, S, E); \
    PH_END(pb + 8) \
    PH_BEGIN(pb + 9, 10)   \
        if ((l) + 1 < DEPTH) { \
            conv_expert_weights(F, args, (l) + 1); \
            norm_phase(F, h, ymoe, args.in[1] + (size_t)((l) + 1) * D, h, xn, nullptr); \
        } else { \
            norm_phase(F, h, ymoe, args.in[36], nullptr, nullptr, args.out); \
        } \
    PH_END(pb + 9) \
}
    LAYER(0)
    LAYER(1)
#undef LAYER
#undef PH_BEGIN
#undef PH_END
}
}

extern "C" void kernel_launch(void* const* d_in, const int* in_sizes, int n_in, void* d_out, int out_size, void* d_ws, size_t ws_size, hipStream_t stream) {
    static int grid = 0;
    if (grid == 0) {
        if (n_in != 37 || ws_size < WS_END) { fprintf(stderr, "kernel_launch: unexpected n_in %d or ws %zu\n", n_in, ws_size); grid = -1; return; }
        int dev = 0, cus = 0;
        if (hipGetDevice(&dev) != hipSuccess || hipDeviceGetAttribute(&cus, hipDeviceAttributeMultiprocessorCount, dev) != hipSuccess) { grid = -1; return; }
        if (hipFuncSetAttribute((const void*)mk_fwd, hipFuncAttributeMaxDynamicSharedMemorySize, LDS_BYTES) != hipSuccess) { fprintf(stderr, "kernel_launch: hipFuncSetAttribute failed\n"); grid = -1; return; }
        grid = cus;
    }
    if (grid < 0) return;
    (void)hipMemsetAsync((char*)d_ws + WS_CTL, 0, 1 * MiB, stream);
    Args a{};
    for (int i = 0; i < 37; ++i) a.in[i] = (const float*)d_in[i];
    a.out = (float*)d_out; a.ws = (unsigned char*)d_ws;
    if (N_LAUNCHES == 1) {
        a.ph_lo = 0; a.ph_hi = N_PHASES;
        hipLaunchKernelGGL(mk_fwd, dim3(grid), dim3(NWAVES * 64), LDS_BYTES, stream, a);
    } else {
        for (int p = 0; p < N_PHASES; ++p) { a.ph_lo = p; a.ph_hi = p + 1; hipLaunchKernelGGL(mk_fwd, dim3(grid), dim3(NWAVES * 64), LDS_BYTES, stream, a); }
    }
}
```

```cpp
#include <hip/hip_runtime.h>
#include <cstdint>
#include <cstdio>

#ifndef MK_N_LAUNCHES
#define MK_N_LAUNCHES 1
#endif

namespace pg8 {
#define PG8_LAS __attribute__((address_space(3)))
typedef unsigned short bf16_t;
typedef short bf16x8 __attribute__((ext_vector_type(8)));
typedef float f32x4 __attribute__((ext_vector_type(4)));
typedef unsigned u32x4 __attribute__((ext_vector_type(4)));
typedef unsigned u32x2 __attribute__((ext_vector_type(2)));
constexpr int BM = 256, BK = 64, HALF = 128, HTB = HALF * BK * 2, STAGE_BYTES = 8 * HTB, NXCD = 8, WGM = 8;

__host__ __device__ __forceinline__ int lds_byte(int r, int c) { const int st = (r >> 4) * 2 + (c >> 5), rr = r & 15, cc = c & 31, ob = rr * 64 + cc * 2; return st * 1024 + (ob ^ (((ob >> 9) & 1) << 5)); }
__host__ __device__ __forceinline__ void stage_rc(int b, int& R, int& C) { const int st = b / 1024, sb = b % 1024, swz = sb ^ (((sb >> 9) & 1) << 5); R = (st >> 1) * 16 + swz / 64; C = (st & 1) * 32 + (swz % 64) / 2; }
__host__ __device__ __forceinline__ int perm32(int rho) { const int n = rho >> 4, i = rho & 15; return 8 * (i >> 2) + 4 * n + (i & 3); }

struct Unit { int pm, pn; };

struct StaticOrder {
    int nM, nN, nwg, G, c;
    __host__ __device__ void init(int M, int N, int G_, int c_) { nM = M / BM; nN = N / BM; nwg = nM * nN; G = G_; c = c_; }
    __host__ __device__ bool next(int i, Unit& u) const {
        const long L = (long)i * G + c; if (L >= nwg) return false;
        int wgid = (int)L; { const int q = nwg / NXCD, r = nwg % NXCD, xcd = wgid % NXCD, off = wgid / NXCD; wgid = (xcd < r ? xcd * (q + 1) : r * (q + 1) + (xcd - r) * q) + off; }
        const int nig = WGM * nN, gid = wgid / nig, fm = gid * WGM, gsz = (nM - fm) < WGM ? (nM - fm) : WGM;
        u.pm = fm + ((wgid % nig) % gsz); u.pn = (wgid % nig) / gsz; return true;
    }
};

typedef int i32x8 __attribute__((ext_vector_type(8)));
typedef int i32x4 __attribute__((ext_vector_type(4)));
__device__ __forceinline__ i32x8 cat8(bf16x8 a, bf16x8 b) { const i32x4 x = __builtin_bit_cast(i32x4, a), y = __builtin_bit_cast(i32x4, b); return __builtin_shufflevector(x, y, 0, 1, 2, 3, 4, 5, 6, 7); }
__device__ __forceinline__ unsigned cvt_pk_bf16(float lo, float hi) { unsigned r; asm volatile("v_cvt_pk_bf16_f32 %0, %1, %2" : "=v"(r) : "v"(lo), "v"(hi)); return r; }

template <class Epi, class Sched, bool ALIGN_EPI, bool SP2, bool FP8 = false>
__device__ __forceinline__ void gemm_phase(PG8_LAS unsigned char* lds, const int tid, const int K, const Sched& S, const Epi& E) {
    const int wid = __builtin_amdgcn_readfirstlane(tid >> 6), lane = tid & 63, wr = wid >> 2, wc = wid & 3, fr = lane & 15, fq = lane >> 4;
    const int nt = FP8 ? K / 128 : K / BK;
    const int ES = FP8 ? 1 : 2;
    unsigned voffB[2]; int RA[2], CA[2];
#pragma unroll
    for (int i = 0; i < 2; ++i) { int R, C; stage_rc(tid * 16 + i * 8192, R, C); const int Rb = Epi::PERM ? ((R & ~31) + perm32(R & 31)) : R;
        voffB[i] = (unsigned)(Rb * K * ES + C * 2); RA[i] = R; CA[i] = C; }
    const size_t kstep = (size_t)(BK * 2);
    const size_t hstepB = (size_t)HALF * K * ES;
    const unsigned ldsw = (unsigned)wid * 1024u;
    const int aoff = lds_byte(wr * 64 + fr, fq * 8), boff = lds_byte(wc * 32 + fr, fq * 8);
#define PG8_SA(b, h) (((b) * 2 + (h)) * HTB)
#define PG8_SB(b, h) ((4 + (b) * 2 + (h)) * HTB)
#define PG8_STAGE(bufoff, gbase, voff) do { _Pragma("unroll") for (int _i = 0; _i < 2; ++_i) \
        __builtin_amdgcn_global_load_lds((const unsigned*)((const char*)(gbase) + (voff)[_i]), (PG8_LAS unsigned*)(lds + (bufoff) + ldsw + _i * 8192), 16, 0, 0); } while (0)
#define PG8_LDA(dst, b, h) do { _Pragma("unroll") for (int m = 0; m < 4; ++m) { if constexpr (FP8) { dst##8[m] = cat8(*(const PG8_LAS bf16x8*)(lds + PG8_SA(b, h) + aoff + m * 2048), *(const PG8_LAS bf16x8*)(lds + PG8_SA(b, h) + aoff + m * 2048 + 1024)); } \
        else { _Pragma("unroll") for (int k = 0; k < 2; ++k) dst[m][k] = *(const PG8_LAS bf16x8*)(lds + PG8_SA(b, h) + aoff + m * 2048 + k * 1024); } } } while (0)
#define PG8_LDB(dst, b, h) do { _Pragma("unroll") for (int n = 0; n < 2; ++n) { if constexpr (FP8) { dst##8[n] = cat8(*(const PG8_LAS bf16x8*)(lds + PG8_SB(b, h) + boff + n * 2048), *(const PG8_LAS bf16x8*)(lds + PG8_SB(b, h) + boff + n * 2048 + 1024)); } \
        else { _Pragma("unroll") for (int k = 0; k < 2; ++k) dst[n][k] = *(const PG8_LAS bf16x8*)(lds + PG8_SB(b, h) + boff + n * 2048 + k * 1024); } } } while (0)
#define PG8_MMA(ai, bj, At, Bt) do { __builtin_amdgcn_s_setprio(1); _Pragma("unroll") for (int m = 0; m < 4; ++m) _Pragma("unroll") for (int n = 0; n < 2; ++n) { \
        if constexpr (FP8) { asm volatile("v_mfma_scale_f32_16x16x128_f8f6f4 %0, %1, %2, %0, %3, %3 op_sel_hi:[0,0,0]" : "+v"(acc[ai][bj][m][n]) : "v"(Bt##8[n]), "v"(At##8[m]), "v"(one_scale));     } \
        else { _Pragma("unroll") for (int k = 0; k < 2; ++k) acc[ai][bj][m][n] = __builtin_amdgcn_mfma_f32_16x16x32_bf16(Bt[n][k], At[m][k], acc[ai][bj][m][n], 0, 0, 0); } } \
        if constexpr (FP8) asm volatile("s_nop 15\n\ts_nop 7" ::: "memory");     \
        __builtin_amdgcn_s_setprio(0); } while (0)
#define PG8_WAIT_V(n) asm volatile("s_waitcnt vmcnt(" #n ")" ::: "memory")
#define PG8_WAIT_L(n) asm volatile("s_waitcnt lgkmcnt(" #n ")" ::: "memory")
#define PG8_BAR __builtin_amdgcn_s_barrier()
#define PG8_SCHED __builtin_amdgcn_sched_barrier(0)
    Unit cur, nxt; int ui = 0;
    if (!S.next(0, cur)) return;
    bool has_next = S.next(1, nxt);
    unsigned offC[2][2], offN[2][2];
#pragma unroll
    for (int h = 0; h < 2; ++h)
#pragma unroll
        for (int i = 0; i < 2; ++i) {
            if constexpr (Sched::GATHER) { offC[h][i] = S.gather_off(cur, h * HALF + RA[i]) + (unsigned)CA[i] * 2u; offN[h][i] = has_next ? S.gather_off(nxt, h * HALF + RA[i]) + (unsigned)CA[i] * 2u : offC[h][i]; }
            else { offC[h][i] = (unsigned)((h * HALF + RA[i]) * S.lda * ES + CA[i] * 2); offN[h][i] = offC[h][i]; }
        }
    f32x4 acc[2][2][4][2];
#pragma unroll
    for (int a = 0; a < 2; ++a)
#pragma unroll
        for (int b = 0; b < 2; ++b)
#pragma unroll
            for (int m = 0; m < 4; ++m)
#pragma unroll
                for (int n = 0; n < 2; ++n) acc[a][b][m][n] = (f32x4){0.f, 0.f, 0.f, 0.f};
    int one_scale = 0x7f7f7f7f; asm volatile("" : "+v"(one_scale));
    bf16x8 At[4][2], B0[2][2], B1[2][2]; i32x8 At8[4], B08[2], B18[2]; (void)At; (void)B0; (void)B1; (void)At8; (void)B08; (void)B18;
    const char* cA = S.a_base(cur); const char* cB = S.b_base(cur);
    if constexpr (Sched::WAITS) S.a_ready(cur);
    if constexpr (SP2) {
        PG8_STAGE(PG8_SB(0, 0), cB, voffB); PG8_STAGE(PG8_SB(0, 1), cB + hstepB, voffB); PG8_STAGE(PG8_SA(0, 0), cA, offC[0]); PG8_STAGE(PG8_SA(0, 1), cA, offC[1]);
        if (wr == 1) PG8_BAR;
        PG8_WAIT_V(2); PG8_BAR;
        PG8_STAGE(PG8_SB(1, 0), cB + kstep, voffB); PG8_STAGE(PG8_SA(1, 0), cA + kstep, offC[0]); PG8_STAGE(PG8_SB(1, 1), cB + hstepB + kstep, voffB);
        PG8_WAIT_V(6); PG8_BAR;
    } else {
        PG8_STAGE(PG8_SB(0, 0), cB, voffB); PG8_STAGE(PG8_SA(0, 0), cA, offC[0]); PG8_STAGE(PG8_SB(0, 1), cB + hstepB, voffB); PG8_STAGE(PG8_SA(0, 1), cA, offC[1]);
        if (wr == 1) PG8_BAR;
        PG8_WAIT_V(4); PG8_BAR;
        PG8_STAGE(PG8_SB(1, 0), cB + kstep, voffB); PG8_STAGE(PG8_SA(1, 0), cA + kstep, offC[0]); PG8_STAGE(PG8_SB(1, 1), cB + hstepB + kstep, voffB);
        PG8_WAIT_V(6); PG8_BAR;
    }
    for (;;) {
        const char* nA = has_next ? S.a_base(nxt) : cA; const char* nB = has_next ? S.b_base(nxt) : cB;
        const bool full = !(Sched::HALF && __builtin_amdgcn_readfirstlane((int)S.half_only(cur)));
#pragma unroll 1
        for (int t = 0; t < nt; t += 2) {
            const bool last = (t == nt - 2);
            const char* a1 = cA + (size_t)(t + 1) * kstep;
            const char* a2 = last ? nA : cA + (size_t)(t + 2) * kstep; const char* b2 = last ? nB : cB + (size_t)(t + 2) * kstep;
            const char* a3 = a2 + kstep; const char* b3 = b2 + kstep;
            if constexpr (Sched::WAITS) { if (last && has_next) S.a_ready(nxt); }
            unsigned o2[2][2];
#pragma unroll
            for (int h = 0; h < 2; ++h)
#pragma unroll
                for (int i = 0; i < 2; ++i) o2[h][i] = (Sched::GATHER && last) ? offN[h][i] : offC[h][i];
            if constexpr (SP2) {
            PG8_LDB(B0, 0, 0); PG8_LDB(B1, 0, 1); PG8_SCHED; PG8_LDA(At, 0, 0); PG8_STAGE(PG8_SA(1, 1), a1, offC[1]);
            PG8_WAIT_V(8); PG8_WAIT_L(0); PG8_BAR; PG8_MMA(0, 0, At, B0); PG8_MMA(0, 1, At, B1); PG8_BAR; PG8_SCHED;
            PG8_LDA(At, 0, 1); PG8_STAGE(PG8_SB(0, 0), b2, voffB); PG8_STAGE(PG8_SB(0, 1), b2 + hstepB, voffB); PG8_STAGE(PG8_SA(0, 0), a2, o2[0]);
            PG8_WAIT_V(8); PG8_WAIT_L(0); PG8_BAR; if (full) { PG8_MMA(1, 0, At, B0); PG8_MMA(1, 1, At, B1); } PG8_BAR; PG8_SCHED;
            PG8_LDB(B0, 1, 0); PG8_LDB(B1, 1, 1); PG8_SCHED; PG8_LDA(At, 1, 0); PG8_STAGE(PG8_SA(0, 1), a2, o2[1]);
            PG8_WAIT_V(8); PG8_WAIT_L(0); PG8_BAR; PG8_MMA(0, 0, At, B0); PG8_MMA(0, 1, At, B1); PG8_BAR; PG8_SCHED;
            PG8_LDA(At, 1, 1); PG8_STAGE(PG8_SB(1, 0), b3, voffB); PG8_STAGE(PG8_SB(1, 1), b3 + hstepB, voffB); PG8_STAGE(PG8_SA(1, 0), a3, o2[0]);
            PG8_WAIT_V(8); PG8_WAIT_L(0); PG8_BAR; if (full) { PG8_MMA(1, 0, At, B0); PG8_MMA(1, 1, At, B1); } PG8_BAR; PG8_SCHED;
            } else {
            PG8_LDB(B0, 0, 0); PG8_SCHED; PG8_LDA(At, 0, 0); PG8_STAGE(PG8_SA(1, 1), a1, offC[1]);
            PG8_WAIT_L(8); PG8_BAR; PG8_WAIT_L(0); PG8_MMA(0, 0, At, B0); PG8_BAR; PG8_SCHED;
            PG8_LDB(B1, 0, 1); PG8_STAGE(PG8_SB(0, 0), b2, voffB);
            PG8_BAR; PG8_WAIT_L(0); PG8_MMA(0, 1, At, B1); PG8_BAR;
            PG8_LDA(At, 0, 1); PG8_STAGE(PG8_SA(0, 0), a2, o2[0]);
            PG8_BAR; PG8_WAIT_L(0); PG8_MMA(1, 0, At, B0); PG8_BAR; PG8_SCHED;
            PG8_STAGE(PG8_SB(0, 1), b2 + hstepB, voffB);
            PG8_WAIT_V(6); PG8_BAR; PG8_MMA(1, 1, At, B1); PG8_BAR;
            PG8_LDB(B0, 1, 0); PG8_SCHED; PG8_LDA(At, 1, 0); PG8_STAGE(PG8_SA(0, 1), a2, o2[1]);
            PG8_WAIT_L(8); PG8_BAR; PG8_WAIT_L(0); PG8_MMA(0, 0, At, B0); PG8_BAR; PG8_SCHED;
            PG8_LDB(B1, 1, 1); PG8_STAGE(PG8_SB(1, 0), b3, voffB);
            PG8_BAR; PG8_WAIT_L(0); PG8_MMA(0, 1, At, B1); PG8_BAR;
            PG8_LDA(At, 1, 1); PG8_STAGE(PG8_SA(1, 0), a3, o2[0]);
            PG8_BAR; PG8_WAIT_L(0); PG8_MMA(1, 0, At, B0); PG8_BAR; PG8_SCHED;
            PG8_STAGE(PG8_SB(1, 1), b3 + hstepB, voffB);
            PG8_WAIT_V(6); PG8_BAR; PG8_MMA(1, 1, At, B1); PG8_BAR;
            }
        }
        if constexpr (ALIGN_EPI) { if (wr == 0) PG8_BAR; }
        Unit nn; bool has_nn = false;
        if constexpr (Sched::GATHER) {
            has_nn = has_next && S.next(ui + 2, nn);
#pragma unroll
            for (int h = 0; h < 2; ++h)
#pragma unroll
                for (int i = 0; i < 2; ++i) { int R_, C_; stage_rc(tid * 16 + i * 8192, R_, C_); offC[h][i] = offN[h][i]; if (has_nn) offN[h][i] = S.gather_off(nn, h * HALF + R_) + (unsigned)C_ * 2u; }
        }
        E(acc, cur, wr, wc, fr, fq);
        if constexpr (Sched::PUBLISHES) S.done(cur);
        if (!has_next) break;
#pragma unroll
        for (int a = 0; a < 2; ++a)
#pragma unroll
            for (int b = 0; b < 2; ++b)
#pragma unroll
                for (int m = 0; m < 4; ++m)
#pragma unroll
                    for (int n = 0; n < 2; ++n) acc[a][b][m][n] = (f32x4){0.f, 0.f, 0.f, 0.f};
        cur = nxt; cA = nA; cB = nB; ++ui;
        if constexpr (Sched::GATHER) { has_next = has_nn; nxt = nn; }
        else { has_next = S.next(ui + 1, nxt); }
        if constexpr (ALIGN_EPI) { if (wr == 1) PG8_BAR; }
    }
    PG8_WAIT_V(0);
    if constexpr (!ALIGN_EPI) { if (wr == 0) PG8_BAR; }
    PG8_BAR;
#undef PG8_SA
#undef PG8_SB
#undef PG8_STAGE
#undef PG8_LDA
#undef PG8_LDB
#undef PG8_MMA
#undef PG8_WAIT_V
#undef PG8_WAIT_L
#undef PG8_BAR
#undef PG8_SCHED
}
}

namespace {
constexpr int NWAVES = 8;
constexpr int N_LAUNCHES = MK_N_LAUNCHES;
constexpr int D = 1024, BATCH = 8, SEQ = 2048, DEPTH = 2, T = BATCH * SEQ;
constexpr int W = 256, IN_COLS = 1792;
constexpr int NEXP = 32, DEXP = 512;
constexpr int CHUNK = 64, NCHUNK = SEQ / CHUNK;
constexpr int CAP = 16384;
constexpr int MAXBLK = 160;
constexpr float EPS = 1e-6f;
constexpr int PH_PER_LAYER = 8, N_PHASES = 1 + PH_PER_LAYER * DEPTH;

typedef unsigned short bf16_t;
typedef float f32x4 __attribute__((ext_vector_type(4)));
typedef unsigned v4u __attribute__((ext_vector_type(4)));
#define GAS __attribute__((address_space(1)))
#define LAS __attribute__((address_space(3)))
typedef GAS unsigned gu32;
#define RLX_AGENT __ATOMIC_RELAXED, __HIP_MEMORY_SCOPE_AGENT
#define LDS_WAIT() asm volatile("s_waitcnt lgkmcnt(0)" ::: "memory")

__device__ __forceinline__ float bf2f(bf16_t b) { return __uint_as_float(((unsigned)b) << 16); }
__device__ __forceinline__ unsigned f2bfu(float f) { unsigned u = __float_as_uint(f); return (u + 0x7fffu + ((u >> 16) & 1u)) >> 16; }
__device__ __forceinline__ bf16_t f2bf(float f) { return (bf16_t)f2bfu(f); }
__device__ __forceinline__ unsigned pk2(float lo, float hi) { return f2bfu(lo) | (f2bfu(hi) << 16); }
__device__ __forceinline__ float sigmoidf_(float x) { return 1.0f / (1.0f + __expf(-x)); }
__device__ __forceinline__ float gelu_tanh(float x) {
    const float z = 0.7978845608028654f * (x + 0.044715f * x * x * x);
    const float t = 1.0f - 2.0f / (__expf(2.0f * z) + 1.0f);
    return 0.5f * x * (1.0f + t);
}

constexpr size_t MiB = 1u << 20;
constexpr size_t WS_CTL = 0;
constexpr size_t WS_TAB = 1 * MiB;
constexpr size_t WS_H = 4 * MiB;
constexpr size_t WS_XN = 68 * MiB;
constexpr size_t WS_PROJ = 100 * MiB;
constexpr size_t WS_MERGED = WS_PROJ;
constexpr size_t WS_YS = 156 * MiB;
constexpr size_t WS_R1 = 188 * MiB;
constexpr size_t WS_HBUF = WS_R1;
constexpr size_t WS_YMOE = WS_R1 + 48 * MiB;
constexpr size_t WS_S5ST = 316 * MiB;
constexpr size_t WS_LRUA = 318 * MiB;
constexpr size_t WS_LRUH = 334 * MiB;
constexpr size_t WS_LRUS = 350 * MiB;
constexpr size_t WS_BUFTS = 351 * MiB;
constexpr size_t WS_BUFW = 353 * MiB;
constexpr size_t WS_WMIX = 356 * MiB;
constexpr size_t WMIX_IN = 0, WMIX_MG = (size_t)1792 * 1024 * 2, WMIX_BR = WMIX_MG + (size_t)4096 * 1024 * 2, WMIX_OUT = WMIX_BR + (size_t)4096 * 256 * 2, WMIX_STRIDE = 16 * MiB;
static_assert(WMIX_OUT + (size_t)1024 * 1024 * 2 <= WMIX_STRIDE, "mixer weights");
constexpr size_t WS_WEXP = 388 * MiB;
constexpr size_t WEXP_W2 = 32 * MiB;
constexpr float MG_SCALE = 32.0f;
constexpr float W13_SCALE = 32.0f, W2_SCALE = 16.0f, H_SCALE = 8.0f;
constexpr size_t WS_XN8 = 484 * MiB;
constexpr size_t WS_END = 500 * MiB;

constexpr int CW_CNT = 8192;
constexpr int CW_BAR = 4096;
constexpr int CW_TMO = 16;
constexpr int CW_MIXF = 49152;
constexpr int CW_RDY = 32768;

constexpr int TB_NLOG = 4096 + 32768, TB_RW = 4096 + 32768 + 256;
constexpr int SM_OFF = 512 * 1024;
constexpr int SM_POOLT = 0, SM_WAT = 32768, SM_WXT = 65536, SM_GLUT = 98304, SM_BRE = 229376, SM_BIM = 262144, SM_CMAT = 294912, SM_ATAB = 360448;


constexpr int RING_BYTES = 131072;
constexpr int LDSCTL_OFF = RING_BYTES, MISC_OFF = LDSCTL_OFF + 320;
constexpr int PLAN_OFF = MISC_OFF + 128;
constexpr int LDS_BYTES = 147456;
static_assert(PLAN_OFF + 4 * 360 <= LDS_BYTES, "LDS map");

#define XB_TMO      128
#define XB_XCNT(j)  (256  + 64 * (j))
#define XB_XSUB(j)  (1280 + 64 * (j))
#define XB_XGEN(j)  (2304 + 64 * (j))
#define XB_TOP      3328
#define XB_TOPGEN   3392
#define XCD_BAR_WORDS 3456
#define XB_SPIN_CAP (1u << 18)
__device__ __forceinline__ unsigned xb_ld(unsigned* p)              { return __hip_atomic_load(p, __ATOMIC_RELAXED, __HIP_MEMORY_SCOPE_AGENT); }
__device__ __forceinline__ unsigned xb_add(unsigned* p, unsigned v) { return __hip_atomic_fetch_add(p, v, __ATOMIC_RELAXED, __HIP_MEMORY_SCOPE_AGENT); }
__device__ __forceinline__ unsigned xb_xcc_id() { return (unsigned)__builtin_amdgcn_s_getreg((3 << 11) | 20) & 0xFu; }
#define XB_SPIN(cond, bar) do { unsigned _sp = 0; while (cond) { __builtin_amdgcn_s_sleep(1); \
    if ((++_sp & 255u) == 0u) { if (xb_ld(&(bar)[XB_TMO])) break; if (_sp > XB_SPIN_CAP) { atomicAdd(&(bar)[XB_TMO], 1u); break; } } } } while (0)
struct XcdBarrier { unsigned* bar; unsigned x; volatile LAS unsigned* st; };
__device__ __forceinline__ XcdBarrier xcd_barrier_post(unsigned* bar, volatile LAS unsigned* st) {
    XcdBarrier b; b.bar = bar; b.x = xb_xcc_id(); b.st = st;
    if (threadIdx.x == 0) (void)xb_add(&bar[XB_XCNT(b.x)], 1u);
    return b;
}
__device__ __forceinline__ void xcd_barrier_complete(unsigned* bar, unsigned x, unsigned& nloc, unsigned& nx) {
    const unsigned G = gridDim.x * gridDim.y * gridDim.z;
    unsigned sum, cnt, mine, sp = 0u;
    for (;;) {
        sum = 0u; cnt = 0u; mine = 0u;
#pragma unroll
        for (unsigned j = 0; j < 16; ++j) { const unsigned c = xb_ld(&bar[XB_XCNT(j)]); sum += c; cnt += (c > 0u) ? 1u : 0u; mine = (j == x) ? c : mine; }
        if (sum == G) break;
        __builtin_amdgcn_s_sleep(1);
        if ((++sp & 255u) == 0u) { if (xb_ld(&bar[XB_TMO])) break; if (sp > XB_SPIN_CAP) { atomicAdd(&bar[XB_TMO], 1u); break; } }
    }
    nloc = mine > 0u ? mine : 1u; nx = cnt > 0u ? cnt : 1u;
}
__device__ __forceinline__ void xcd_barrier(const XcdBarrier& b) {
    asm volatile("s_waitcnt vmcnt(0)" ::: "memory");
    __syncthreads();
    if (threadIdx.x == 0) {
        unsigned* bar = b.bar;
        __builtin_amdgcn_s_waitcnt(0);
        unsigned nloc = b.st[0], nx = b.st[1];
        if (nloc == 0u) { xcd_barrier_complete(bar, b.x, nloc, nx); b.st[0] = nloc; b.st[1] = nx; }
        const unsigned old = xb_add(&bar[XB_XSUB(b.x)], 1u);
        const unsigned gen = old / nloc;
        if (old + 1u == (gen + 1u) * nloc) {
            __builtin_amdgcn_fence(__ATOMIC_RELEASE, "agent");
            asm volatile("s_waitcnt vmcnt(0)" ::: "memory");
            const unsigned og = xb_add(&bar[XB_TOP], 1u);
            const unsigned tg = og / nx;
            if (og + 1u == (tg + 1u) * nx) xb_add(&bar[XB_TOPGEN], 1u);
            else XB_SPIN(xb_ld(&bar[XB_TOPGEN]) == tg, bar);
            __builtin_amdgcn_fence(__ATOMIC_ACQUIRE, "agent");
            xb_add(&bar[XB_XGEN(b.x)], 1u);
            asm volatile("s_waitcnt vmcnt(0)" ::: "memory");
        } else {
            XB_SPIN(xb_ld(&bar[XB_XGEN(b.x)]) == gen, bar);
            __builtin_amdgcn_fence(__ATOMIC_ACQUIRE, "agent");
            asm volatile("s_waitcnt vmcnt(0)" ::: "memory");
        }
    }
    __syncthreads();
}

#ifdef PROBE_A
#define STAMP(id) do { if (threadIdx.x == 0) ((unsigned long long*)(g_dbg))[(size_t)blockIdx.x * 64 + (id)] = __builtin_amdgcn_s_memrealtime(); } while (0)
#else
#define STAMP(id) do { } while (0)
#endif
#define g_dbg (F.ws + WS_END)

struct Args { const float* in[37]; float* out; unsigned char* ws; int ph_lo, ph_hi; int flags, pad; };

struct Frame {
    LAS unsigned char* lds;
    unsigned char* smem;
    volatile LAS unsigned* MISC;
    unsigned* ctl;
    int tid, lane, wave, vcu, G;
    unsigned char* ws;
};

struct MapNat { int off; __device__ __forceinline__ int operator()(int n) const { return off + n; } };
struct MapGate { __device__ __forceinline__ int operator()(int s) const {
    const int k4 = s >> 10, d = s & 1023, pn = d >> 6, dd = d & 63;
    return pn * 256 + 128 * (k4 >> 1) + 32 * (dd >> 4) + 16 * (k4 & 1) + 4 * ((dd >> 2) & 3) + (dd & 3); } };
struct MapMoe13 { int which; __device__ __forceinline__ int operator()(int hid) const {
    const int pn = hid >> 7, r = hid & 127;
    return pn * 256 + 128 * (r >> 6) + 32 * ((r >> 4) & 3) + 16 * which + 4 * ((r >> 2) & 3) + (r & 3); } };

template <class RowMap>
__device__ __forceinline__ void transpose_item(const float* W, int K, int N, bf16_t* WT, LAS float* scr, int item, int lane, const RowMap rm) {
    const int nblk = N / 32, kb = item / nblk, nb = item % nblk, k0 = 64 * kb, n0 = 32 * nb;
#pragma unroll 8
    for (int i = 0; i < 32; ++i) { const int kk = 2 * i + (lane >> 5); scr[kk * 33 + (lane & 31)] = W[(size_t)(k0 + kk) * N + n0 + (lane & 31)]; }
    LDS_WAIT(); asm volatile("" ::: "memory");
    const int c = lane & 7;
#pragma unroll
    for (int j = 0; j < 4; ++j) { const int n = (lane >> 3) + 8 * j; const LAS float* s = scr + (8 * c) * 33 + n;
        v4u o; o.x = pk2(s[0 * 33], s[1 * 33]); o.y = pk2(s[2 * 33], s[3 * 33]); o.z = pk2(s[4 * 33], s[5 * 33]); o.w = pk2(s[6 * 33], s[7 * 33]);
        *(GAS v4u*)(WT + (size_t)rm(n0 + n) * K + k0 + 8 * c) = o; }
    LDS_WAIT(); asm volatile("" ::: "memory");
}

__device__ __forceinline__ unsigned pk4_fp8(float a, float b, float c, float d) { int w = 0; w = __builtin_amdgcn_cvt_pk_fp8_f32(a, b, w, false); w = __builtin_amdgcn_cvt_pk_fp8_f32(c, d, w, true); return (unsigned)w; }
template <class RowMap>
__device__ __forceinline__ void transpose_item_fp8(const float* W, int K, int N, unsigned char* WT, LAS unsigned char* scr, int item, int lane, const RowMap rm, const float scl) {
    const int nblk = N / 32, kb = item / nblk, nb = item % nblk, k0 = 128 * kb, n0 = 32 * nb;
#pragma unroll 16
    for (int i = 0; i < 64; ++i) { const int kk = 2 * i + (lane >> 5); const float v = W[(size_t)(k0 + kk) * N + n0 + (lane & 31)] * scl;
        scr[(lane & 31) * 144 + kk] = (unsigned char)__builtin_amdgcn_cvt_pk_fp8_f32(v, 0.f, 0, false); }
    LDS_WAIT(); asm volatile("" ::: "memory");
    const int c = lane & 7;
#pragma unroll
    for (int j = 0; j < 4; ++j) { const int n = (lane >> 3) + 8 * j;
        *(GAS v4u*)(WT + (size_t)rm(n0 + n) * K + k0 + 16 * c) = *(const LAS v4u*)(scr + n * 144 + 16 * c); }
    LDS_WAIT(); asm volatile("" ::: "memory");
}

__device__ __forceinline__ void conv_mixer_weights(Frame& F, const Args& a) {
    LAS float* scr = (LAS float*)(F.lds + F.wave * 16384);
    const int gw = F.vcu * NWAVES + F.wave, NGW = F.G * NWAVES;
    constexpr int I_IN = 16 * 56, I_MG = 8 * 128, I_BR = 4 * 32, I_OUT = 16 * 32, PER_L = I_IN + I_MG + 4 * I_BR + I_OUT;
    for (int it = gw; it < DEPTH * PER_L; it += NGW) {
        const int l = it / PER_L; int r = it % PER_L;
        unsigned char* wb = F.ws + WS_WMIX + (size_t)l * WMIX_STRIDE;
        if (r < I_IN) { transpose_item(a.in[2] + (size_t)l * D * IN_COLS, D, IN_COLS, (bf16_t*)(wb + WMIX_IN), scr, r, F.lane, MapNat{0}); continue; } r -= I_IN;
        if (r < I_MG) { transpose_item_fp8(a.in[24] + (size_t)l * D * 4096, D, 4096, wb + WMIX_MG, (LAS unsigned char*)scr, r, F.lane, MapGate{}, MG_SCALE); continue; } r -= I_MG;
        if (r < 4 * I_BR) { const int k4 = r / I_BR; transpose_item(a.in[26] + ((size_t)l * 4 + k4) * W * D, W, D, (bf16_t*)(wb + WMIX_BR), scr, r % I_BR, F.lane, MapNat{k4 * 1024}); continue; } r -= 4 * I_BR;
        transpose_item(a.in[27] + (size_t)l * D * D, D, D, (bf16_t*)(wb + WMIX_OUT), scr, r, F.lane, MapNat{0});
    }
}
__device__ __forceinline__ void conv_expert_weights(Frame& F, const Args& a, int l) {
    LAS unsigned char* scr = F.lds + F.wave * 16384;
    const int gw = F.vcu * NWAVES + F.wave, NGW = F.G * NWAVES;
    constexpr int I_13 = 8 * 16, I_2 = 4 * 32, PER_E = 2 * I_13 + I_2;
    for (int it = gw; it < NEXP * PER_E; it += NGW) {
        const int e = it / PER_E; int r = it % PER_E;
        unsigned char* w13 = F.ws + WS_WEXP + (size_t)e * 1024 * 1024;
        unsigned char* w2t = F.ws + WS_WEXP + WEXP_W2 + (size_t)e * 1024 * 512;
        if (r < I_13) { transpose_item_fp8(a.in[33] + ((size_t)l * NEXP + e) * D * DEXP, D, DEXP, w13, scr, r, F.lane, MapMoe13{0}, W13_SCALE); continue; } r -= I_13;
        if (r < I_13) { transpose_item_fp8(a.in[34] + ((size_t)l * NEXP + e) * D * DEXP, D, DEXP, w13, scr, r, F.lane, MapMoe13{1}, W13_SCALE); continue; } r -= I_13;
        transpose_item_fp8(a.in[35] + ((size_t)l * NEXP + e) * DEXP * D, DEXP, D, w2t, scr, r, F.lane, MapNat{0}, W2_SCALE);
    }
}
__device__ __forceinline__ void prep_tables(Frame& F, const Args& a) {
    for (int idx = F.vcu * 512 + F.tid; idx < DEPTH * 65536; idx += F.G * 512) {
        const int l = idx >> 16, gid = idx & 65535;
        float* tab = (float*)(F.ws + WS_TAB + (size_t)l * MiB);
        unsigned char* sm = F.ws + WS_TAB + (size_t)l * MiB + SM_OFF;
        if (gid < 1024) {
            const int g = gid >> 6;
            const double lre = fmin((double)a.in[7][l * 1024 + gid], -1e-4);
            const double lim = (double)a.in[8][l * 1024 + gid];
            const double step = exp((double)a.in[9][l * 16 + g]);
            const double er = exp(lre * step), ar = er * cos(lim * step), ai = er * sin(lim * step);
            const double nr = ar - 1.0, ni = ai, den = lre * lre + lim * lim;
            const double cr = (nr * lre + ni * lim) / den, ci = (ni * lre - nr * lim) / den;
            float* at = (float*)(sm + SM_ATAB) + gid * 12;
            const double pw[5] = {1.0, 4.0, 8.0, 12.0, 64.0};
            for (int i = 0; i < 5; ++i) { const double e = exp(lre * step * pw[i]); at[2 * i] = (float)(e * cos(lim * step * pw[i])); at[2 * i + 1] = (float)(e * sin(lim * step * pw[i])); }
            at[10] = 0.f; at[11] = 0.f;
            for (int h = 0; h < 16; ++h) {
                const double br = (double)a.in[10][((size_t)l * 1024 + gid) * 16 + h], bi = (double)a.in[11][((size_t)l * 1024 + gid) * 16 + h];
                ((bf16_t*)(sm + SM_BRE))[gid * 16 + h] = f2bf((float)(cr * br - ci * bi));
                ((bf16_t*)(sm + SM_BIM))[gid * 16 + h] = f2bf((float)(cr * bi + ci * br));
            }
        }
        if (gid < 256) { const double lam = (double)a.in[23][l * 256 + gid]; tab[TB_NLOG + gid] = (float)(-8.0 * log1p(exp(-lam))); }
        if (gid < 49152) { const int k = gid / 48, o = gid % 48; const float gk = a.in[28][(size_t)l * 1024 + k];
            tab[TB_RW + gid] = (o < 4) ? gk * a.in[29][((size_t)l * 1024 + k) * 4 + o] : (o < 36 ? gk * a.in[31][((size_t)l * 1024 + k) * 32 + (o - 4)] : 0.f); }
        if (gid < 16384) { const int g = gid >> 12, d = (gid >> 6) & 63, cc = gid & 63; const size_t si = ((size_t)(l * 4 + g) * 64 + cc) * 64 + d;
            ((bf16_t*)(sm + SM_POOLT))[gid] = f2bf(a.in[4][si]); ((bf16_t*)(sm + SM_WAT))[gid] = f2bf(a.in[19][si]); ((bf16_t*)(sm + SM_WXT))[gid] = f2bf(a.in[21][si]); }
        if (gid < 32768) { const int g = gid >> 11, cc = (gid >> 7) & 15, k = gid & 127, p = k >> 1; const size_t si = ((size_t)(l * 16 + g) * 16 + cc) * 64 + p;
            ((bf16_t*)(sm + SM_CMAT))[gid] = f2bf((k & 1) ? -a.in[13][si] : a.in[12][si]); }
        { const int col = gid >> 8, k = gid & 255; ((bf16_t*)(sm + SM_GLUT))[gid] = f2bf(a.in[15][((size_t)l * 256 + k) * 256 + col]); }
    }
}

__device__ __forceinline__ void norm_phase(Frame& F, const float* hin, const bf16_t* y, const float* g, float* hout, bf16_t* xn, float* out, const float oadd = 0.0f, unsigned char* xn8 = nullptr) {
    const int gw = F.vcu * NWAVES + F.wave, NGW = F.G * NWAVES, lane = F.lane;
    f32x4 gg[4];
#pragma unroll
    for (int j = 0; j < 4; ++j) gg[j] = *(const f32x4*)(g + 4 * lane + 256 * j);
    for (int m0 = gw; m0 < T; m0 += 4 * NGW) {
        f32x4 v[4][4]; uint2 ya[4][4], yb[4][4];
#pragma unroll
        for (int i = 0; i < 4; ++i) {
            const int m = m0 + i * NGW;
            if (m < T) {
#pragma unroll
                for (int j = 0; j < 4; ++j) {
                    const int col = 4 * lane + 256 * j;
                    v[i][j] = *(const f32x4*)(hin + (size_t)m * D + col);
                    if (y) { ya[i][j] = *(const uint2*)(y + ((size_t)m * 2 + 0) * D + col); yb[i][j] = *(const uint2*)(y + ((size_t)m * 2 + 1) * D + col); }
                }
            }
        }
            __builtin_amdgcn_sched_barrier(0);
#pragma unroll
        for (int i = 0; i < 4; ++i) {
            const int m = m0 + i * NGW;
            if (m < T) {
                float s = 0.f;
#pragma unroll
                for (int j = 0; j < 4; ++j) {
                    if (y) {
                        v[i][j].x += __uint_as_float(ya[i][j].x << 16) + __uint_as_float(yb[i][j].x << 16);
                        v[i][j].y += __uint_as_float(ya[i][j].x & 0xffff0000u) + __uint_as_float(yb[i][j].x & 0xffff0000u);
                        v[i][j].z += __uint_as_float(ya[i][j].y << 16) + __uint_as_float(yb[i][j].y << 16);
                        v[i][j].w += __uint_as_float(ya[i][j].y & 0xffff0000u) + __uint_as_float(yb[i][j].y & 0xffff0000u);
                    }
                    s += v[i][j].x * v[i][j].x + v[i][j].y * v[i][j].y + v[i][j].z * v[i][j].z + v[i][j].w * v[i][j].w;
                }
#pragma unroll
                for (int o = 1; o < 64; o <<= 1) s += __shfl_xor(s, o);
                const float rstd = rsqrtf(s * (1.0f / D) + EPS);
#pragma unroll
                for (int j = 0; j < 4; ++j) {
                    const int col = 4 * lane + 256 * j;
                    if (hout) *(f32x4*)(hout + (size_t)m * D + col) = v[i][j];
                    const f32x4 o = v[i][j] * rstd * gg[j];
                    if (xn) { uint2 w; w.x = pk2(o.x, o.y); w.y = pk2(o.z, o.w); *(uint2*)(xn + (size_t)m * D + col) = w; }
                    if (xn8) *(unsigned*)(xn8 + (size_t)m * D + col) = pk4_fp8(o.x, o.y, o.z, o.w);
                    if (out) { f32x4 oo = o; if (m == 0 && col == 0) oo.x += oadd; *(f32x4*)(out + (size_t)m * D + col) = oo; }
                }
            }
        }
    }
}

constexpr int TROW = 528;
constexpr int TILE_BYTES = 64 * TROW;
constexpr int HROW = 272, HTILE = 16 * HROW;
constexpr int CARRY_OFF = 2 * TILE_BYTES + 8 * HTILE;

struct MixArgs {
    const bf16_t* proj; bf16_t* ys; const float* tab; const unsigned char* sm; unsigned char* ws;
    float2* s5st; float2* lruS; unsigned* flags; unsigned* tmo;
    const float *conv_a_w, *pool_b, *pool_scale, *s5_d, *glu_b, *lconv_w, *lconv_b, *ba, *bx;
};

typedef short bf16x8 __attribute__((ext_vector_type(8)));
__device__ __forceinline__ f32x4 mma16(bf16x8 a, bf16x8 b, f32x4 c) { return __builtin_amdgcn_mfma_f32_16x16x32_bf16(a, b, c, 0, 0, 0); }
__device__ __forceinline__ void ld8(const bf16_t* p, float (&x)[8]) {
    const v4u v = *(const v4u*)p;
    x[0] = __uint_as_float(v.x << 16); x[1] = __uint_as_float(v.x & 0xffff0000u); x[2] = __uint_as_float(v.y << 16); x[3] = __uint_as_float(v.y & 0xffff0000u);
    x[4] = __uint_as_float(v.z << 16); x[5] = __uint_as_float(v.z & 0xffff0000u); x[6] = __uint_as_float(v.w << 16); x[7] = __uint_as_float(v.w & 0xffff0000u);
}
__device__ __forceinline__ void ldf8(const float* p, float (&x)[8]) { const f32x4 a = *(const f32x4*)p, b = *(const f32x4*)(p + 4); x[0] = a.x; x[1] = a.y; x[2] = a.z; x[3] = a.w; x[4] = b.x; x[5] = b.y; x[6] = b.z; x[7] = b.w; }
typedef unsigned v2u __attribute__((ext_vector_type(2)));
__device__ __forceinline__ v4u pack8(const float (&x)[8]) { v4u o; o.x = pk2(x[0], x[1]); o.y = pk2(x[2], x[3]); o.z = pk2(x[4], x[5]); o.w = pk2(x[6], x[7]); return o; }
template <int N> __device__ __forceinline__ float dpp_row_shr(float oldv, float src) {
    return __int_as_float(__builtin_amdgcn_update_dpp(__float_as_int(oldv), __float_as_int(src), 0x110 + N, 0xf, 0xf, false));
}

typedef float f32x2_ __attribute__((ext_vector_type(2)));
template <bool FULL>
__device__ __forceinline__ void s5_groups(const MixArgs& A, LAS unsigned char* T0, LAS unsigned char* T1, LAS unsigned char* Hw, const LAS f32x2_* cS5, const int wave, const int lane, const int b, const int c) {
    const int j = lane & 15, q = lane >> 4; const unsigned char* sm = A.sm;
    const bf16x8 zf = (bf16x8){0, 0, 0, 0, 0, 0, 0, 0};
#pragma unroll 1
    for (int gi = 0; gi < 2; ++gi) {
        const int g = wave * 2 + gi;
        float ar[4], ai[4], a4r[4], a4i[4], a8r[4], a8i[4], aqr[4], aqi[4], hr[4], hi[4];
        bf16x8 bref[4], bimf[4];
#pragma unroll
        for (int st = 0; st < 4; ++st) {
            const int si = g * 64 + st * 16 + j;
            const float* at = (const float*)(sm + SM_ATAB) + si * 12;
            const f32x4 t0v = *(const f32x4*)at, t1v = *(const f32x4*)(at + 4);
            ar[st] = t0v.x; ai[st] = t0v.y; a4r[st] = t0v.z; a4i[st] = t0v.w; a8r[st] = t1v.x; a8i[st] = t1v.y;
            aqr[st] = q == 0 ? 1.f : (q == 1 ? t0v.z : (q == 2 ? t1v.x : t1v.z));
            aqi[st] = q == 0 ? 0.f : (q == 1 ? t0v.w : (q == 2 ? t1v.y : t1v.w));
            hr[st] = 0.f; hi[st] = 0.f;
            if (FULL) { const f32x2_ cv = cS5[si]; hr[st] = cv.x; hi[st] = cv.y; }
            bref[st] = (q < 2) ? *(const bf16x8*)((const bf16_t*)(sm + SM_BRE) + si * 16 + 8 * q) : zf;
            bimf[st] = (q < 2) ? *(const bf16x8*)((const bf16_t*)(sm + SM_BIM) + si * 16 + 8 * q) : zf;
        }
        bf16x8 cf[4];
        if (FULL) {
#pragma unroll
            for (int ks = 0; ks < 4; ++ks) cf[ks] = *(const bf16x8*)((const bf16_t*)(sm + SM_CMAT) + (g * 16 + j) * 128 + ks * 32 + 8 * q);
        }
        const f32x4 dv = *(const f32x4*)(A.s5_d + g * 16 + 4 * q);
#pragma unroll 1
        for (int tt = 0; tt < 4; ++tt) {
            const bf16x8 uf = (q < 2) ? *(const LAS bf16x8*)(T0 + (tt * 16 + j) * TROW + (g * 16 + 8 * q) * 2) : zf;
#pragma unroll
            for (int st = 0; st < 4; ++st) {
                const f32x4 z4 = (f32x4){0.f, 0.f, 0.f, 0.f};
                const f32x4 dre = mma16(uf, bref[st], z4), dim = mma16(uf, bimf[st], z4);
                float er = dre[0], ei = dim[0];
#pragma unroll
                for (int r = 1; r < 4; ++r) { const float nr = ar[st] * er - ai[st] * ei + dre[r], ni = ar[st] * ei + ai[st] * er + dim[r]; er = nr; ei = ni; }
                float x1r = __shfl_up(er, 16), x1i = __shfl_up(ei, 16), x2r = __shfl_up(er, 32), x2i = __shfl_up(ei, 32), x3r = __shfl_up(er, 48), x3i = __shfl_up(ei, 48);
                if (q < 1) { x1r = 0.f; x1i = 0.f; } if (q < 2) { x2r = 0.f; x2i = 0.f; } if (q < 3) { x3r = 0.f; x3i = 0.f; }
                float pr = x1r + (a4r[st] * x2r - a4i[st] * x2i) + (a8r[st] * x3r - a8i[st] * x3i) + (aqr[st] * hr[st] - aqi[st] * hi[st]);
                float pi = x1i + (a4r[st] * x2i + a4i[st] * x2r) + (a8r[st] * x3i + a8i[st] * x3r) + (aqr[st] * hi[st] + aqi[st] * hr[st]);
#pragma unroll
                for (int r = 0; r < 4; ++r) {
                    const float nr = ar[st] * pr - ai[st] * pi + dre[r], ni = ar[st] * pi + ai[st] * pr + dim[r]; pr = nr; pi = ni;
                    if (FULL) *(LAS unsigned*)(Hw + (4 * q + r) * HROW + (st * 16 + j) * 4) = pk2(nr, ni);
                }
                hr[st] = __shfl(pr, 48 + j); hi[st] = __shfl(pi, 48 + j);
            }
            if (FULL) {
                f32x4 y = (f32x4){0.f, 0.f, 0.f, 0.f};
#pragma unroll
                for (int ks = 0; ks < 4; ++ks) { const bf16x8 hf = *(const LAS bf16x8*)(Hw + j * HROW + (ks * 32 + 8 * q) * 2); y = mma16(cf[ks], hf, y); }
                const v2u uw = *(const LAS v2u*)(T0 + (tt * 16 + j) * TROW + (g * 16 + 4 * q) * 2);
                const float y0 = gelu_tanh(y[0] + dv[0] * __uint_as_float(uw.x << 16)), y1 = gelu_tanh(y[1] + dv[1] * __uint_as_float(uw.x & 0xffff0000u));
                const float y2 = gelu_tanh(y[2] + dv[2] * __uint_as_float(uw.y << 16)), y3 = gelu_tanh(y[3] + dv[3] * __uint_as_float(uw.y & 0xffff0000u));
                v2u w; w.x = pk2(y0, y1); w.y = pk2(y2, y3);
                *(LAS v2u*)(T1 + (tt * 16 + j) * TROW + (g * 16 + 4 * q) * 2) = w;
            }
        }
        if (!FULL && q == 0) {
#pragma unroll
            for (int st = 0; st < 4; ++st) __hip_atomic_store((unsigned long long*)(A.s5st + ((size_t)b * NCHUNK + c) * 1024 + g * 64 + st * 16 + j), (unsigned long long)__float_as_uint(hr[st]) | ((unsigned long long)__float_as_uint(hi[st]) << 32), RLX_AGENT);
        }
    }
}

__device__ __forceinline__ void mix_unit(const MixArgs& A, LAS unsigned char* lds, int unit, int tid, const XcdBarrier& bar_) {
    const int lane = tid & 63, wave = __builtin_amdgcn_readfirstlane(tid >> 6), j = lane & 15, q = lane >> 4;
    const int b = unit >> 5, c = unit & 31;
    const size_t t0 = (size_t)b * SEQ + c * CHUNK;
    LAS unsigned char* T0 = lds; LAS unsigned char* T1 = lds + TILE_BYTES; LAS unsigned char* Hw = lds + 2 * TILE_BYTES + wave * HTILE;
    const int cg = tid & 31, tg = tid >> 5, tl0 = tg * 4, pos0 = c * CHUNK + tl0;
    const bf16_t* prow = A.proj + (t0 + tl0) * IN_COLS + cg * 8;
    const unsigned char* sm = A.sm;
    LAS f32x2_* cS5 = (LAS f32x2_*)(lds + CARRY_OFF);
    LAS float* cLru = (LAS float*)(lds + CARRY_OFF + 8192);

    {
        float w0[8], w1[8], w2[8];
        ldf8(A.conv_a_w + 0 * 256 + cg * 8, w0); ldf8(A.conv_a_w + 1 * 256 + cg * 8, w1); ldf8(A.conv_a_w + 2 * 256 + cg * 8, w2);
        float v[6][8];
#pragma unroll
        for (int i = 0; i < 6; ++i) {
            if (pos0 - 2 + i >= 0) { float ac[8], ax[8]; ld8(prow + (long)(i - 2) * IN_COLS + 256, ac); ld8(prow + (long)(i - 2) * IN_COLS + 512, ax);
#pragma unroll
                for (int e = 0; e < 8; ++e) v[i][e] = ac[e] * ax[e]; }
            else {
#pragma unroll
                for (int e = 0; e < 8; ++e) v[i][e] = 0.f; }
        }
#pragma unroll
        for (int n = 0; n < 4; ++n) {
            float ab[8], o[8]; ld8(prow + (long)n * IN_COLS, ab);
#pragma unroll
            for (int e = 0; e < 8; ++e) o[e] = ab[e] * (w0[e] * v[n][e] + w1[e] * v[n + 1][e] + w2[e] * v[n + 2][e]);
            *(v4u*)(A.ys + (t0 + tl0 + n) * 1024 + cg * 8) = pack8(o);
        }
    }
    {
        const int win = 2 << (cg >> 3);
        float S[8], x0[8];
#pragma unroll
        for (int e = 0; e < 8; ++e) S[e] = 0.f;
        ld8(prow + 768, x0);
#pragma unroll
        for (int e = 0; e < 8; ++e) S[e] = x0[e];
        for (int i = 1; i < win; ++i) if (pos0 - i >= 0) { float x[8]; ld8(prow - (long)i * IN_COLS + 768, x);
#pragma unroll
            for (int e = 0; e < 8; ++e) S[e] += x[e]; }
        {
            const int cnt = (pos0 + 1 < win) ? pos0 + 1 : win; const float inv = 1.0f / (float)cnt; float o[8];
#pragma unroll
            for (int e = 0; e < 8; ++e) o[e] = S[e] * inv - x0[e];
            *(LAS v4u*)(T0 + tl0 * TROW + cg * 16) = pack8(o);
        }
#pragma unroll 1
        for (int n = 1; n < 4; ++n) {
            float xn_[8]; ld8(prow + (long)n * IN_COLS + 768, xn_);
#pragma unroll
            for (int e = 0; e < 8; ++e) S[e] += xn_[e];
            if (pos0 + n - win >= 0) { float xo[8]; ld8(prow + (long)(n - win) * IN_COLS + 768, xo);
#pragma unroll
                for (int e = 0; e < 8; ++e) S[e] -= xo[e]; }
            const int cnt = (pos0 + n + 1 < win) ? pos0 + n + 1 : win; const float inv = 1.0f / (float)cnt; float o[8];
#pragma unroll
            for (int e = 0; e < 8; ++e) o[e] = S[e] * inv - xn_[e];
            *(LAS v4u*)(T0 + (tl0 + n) * TROW + cg * 16) = pack8(o);
        }
    }
    {
        float w0[8], w1[8], w2[8], w3[8], cb[8];
        ldf8(A.lconv_w + 0 * 256 + cg * 8, w0); ldf8(A.lconv_w + 1 * 256 + cg * 8, w1); ldf8(A.lconv_w + 2 * 256 + cg * 8, w2); ldf8(A.lconv_w + 3 * 256 + cg * 8, w3); ldf8(A.lconv_b + cg * 8, cb);
        float x[7][8];
#pragma unroll
        for (int i = 0; i < 7; ++i) {
            if (pos0 - 3 + i >= 0) ld8(prow + (long)(i - 3) * IN_COLS + 1280, x[i]);
            else {
#pragma unroll
                for (int e = 0; e < 8; ++e) x[i][e] = 0.f; }
        }
#pragma unroll
        for (int n = 0; n < 4; ++n) {
            float o[8];
#pragma unroll
            for (int e = 0; e < 8; ++e) o[e] = w0[e] * x[n][e] + w1[e] * x[n + 1][e] + w2[e] * x[n + 2][e] + w3[e] * x[n + 3][e] + cb[e];
            *(LAS v4u*)(T1 + (tl0 + n) * TROW + cg * 16) = pack8(o);
        }
    }
    __syncthreads();

    const int hd = wave >> 1, dt0 = 2 * (wave & 1);
    {
        const bf16_t* WT = (const bf16_t*)(sm + SM_POOLT) + hd * 4096;
        f32x4 acc[2][4];
#pragma unroll
        for (int d = 0; d < 2; ++d)
#pragma unroll
            for (int tt = 0; tt < 4; ++tt) acc[d][tt] = (f32x4){0.f, 0.f, 0.f, 0.f};
#pragma unroll
        for (int ks = 0; ks < 2; ++ks) {
            bf16x8 wf[2];
#pragma unroll
            for (int d = 0; d < 2; ++d) wf[d] = *(const bf16x8*)(WT + ((dt0 + d) * 16 + j) * 64 + ks * 32 + 8 * q);
#pragma unroll
            for (int tt = 0; tt < 4; ++tt) { const bf16x8 xf = *(const LAS bf16x8*)(T0 + (tt * 16 + j) * TROW + (hd * 64 + ks * 32 + 8 * q) * 2);
#pragma unroll
                for (int d = 0; d < 2; ++d) acc[d][tt] = mma16(wf[d], xf, acc[d][tt]); }
        }
#pragma unroll
        for (int d = 0; d < 2; ++d) {
            const int ch0 = hd * 64 + (dt0 + d) * 16 + 4 * q;
            const f32x4 pb = *(const f32x4*)(A.pool_b + ch0), ps = *(const f32x4*)(A.pool_scale + ch0);
#pragma unroll
            for (int tt = 0; tt < 4; ++tt) { const f32x4 o = (acc[d][tt] + pb) * ps; v2u w; w.x = pk2(o.x, o.y); w.y = pk2(o.z, o.w);
                *(v2u*)(A.ys + (t0 + tt * 16 + j) * 1024 + 256 + ch0) = w; }
        }
    }
    float hloc[2][4][4], acum[2][4][4];
    {
        const bf16_t* WA = (const bf16_t*)(sm + SM_WAT) + hd * 4096; const bf16_t* WX = (const bf16_t*)(sm + SM_WXT) + hd * 4096;
        f32x4 ga[2][4], gx[2][4];
#pragma unroll
        for (int d = 0; d < 2; ++d)
#pragma unroll
            for (int tt = 0; tt < 4; ++tt) { ga[d][tt] = (f32x4){0.f, 0.f, 0.f, 0.f}; gx[d][tt] = (f32x4){0.f, 0.f, 0.f, 0.f}; }
#pragma unroll
        for (int ks = 0; ks < 2; ++ks) {
            bf16x8 wa[2], wx[2];
#pragma unroll
            for (int d = 0; d < 2; ++d) { wa[d] = *(const bf16x8*)(WA + ((dt0 + d) * 16 + j) * 64 + ks * 32 + 8 * q); wx[d] = *(const bf16x8*)(WX + ((dt0 + d) * 16 + j) * 64 + ks * 32 + 8 * q); }
#pragma unroll
            for (int tt = 0; tt < 4; ++tt) { const bf16x8 xf = *(const LAS bf16x8*)(T1 + (tt * 16 + j) * TROW + (hd * 64 + ks * 32 + 8 * q) * 2);
#pragma unroll
                for (int d = 0; d < 2; ++d) { ga[d][tt] = mma16(wa[d], xf, ga[d][tt]); gx[d][tt] = mma16(wx[d], xf, gx[d][tt]); } }
        }
#pragma unroll
        for (int d = 0; d < 2; ++d) {
            const int ch0 = hd * 64 + (dt0 + d) * 16 + 4 * q;
            const f32x4 bav = *(const f32x4*)(A.ba + ch0), bxv = *(const f32x4*)(A.bx + ch0), nlg = *(const f32x4*)(A.tab + TB_NLOG + ch0);
            float hin[4] = {0.f, 0.f, 0.f, 0.f}, aprod[4] = {1.f, 1.f, 1.f, 1.f};
#pragma unroll
            for (int tt = 0; tt < 4; ++tt) {
                const v2u xcw = *(const LAS v2u*)(T1 + (tt * 16 + j) * TROW + ch0 * 2);
                const float xc[4] = {__uint_as_float(xcw.x << 16), __uint_as_float(xcw.x & 0xffff0000u), __uint_as_float(xcw.y << 16), __uint_as_float(xcw.y & 0xffff0000u)};
#pragma unroll
                for (int r = 0; r < 4; ++r) {
                    const float rg = sigmoidf_(ga[d][tt][r] + bav[r]), ig = sigmoidf_(gx[d][tt][r] + bxv[r]);
                    const float la = nlg[r] * rg; float av = __expf(la); const float mult = sqrtf(fmaxf(1.0f - av * av, 0.f));
                    float bv = mult * ig * xc[r];
                    { const float ap = dpp_row_shr<1>(1.f, av), bp = dpp_row_shr<1>(0.f, bv); bv = av * bp + bv; av = av * ap; }
                    { const float ap = dpp_row_shr<2>(1.f, av), bp = dpp_row_shr<2>(0.f, bv); bv = av * bp + bv; av = av * ap; }
                    { const float ap = dpp_row_shr<4>(1.f, av), bp = dpp_row_shr<4>(0.f, bv); bv = av * bp + bv; av = av * ap; }
                    { const float ap = dpp_row_shr<8>(1.f, av), bp = dpp_row_shr<8>(0.f, bv); bv = av * bp + bv; av = av * ap; }
                    const float h = bv + av * hin[r], ac = av * aprod[r];
                    hloc[d][tt][r] = h; acum[d][tt][r] = ac;
                    hin[r] = __shfl(h, (lane & 48) | 15); aprod[r] = __shfl(ac, (lane & 48) | 15);
                }
            }
            if (j == 15) {
                float2* sp = A.lruS + ((size_t)b * NCHUNK + c) * 256 + ch0;
#pragma unroll
                for (int r = 0; r < 4; ++r) __hip_atomic_store((unsigned long long*)(sp + r), (unsigned long long)__float_as_uint(aprod[r]) | ((unsigned long long)__float_as_uint(hin[r]) << 32), RLX_AGENT);
            }
        }
    }
    __syncthreads();

#pragma unroll
    for (int n = 0; n < 4; ++n) *(LAS v4u*)(T0 + (tl0 + n) * TROW + cg * 16) = *(const v4u*)(prow + (long)n * IN_COLS + 1024);
    __syncthreads();
    s5_groups<false>(A, T0, T1, Hw, cS5, wave, lane, b, c);

    asm volatile("s_waitcnt vmcnt(0)" ::: "memory");
    __syncthreads();
    xcd_barrier(bar_);
    {
#pragma unroll
        for (int s2 = 0; s2 < 2; ++s2) {
            const int si = tid + 512 * s2;
            const float a64r = ((const float*)(sm + SM_ATAB))[si * 12 + 8], a64i = ((const float*)(sm + SM_ATAB))[si * 12 + 9];
            float hr_ = 0.f, hi_ = 0.f;
            for (int j0 = 0; j0 < c; j0 += 8) {
                unsigned long long sv[8];
#pragma unroll
                for (int u = 0; u < 8; ++u) { const int jj = (j0 + u < c) ? j0 + u : c - 1; sv[u] = __hip_atomic_load((const unsigned long long*)(A.s5st + ((size_t)b * NCHUNK + jj) * 1024 + si), RLX_AGENT); }
#pragma unroll
                for (int u = 0; u < 8; ++u) if (j0 + u < c) { const float sx = __uint_as_float((unsigned)sv[u]), sy = __uint_as_float((unsigned)(sv[u] >> 32)); const float nr = a64r * hr_ - a64i * hi_ + sx, ni = a64r * hi_ + a64i * hr_ + sy; hr_ = nr; hi_ = ni; }
            }
            cS5[si] = (f32x2_){hr_, hi_};
        }
        if (tid < 256) {
            float hin_ = 0.f;
            for (int j0 = 0; j0 < c; j0 += 8) {
                unsigned long long sv[8];
#pragma unroll
                for (int u = 0; u < 8; ++u) { const int jj = (j0 + u < c) ? j0 + u : c - 1; sv[u] = __hip_atomic_load((const unsigned long long*)(A.lruS + ((size_t)b * NCHUNK + jj) * 256 + tid), RLX_AGENT); }
#pragma unroll
                for (int u = 0; u < 8; ++u) if (j0 + u < c) hin_ = __uint_as_float((unsigned)sv[u]) * hin_ + __uint_as_float((unsigned)(sv[u] >> 32));
            }
            cLru[tid] = hin_;
        }
    }
    __syncthreads();

#pragma unroll
    for (int d = 0; d < 2; ++d) {
        const int ch0 = hd * 64 + (dt0 + d) * 16 + 4 * q;
        float hin[4];
#pragma unroll
        for (int r = 0; r < 4; ++r) hin[r] = cLru[ch0 + r];
#pragma unroll
        for (int tt = 0; tt < 4; ++tt) {
            const v2u gw = *(const v2u*)(A.proj + (t0 + tt * 16 + j) * IN_COLS + 1536 + ch0);
            const float g0 = gelu_tanh(__uint_as_float(gw.x << 16)), g1 = gelu_tanh(__uint_as_float(gw.x & 0xffff0000u)), g2 = gelu_tanh(__uint_as_float(gw.y << 16)), g3 = gelu_tanh(__uint_as_float(gw.y & 0xffff0000u));
            v2u w; w.x = pk2((hloc[d][tt][0] + acum[d][tt][0] * hin[0]) * g0, (hloc[d][tt][1] + acum[d][tt][1] * hin[1]) * g1);
            w.y = pk2((hloc[d][tt][2] + acum[d][tt][2] * hin[2]) * g2, (hloc[d][tt][3] + acum[d][tt][3] * hin[3]) * g3);
            *(v2u*)(A.ys + (t0 + tt * 16 + j) * 1024 + 768 + ch0) = w;
        }
    }

    s5_groups<true>(A, T0, T1, Hw, cS5, wave, lane, b, c);
    {
        __syncthreads();
        const bf16_t* GT = (const bf16_t*)(sm + SM_GLUT);
        f32x4 acc[2][4];
#pragma unroll
        for (int d = 0; d < 2; ++d)
#pragma unroll
            for (int tt = 0; tt < 4; ++tt) acc[d][tt] = (f32x4){0.f, 0.f, 0.f, 0.f};
#pragma unroll 2
        for (int ks = 0; ks < 8; ++ks) {
            bf16x8 wf[2];
#pragma unroll
            for (int d = 0; d < 2; ++d) wf[d] = *(const bf16x8*)(GT + ((wave * 2 + d) * 16 + j) * 256 + ks * 32 + 8 * q);
#pragma unroll
            for (int tt = 0; tt < 4; ++tt) { const bf16x8 xf = *(const LAS bf16x8*)(T1 + (tt * 16 + j) * TROW + (ks * 32 + 8 * q) * 2);
#pragma unroll
                for (int d = 0; d < 2; ++d) acc[d][tt] = mma16(wf[d], xf, acc[d][tt]); }
        }
#pragma unroll
        for (int d = 0; d < 2; ++d) {
            const int col0 = (wave * 2 + d) * 16 + 4 * q;
            const f32x4 gb = *(const f32x4*)(A.glu_b + col0);
#pragma unroll
            for (int tt = 0; tt < 4; ++tt) {
                const v2u yw = *(const LAS v2u*)(T1 + (tt * 16 + j) * TROW + col0 * 2);
                const f32x4 s = acc[d][tt] + gb;
                v2u w; w.x = pk2(__uint_as_float(yw.x << 16) * sigmoidf_(s.x), __uint_as_float(yw.x & 0xffff0000u) * sigmoidf_(s.y));
                w.y = pk2(__uint_as_float(yw.y << 16) * sigmoidf_(s.z), __uint_as_float(yw.y & 0xffff0000u) * sigmoidf_(s.w));
                *(v2u*)(A.ys + (t0 + tt * 16 + j) * 1024 + 512 + col0) = w;
            }
        }
    }
    __syncthreads();
}

__device__ __forceinline__ void router_phase(Frame& F, const float* h, const float* g2, const float* Wp, const float* rgb, const float* reb,
                                             bf16_t* xn, unsigned* cnt, int* buf_ts, float* buf_w) {
    LAS float* part = (LAS float*)(F.lds);
    LAS float* lg = (LAS float*)(F.lds + 98304);
    LAS float* rs = (LAS float*)(F.lds + 98304 + 12288);
    const int lane = F.lane, wave = F.wave, tid = F.tid, j = lane & 15, q = lane >> 4;
    for (int blk = blockIdx.x; blk < T / 64; blk += F.G) {
        const int m0 = blk * 64;
        {
            f32x4 v[8][4];
#pragma unroll
            for (int i = 0; i < 8; ++i)
#pragma unroll
                for (int jj = 0; jj < 4; ++jj) v[i][jj] = *(const f32x4*)(h + (size_t)(m0 + wave * 8 + i) * D + 4 * lane + 256 * jj);
            f32x4 gg[4];
#pragma unroll
            for (int jj = 0; jj < 4; ++jj) gg[jj] = *(const f32x4*)(g2 + 4 * lane + 256 * jj);
            __builtin_amdgcn_sched_barrier(0);
#pragma unroll
            for (int i = 0; i < 8; ++i) {
                float s = 0.f;
#pragma unroll
                for (int jj = 0; jj < 4; ++jj) s += v[i][jj].x * v[i][jj].x + v[i][jj].y * v[i][jj].y + v[i][jj].z * v[i][jj].z + v[i][jj].w * v[i][jj].w;
#pragma unroll
                for (int o = 1; o < 64; o <<= 1) s += __shfl_xor(s, o);
                const float rstd = rsqrtf(s * (1.0f / D) + EPS);
                if (lane == 0) rs[wave * 8 + i] = rstd;
#pragma unroll
                for (int jj = 0; jj < 4; ++jj) {
                    const f32x4 o = v[i][jj] * rstd * gg[jj];
                    *(unsigned*)((unsigned char*)xn + (size_t)(m0 + wave * 8 + i) * D + 4 * lane + 256 * jj) = pk4_fp8(o.x, o.y, o.z, o.w);
                }
            }
        }
        STAMP(48);
        f32x4 acc[3][4];
#pragma unroll
        for (int ot = 0; ot < 3; ++ot)
#pragma unroll
            for (int tt = 0; tt < 4; ++tt) acc[ot][tt] = (f32x4){0.f, 0.f, 0.f, 0.f};
        LAS float* xq = (LAS float*)(F.lds);
#pragma unroll 1
        for (int kq = 0; kq < 4; ++kq) {
            f32x4 hv[8]; float af[8][3];
#pragma unroll
            for (int i = 0; i < 8; ++i) hv[i] = *(const f32x4*)(h + (size_t)(m0 + wave * 8 + i) * D + kq * 256 + 4 * lane);
#pragma unroll
            for (int ks = 0; ks < 8; ++ks)
#pragma unroll
                for (int ot = 0; ot < 3; ++ot) af[ks][ot] = Wp[(size_t)(kq * 256 + wave * 32 + ks * 4 + q) * 48 + ot * 16 + j];
            __builtin_amdgcn_sched_barrier(0);
            if (kq) __syncthreads();
#pragma unroll
            for (int i = 0; i < 8; ++i) {
                typedef float f32x2q __attribute__((ext_vector_type(2)));
                LAS float* dst = xq + (wave * 8 + i) * 258 + 4 * lane;
                *(LAS f32x2q*)dst = (f32x2q){hv[i].x, hv[i].y}; *(LAS f32x2q*)(dst + 2) = (f32x2q){hv[i].z, hv[i].w};
            }
            __syncthreads();
#pragma unroll
            for (int ks = 0; ks < 8; ++ks) {
                float bf[4];
#pragma unroll
                for (int tt = 0; tt < 4; ++tt) bf[tt] = xq[(tt * 16 + j) * 258 + wave * 32 + ks * 4 + q];
#pragma unroll
                for (int ot = 0; ot < 3; ++ot)
#pragma unroll
                    for (int tt = 0; tt < 4; ++tt) acc[ot][tt] = __builtin_amdgcn_mfma_f32_16x16x4f32(af[ks][ot], bf[tt], acc[ot][tt], 0, 0, 0);
            }
        }
        __syncthreads();
#pragma unroll
        for (int ot = 0; ot < 3; ++ot)
#pragma unroll
            for (int tt = 0; tt < 4; ++tt) *(LAS f32x4*)(part + ((wave * 12 + ot * 4 + tt) * 64 + lane) * 4) = acc[ot][tt];
        STAMP(49);
        __syncthreads();
        STAMP(50);
        for (int idx = tid; idx < 12 * 256; idx += 512) {
            const int tile = idx >> 8, ln = (idx >> 2) & 63, r = idx & 3, ot = tile >> 2, tt = tile & 3;
            float s = 0.f;
#pragma unroll
            for (int w = 0; w < 8; ++w) s += part[(w * 12 + tile) * 256 + (idx & 255)];
            const int tok = tt * 16 + (ln & 15), o = ot * 16 + 4 * (ln >> 4) + r;
            lg[tok * 48 + o] = s * rs[tok];
        }
        __syncthreads();
        STAMP(51);
        if (tid < 64) {
            const int m = m0 + tid;
            float gl[4], mx = -1e30f; int gi = 0;
#pragma unroll
            for (int i = 0; i < 4; ++i) { gl[i] = lg[tid * 48 + i] + rgb[i]; if (gl[i] > mx) { mx = gl[i]; gi = i; } }
            float den = 0.f;
#pragma unroll
            for (int i = 0; i < 4; ++i) den += __expf(gl[i] - mx);
            const float gval = 1.0f / den;
            float v1 = -1e30f, v2 = -1e30f; int i1 = 0, i2 = 0;
            for (int i = 0; i < 8; ++i) { const float el = lg[tid * 48 + 4 + gi * 8 + i] + reb[gi * 8 + i]; if (el > v1) { v2 = v1; i2 = i1; v1 = el; i1 = i; } else if (el > v2) { v2 = el; i2 = i; } }
            const float e2 = __expf(v2 - v1), w1 = gval / (1.0f + e2), w2 = gval * e2 / (1.0f + e2);
            const int ex1 = gi * 8 + i1, ex2 = gi * 8 + i2;
            const unsigned r1 = atomicAdd(&cnt[ex1 * 64], 1u), r2 = atomicAdd(&cnt[ex2 * 64], 1u);
            buf_ts[ex1 * CAP + r1] = m * 2 + 0; buf_w[ex1 * CAP + r1] = w1;
            buf_ts[ex2 * CAP + r2] = m * 2 + 1; buf_w[ex2 * CAP + r2] = w2;
        }
        __syncthreads();
    }
}

__device__ __forceinline__ void build_plan(Frame& F, const unsigned* cnt) {
    LAS int* plan = (LAS int*)(F.lds + PLAN_OFF);
    if (F.tid < 64) {
        const int e = F.tid & 31;
        const int ce = (int)__hip_atomic_load(cnt + e * 64, RLX_AGENT);
        const int nf = ce >> 8, rem = ce & 255, big = rem > 128 ? 1 : 0, sml = (rem > 0 && rem <= 128) ? 1 : 0;
        int pf = nf, pb = big, ps = sml;
#pragma unroll
        for (int o = 1; o < 32; o <<= 1) { const int a = __shfl_up(pf, o, 32), b = __shfl_up(pb, o, 32), c = __shfl_up(ps, o, 32); if (e >= o) { pf += a; pb += b; ps += c; } }
        const int NF = __shfl(pf, 31, 32), NB = __shfl(pb, 31, 32), NS = __shfl(ps, 31, 32);
        if (F.tid < 32) {
            plan[321 + e] = ce;
            for (int jb = 0; jb < nf; ++jb) { const int p = pf - nf + jb; if (p < MAXBLK) { plan[1 + p] = e; plan[1 + MAXBLK + p] = jb; } }
            if (big) { const int p = NF + pb - 1; if (p < MAXBLK) { plan[1 + p] = e; plan[1 + MAXBLK + p] = nf; } }
            if (sml) { const int p = NF + NB + ps - 1; if (p < MAXBLK) { plan[1 + p] = e; plan[1 + MAXBLK + p] = nf; } }
            if (e == 0) { const int tot = NF + NB + NS; plan[0] = tot < MAXBLK ? tot : MAXBLK; }
        }
    }
    __syncthreads();
}

struct DenseSched {
    static constexpr bool GATHER = false, HALF = false, WAITS = false, PUBLISHES = false;
    pg8::StaticOrder ord; const char* A; const char* Bt; int lda, K; int a_sh, a_cs; int es;
    __device__ __forceinline__ bool next(int i, pg8::Unit& u) const { return ord.next(i, u); }
    __device__ __forceinline__ const char* a_base(const pg8::Unit& u) const { return A + (size_t)u.pm * 256 * lda * es + (size_t)((u.pn >> a_sh) * a_cs); }
    __device__ __forceinline__ const char* b_base(const pg8::Unit& u) const { return Bt + (size_t)u.pn * 256 * K * es; }
    __device__ __forceinline__ unsigned gather_off(const pg8::Unit&, int) const { return 0u; }
    __device__ __forceinline__ bool half_only(const pg8::Unit&) const { return false; }
};
struct Moe1Sched {
    static constexpr bool GATHER = true, HALF = true, WAITS = false, PUBLISHES = false;
    const char* xn; const char* w13; const LAS int* plan; const int* buf_ts; int G, c, lda; unsigned* ready;
    __device__ __forceinline__ void done(const pg8::Unit& u) const { asm volatile("s_waitcnt vmcnt(0)" ::: "memory"); if ((threadIdx.x & 63) == 0) __hip_atomic_fetch_add(ready + 16 * u.pm, 1u, RLX_AGENT); }
    __device__ __forceinline__ bool next(int i, pg8::Unit& u) const { const int L = i * G + c; if (L >= 4 * plan[0]) return false; u.pm = L >> 2; u.pn = L & 3; return true; }
    __device__ __forceinline__ const char* a_base(const pg8::Unit&) const { return xn; }
    __device__ __forceinline__ const char* b_base(const pg8::Unit& u) const { return w13 + (size_t)plan[1 + u.pm] * (1024 * 1024) + (size_t)u.pn * (256 * 1024); }
    __device__ __forceinline__ unsigned gather_off(const pg8::Unit& u, int r) const {
        const int e = plan[1 + u.pm], lb = plan[1 + MAXBLK + u.pm], ce = plan[321 + e];
        int pos = lb * 256 + r; pos = pos < ce ? pos : ce - 1;
        return (unsigned)(buf_ts[e * CAP + pos] >> 1) * (unsigned)D;
    }
    __device__ __forceinline__ bool half_only(const pg8::Unit& u) const { const int e = plan[1 + u.pm], lb = plan[1 + MAXBLK + u.pm]; return plan[321 + e] - lb * 256 <= 128; }
};
struct Moe2Sched {
    static constexpr bool GATHER = false, HALF = true, WAITS = false, PUBLISHES = false;
    const char* hbuf; const char* w2t; const LAS int* plan; int G, c, lda; const unsigned* ready; unsigned* tmo;
    __device__ __forceinline__ void a_ready(const pg8::Unit& u) const {
        if (threadIdx.x < 64) {
            const unsigned long long t0 = __builtin_amdgcn_s_memrealtime(); unsigned polls = 0;
            while ((unsigned)__builtin_amdgcn_readfirstlane(__hip_atomic_load(ready + 16 * u.pm, RLX_AGENT)) < 32u) {
                if ((++polls & 255u) == 0u && __builtin_amdgcn_readfirstlane(__hip_atomic_load(tmo, RLX_AGENT)) != 0u) break;
                if (__builtin_amdgcn_s_memrealtime() - t0 > 2000000ull) { if (threadIdx.x == 0) __hip_atomic_store(tmo, 1u, RLX_AGENT); break; }
                __builtin_amdgcn_s_sleep(2); }
            __builtin_amdgcn_fence(__ATOMIC_ACQUIRE, "agent");
            asm volatile("s_waitcnt vmcnt(0)" ::: "memory");
        }
        asm volatile("" ::: "memory"); __builtin_amdgcn_s_barrier(); asm volatile("" ::: "memory");
    }
    __device__ __forceinline__ bool next(int i, pg8::Unit& u) const { const int L = i * G + c; if (L >= 4 * plan[0]) return false; u.pm = L >> 2; u.pn = L & 3; return true; }
    __device__ __forceinline__ const char* a_base(const pg8::Unit& u) const { return hbuf + (size_t)u.pm * 256 * DEXP; }
    __device__ __forceinline__ const char* b_base(const pg8::Unit& u) const { return w2t + (size_t)plan[1 + u.pm] * (1024 * 512) + (size_t)u.pn * (256 * 512); }
    __device__ __forceinline__ unsigned gather_off(const pg8::Unit&, int) const { return 0u; }
    __device__ __forceinline__ bool half_only(const pg8::Unit& u) const { const int e = plan[1 + u.pm], lb = plan[1 + MAXBLK + u.pm]; return plan[321 + e] - lb * 256 <= 128; }
};

using pg8::f32x4; using pg8::u32x4; using pg8::u32x2; using pg8::cvt_pk_bf16; using pg8::Unit; using pg8::HALF; using pg8::BM;
struct EpiStoreBf16 {
    static constexpr bool PERM = true;
    bf16_t* O; int ldc;
    __device__ __forceinline__ void operator()(const f32x4 (&acc)[2][2][4][2], const Unit& u, int wr, int wc, int fr, int fq) const {
        const int row0 = u.pm * BM + wr * 64 + fr, col0 = u.pn * BM + wc * 32 + 8 * fq;
#pragma unroll
        for (int ai = 0; ai < 2; ++ai)
#pragma unroll
            for (int m = 0; m < 4; ++m) { bf16_t* rowp = O + (size_t)(row0 + ai * HALF + m * 16) * ldc + col0;
#pragma unroll
                for (int bj = 0; bj < 2; ++bj) { const f32x4 v0 = acc[ai][bj][m][0], v1 = acc[ai][bj][m][1];
                    u32x4 w; w.x = cvt_pk_bf16(v0[0], v0[1]); w.y = cvt_pk_bf16(v0[2], v0[3]); w.z = cvt_pk_bf16(v1[0], v1[1]); w.w = cvt_pk_bf16(v1[2], v1[3]);
                    *(u32x4*)(rowp + bj * HALF) = w; } }
    }
};
struct EpiGateMerge {
    static constexpr bool PERM = false;
    const float* bias; const bf16_t* br; bf16_t* merged;
    __device__ __forceinline__ void operator()(const f32x4 (&acc)[2][2][4][2], const Unit& u, int wr, int wc, int fr, int fq) const {
        const int row0 = u.pm * BM + wr * 64 + fr, d0 = u.pn * 64 + wc * 16 + 4 * fq;
        f32x4 bv[4];
#pragma unroll
        for (int k4 = 0; k4 < 4; ++k4) bv[k4] = *(const f32x4*)(bias + k4 * 1024 + d0);
#pragma unroll
        for (int ai = 0; ai < 2; ++ai)
#pragma unroll
            for (int m = 0; m < 4; ++m) {
                const size_t row = (size_t)(row0 + ai * HALF + m * 16);
                f32x4 s = (f32x4){0.f, 0.f, 0.f, 0.f};
#pragma unroll
                for (int k4 = 0; k4 < 4; ++k4) {
                    const u32x2 b2 = *(const u32x2*)(br + row * 4096 + k4 * 1024 + d0);
                    const f32x4 a = acc[ai][k4 >> 1][m][k4 & 1] * (1.0f / MG_SCALE) + bv[k4];
                    s[0] += sigmoidf_(a[0]) * __uint_as_float(b2.x << 16);
                    s[1] += sigmoidf_(a[1]) * __uint_as_float(b2.x & 0xffff0000u);
                    s[2] += sigmoidf_(a[2]) * __uint_as_float(b2.y << 16);
                    s[3] += sigmoidf_(a[3]) * __uint_as_float(b2.y & 0xffff0000u);
                }
                u32x2 w; w.x = cvt_pk_bf16(s[0], s[1]); w.y = cvt_pk_bf16(s[2], s[3]);
                *(u32x2*)(merged + row * D + d0) = w;
            }
    }
};
struct EpiAddF32 {
    static constexpr bool PERM = false;
    float* h;
    __device__ __forceinline__ void operator()(const f32x4 (&acc)[2][2][4][2], const Unit& u, int wr, int wc, int fr, int fq) const {
        const int row0 = u.pm * BM + wr * 64 + fr, col0 = u.pn * BM + wc * 32 + 4 * fq;
#pragma unroll
        for (int ai = 0; ai < 2; ++ai)
#pragma unroll
            for (int m = 0; m < 4; ++m) { float* rowp = h + (size_t)(row0 + ai * HALF + m * 16) * D + col0;
#pragma unroll
                for (int bj = 0; bj < 2; ++bj)
#pragma unroll
                    for (int n = 0; n < 2; ++n) { f32x4* p = (f32x4*)(rowp + bj * HALF + n * 16); *p = *p + acc[ai][bj][m][n]; } }
    }
};
struct EpiMoe1 {
    static constexpr bool PERM = false;
    unsigned char* hbuf;
    __device__ __forceinline__ void operator()(const f32x4 (&acc)[2][2][4][2], const Unit& u, int wr, int wc, int fr, int fq) const {
        const int row0 = u.pm * BM + wr * 64 + fr, h0 = u.pn * 128 + wc * 16 + 4 * fq;
        const float si = 1.0f / W13_SCALE;
#pragma unroll
        for (int ai = 0; ai < 2; ++ai)
#pragma unroll
            for (int m = 0; m < 4; ++m) { unsigned char* rowp = hbuf + (size_t)(row0 + ai * HALF + m * 16) * DEXP + h0;
#pragma unroll
                for (int bj = 0; bj < 2; ++bj) { const f32x4 a1 = acc[ai][bj][m][0] * si, a3 = acc[ai][bj][m][1] * (si * H_SCALE);
                    const unsigned w = pk4_fp8(a1[0] * sigmoidf_(a1[0]) * a3[0], a1[1] * sigmoidf_(a1[1]) * a3[1], a1[2] * sigmoidf_(a1[2]) * a3[2], a1[3] * sigmoidf_(a1[3]) * a3[3]);
                    *(unsigned*)(rowp + bj * 64) = w; } }
    }
};
struct EpiMoe2 {
    static constexpr bool PERM = true;
    bf16_t* ymoe; const LAS int* plan; const int* buf_ts; const float* buf_w;
    __device__ __forceinline__ void operator()(const f32x4 (&acc)[2][2][4][2], const Unit& u, int wr, int wc, int fr, int fq) const {
        const int e = plan[1 + u.pm], lb = plan[1 + MAXBLK + u.pm], ce = plan[321 + e];
        const int col0 = u.pn * BM + wc * 32 + 8 * fq;
#pragma unroll
        for (int ai = 0; ai < 2; ++ai)
#pragma unroll
            for (int m = 0; m < 4; ++m) {
                const int pos = lb * 256 + ai * HALF + wr * 64 + m * 16 + fr;
                if (pos < ce) {
                    const int ts = buf_ts[e * CAP + pos]; const float wt = buf_w[e * CAP + pos] * (1.0f / (W2_SCALE * H_SCALE));
                    bf16_t* rowp = ymoe + (size_t)ts * D + col0;
#pragma unroll
                    for (int bj = 0; bj < 2; ++bj) { const f32x4 v0 = acc[ai][bj][m][0] * wt, v1 = acc[ai][bj][m][1] * wt;
                        u32x4 w; w.x = cvt_pk_bf16(v0[0], v0[1]); w.y = cvt_pk_bf16(v0[2], v0[3]); w.z = cvt_pk_bf16(v1[0], v1[1]); w.w = cvt_pk_bf16(v1[2], v1[3]);
                        *(u32x4*)(rowp + bj * HALF) = w; }
                }
            }
    }
};

__device__ __forceinline__ void make_mix_args(MixArgs& A, const Args& args, unsigned char* ws, int l) {
    A.proj = (const bf16_t*)(ws + WS_PROJ); A.ys = (bf16_t*)(ws + WS_YS); A.tab = (const float*)(ws + WS_TAB + (size_t)l * MiB); A.sm = ws + WS_TAB + (size_t)l * MiB + SM_OFF; A.ws = ws;
    A.s5st = (float2*)(ws + WS_S5ST); A.lruS = (float2*)(ws + WS_LRUS); A.flags = (unsigned*)(ws + WS_CTL) + CW_MIXF + 4096 * l; A.tmo = (unsigned*)(ws + WS_CTL) + CW_TMO;
    A.conv_a_w = args.in[3] + (size_t)l * 3 * W; A.pool_b = args.in[5] + (size_t)l * W; A.pool_scale = args.in[6] + (size_t)l * W;
    A.s5_d = args.in[14] + (size_t)l * W; A.glu_b = args.in[16] + (size_t)l * W;
    A.lconv_w = args.in[17] + (size_t)l * 4 * W; A.lconv_b = args.in[18] + (size_t)l * W; A.ba = args.in[20] + (size_t)l * W; A.bx = args.in[22] + (size_t)l * W;
}

__global__ void __launch_bounds__(NWAVES * 64, 2) mk_fwd(Args args) {
    extern __shared__ __attribute__((aligned(16))) unsigned char lds[];
    Frame F;
    F.lds = (LAS unsigned char*)lds; F.smem = lds;
    F.MISC = (volatile LAS unsigned*)(F.lds + MISC_OFF);
    F.tid = threadIdx.x; F.lane = F.tid & 63; F.wave = __builtin_amdgcn_readfirstlane(F.tid >> 6);
    F.G = gridDim.x; { const int bx = blockIdx.x; F.vcu = (F.G % 8 == 0) ? (bx % 8) * (F.G / 8) + bx / 8 : bx; }
    F.ws = args.ws; F.ctl = (unsigned*)(args.ws + WS_CTL);
    unsigned char* ws = args.ws; unsigned char* const args_ws_ = args.ws; (void)args_ws_;
    for (int u = F.tid; u < (LDS_BYTES - LDSCTL_OFF) / 4; u += NWAVES * 64) ((LAS unsigned*)(F.lds + LDSCTL_OFF))[u] = 0u;
    __syncthreads();
    XcdBarrier bar; bar.bar = F.ctl + CW_BAR; bar.x = 0; bar.st = nullptr;
    if (N_LAUNCHES == 1) bar = xcd_barrier_post(F.ctl + CW_BAR, F.MISC + 8);
    const int lo = args.ph_lo, hi = args.ph_hi;
    float* h = (float*)(ws + WS_H); bf16_t* xn = (bf16_t*)(ws + WS_XN); bf16_t* proj = (bf16_t*)(ws + WS_PROJ); bf16_t* ys = (bf16_t*)(ws + WS_YS);
    bf16_t* br = (bf16_t*)(ws + WS_R1); bf16_t* hbuf = (bf16_t*)(ws + WS_HBUF); bf16_t* ymoe = (bf16_t*)(ws + WS_YMOE); bf16_t* merged = (bf16_t*)(ws + WS_MERGED);
    int* buf_ts = (int*)(ws + WS_BUFTS); float* buf_w = (float*)(ws + WS_BUFW);

#ifndef KIND_MASK
#define KIND_MASK 0x7ff
#endif
#define PH_BEGIN(k, kind) if (lo <= (k) && (k) < hi && ((KIND_MASK >> (kind)) & 1)) { \
        { int t_ = threadIdx.x; asm volatile("" : "+v"(t_)); F.tid = t_; F.lane = t_ & 63; F.wave = __builtin_amdgcn_readfirstlane(t_ >> 6); } STAMP(2 * (k));
#ifdef PROBE_A
#define PH_END(k) __syncthreads(); STAMP(2 * (k) + 1); if ((k) + 1 < hi) xcd_barrier(bar); }
#else
#define PH_END(k) if ((k) + 1 < hi) xcd_barrier(bar); }
#endif

    PH_BEGIN(0, 0)
        prep_tables(F, args);
        conv_mixer_weights(F, args);
        conv_expert_weights(F, args, 0);
        norm_phase(F, args.in[0], nullptr, args.in[1], h, xn, nullptr, 0.0f, ws + WS_XN8);
    PH_END(0)

#ifdef PROBE_A
#ifndef PROBE_MODE
#define PROBE_MODE 0
#endif
#ifndef PROBE_SCALE
#define PROBE_SCALE 300
#endif
#ifndef PROBE_SHIFT
#define PROBE_SHIFT 0.0f
#endif
#define PROBE_REDUCE() { xcd_barrier(bar); \
        if (blockIdx.x == 0) { LAS float* red = (LAS float*)F.lds; const unsigned long long* dd = (const unsigned long long*)(g_dbg); \
            if (F.tid < 256) { const unsigned long long ta = __hip_atomic_load(dd + (size_t)F.tid * 64 + (PROBE_A), RLX_AGENT), tb = __hip_atomic_load(dd + (size_t)F.tid * 64 + (PROBE_B), RLX_AGENT), t00 = __hip_atomic_load(dd + (PROBE_A), RLX_AGENT); \
                red[F.tid] = (float)(long long)(tb - ta) * 0.01f; red[256 + F.tid] = (float)(long long)(ta - t00) * 0.01f; red[512 + F.tid] = (float)(long long)(tb - t00) * 0.01f; } \
            __syncthreads(); \
            if (F.tid == 0) { float sum = 0.f, mx = -1e30f, mna = 1e30f, mxb = -1e30f; for (int i = 0; i < 256; ++i) { sum += red[i]; mx = fmaxf(mx, red[i]); mna = fminf(mna, red[256 + i]); mxb = fmaxf(mxb, red[512 + i]); } \
                const float val = PROBE_MODE == 0 ? sum * (1.0f / 256.0f) : (PROBE_MODE == 1 ? mx : mxb - mna); \
                const float vq = val; \
                __hip_atomic_store((float*)((unsigned long long*)(g_dbg) + 256 * 64), vq, RLX_AGENT); } \
            __syncthreads(); } \
        xcd_barrier(bar); \
        oscale_ = __hip_atomic_load((float*)((unsigned long long*)(g_dbg) + 256 * 64), RLX_AGENT) * (1.0f / (float)(PROBE_SCALE)); }
#else
#define PROBE_REDUCE()
#endif
#define LAYER(l) { \
    const int pb = 1 + PH_PER_LAYER * (l); \
    const float* tab = (const float*)(ws + WS_TAB + (size_t)(l) * MiB); \
    const unsigned char* wmix = ws + WS_WMIX + (size_t)(l) * WMIX_STRIDE; \
    unsigned* cnt = F.ctl + CW_CNT + 2048 * (l); \
    PH_BEGIN(pb + 0, 1)   \
        DenseSched S; S.ord.init(T, IN_COLS, F.G, (int)blockIdx.x); S.A = (const char*)xn; S.Bt = (const char*)(wmix + WMIX_IN); S.lda = D; S.K = D; S.a_sh = 0; S.a_cs = 0; S.es = 2; \
        EpiStoreBf16 E{proj, IN_COLS}; \
        pg8::gemm_phase<EpiStoreBf16, DenseSched, true, true>(F.lds, F.tid, D, S, E); \
    PH_END(pb + 0) \
    PH_BEGIN(pb + 1, 2)   \
        MixArgs A; make_mix_args(A, args, ws, (l)); \
        for (int u = blockIdx.x; u < BATCH * NCHUNK; u += F.G) { int t_ = F.tid; asm volatile("" : "+v"(t_)); mix_unit(A, F.lds, u, t_, bar); } \
    PH_END(pb + 1) \
    PH_BEGIN(pb + 2, 3)   \
        DenseSched S; S.ord.init(T, 4096, F.G, (int)blockIdx.x); S.A = (const char*)ys; S.Bt = (const char*)(wmix + WMIX_BR); S.lda = 1024; S.K = 256; S.a_sh = 2; S.a_cs = 512; S.es = 2; \
        EpiStoreBf16 E{br, 4096}; \
        pg8::gemm_phase<EpiStoreBf16, DenseSched, true, true>(F.lds, F.tid, 256, S, E); \
    PH_END(pb + 2) \
    PH_BEGIN(pb + 3, 4)   \
        DenseSched S; S.ord.init(T, 4096, F.G, (int)blockIdx.x); S.A = (const char*)(ws + WS_XN8); S.Bt = (const char*)(wmix + WMIX_MG); S.lda = D; S.K = D; S.a_sh = 0; S.a_cs = 0; S.es = 1; \
        EpiGateMerge E{args.in[25] + (size_t)(l) * 4096, br, merged}; \
        pg8::gemm_phase<EpiGateMerge, DenseSched, true, true, true>(F.lds, F.tid, D, S, E); \
    PH_END(pb + 3) \
    PH_BEGIN(pb + 4, 5)   \
        DenseSched S; S.ord.init(T, D, F.G, (int)blockIdx.x); S.A = (const char*)merged; S.Bt = (const char*)(wmix + WMIX_OUT); S.lda = D; S.K = D; S.a_sh = 0; S.a_cs = 0; S.es = 2; \
        EpiAddF32 E{(args.flags & 1) ? (float*)(ws + WS_R1) : h}; \
        pg8::gemm_phase<EpiAddF32, DenseSched, true, true>(F.lds, F.tid, D, S, E); \
    PH_END(pb + 4) \
    PH_BEGIN(pb + 5, 6)   \
        if (args.flags & 1) router_phase(F, h, args.in[28] + (size_t)(l) * D, tab + TB_RW, args.in[30] + (size_t)(l) * 4, args.in[32] + (size_t)(l) * 32, xn, F.ctl + 16384, (int*)(ws + WS_END), (float*)(ws + WS_END + 2 * MiB)); \
        else router_phase(F, h, args.in[28] + (size_t)(l) * D, tab + TB_RW, args.in[30] + (size_t)(l) * 4, args.in[32] + (size_t)(l) * 32, xn, cnt, buf_ts, buf_w); \
    PH_END(pb + 5) \
    PH_BEGIN(pb + 6, 7)   \
        build_plan(F, cnt); \
        unsigned* rdy = F.ctl + CW_RDY + 4096 * (l); \
        { Moe1Sched S{(const char*)xn, (const char*)(ws + WS_WEXP), (const LAS int*)(F.lds + PLAN_OFF), buf_ts, F.G, F.vcu, D, rdy}; \
          EpiMoe1 E{(unsigned char*)hbuf}; \
          pg8::gemm_phase<EpiMoe1, Moe1Sched, true, true, true>(F.lds, F.tid, D, S, E); } \
        xcd_barrier(bar);     \
        { Moe2Sched S{(const char*)hbuf, (const char*)(ws + WS_WEXP + WEXP_W2), (const LAS int*)(F.lds + PLAN_OFF), F.G, F.G - 1 - F.vcu, DEXP, rdy, F.ctl + CW_TMO}; \
          EpiMoe2 E{ymoe, (const LAS int*)(F.lds + PLAN_OFF), buf_ts, buf_w}; \
          pg8::gemm_phase<EpiMoe2, Moe2Sched, true, true, true>(F.lds, F.tid, DEXP, S, E); } \
    PH_END(pb + 6) \
    PH_BEGIN(pb + 7, 8)   \
        if ((l) + 1 < DEPTH) { \
            conv_expert_weights(F, args, (l) + 1); \
            norm_phase(F, h, ymoe, args.in[1] + (size_t)((l) + 1) * D, (args.flags & 1) ? nullptr : h, xn, nullptr, 0.0f, ws + WS_XN8); \
        } else { \
            float oscale_ = 0.0f; \
            PROBE_REDUCE() \
            norm_phase(F, h, ymoe, args.in[36], nullptr, nullptr, args.out, oscale_); \
        } \
    PH_END(pb + 7) \
}
    LAYER(0)
    LAYER(1)
#undef LAYER
#undef PH_BEGIN
#undef PH_END
}
}

extern "C" void kernel_launch(void* const* d_in, const int* in_sizes, int n_in, void* d_out, int out_size, void* d_ws, size_t ws_size, hipStream_t stream) {
    static int grid = 0;
    if (grid == 0) {
        if (n_in != 37 || ws_size < WS_END) { fprintf(stderr, "kernel_launch: unexpected n_in %d or ws %zu\n", n_in, ws_size); grid = -1; return; }
        int dev = 0, cus = 0;
        if (hipGetDevice(&dev) != hipSuccess || hipDeviceGetAttribute(&cus, hipDeviceAttributeMultiprocessorCount, dev) != hipSuccess) { grid = -1; return; }
        if (hipFuncSetAttribute((const void*)mk_fwd, hipFuncAttributeMaxDynamicSharedMemorySize, LDS_BYTES) != hipSuccess) { fprintf(stderr, "kernel_launch: hipFuncSetAttribute failed\n"); grid = -1; return; }
        grid = cus;
    }
    if (grid < 0) return;
    (void)hipMemsetAsync((char*)d_ws + WS_CTL, 0, 1 * MiB, stream);
    Args a{};
    for (int i = 0; i < 37; ++i) a.in[i] = (const float*)d_in[i];
    a.out = (float*)d_out; a.ws = (unsigned char*)d_ws;
    if (N_LAUNCHES == 1) {
        a.ph_lo = 0; a.ph_hi = N_PHASES;
        hipLaunchKernelGGL(mk_fwd, dim3(grid), dim3(NWAVES * 64), LDS_BYTES, stream, a);
    } else {
#ifndef REP_MASK
#define REP_MASK 0
#endif
#ifndef REP_N
#define REP_N 2
#endif
        for (int p = 0; p < N_PHASES; ++p) { a.ph_lo = p; a.ph_hi = p + 1; const int kind = p == 0 ? 0 : 1 + (p - 1) % PH_PER_LAYER; const int nrep = ((REP_MASK >> kind) & 1) ? REP_N : 1;
            for (int r = 0; r < nrep; ++r) { a.flags = (r + 1 < nrep) ? 1 : 0; hipLaunchKernelGGL(mk_fwd, dim3(grid), dim3(NWAVES * 64), LDS_BYTES, stream, a); } }
    }
}
```

```cpp
#include <hip/hip_runtime.h>
#include <cstdint>
#include <cstdio>

#ifndef MK_N_LAUNCHES
#define MK_N_LAUNCHES 1
#endif

namespace pg8 {
#define PG8_LAS __attribute__((address_space(3)))
typedef unsigned short bf16_t;
typedef short bf16x8 __attribute__((ext_vector_type(8)));
typedef float f32x4 __attribute__((ext_vector_type(4)));
typedef unsigned u32x4 __attribute__((ext_vector_type(4)));
typedef unsigned u32x2 __attribute__((ext_vector_type(2)));
constexpr int BM = 256, BK = 64, HALF = 128, HTB = HALF * BK * 2, STAGE_BYTES = 8 * HTB, NXCD = 8, WGM = 8;

__host__ __device__ __forceinline__ int lds_byte(int r, int c) { const int st = (r >> 4) * 2 + (c >> 5), rr = r & 15, cc = c & 31, ob = rr * 64 + cc * 2; return st * 1024 + (ob ^ (((ob >> 9) & 1) << 5)); }
__host__ __device__ __forceinline__ void stage_rc(int b, int& R, int& C) { const int st = b / 1024, sb = b % 1024, swz = sb ^ (((sb >> 9) & 1) << 5); R = (st >> 1) * 16 + swz / 64; C = (st & 1) * 32 + (swz % 64) / 2; }
__host__ __device__ __forceinline__ int perm32(int rho) { const int n = rho >> 4, i = rho & 15; return 8 * (i >> 2) + 4 * n + (i & 3); }

struct Unit { int pm, pn; };

struct StaticOrder {
    int nM, nN, nwg, G, c;
    __host__ __device__ void init(int M, int N, int G_, int c_) { nM = M / BM; nN = N / BM; nwg = nM * nN; G = G_; c = c_; }
    __host__ __device__ bool next(int i, Unit& u) const {
        const long L = (long)i * G + c; if (L >= nwg) return false;
        int wgid = (int)L; { const int q = nwg / NXCD, r = nwg % NXCD, xcd = wgid % NXCD, off = wgid / NXCD; wgid = (xcd < r ? xcd * (q + 1) : r * (q + 1) + (xcd - r) * q) + off; }
        const int nig = WGM * nN, gid = wgid / nig, fm = gid * WGM, gsz = (nM - fm) < WGM ? (nM - fm) : WGM;
        u.pm = fm + ((wgid % nig) % gsz); u.pn = (wgid % nig) / gsz; return true;
    }
};

typedef int i32x8 __attribute__((ext_vector_type(8)));
typedef int i32x4 __attribute__((ext_vector_type(4)));
__device__ __forceinline__ i32x8 cat8(bf16x8 a, bf16x8 b) { const i32x4 x = __builtin_bit_cast(i32x4, a), y = __builtin_bit_cast(i32x4, b); return __builtin_shufflevector(x, y, 0, 1, 2, 3, 4, 5, 6, 7); }
__device__ __forceinline__ unsigned cvt_pk_bf16(float lo, float hi) { unsigned r; asm volatile("v_cvt_pk_bf16_f32 %0, %1, %2" : "=v"(r) : "v"(lo), "v"(hi)); return r; }

template <class Epi, class Sched, bool ALIGN_EPI, bool SP2, bool FP8 = false>
__device__ __forceinline__ void gemm_phase(PG8_LAS unsigned char* lds, const int tid, const int K, const Sched& S, const Epi& E) {
    const int wid = __builtin_amdgcn_readfirstlane(tid >> 6), lane = tid & 63, wr = wid >> 2, wc = wid & 3, fr = lane & 15, fq = lane >> 4;
    const int nt = FP8 ? K / 128 : K / BK;
    const int ES = FP8 ? 1 : 2;
    unsigned voffB[2]; int RA[2], CA[2];
#pragma unroll
    for (int i = 0; i < 2; ++i) { int R, C; stage_rc(tid * 16 + i * 8192, R, C); const int Rb = Epi::PERM ? ((R & ~31) + perm32(R & 31)) : R;
        voffB[i] = (unsigned)(Rb * K * ES + C * 2); RA[i] = R; CA[i] = C; }
    const size_t kstep = (size_t)(BK * 2);
    const size_t hstepB = (size_t)HALF * K * ES;
    const unsigned ldsw = (unsigned)wid * 1024u;
    const int aoff = lds_byte(wr * 64 + fr, fq * 8), boff = lds_byte(wc * 32 + fr, fq * 8);
#define PG8_SA(b, h) (((b) * 2 + (h)) * HTB)
#define PG8_SB(b, h) ((4 + (b) * 2 + (h)) * HTB)
#define PG8_STAGE(bufoff, gbase, voff) do { _Pragma("unroll") for (int _i = 0; _i < 2; ++_i) \
        __builtin_amdgcn_global_load_lds((const unsigned*)((const char*)(gbase) + (voff)[_i]), (PG8_LAS unsigned*)(lds + (bufoff) + ldsw + _i * 8192), 16, 0, 0); } while (0)
#define PG8_LDA(dst, b, h) do { _Pragma("unroll") for (int m = 0; m < 4; ++m) { if constexpr (FP8) { dst##8[m] = cat8(*(const PG8_LAS bf16x8*)(lds + PG8_SA(b, h) + aoff + m * 2048), *(const PG8_LAS bf16x8*)(lds + PG8_SA(b, h) + aoff + m * 2048 + 1024)); } \
        else { _Pragma("unroll") for (int k = 0; k < 2; ++k) dst[m][k] = *(const PG8_LAS bf16x8*)(lds + PG8_SA(b, h) + aoff + m * 2048 + k * 1024); } } } while (0)
#define PG8_LDB(dst, b, h) do { _Pragma("unroll") for (int n = 0; n < 2; ++n) { if constexpr (FP8) { dst##8[n] = cat8(*(const PG8_LAS bf16x8*)(lds + PG8_SB(b, h) + boff + n * 2048), *(const PG8_LAS bf16x8*)(lds + PG8_SB(b, h) + boff + n * 2048 + 1024)); } \
        else { _Pragma("unroll") for (int k = 0; k < 2; ++k) dst[n][k] = *(const PG8_LAS bf16x8*)(lds + PG8_SB(b, h) + boff + n * 2048 + k * 1024); } } } while (0)
#define PG8_MMA(ai, bj, At, Bt) do { __builtin_amdgcn_s_setprio(1); _Pragma("unroll") for (int m = 0; m < 4; ++m) _Pragma("unroll") for (int n = 0; n < 2; ++n) { \
        if constexpr (FP8) { asm volatile("v_mfma_scale_f32_16x16x128_f8f6f4 %0, %1, %2, %0, %3, %3 op_sel_hi:[0,0,0]" : "+v"(acc[ai][bj][m][n]) : "v"(Bt##8[n]), "v"(At##8[m]), "v"(one_scale));     } \
        else { _Pragma("unroll") for (int k = 0; k < 2; ++k) acc[ai][bj][m][n] = __builtin_amdgcn_mfma_f32_16x16x32_bf16(Bt[n][k], At[m][k], acc[ai][bj][m][n], 0, 0, 0); } } \
        if constexpr (FP8) asm volatile("s_nop 15\n\ts_nop 7" ::: "memory");     \
        __builtin_amdgcn_s_setprio(0); } while (0)
#define PG8_WAIT_V(n) asm volatile("s_waitcnt vmcnt(" #n ")" ::: "memory")
#define PG8_WAIT_L(n) asm volatile("s_waitcnt lgkmcnt(" #n ")" ::: "memory")
#define PG8_BAR __builtin_amdgcn_s_barrier()
#define PG8_SCHED __builtin_amdgcn_sched_barrier(0)
    Unit cur, nxt; int ui = 0;
    if (!S.next(0, cur)) return;
    bool has_next = S.next(1, nxt);
    unsigned offC[2][2], offN[2][2];
#pragma unroll
    for (int h = 0; h < 2; ++h)
#pragma unroll
        for (int i = 0; i < 2; ++i) {
            if constexpr (Sched::GATHER) { offC[h][i] = S.gather_off(cur, h * HALF + RA[i]) + (unsigned)CA[i] * 2u; offN[h][i] = has_next ? S.gather_off(nxt, h * HALF + RA[i]) + (unsigned)CA[i] * 2u : offC[h][i]; }
            else { offC[h][i] = (unsigned)((h * HALF + RA[i]) * S.lda * ES + CA[i] * 2); offN[h][i] = offC[h][i]; }
        }
    f32x4 acc[2][2][4][2];
#pragma unroll
    for (int a = 0; a < 2; ++a)
#pragma unroll
        for (int b = 0; b < 2; ++b)
#pragma unroll
            for (int m = 0; m < 4; ++m)
#pragma unroll
                for (int n = 0; n < 2; ++n) acc[a][b][m][n] = (f32x4){0.f, 0.f, 0.f, 0.f};
    int one_scale = 0x7f7f7f7f; asm volatile("" : "+v"(one_scale));
    bf16x8 At[4][2], B0[2][2], B1[2][2]; i32x8 At8[4], B08[2], B18[2]; (void)At; (void)B0; (void)B1; (void)At8; (void)B08; (void)B18;
    const char* cA = S.a_base(cur); const char* cB = S.b_base(cur);
    if constexpr (Sched::WAITS) S.a_ready(cur);
    if constexpr (SP2) {
        PG8_STAGE(PG8_SB(0, 0), cB, voffB); PG8_STAGE(PG8_SB(0, 1), cB + hstepB, voffB); PG8_STAGE(PG8_SA(0, 0), cA, offC[0]); PG8_STAGE(PG8_SA(0, 1), cA, offC[1]);
        if (wr == 1) PG8_BAR;
        PG8_WAIT_V(2); PG8_BAR;
        PG8_STAGE(PG8_SB(1, 0), cB + kstep, voffB); PG8_STAGE(PG8_SA(1, 0), cA + kstep, offC[0]); PG8_STAGE(PG8_SB(1, 1), cB + hstepB + kstep, voffB);
        PG8_WAIT_V(6); PG8_BAR;
    } else {
        PG8_STAGE(PG8_SB(0, 0), cB, voffB); PG8_STAGE(PG8_SA(0, 0), cA, offC[0]); PG8_STAGE(PG8_SB(0, 1), cB + hstepB, voffB); PG8_STAGE(PG8_SA(0, 1), cA, offC[1]);
        if (wr == 1) PG8_BAR;
        PG8_WAIT_V(4); PG8_BAR;
        PG8_STAGE(PG8_SB(1, 0), cB + kstep, voffB); PG8_STAGE(PG8_SA(1, 0), cA + kstep, offC[0]); PG8_STAGE(PG8_SB(1, 1), cB + hstepB + kstep, voffB);
        PG8_WAIT_V(6); PG8_BAR;
    }
    for (;;) {
        const char* nA = has_next ? S.a_base(nxt) : cA; const char* nB = has_next ? S.b_base(nxt) : cB;
        const bool full = !(Sched::HALF && __builtin_amdgcn_readfirstlane((int)S.half_only(cur)));
#pragma unroll 1
        for (int t = 0; t < nt; t += 2) {
            const bool last = (t == nt - 2);
            const char* a1 = cA + (size_t)(t + 1) * kstep;
            const char* a2 = last ? nA : cA + (size_t)(t + 2) * kstep; const char* b2 = last ? nB : cB + (size_t)(t + 2) * kstep;
            const char* a3 = a2 + kstep; const char* b3 = b2 + kstep;
            if constexpr (Sched::WAITS) { if (last && has_next) S.a_ready(nxt); }
            unsigned o2[2][2];
#pragma unroll
            for (int h = 0; h < 2; ++h)
#pragma unroll
                for (int i = 0; i < 2; ++i) o2[h][i] = (Sched::GATHER && last) ? offN[h][i] : offC[h][i];
            if constexpr (SP2) {
            PG8_LDB(B0, 0, 0); PG8_LDB(B1, 0, 1); PG8_SCHED; PG8_LDA(At, 0, 0); PG8_STAGE(PG8_SA(1, 1), a1, offC[1]);
            PG8_WAIT_V(8); PG8_WAIT_L(0); PG8_BAR; PG8_MMA(0, 0, At, B0); PG8_MMA(0, 1, At, B1); PG8_BAR; PG8_SCHED;
            PG8_LDA(At, 0, 1); PG8_STAGE(PG8_SB(0, 0), b2, voffB); PG8_STAGE(PG8_SB(0, 1), b2 + hstepB, voffB); PG8_STAGE(PG8_SA(0, 0), a2, o2[0]);
            PG8_WAIT_V(8); PG8_WAIT_L(0); PG8_BAR; if (full) { PG8_MMA(1, 0, At, B0); PG8_MMA(1, 1, At, B1); } PG8_BAR; PG8_SCHED;
            PG8_LDB(B0, 1, 0); PG8_LDB(B1, 1, 1); PG8_SCHED; PG8_LDA(At, 1, 0); PG8_STAGE(PG8_SA(0, 1), a2, o2[1]);
            PG8_WAIT_V(8); PG8_WAIT_L(0); PG8_BAR; PG8_MMA(0, 0, At, B0); PG8_MMA(0, 1, At, B1); PG8_BAR; PG8_SCHED;
            PG8_LDA(At, 1, 1); PG8_STAGE(PG8_SB(1, 0), b3, voffB); PG8_STAGE(PG8_SB(1, 1), b3 + hstepB, voffB); PG8_STAGE(PG8_SA(1, 0), a3, o2[0]);
            PG8_WAIT_V(8); PG8_WAIT_L(0); PG8_BAR; if (full) { PG8_MMA(1, 0, At, B0); PG8_MMA(1, 1, At, B1); } PG8_BAR; PG8_SCHED;
            } else {
            PG8_LDB(B0, 0, 0); PG8_SCHED; PG8_LDA(At, 0, 0); PG8_STAGE(PG8_SA(1, 1), a1, offC[1]);
            PG8_WAIT_L(8); PG8_BAR; PG8_WAIT_L(0); PG8_MMA(0, 0, At, B0); PG8_BAR; PG8_SCHED;
            PG8_LDB(B1, 0, 1); PG8_STAGE(PG8_SB(0, 0), b2, voffB);
            PG8_BAR; PG8_WAIT_L(0); PG8_MMA(0, 1, At, B1); PG8_BAR;
            PG8_LDA(At, 0, 1); PG8_STAGE(PG8_SA(0, 0), a2, o2[0]);
            PG8_BAR; PG8_WAIT_L(0); PG8_MMA(1, 0, At, B0); PG8_BAR; PG8_SCHED;
            PG8_STAGE(PG8_SB(0, 1), b2 + hstepB, voffB);
            PG8_WAIT_V(6); PG8_BAR; PG8_MMA(1, 1, At, B1); PG8_BAR;
            PG8_LDB(B0, 1, 0); PG8_SCHED; PG8_LDA(At, 1, 0); PG8_STAGE(PG8_SA(0, 1), a2, o2[1]);
            PG8_WAIT_L(8); PG8_BAR; PG8_WAIT_L(0); PG8_MMA(0, 0, At, B0); PG8_BAR; PG8_SCHED;
            PG8_LDB(B1, 1, 1); PG8_STAGE(PG8_SB(1, 0), b3, voffB);
            PG8_BAR; PG8_WAIT_L(0); PG8_MMA(0, 1, At, B1); PG8_BAR;
            PG8_LDA(At, 1, 1); PG8_STAGE(PG8_SA(1, 0), a3, o2[0]);
            PG8_BAR; PG8_WAIT_L(0); PG8_MMA(1, 0, At, B0); PG8_BAR; PG8_SCHED;
            PG8_STAGE(PG8_SB(1, 1), b3 + hstepB, voffB);
            PG8_WAIT_V(6); PG8_BAR; PG8_MMA(1, 1, At, B1); PG8_BAR;
            }
        }
        if constexpr (ALIGN_EPI) { if (wr == 0) PG8_BAR; }
        Unit nn; bool has_nn = false;
        if constexpr (Sched::GATHER) {
            has_nn = has_next && S.next(ui + 2, nn);
#pragma unroll
            for (int h = 0; h < 2; ++h)
#pragma unroll
                for (int i = 0; i < 2; ++i) { int R_, C_; stage_rc(tid * 16 + i * 8192, R_, C_); offC[h][i] = offN[h][i]; if (has_nn) offN[h][i] = S.gather_off(nn, h * HALF + R_) + (unsigned)C_ * 2u; }
        }
        E(acc, cur, wr, wc, fr, fq);
        if constexpr (Sched::PUBLISHES) S.done(cur);
        if (!has_next) break;
#pragma unroll
        for (int a = 0; a < 2; ++a)
#pragma unroll
            for (int b = 0; b < 2; ++b)
#pragma unroll
                for (int m = 0; m < 4; ++m)
#pragma unroll
                    for (int n = 0; n < 2; ++n) acc[a][b][m][n] = (f32x4){0.f, 0.f, 0.f, 0.f};
        cur = nxt; cA = nA; cB = nB; ++ui;
        if constexpr (Sched::GATHER) { has_next = has_nn; nxt = nn; }
        else { has_next = S.next(ui + 1, nxt); }
        if constexpr (ALIGN_EPI) { if (wr == 1) PG8_BAR; }
    }
    PG8_WAIT_V(0);
    if constexpr (!ALIGN_EPI) { if (wr == 0) PG8_BAR; }
    PG8_BAR;
#undef PG8_SA
#undef PG8_SB
#undef PG8_STAGE
#undef PG8_LDA
#undef PG8_LDB
#undef PG8_MMA
#undef PG8_WAIT_V
#undef PG8_WAIT_L
#undef PG8_BAR
#undef PG8_SCHED
}
}

namespace {
constexpr int NWAVES = 8;
constexpr int N_LAUNCHES = MK_N_LAUNCHES;
constexpr int D = 1024, BATCH = 8, SEQ = 2048, DEPTH = 2, T = BATCH * SEQ;
constexpr int W = 256, IN_COLS = 1792;
constexpr int NEXP = 32, DEXP = 512;
constexpr int CHUNK = 64, NCHUNK = SEQ / CHUNK;
constexpr int CAP = 16384;
constexpr int MAXBLK = 160;
constexpr float EPS = 1e-6f;
constexpr int PH_PER_LAYER = 9, N_PHASES = 1 + PH_PER_LAYER * DEPTH;

typedef unsigned short bf16_t;
typedef float f32x4 __attribute__((ext_vector_type(4)));
typedef unsigned v4u __attribute__((ext_vector_type(4)));
#define GAS __attribute__((address_space(1)))
#define LAS __attribute__((address_space(3)))
typedef GAS unsigned gu32;
#define RLX_AGENT __ATOMIC_RELAXED, __HIP_MEMORY_SCOPE_AGENT
#define LDS_WAIT() asm volatile("s_waitcnt lgkmcnt(0)" ::: "memory")

__device__ __forceinline__ float bf2f(bf16_t b) { return __uint_as_float(((unsigned)b) << 16); }
__device__ __forceinline__ unsigned f2bfu(float f) { unsigned u = __float_as_uint(f); return (u + 0x7fffu + ((u >> 16) & 1u)) >> 16; }
__device__ __forceinline__ bf16_t f2bf(float f) { return (bf16_t)f2bfu(f); }
__device__ __forceinline__ unsigned pk2(float lo, float hi) { return f2bfu(lo) | (f2bfu(hi) << 16); }
__device__ __forceinline__ float sigmoidf_(float x) { return 1.0f / (1.0f + __expf(-x)); }
__device__ __forceinline__ float gelu_tanh(float x) {
    const float z = 0.7978845608028654f * (x + 0.044715f * x * x * x);
    const float t = 1.0f - 2.0f / (__expf(2.0f * z) + 1.0f);
    return 0.5f * x * (1.0f + t);
}

constexpr size_t MiB = 1u << 20;
constexpr size_t WS_CTL = 0;
constexpr size_t WS_TAB = 1 * MiB;
constexpr size_t WS_H = 4 * MiB;
constexpr size_t WS_XN = 68 * MiB;
constexpr size_t WS_PROJ = 100 * MiB;
constexpr size_t WS_MERGED = WS_PROJ;
constexpr size_t WS_YS = 156 * MiB;
constexpr size_t WS_R1 = 188 * MiB;
constexpr size_t WS_HBUF = WS_R1;
constexpr size_t WS_YMOE = WS_R1 + 48 * MiB;
constexpr size_t WS_S5ST = 316 * MiB;
constexpr size_t WS_LRUA = 318 * MiB;
constexpr size_t WS_LRUH = 334 * MiB;
constexpr size_t WS_LRUS = 350 * MiB;
constexpr size_t WS_BUFTS = 351 * MiB;
constexpr size_t WS_BUFW = 353 * MiB;
constexpr size_t WS_WMIX = 356 * MiB;
constexpr size_t WMIX_IN = 0, WMIX_MG = (size_t)1792 * 1024 * 2, WMIX_BR = WMIX_MG + (size_t)4096 * 1024 * 2, WMIX_OUT = WMIX_BR + (size_t)4096 * 256 * 2, WMIX_STRIDE = 16 * MiB;
static_assert(WMIX_OUT + (size_t)1024 * 1024 * 2 <= WMIX_STRIDE, "mixer weights");
constexpr size_t WS_WEXP = 388 * MiB;
constexpr size_t WEXP_W2 = 32 * MiB;
constexpr float MG_SCALE = 32.0f;
constexpr float W13_SCALE = 32.0f, W2_SCALE = 16.0f, H_SCALE = 8.0f;
constexpr size_t WS_XN8 = 484 * MiB;
constexpr size_t WS_END = 500 * MiB;

constexpr int CW_CNT = 8192;
constexpr int CW_BAR = 4096;
constexpr int CW_TMO = 16;
constexpr int CW_RDY = 32768;

constexpr int TB_NLOG = 4096 + 32768, TB_RW = 4096 + 32768 + 256;
constexpr int SM_OFF = 512 * 1024;
constexpr int SM_POOLT = 0, SM_WAT = 32768, SM_WXT = 65536, SM_GLUT = 98304, SM_BRE = 229376, SM_BIM = 262144, SM_CMAT = 294912, SM_ATAB = 360448;


constexpr int RING_BYTES = 131072;
constexpr int LDSCTL_OFF = RING_BYTES, MISC_OFF = LDSCTL_OFF + 320;
constexpr int PLAN_OFF = MISC_OFF + 128;
constexpr int LDS_BYTES = 147456;
static_assert(PLAN_OFF + 4 * 360 <= LDS_BYTES, "LDS map");

#define XB_TMO      128
#define XB_XCNT(j)  (256  + 64 * (j))
#define XB_XSUB(j)  (1280 + 64 * (j))
#define XB_XGEN(j)  (2304 + 64 * (j))
#define XB_TOP      3328
#define XB_TOPGEN   3392
#define XCD_BAR_WORDS 3456
#define XB_SPIN_CAP (1u << 18)
__device__ __forceinline__ unsigned xb_ld(unsigned* p)              { return __hip_atomic_load(p, __ATOMIC_RELAXED, __HIP_MEMORY_SCOPE_AGENT); }
__device__ __forceinline__ unsigned xb_add(unsigned* p, unsigned v) { return __hip_atomic_fetch_add(p, v, __ATOMIC_RELAXED, __HIP_MEMORY_SCOPE_AGENT); }
__device__ __forceinline__ unsigned xb_xcc_id() { return (unsigned)__builtin_amdgcn_s_getreg((3 << 11) | 20) & 0xFu; }
#define XB_SPIN(cond, bar) do { unsigned _sp = 0; while (cond) { __builtin_amdgcn_s_sleep(1); \
    if ((++_sp & 255u) == 0u) { if (xb_ld(&(bar)[XB_TMO])) break; if (_sp > XB_SPIN_CAP) { atomicAdd(&(bar)[XB_TMO], 1u); break; } } } } while (0)
struct XcdBarrier { unsigned* bar; unsigned x; volatile LAS unsigned* st; };
__device__ __forceinline__ XcdBarrier xcd_barrier_post(unsigned* bar, volatile LAS unsigned* st) {
    XcdBarrier b; b.bar = bar; b.x = xb_xcc_id(); b.st = st;
    if (threadIdx.x == 0) (void)xb_add(&bar[XB_XCNT(b.x)], 1u);
    return b;
}
__device__ __forceinline__ void xcd_barrier_complete(unsigned* bar, unsigned x, unsigned& nloc, unsigned& nx) {
    const unsigned G = gridDim.x * gridDim.y * gridDim.z;
    unsigned sum, cnt, mine, sp = 0u;
    for (;;) {
        sum = 0u; cnt = 0u; mine = 0u;
#pragma unroll
        for (unsigned j = 0; j < 16; ++j) { const unsigned c = xb_ld(&bar[XB_XCNT(j)]); sum += c; cnt += (c > 0u) ? 1u : 0u; mine = (j == x) ? c : mine; }
        if (sum == G) break;
        __builtin_amdgcn_s_sleep(1);
        if ((++sp & 255u) == 0u) { if (xb_ld(&bar[XB_TMO])) break; if (sp > XB_SPIN_CAP) { atomicAdd(&bar[XB_TMO], 1u); break; } }
    }
    nloc = mine > 0u ? mine : 1u; nx = cnt > 0u ? cnt : 1u;
}
__device__ __forceinline__ void xcd_barrier(const XcdBarrier& b) {
    asm volatile("s_waitcnt vmcnt(0)" ::: "memory");
    __syncthreads();
    if (threadIdx.x == 0) {
        unsigned* bar = b.bar;
        __builtin_amdgcn_s_waitcnt(0);
        unsigned nloc = b.st[0], nx = b.st[1];
        if (nloc == 0u) { xcd_barrier_complete(bar, b.x, nloc, nx); b.st[0] = nloc; b.st[1] = nx; }
        const unsigned old = xb_add(&bar[XB_XSUB(b.x)], 1u);
        const unsigned gen = old / nloc;
        if (old + 1u == (gen + 1u) * nloc) {
            __builtin_amdgcn_fence(__ATOMIC_RELEASE, "agent");
            asm volatile("s_waitcnt vmcnt(0)" ::: "memory");
            const unsigned og = xb_add(&bar[XB_TOP], 1u);
            const unsigned tg = og / nx;
            if (og + 1u == (tg + 1u) * nx) xb_add(&bar[XB_TOPGEN], 1u);
            else XB_SPIN(xb_ld(&bar[XB_TOPGEN]) == tg, bar);
            __builtin_amdgcn_fence(__ATOMIC_ACQUIRE, "agent");
            xb_add(&bar[XB_XGEN(b.x)], 1u);
            asm volatile("s_waitcnt vmcnt(0)" ::: "memory");
        } else {
            XB_SPIN(xb_ld(&bar[XB_XGEN(b.x)]) == gen, bar);
            __builtin_amdgcn_fence(__ATOMIC_ACQUIRE, "agent");
            asm volatile("s_waitcnt vmcnt(0)" ::: "memory");
        }
    }
    __syncthreads();
}

#ifdef PROBE_A
#define STAMP(id) do { if (threadIdx.x == 0) ((unsigned long long*)(g_dbg))[(size_t)blockIdx.x * 64 + (id)] = __builtin_amdgcn_s_memrealtime(); } while (0)
#else
#define STAMP(id) do { } while (0)
#endif
#define g_dbg (F.ws + WS_END)

struct Args { const float* in[37]; float* out; unsigned char* ws; int ph_lo, ph_hi; int flags, pad; };

struct Frame {
    LAS unsigned char* lds;
    unsigned char* smem;
    volatile LAS unsigned* MISC;
    unsigned* ctl;
    int tid, lane, wave, vcu, G;
    unsigned char* ws;
};

struct MapNat { int off; __device__ __forceinline__ int operator()(int n) const { return off + n; } };
struct MapGate { __device__ __forceinline__ int operator()(int s) const {
    const int k4 = s >> 10, d = s & 1023, pn = d >> 6, dd = d & 63;
    return pn * 256 + 128 * (k4 >> 1) + 32 * (dd >> 4) + 16 * (k4 & 1) + 4 * ((dd >> 2) & 3) + (dd & 3); } };
struct MapMoe13 { int which; __device__ __forceinline__ int operator()(int hid) const {
    const int pn = hid >> 7, r = hid & 127;
    return pn * 256 + 128 * (r >> 6) + 32 * ((r >> 4) & 3) + 16 * which + 4 * ((r >> 2) & 3) + (r & 3); } };

template <class RowMap>
__device__ __forceinline__ void transpose_item(const float* W, int K, int N, bf16_t* WT, LAS float* scr, int item, int lane, const RowMap rm) {
    const int nblk = N / 32, kb = item / nblk, nb = item % nblk, k0 = 64 * kb, n0 = 32 * nb;
#pragma unroll 8
    for (int i = 0; i < 32; ++i) { const int kk = 2 * i + (lane >> 5); scr[kk * 33 + (lane & 31)] = W[(size_t)(k0 + kk) * N + n0 + (lane & 31)]; }
    LDS_WAIT(); asm volatile("" ::: "memory");
    const int c = lane & 7;
#pragma unroll
    for (int j = 0; j < 4; ++j) { const int n = (lane >> 3) + 8 * j; const LAS float* s = scr + (8 * c) * 33 + n;
        v4u o; o.x = pk2(s[0 * 33], s[1 * 33]); o.y = pk2(s[2 * 33], s[3 * 33]); o.z = pk2(s[4 * 33], s[5 * 33]); o.w = pk2(s[6 * 33], s[7 * 33]);
        *(GAS v4u*)(WT + (size_t)rm(n0 + n) * K + k0 + 8 * c) = o; }
    LDS_WAIT(); asm volatile("" ::: "memory");
}

__device__ __forceinline__ unsigned pk4_fp8(float a, float b, float c, float d) { int w = 0; w = __builtin_amdgcn_cvt_pk_fp8_f32(a, b, w, false); w = __builtin_amdgcn_cvt_pk_fp8_f32(c, d, w, true); return (unsigned)w; }
template <class RowMap>
__device__ __forceinline__ void transpose_item_fp8(const float* W, int K, int N, unsigned char* WT, LAS unsigned char* scr, int item, int lane, const RowMap rm, const float scl) {
    const int nblk = N / 32, kb = item / nblk, nb = item % nblk, k0 = 128 * kb, n0 = 32 * nb;
#pragma unroll 16
    for (int i = 0; i < 64; ++i) { const int kk = 2 * i + (lane >> 5); const float v = W[(size_t)(k0 + kk) * N + n0 + (lane & 31)] * scl;
        scr[(lane & 31) * 144 + kk] = (unsigned char)__builtin_amdgcn_cvt_pk_fp8_f32(v, 0.f, 0, false); }
    LDS_WAIT(); asm volatile("" ::: "memory");
    const int c = lane & 7;
#pragma unroll
    for (int j = 0; j < 4; ++j) { const int n = (lane >> 3) + 8 * j;
        *(GAS v4u*)(WT + (size_t)rm(n0 + n) * K + k0 + 16 * c) = *(const LAS v4u*)(scr + n * 144 + 16 * c); }
    LDS_WAIT(); asm volatile("" ::: "memory");
}

__device__ __forceinline__ void conv_mixer_weights(Frame& F, const Args& a) {
    LAS float* scr = (LAS float*)(F.lds + F.wave * 16384);
    const int gw = F.vcu * NWAVES + F.wave, NGW = F.G * NWAVES;
    constexpr int I_IN = 16 * 56, I_MG = 8 * 128, I_BR = 4 * 32, I_OUT = 16 * 32, PER_L = I_IN + I_MG + 4 * I_BR + I_OUT;
    for (int it = gw; it < DEPTH * PER_L; it += NGW) {
        const int l = it / PER_L; int r = it % PER_L;
        unsigned char* wb = F.ws + WS_WMIX + (size_t)l * WMIX_STRIDE;
        if (r < I_IN) { transpose_item(a.in[2] + (size_t)l * D * IN_COLS, D, IN_COLS, (bf16_t*)(wb + WMIX_IN), scr, r, F.lane, MapNat{0}); continue; } r -= I_IN;
        if (r < I_MG) { transpose_item_fp8(a.in[24] + (size_t)l * D * 4096, D, 4096, wb + WMIX_MG, (LAS unsigned char*)scr, r, F.lane, MapGate{}, MG_SCALE); continue; } r -= I_MG;
        if (r < 4 * I_BR) { const int k4 = r / I_BR; transpose_item(a.in[26] + ((size_t)l * 4 + k4) * W * D, W, D, (bf16_t*)(wb + WMIX_BR), scr, r % I_BR, F.lane, MapNat{k4 * 1024}); continue; } r -= 4 * I_BR;
        transpose_item(a.in[27] + (size_t)l * D * D, D, D, (bf16_t*)(wb + WMIX_OUT), scr, r, F.lane, MapNat{0});
    }
}
__device__ __forceinline__ void conv_expert_weights(Frame& F, const Args& a, int l) {
    LAS unsigned char* scr = F.lds + F.wave * 16384;
    const int gw = F.vcu * NWAVES + F.wave, NGW = F.G * NWAVES;
    constexpr int I_13 = 8 * 16, I_2 = 4 * 32, PER_E = 2 * I_13 + I_2;
    for (int it = gw; it < NEXP * PER_E; it += NGW) {
        const int e = it / PER_E; int r = it % PER_E;
        unsigned char* w13 = F.ws + WS_WEXP + (size_t)e * 1024 * 1024;
        unsigned char* w2t = F.ws + WS_WEXP + WEXP_W2 + (size_t)e * 1024 * 512;
        if (r < I_13) { transpose_item_fp8(a.in[33] + ((size_t)l * NEXP + e) * D * DEXP, D, DEXP, w13, scr, r, F.lane, MapMoe13{0}, W13_SCALE); continue; } r -= I_13;
        if (r < I_13) { transpose_item_fp8(a.in[34] + ((size_t)l * NEXP + e) * D * DEXP, D, DEXP, w13, scr, r, F.lane, MapMoe13{1}, W13_SCALE); continue; } r -= I_13;
        transpose_item_fp8(a.in[35] + ((size_t)l * NEXP + e) * DEXP * D, DEXP, D, w2t, scr, r, F.lane, MapNat{0}, W2_SCALE);
    }
}
__device__ __forceinline__ void prep_tables(Frame& F, const Args& a) {
    for (int idx = F.vcu * 512 + F.tid; idx < DEPTH * 65536; idx += F.G * 512) {
        const int l = idx >> 16, gid = idx & 65535;
        float* tab = (float*)(F.ws + WS_TAB + (size_t)l * MiB);
        unsigned char* sm = F.ws + WS_TAB + (size_t)l * MiB + SM_OFF;
        if (gid < 1024) {
            const int g = gid >> 6;
            const double lre = fmin((double)a.in[7][l * 1024 + gid], -1e-4);
            const double lim = (double)a.in[8][l * 1024 + gid];
            const double step = exp((double)a.in[9][l * 16 + g]);
            const double er = exp(lre * step), ar = er * cos(lim * step), ai = er * sin(lim * step);
            const double nr = ar - 1.0, ni = ai, den = lre * lre + lim * lim;
            const double cr = (nr * lre + ni * lim) / den, ci = (ni * lre - nr * lim) / den;
            float* at = (float*)(sm + SM_ATAB) + gid * 12;
            const double pw[5] = {1.0, 4.0, 8.0, 12.0, 64.0};
            for (int i = 0; i < 5; ++i) { const double e = exp(lre * step * pw[i]); at[2 * i] = (float)(e * cos(lim * step * pw[i])); at[2 * i + 1] = (float)(e * sin(lim * step * pw[i])); }
            at[10] = 0.f; at[11] = 0.f;
            for (int h = 0; h < 16; ++h) {
                const double br = (double)a.in[10][((size_t)l * 1024 + gid) * 16 + h], bi = (double)a.in[11][((size_t)l * 1024 + gid) * 16 + h];
                ((bf16_t*)(sm + SM_BRE))[gid * 16 + h] = f2bf((float)(cr * br - ci * bi));
                ((bf16_t*)(sm + SM_BIM))[gid * 16 + h] = f2bf((float)(cr * bi + ci * br));
            }
        }
        if (gid < 256) { const double lam = (double)a.in[23][l * 256 + gid]; tab[TB_NLOG + gid] = (float)(-8.0 * log1p(exp(-lam))); }
        if (gid < 49152) { const int k = gid / 48, o = gid % 48; const float gk = a.in[28][(size_t)l * 1024 + k];
            tab[TB_RW + gid] = (o < 4) ? gk * a.in[29][((size_t)l * 1024 + k) * 4 + o] : (o < 36 ? gk * a.in[31][((size_t)l * 1024 + k) * 32 + (o - 4)] : 0.f); }
        if (gid < 16384) { const int g = gid >> 12, d = (gid >> 6) & 63, cc = gid & 63; const size_t si = ((size_t)(l * 4 + g) * 64 + cc) * 64 + d;
            ((bf16_t*)(sm + SM_POOLT))[gid] = f2bf(a.in[4][si]); ((bf16_t*)(sm + SM_WAT))[gid] = f2bf(a.in[19][si]); ((bf16_t*)(sm + SM_WXT))[gid] = f2bf(a.in[21][si]); }
        if (gid < 32768) { const int g = gid >> 11, cc = (gid >> 7) & 15, k = gid & 127, p = k >> 1; const size_t si = ((size_t)(l * 16 + g) * 16 + cc) * 64 + p;
            ((bf16_t*)(sm + SM_CMAT))[gid] = f2bf((k & 1) ? -a.in[13][si] : a.in[12][si]); }
        { const int col = gid >> 8, k = gid & 255; ((bf16_t*)(sm + SM_GLUT))[gid] = f2bf(a.in[15][((size_t)l * 256 + k) * 256 + col]); }
    }
}

__device__ __forceinline__ void norm_phase(Frame& F, const float* hin, const bf16_t* y, const float* g, float* hout, bf16_t* xn, float* out, const float oadd = 0.0f, unsigned char* xn8 = nullptr) {
    const int gw = F.vcu * NWAVES + F.wave, NGW = F.G * NWAVES, lane = F.lane;
    f32x4 gg[4];
#pragma unroll
    for (int j = 0; j < 4; ++j) gg[j] = *(const f32x4*)(g + 4 * lane + 256 * j);
    for (int m0 = gw; m0 < T; m0 += 4 * NGW) {
        f32x4 v[4][4]; uint2 ya[4][4], yb[4][4];
#pragma unroll
        for (int i = 0; i < 4; ++i) {
            const int m = m0 + i * NGW;
            if (m < T) {
#pragma unroll
                for (int j = 0; j < 4; ++j) {
                    const int col = 4 * lane + 256 * j;
                    v[i][j] = *(const f32x4*)(hin + (size_t)m * D + col);
                    if (y) { ya[i][j] = *(const uint2*)(y + ((size_t)m * 2 + 0) * D + col); yb[i][j] = *(const uint2*)(y + ((size_t)m * 2 + 1) * D + col); }
                }
            }
        }
            __builtin_amdgcn_sched_barrier(0);
#pragma unroll
        for (int i = 0; i < 4; ++i) {
            const int m = m0 + i * NGW;
            if (m < T) {
                float s = 0.f;
#pragma unroll
                for (int j = 0; j < 4; ++j) {
                    if (y) {
                        v[i][j].x += __uint_as_float(ya[i][j].x << 16) + __uint_as_float(yb[i][j].x << 16);
                        v[i][j].y += __uint_as_float(ya[i][j].x & 0xffff0000u) + __uint_as_float(yb[i][j].x & 0xffff0000u);
                        v[i][j].z += __uint_as_float(ya[i][j].y << 16) + __uint_as_float(yb[i][j].y << 16);
                        v[i][j].w += __uint_as_float(ya[i][j].y & 0xffff0000u) + __uint_as_float(yb[i][j].y & 0xffff0000u);
                    }
                    s += v[i][j].x * v[i][j].x + v[i][j].y * v[i][j].y + v[i][j].z * v[i][j].z + v[i][j].w * v[i][j].w;
                }
#pragma unroll
                for (int o = 1; o < 64; o <<= 1) s += __shfl_xor(s, o);
                const float rstd = rsqrtf(s * (1.0f / D) + EPS);
#pragma unroll
                for (int j = 0; j < 4; ++j) {
                    const int col = 4 * lane + 256 * j;
                    if (hout) *(f32x4*)(hout + (size_t)m * D + col) = v[i][j];
                    const f32x4 o = v[i][j] * rstd * gg[j];
                    if (xn) { uint2 w; w.x = pk2(o.x, o.y); w.y = pk2(o.z, o.w); *(uint2*)(xn + (size_t)m * D + col) = w; }
                    if (xn8) *(unsigned*)(xn8 + (size_t)m * D + col) = pk4_fp8(o.x, o.y, o.z, o.w);
                    if (out) { f32x4 oo = o; if (m == 0 && col == 0) oo.x += oadd; *(f32x4*)(out + (size_t)m * D + col) = oo; }
                }
            }
        }
    }
}

constexpr int TROW = 528;
constexpr int TILE_BYTES = 64 * TROW;
constexpr int HROW = 272, HTILE = 16 * HROW;
constexpr int CARRY_OFF = 2 * TILE_BYTES + 8 * HTILE;

struct MixArgs {
    const bf16_t* proj; bf16_t* ys; const float* tab; const unsigned char* sm; unsigned char* ws;
    float2* s5st; float2* lruS;
    const float *conv_a_w, *pool_b, *pool_scale, *s5_d, *glu_b, *lconv_w, *lconv_b, *ba, *bx;
};

typedef short bf16x8 __attribute__((ext_vector_type(8)));
__device__ __forceinline__ f32x4 mma16(bf16x8 a, bf16x8 b, f32x4 c) { return __builtin_amdgcn_mfma_f32_16x16x32_bf16(a, b, c, 0, 0, 0); }
__device__ __forceinline__ void ld8(const bf16_t* p, float (&x)[8]) {
    const v4u v = *(const v4u*)p;
    x[0] = __uint_as_float(v.x << 16); x[1] = __uint_as_float(v.x & 0xffff0000u); x[2] = __uint_as_float(v.y << 16); x[3] = __uint_as_float(v.y & 0xffff0000u);
    x[4] = __uint_as_float(v.z << 16); x[5] = __uint_as_float(v.z & 0xffff0000u); x[6] = __uint_as_float(v.w << 16); x[7] = __uint_as_float(v.w & 0xffff0000u);
}
__device__ __forceinline__ void ldf8(const float* p, float (&x)[8]) { const f32x4 a = *(const f32x4*)p, b = *(const f32x4*)(p + 4); x[0] = a.x; x[1] = a.y; x[2] = a.z; x[3] = a.w; x[4] = b.x; x[5] = b.y; x[6] = b.z; x[7] = b.w; }
typedef unsigned v2u __attribute__((ext_vector_type(2)));
__device__ __forceinline__ v4u pack8(const float (&x)[8]) { v4u o; o.x = pk2(x[0], x[1]); o.y = pk2(x[2], x[3]); o.z = pk2(x[4], x[5]); o.w = pk2(x[6], x[7]); return o; }
template <int N> __device__ __forceinline__ float dpp_row_shr(float oldv, float src) {
    return __int_as_float(__builtin_amdgcn_update_dpp(__float_as_int(oldv), __float_as_int(src), 0x110 + N, 0xf, 0xf, false));
}

template <int PH>
__device__ __forceinline__ void mix_unit(const MixArgs& A, LAS unsigned char* lds, int unit, int tid) {
    const int lane = tid & 63, wave = __builtin_amdgcn_readfirstlane(tid >> 6), j = lane & 15, q = lane >> 4;
    const int b = unit >> 5, c = unit & 31;
    const size_t t0 = (size_t)b * SEQ + c * CHUNK;
    LAS unsigned char* T0 = lds; LAS unsigned char* T1 = lds + TILE_BYTES; LAS unsigned char* Hw = lds + 2 * TILE_BYTES + wave * HTILE;
    const int cg = tid & 31, tg = tid >> 5, tl0 = tg * 4, pos0 = c * CHUNK + tl0;
    const bf16_t* prow = A.proj + (t0 + tl0) * IN_COLS + cg * 8;
    const unsigned char* sm = A.sm;
    const struct { unsigned char* ws; } F = {A.ws}; (void)F;
    typedef float f32x2_ __attribute__((ext_vector_type(2)));
    LAS f32x2_* cS5 = (LAS f32x2_*)(lds + CARRY_OFF);
    LAS float* cLru = (LAS float*)(lds + CARRY_OFF + 8192);
    if (PH == 2) {
#pragma unroll
        for (int s2 = 0; s2 < 2; ++s2) {
            const int si = tid + 512 * s2;
            const float a64r = ((const float*)(sm + SM_ATAB))[si * 12 + 8], a64i = ((const float*)(sm + SM_ATAB))[si * 12 + 9];
            float hr_ = 0.f, hi_ = 0.f;
            for (int j0 = 0; j0 < c; j0 += 8) {
                float2 sv[8];
#pragma unroll
                for (int u = 0; u < 8; ++u) { const int jj = (j0 + u < c) ? j0 + u : c - 1; sv[u] = A.s5st[((size_t)b * NCHUNK + jj) * 1024 + si]; }
#pragma unroll
                for (int u = 0; u < 8; ++u) if (j0 + u < c) { const float nr = a64r * hr_ - a64i * hi_ + sv[u].x, ni = a64r * hi_ + a64i * hr_ + sv[u].y; hr_ = nr; hi_ = ni; }
            }
            cS5[si] = (f32x2_){hr_, hi_};
        }
        if (tid < 256) {
            float hin_ = 0.f;
            for (int j0 = 0; j0 < c; j0 += 8) {
                float2 sv[8];
#pragma unroll
                for (int u = 0; u < 8; ++u) { const int jj = (j0 + u < c) ? j0 + u : c - 1; sv[u] = A.lruS[((size_t)b * NCHUNK + jj) * 256 + tid]; }
#pragma unroll
                for (int u = 0; u < 8; ++u) if (j0 + u < c) hin_ = sv[u].x * hin_ + sv[u].y;
            }
            cLru[tid] = hin_;
        }
    }

    if (PH == 2) STAMP(52);
    if (PH == 2) {
        float w0[8], w1[8], w2[8];
        ldf8(A.conv_a_w + 0 * 256 + cg * 8, w0); ldf8(A.conv_a_w + 1 * 256 + cg * 8, w1); ldf8(A.conv_a_w + 2 * 256 + cg * 8, w2);
        float v[6][8];
#pragma unroll
        for (int i = 0; i < 6; ++i) {
            if (pos0 - 2 + i >= 0) { float ac[8], ax[8]; ld8(prow + (long)(i - 2) * IN_COLS + 256, ac); ld8(prow + (long)(i - 2) * IN_COLS + 512, ax);
#pragma unroll
                for (int e = 0; e < 8; ++e) v[i][e] = ac[e] * ax[e]; }
            else {
#pragma unroll
                for (int e = 0; e < 8; ++e) v[i][e] = 0.f; }
        }
#pragma unroll
        for (int n = 0; n < 4; ++n) {
            float ab[8], o[8]; ld8(prow + (long)n * IN_COLS, ab);
#pragma unroll
            for (int e = 0; e < 8; ++e) o[e] = ab[e] * (w0[e] * v[n][e] + w1[e] * v[n + 1][e] + w2[e] * v[n + 2][e]);
            *(v4u*)(A.ys + (t0 + tl0 + n) * 1024 + cg * 8) = pack8(o);
        }
    }
    if (PH == 2) {
        const int win = 2 << (cg >> 3);
        float S[8], x0[8];
#pragma unroll
        for (int e = 0; e < 8; ++e) S[e] = 0.f;
        ld8(prow + 768, x0);
#pragma unroll
        for (int e = 0; e < 8; ++e) S[e] = x0[e];
        for (int i = 1; i < win; ++i) if (pos0 - i >= 0) { float x[8]; ld8(prow - (long)i * IN_COLS + 768, x);
#pragma unroll
            for (int e = 0; e < 8; ++e) S[e] += x[e]; }
        {
            const int cnt = (pos0 + 1 < win) ? pos0 + 1 : win; const float inv = 1.0f / (float)cnt; float o[8];
#pragma unroll
            for (int e = 0; e < 8; ++e) o[e] = S[e] * inv - x0[e];
            *(LAS v4u*)(T0 + tl0 * TROW + cg * 16) = pack8(o);
        }
#pragma unroll 1
        for (int n = 1; n < 4; ++n) {
            float xn_[8]; ld8(prow + (long)n * IN_COLS + 768, xn_);
#pragma unroll
            for (int e = 0; e < 8; ++e) S[e] += xn_[e];
            if (pos0 + n - win >= 0) { float xo[8]; ld8(prow + (long)(n - win) * IN_COLS + 768, xo);
#pragma unroll
                for (int e = 0; e < 8; ++e) S[e] -= xo[e]; }
            const int cnt = (pos0 + n + 1 < win) ? pos0 + n + 1 : win; const float inv = 1.0f / (float)cnt; float o[8];
#pragma unroll
            for (int e = 0; e < 8; ++e) o[e] = S[e] * inv - xn_[e];
            *(LAS v4u*)(T0 + (tl0 + n) * TROW + cg * 16) = pack8(o);
        }
    }
    {
        float w0[8], w1[8], w2[8], w3[8], cb[8];
        ldf8(A.lconv_w + 0 * 256 + cg * 8, w0); ldf8(A.lconv_w + 1 * 256 + cg * 8, w1); ldf8(A.lconv_w + 2 * 256 + cg * 8, w2); ldf8(A.lconv_w + 3 * 256 + cg * 8, w3); ldf8(A.lconv_b + cg * 8, cb);
        float x[7][8];
#pragma unroll
        for (int i = 0; i < 7; ++i) {
            if (pos0 - 3 + i >= 0) ld8(prow + (long)(i - 3) * IN_COLS + 1280, x[i]);
            else {
#pragma unroll
                for (int e = 0; e < 8; ++e) x[i][e] = 0.f; }
        }
#pragma unroll
        for (int n = 0; n < 4; ++n) {
            float o[8];
#pragma unroll
            for (int e = 0; e < 8; ++e) o[e] = w0[e] * x[n][e] + w1[e] * x[n + 1][e] + w2[e] * x[n + 2][e] + w3[e] * x[n + 3][e] + cb[e];
            *(LAS v4u*)(T1 + (tl0 + n) * TROW + cg * 16) = pack8(o);
        }
    }
    __syncthreads();
    if (PH == 2) STAMP(53);

    const int hd = wave >> 1, dt0 = 2 * (wave & 1);
    if (PH == 2) {
        const bf16_t* WT = (const bf16_t*)(sm + SM_POOLT) + hd * 4096;
        f32x4 acc[2][4];
#pragma unroll
        for (int d = 0; d < 2; ++d)
#pragma unroll
            for (int tt = 0; tt < 4; ++tt) acc[d][tt] = (f32x4){0.f, 0.f, 0.f, 0.f};
#pragma unroll
        for (int ks = 0; ks < 2; ++ks) {
            bf16x8 wf[2];
#pragma unroll
            for (int d = 0; d < 2; ++d) wf[d] = *(const bf16x8*)(WT + ((dt0 + d) * 16 + j) * 64 + ks * 32 + 8 * q);
#pragma unroll
            for (int tt = 0; tt < 4; ++tt) { const bf16x8 xf = *(const LAS bf16x8*)(T0 + (tt * 16 + j) * TROW + (hd * 64 + ks * 32 + 8 * q) * 2);
#pragma unroll
                for (int d = 0; d < 2; ++d) acc[d][tt] = mma16(wf[d], xf, acc[d][tt]); }
        }
#pragma unroll
        for (int d = 0; d < 2; ++d) {
            const int ch0 = hd * 64 + (dt0 + d) * 16 + 4 * q;
            const f32x4 pb = *(const f32x4*)(A.pool_b + ch0), ps = *(const f32x4*)(A.pool_scale + ch0);
#pragma unroll
            for (int tt = 0; tt < 4; ++tt) { const f32x4 o = (acc[d][tt] + pb) * ps; v2u w; w.x = pk2(o.x, o.y); w.y = pk2(o.z, o.w);
                *(v2u*)(A.ys + (t0 + tt * 16 + j) * 1024 + 256 + ch0) = w; }
        }
    }
    if (PH == 2) STAMP(54);
    {
        const bf16_t* WA = (const bf16_t*)(sm + SM_WAT) + hd * 4096; const bf16_t* WX = (const bf16_t*)(sm + SM_WXT) + hd * 4096;
        f32x4 ga[2][4], gx[2][4];
#pragma unroll
        for (int d = 0; d < 2; ++d)
#pragma unroll
            for (int tt = 0; tt < 4; ++tt) { ga[d][tt] = (f32x4){0.f, 0.f, 0.f, 0.f}; gx[d][tt] = (f32x4){0.f, 0.f, 0.f, 0.f}; }
#pragma unroll
        for (int ks = 0; ks < 2; ++ks) {
            bf16x8 wa[2], wx[2];
#pragma unroll
            for (int d = 0; d < 2; ++d) { wa[d] = *(const bf16x8*)(WA + ((dt0 + d) * 16 + j) * 64 + ks * 32 + 8 * q); wx[d] = *(const bf16x8*)(WX + ((dt0 + d) * 16 + j) * 64 + ks * 32 + 8 * q); }
#pragma unroll
            for (int tt = 0; tt < 4; ++tt) { const bf16x8 xf = *(const LAS bf16x8*)(T1 + (tt * 16 + j) * TROW + (hd * 64 + ks * 32 + 8 * q) * 2);
#pragma unroll
                for (int d = 0; d < 2; ++d) { ga[d][tt] = mma16(wa[d], xf, ga[d][tt]); gx[d][tt] = mma16(wx[d], xf, gx[d][tt]); } }
        }
#pragma unroll
        for (int d = 0; d < 2; ++d) {
            const int ch0 = hd * 64 + (dt0 + d) * 16 + 4 * q;
            const f32x4 bav = *(const f32x4*)(A.ba + ch0), bxv = *(const f32x4*)(A.bx + ch0), nlg = *(const f32x4*)(A.tab + TB_NLOG + ch0);
            float hin[4] = {0.f, 0.f, 0.f, 0.f}, aprod[4] = {1.f, 1.f, 1.f, 1.f};
            if (PH == 2) {
#pragma unroll
                for (int r = 0; r < 4; ++r) hin[r] = cLru[ch0 + r];
            }
#pragma unroll
            for (int tt = 0; tt < 4; ++tt) {
                const v2u xcw = *(const LAS v2u*)(T1 + (tt * 16 + j) * TROW + ch0 * 2);
                const float xc[4] = {__uint_as_float(xcw.x << 16), __uint_as_float(xcw.x & 0xffff0000u), __uint_as_float(xcw.y << 16), __uint_as_float(xcw.y & 0xffff0000u)};
                float hv[4];
#pragma unroll
                for (int r = 0; r < 4; ++r) {
                    const float rg = sigmoidf_(ga[d][tt][r] + bav[r]), ig = sigmoidf_(gx[d][tt][r] + bxv[r]);
                    const float la = nlg[r] * rg; float av = __expf(la); const float mult = sqrtf(fmaxf(-expm1f(2.0f * la), 0.f));
                    float bv = mult * ig * xc[r];
                    { const float ap = dpp_row_shr<1>(1.f, av), bp = dpp_row_shr<1>(0.f, bv); bv = av * bp + bv; av = av * ap; }
                    { const float ap = dpp_row_shr<2>(1.f, av), bp = dpp_row_shr<2>(0.f, bv); bv = av * bp + bv; av = av * ap; }
                    { const float ap = dpp_row_shr<4>(1.f, av), bp = dpp_row_shr<4>(0.f, bv); bv = av * bp + bv; av = av * ap; }
                    { const float ap = dpp_row_shr<8>(1.f, av), bp = dpp_row_shr<8>(0.f, bv); bv = av * bp + bv; av = av * ap; }
                    const float h = bv + av * hin[r];
                    hv[r] = h;
                    hin[r] = __shfl(h, (lane & 48) | 15);
                    if (PH == 1) aprod[r] *= __shfl(av, (lane & 48) | 15);
                }
                if (PH == 2) {
                    const v2u gw = *(const v2u*)(A.proj + (t0 + tt * 16 + j) * IN_COLS + 1536 + ch0);
                    const float g0 = gelu_tanh(__uint_as_float(gw.x << 16)), g1 = gelu_tanh(__uint_as_float(gw.x & 0xffff0000u)), g2 = gelu_tanh(__uint_as_float(gw.y << 16)), g3 = gelu_tanh(__uint_as_float(gw.y & 0xffff0000u));
                    v2u w; w.x = pk2(hv[0] * g0, hv[1] * g1); w.y = pk2(hv[2] * g2, hv[3] * g3);
                    *(v2u*)(A.ys + (t0 + tt * 16 + j) * 1024 + 768 + ch0) = w;
                }
            }
            if (PH == 1 && j == 15) {
                float2* sp = A.lruS + ((size_t)b * NCHUNK + c) * 256 + ch0;
#pragma unroll
                for (int r = 0; r < 4; ++r) sp[r] = make_float2(aprod[r], hin[r]);
            }
        }
    }
    if (PH == 2) STAMP(55);
    __syncthreads();

#pragma unroll
    for (int n = 0; n < 4; ++n) *(LAS v4u*)(T0 + (tl0 + n) * TROW + cg * 16) = *(const v4u*)(prow + (long)n * IN_COLS + 1024);
    __syncthreads();
    const bf16x8 zf = (bf16x8){0, 0, 0, 0, 0, 0, 0, 0};
    if (PH == 2) STAMP(56);
#pragma unroll 1
    for (int gi = 0; gi < 2; ++gi) {
        const int g = wave * 2 + gi;
        float ar[4], ai[4], a4r[4], a4i[4], a8r[4], a8i[4], aqr[4], aqi[4], hr[4], hi[4];
        bf16x8 bref[4], bimf[4];
#pragma unroll
        for (int st = 0; st < 4; ++st) {
            const int si = g * 64 + st * 16 + j;
            const float* at = (const float*)(sm + SM_ATAB) + si * 12;
            const f32x4 t0v = *(const f32x4*)at, t1v = *(const f32x4*)(at + 4);
            ar[st] = t0v.x; ai[st] = t0v.y; a4r[st] = t0v.z; a4i[st] = t0v.w; a8r[st] = t1v.x; a8i[st] = t1v.y;
            aqr[st] = q == 0 ? 1.f : (q == 1 ? t0v.z : (q == 2 ? t1v.x : t1v.z));
            aqi[st] = q == 0 ? 0.f : (q == 1 ? t0v.w : (q == 2 ? t1v.y : t1v.w));
            hr[st] = 0.f; hi[st] = 0.f;
            if (PH == 2) { const f32x2_ cv = cS5[si]; hr[st] = cv.x; hi[st] = cv.y; }
            bref[st] = (q < 2) ? *(const bf16x8*)((const bf16_t*)(sm + SM_BRE) + si * 16 + 8 * q) : zf;
            bimf[st] = (q < 2) ? *(const bf16x8*)((const bf16_t*)(sm + SM_BIM) + si * 16 + 8 * q) : zf;
        }
        bf16x8 cf[4];
        if (PH == 2) {
#pragma unroll
            for (int ks = 0; ks < 4; ++ks) cf[ks] = *(const bf16x8*)((const bf16_t*)(sm + SM_CMAT) + (g * 16 + j) * 128 + ks * 32 + 8 * q);
        }
        const f32x4 dv = *(const f32x4*)(A.s5_d + g * 16 + 4 * q);
#pragma unroll 1
        for (int tt = 0; tt < 4; ++tt) {
            const bf16x8 uf = (q < 2) ? *(const LAS bf16x8*)(T0 + (tt * 16 + j) * TROW + (g * 16 + 8 * q) * 2) : zf;
#pragma unroll
            for (int st = 0; st < 4; ++st) {
                const f32x4 z4 = (f32x4){0.f, 0.f, 0.f, 0.f};
                const f32x4 dre = mma16(uf, bref[st], z4), dim = mma16(uf, bimf[st], z4);
                float er = dre[0], ei = dim[0];
#pragma unroll
                for (int r = 1; r < 4; ++r) { const float nr = ar[st] * er - ai[st] * ei + dre[r], ni = ar[st] * ei + ai[st] * er + dim[r]; er = nr; ei = ni; }
                float x1r = __shfl_up(er, 16), x1i = __shfl_up(ei, 16), x2r = __shfl_up(er, 32), x2i = __shfl_up(ei, 32), x3r = __shfl_up(er, 48), x3i = __shfl_up(ei, 48);
                if (q < 1) { x1r = 0.f; x1i = 0.f; } if (q < 2) { x2r = 0.f; x2i = 0.f; } if (q < 3) { x3r = 0.f; x3i = 0.f; }
                float pr = x1r + (a4r[st] * x2r - a4i[st] * x2i) + (a8r[st] * x3r - a8i[st] * x3i) + (aqr[st] * hr[st] - aqi[st] * hi[st]);
                float pi = x1i + (a4r[st] * x2i + a4i[st] * x2r) + (a8r[st] * x3i + a8i[st] * x3r) + (aqr[st] * hi[st] + aqi[st] * hr[st]);
#pragma unroll
                for (int r = 0; r < 4; ++r) {
                    const float nr = ar[st] * pr - ai[st] * pi + dre[r], ni = ar[st] * pi + ai[st] * pr + dim[r]; pr = nr; pi = ni;
                    if (PH == 2) *(LAS unsigned*)(Hw + (4 * q + r) * HROW + (st * 16 + j) * 4) = pk2(nr, ni);
                }
                hr[st] = __shfl(pr, 48 + j); hi[st] = __shfl(pi, 48 + j);
            }
            if (PH == 2) {
                f32x4 y = (f32x4){0.f, 0.f, 0.f, 0.f};
#pragma unroll
                for (int ks = 0; ks < 4; ++ks) { const bf16x8 hf = *(const LAS bf16x8*)(Hw + j * HROW + (ks * 32 + 8 * q) * 2); y = mma16(cf[ks], hf, y); }
                const v2u uw = *(const LAS v2u*)(T0 + (tt * 16 + j) * TROW + (g * 16 + 4 * q) * 2);
                const float y0 = gelu_tanh(y[0] + dv[0] * __uint_as_float(uw.x << 16)), y1 = gelu_tanh(y[1] + dv[1] * __uint_as_float(uw.x & 0xffff0000u));
                const float y2 = gelu_tanh(y[2] + dv[2] * __uint_as_float(uw.y << 16)), y3 = gelu_tanh(y[3] + dv[3] * __uint_as_float(uw.y & 0xffff0000u));
                v2u w; w.x = pk2(y0, y1); w.y = pk2(y2, y3);
                *(LAS v2u*)(T1 + (tt * 16 + j) * TROW + (g * 16 + 4 * q) * 2) = w;
            }
        }
        if (PH == 1 && q == 0) {
#pragma unroll
            for (int st = 0; st < 4; ++st) A.s5st[((size_t)b * NCHUNK + c) * 1024 + g * 64 + st * 16 + j] = make_float2(hr[st], hi[st]);
        }
    }
    if (PH == 2) {
        STAMP(57);
        __syncthreads();
        STAMP(58);
        const bf16_t* GT = (const bf16_t*)(sm + SM_GLUT);
        f32x4 acc[2][4];
#pragma unroll
        for (int d = 0; d < 2; ++d)
#pragma unroll
            for (int tt = 0; tt < 4; ++tt) acc[d][tt] = (f32x4){0.f, 0.f, 0.f, 0.f};
#pragma unroll 2
        for (int ks = 0; ks < 8; ++ks) {
            bf16x8 wf[2];
#pragma unroll
            for (int d = 0; d < 2; ++d) wf[d] = *(const bf16x8*)(GT + ((wave * 2 + d) * 16 + j) * 256 + ks * 32 + 8 * q);
#pragma unroll
            for (int tt = 0; tt < 4; ++tt) { const bf16x8 xf = *(const LAS bf16x8*)(T1 + (tt * 16 + j) * TROW + (ks * 32 + 8 * q) * 2);
#pragma unroll
                for (int d = 0; d < 2; ++d) acc[d][tt] = mma16(wf[d], xf, acc[d][tt]); }
        }
#pragma unroll
        for (int d = 0; d < 2; ++d) {
            const int col0 = (wave * 2 + d) * 16 + 4 * q;
            const f32x4 gb = *(const f32x4*)(A.glu_b + col0);
#pragma unroll
            for (int tt = 0; tt < 4; ++tt) {
                const v2u yw = *(const LAS v2u*)(T1 + (tt * 16 + j) * TROW + col0 * 2);
                const f32x4 s = acc[d][tt] + gb;
                v2u w; w.x = pk2(__uint_as_float(yw.x << 16) * sigmoidf_(s.x), __uint_as_float(yw.x & 0xffff0000u) * sigmoidf_(s.y));
                w.y = pk2(__uint_as_float(yw.y << 16) * sigmoidf_(s.z), __uint_as_float(yw.y & 0xffff0000u) * sigmoidf_(s.w));
                *(v2u*)(A.ys + (t0 + tt * 16 + j) * 1024 + 512 + col0) = w;
            }
        }
    }
    __syncthreads();
}

__device__ __forceinline__ void router_phase(Frame& F, const float* h, const float* g2, const float* Wp, const float* rgb, const float* reb,
                                             bf16_t* xn, unsigned* cnt, int* buf_ts, float* buf_w) {
    LAS float* part = (LAS float*)(F.lds);
    LAS float* lg = (LAS float*)(F.lds + 98304);
    LAS float* rs = (LAS float*)(F.lds + 98304 + 12288);
    const int lane = F.lane, wave = F.wave, tid = F.tid, j = lane & 15, q = lane >> 4;
    for (int blk = blockIdx.x; blk < T / 64; blk += F.G) {
        const int m0 = blk * 64;
        {
            f32x4 v[8][4];
#pragma unroll
            for (int i = 0; i < 8; ++i)
#pragma unroll
                for (int jj = 0; jj < 4; ++jj) v[i][jj] = *(const f32x4*)(h + (size_t)(m0 + wave * 8 + i) * D + 4 * lane + 256 * jj);
            f32x4 gg[4];
#pragma unroll
            for (int jj = 0; jj < 4; ++jj) gg[jj] = *(const f32x4*)(g2 + 4 * lane + 256 * jj);
            __builtin_amdgcn_sched_barrier(0);
#pragma unroll
            for (int i = 0; i < 8; ++i) {
                float s = 0.f;
#pragma unroll
                for (int jj = 0; jj < 4; ++jj) s += v[i][jj].x * v[i][jj].x + v[i][jj].y * v[i][jj].y + v[i][jj].z * v[i][jj].z + v[i][jj].w * v[i][jj].w;
#pragma unroll
                for (int o = 1; o < 64; o <<= 1) s += __shfl_xor(s, o);
                const float rstd = rsqrtf(s * (1.0f / D) + EPS);
                if (lane == 0) rs[wave * 8 + i] = rstd;
#pragma unroll
                for (int jj = 0; jj < 4; ++jj) {
                    const f32x4 o = v[i][jj] * rstd * gg[jj];
                    *(unsigned*)((unsigned char*)xn + (size_t)(m0 + wave * 8 + i) * D + 4 * lane + 256 * jj) = pk4_fp8(o.x, o.y, o.z, o.w);
                }
            }
        }
        STAMP(48);
        f32x4 acc[3][4];
#pragma unroll
        for (int ot = 0; ot < 3; ++ot)
#pragma unroll
            for (int tt = 0; tt < 4; ++tt) acc[ot][tt] = (f32x4){0.f, 0.f, 0.f, 0.f};
        LAS float* xq = (LAS float*)(F.lds);
#pragma unroll 1
        for (int kq = 0; kq < 4; ++kq) {
            f32x4 hv[8]; float af[8][3];
#pragma unroll
            for (int i = 0; i < 8; ++i) hv[i] = *(const f32x4*)(h + (size_t)(m0 + wave * 8 + i) * D + kq * 256 + 4 * lane);
#pragma unroll
            for (int ks = 0; ks < 8; ++ks)
#pragma unroll
                for (int ot = 0; ot < 3; ++ot) af[ks][ot] = Wp[(size_t)(kq * 256 + wave * 32 + ks * 4 + q) * 48 + ot * 16 + j];
            __builtin_amdgcn_sched_barrier(0);
            if (kq) __syncthreads();
#pragma unroll
            for (int i = 0; i < 8; ++i) {
                typedef float f32x2q __attribute__((ext_vector_type(2)));
                LAS float* dst = xq + (wave * 8 + i) * 258 + 4 * lane;
                *(LAS f32x2q*)dst = (f32x2q){hv[i].x, hv[i].y}; *(LAS f32x2q*)(dst + 2) = (f32x2q){hv[i].z, hv[i].w};
            }
            __syncthreads();
#pragma unroll
            for (int ks = 0; ks < 8; ++ks) {
                float bf[4];
#pragma unroll
                for (int tt = 0; tt < 4; ++tt) bf[tt] = xq[(tt * 16 + j) * 258 + wave * 32 + ks * 4 + q];
#pragma unroll
                for (int ot = 0; ot < 3; ++ot)
#pragma unroll
                    for (int tt = 0; tt < 4; ++tt) acc[ot][tt] = __builtin_amdgcn_mfma_f32_16x16x4f32(af[ks][ot], bf[tt], acc[ot][tt], 0, 0, 0);
            }
        }
        __syncthreads();
#pragma unroll
        for (int ot = 0; ot < 3; ++ot)
#pragma unroll
            for (int tt = 0; tt < 4; ++tt) *(LAS f32x4*)(part + ((wave * 12 + ot * 4 + tt) * 64 + lane) * 4) = acc[ot][tt];
        STAMP(49);
        __syncthreads();
        STAMP(50);
        for (int idx = tid; idx < 12 * 256; idx += 512) {
            const int tile = idx >> 8, ln = (idx >> 2) & 63, r = idx & 3, ot = tile >> 2, tt = tile & 3;
            float s = 0.f;
#pragma unroll
            for (int w = 0; w < 8; ++w) s += part[(w * 12 + tile) * 256 + (idx & 255)];
            const int tok = tt * 16 + (ln & 15), o = ot * 16 + 4 * (ln >> 4) + r;
            lg[tok * 48 + o] = s * rs[tok];
        }
        __syncthreads();
        STAMP(51);
        if (tid < 64) {
            const int m = m0 + tid;
            float gl[4], mx = -1e30f; int gi = 0;
#pragma unroll
            for (int i = 0; i < 4; ++i) { gl[i] = lg[tid * 48 + i] + rgb[i]; if (gl[i] > mx) { mx = gl[i]; gi = i; } }
            float den = 0.f;
#pragma unroll
            for (int i = 0; i < 4; ++i) den += __expf(gl[i] - mx);
            const float gval = 1.0f / den;
            float v1 = -1e30f, v2 = -1e30f; int i1 = 0, i2 = 0;
            for (int i = 0; i < 8; ++i) { const float el = lg[tid * 48 + 4 + gi * 8 + i] + reb[gi * 8 + i]; if (el > v1) { v2 = v1; i2 = i1; v1 = el; i1 = i; } else if (el > v2) { v2 = el; i2 = i; } }
            const float e2 = __expf(v2 - v1), w1 = gval / (1.0f + e2), w2 = gval * e2 / (1.0f + e2);
            const int ex1 = gi * 8 + i1, ex2 = gi * 8 + i2;
            const unsigned r1 = atomicAdd(&cnt[ex1 * 64], 1u), r2 = atomicAdd(&cnt[ex2 * 64], 1u);
            buf_ts[ex1 * CAP + r1] = m * 2 + 0; buf_w[ex1 * CAP + r1] = w1;
            buf_ts[ex2 * CAP + r2] = m * 2 + 1; buf_w[ex2 * CAP + r2] = w2;
        }
        __syncthreads();
    }
}

__device__ __forceinline__ void build_plan(Frame& F, const unsigned* cnt) {
    LAS int* plan = (LAS int*)(F.lds + PLAN_OFF);
    if (F.tid < 64) {
        const int e = F.tid & 31;
        const int ce = (int)__hip_atomic_load(cnt + e * 64, RLX_AGENT);
        const int nf = ce >> 8, rem = ce & 255, big = rem > 128 ? 1 : 0, sml = (rem > 0 && rem <= 128) ? 1 : 0;
        int pf = nf, pb = big, ps = sml;
#pragma unroll
        for (int o = 1; o < 32; o <<= 1) { const int a = __shfl_up(pf, o, 32), b = __shfl_up(pb, o, 32), c = __shfl_up(ps, o, 32); if (e >= o) { pf += a; pb += b; ps += c; } }
        const int NF = __shfl(pf, 31, 32), NB = __shfl(pb, 31, 32), NS = __shfl(ps, 31, 32);
        if (F.tid < 32) {
            plan[321 + e] = ce;
            for (int jb = 0; jb < nf; ++jb) { const int p = pf - nf + jb; if (p < MAXBLK) { plan[1 + p] = e; plan[1 + MAXBLK + p] = jb; } }
            if (big) { const int p = NF + pb - 1; if (p < MAXBLK) { plan[1 + p] = e; plan[1 + MAXBLK + p] = nf; } }
            if (sml) { const int p = NF + NB + ps - 1; if (p < MAXBLK) { plan[1 + p] = e; plan[1 + MAXBLK + p] = nf; } }
            if (e == 0) { const int tot = NF + NB + NS; plan[0] = tot < MAXBLK ? tot : MAXBLK; }
        }
    }
    __syncthreads();
}

struct DenseSched {
    static constexpr bool GATHER = false, HALF = false, WAITS = false, PUBLISHES = false;
    pg8::StaticOrder ord; const char* A; const char* Bt; int lda, K; int a_sh, a_cs; int es;
    __device__ __forceinline__ bool next(int i, pg8::Unit& u) const { return ord.next(i, u); }
    __device__ __forceinline__ const char* a_base(const pg8::Unit& u) const { return A + (size_t)u.pm * 256 * lda * es + (size_t)((u.pn >> a_sh) * a_cs); }
    __device__ __forceinline__ const char* b_base(const pg8::Unit& u) const { return Bt + (size_t)u.pn * 256 * K * es; }
    __device__ __forceinline__ unsigned gather_off(const pg8::Unit&, int) const { return 0u; }
    __device__ __forceinline__ bool half_only(const pg8::Unit&) const { return false; }
};
struct Moe1Sched {
    static constexpr bool GATHER = true, HALF = true, WAITS = false, PUBLISHES = false;
    const char* xn; const char* w13; const LAS int* plan; const int* buf_ts; int G, c, lda; unsigned* ready;
    __device__ __forceinline__ void done(const pg8::Unit& u) const { asm volatile("s_waitcnt vmcnt(0)" ::: "memory"); if ((threadIdx.x & 63) == 0) __hip_atomic_fetch_add(ready + 16 * u.pm, 1u, RLX_AGENT); }
    __device__ __forceinline__ bool next(int i, pg8::Unit& u) const { const int L = i * G + c; if (L >= 4 * plan[0]) return false; u.pm = L >> 2; u.pn = L & 3; return true; }
    __device__ __forceinline__ const char* a_base(const pg8::Unit&) const { return xn; }
    __device__ __forceinline__ const char* b_base(const pg8::Unit& u) const { return w13 + (size_t)plan[1 + u.pm] * (1024 * 1024) + (size_t)u.pn * (256 * 1024); }
    __device__ __forceinline__ unsigned gather_off(const pg8::Unit& u, int r) const {
        const int e = plan[1 + u.pm], lb = plan[1 + MAXBLK + u.pm], ce = plan[321 + e];
        int pos = lb * 256 + r; pos = pos < ce ? pos : ce - 1;
        return (unsigned)(buf_ts[e * CAP + pos] >> 1) * (unsigned)D;
    }
    __device__ __forceinline__ bool half_only(const pg8::Unit& u) const { const int e = plan[1 + u.pm], lb = plan[1 + MAXBLK + u.pm]; return plan[321 + e] - lb * 256 <= 128; }
};
struct Moe2Sched {
    static constexpr bool GATHER = false, HALF = true, WAITS = false, PUBLISHES = false;
    const char* hbuf; const char* w2t; const LAS int* plan; int G, c, lda; const unsigned* ready; unsigned* tmo;
    __device__ __forceinline__ void a_ready(const pg8::Unit& u) const {
        if (threadIdx.x < 64) {
            const unsigned long long t0 = __builtin_amdgcn_s_memrealtime(); unsigned polls = 0;
            while ((unsigned)__builtin_amdgcn_readfirstlane(__hip_atomic_load(ready + 16 * u.pm, RLX_AGENT)) < 32u) {
                if ((++polls & 255u) == 0u && __builtin_amdgcn_readfirstlane(__hip_atomic_load(tmo, RLX_AGENT)) != 0u) break;
                if (__builtin_amdgcn_s_memrealtime() - t0 > 2000000ull) { if (threadIdx.x == 0) __hip_atomic_store(tmo, 1u, RLX_AGENT); break; }
                __builtin_amdgcn_s_sleep(2); }
            __builtin_amdgcn_fence(__ATOMIC_ACQUIRE, "agent");
            asm volatile("s_waitcnt vmcnt(0)" ::: "memory");
        }
        asm volatile("" ::: "memory"); __builtin_amdgcn_s_barrier(); asm volatile("" ::: "memory");
    }
    __device__ __forceinline__ bool next(int i, pg8::Unit& u) const { const int L = i * G + c; if (L >= 4 * plan[0]) return false; u.pm = L >> 2; u.pn = L & 3; return true; }
    __device__ __forceinline__ const char* a_base(const pg8::Unit& u) const { return hbuf + (size_t)u.pm * 256 * DEXP; }
    __device__ __forceinline__ const char* b_base(const pg8::Unit& u) const { return w2t + (size_t)plan[1 + u.pm] * (1024 * 512) + (size_t)u.pn * (256 * 512); }
    __device__ __forceinline__ unsigned gather_off(const pg8::Unit&, int) const { return 0u; }
    __device__ __forceinline__ bool half_only(const pg8::Unit& u) const { const int e = plan[1 + u.pm], lb = plan[1 + MAXBLK + u.pm]; return plan[321 + e] - lb * 256 <= 128; }
};

using pg8::f32x4; using pg8::u32x4; using pg8::u32x2; using pg8::cvt_pk_bf16; using pg8::Unit; using pg8::HALF; using pg8::BM;
struct EpiStoreBf16 {
    static constexpr bool PERM = true;
    bf16_t* O; int ldc;
    __device__ __forceinline__ void operator()(const f32x4 (&acc)[2][2][4][2], const Unit& u, int wr, int wc, int fr, int fq) const {
        const int row0 = u.pm * BM + wr * 64 + fr, col0 = u.pn * BM + wc * 32 + 8 * fq;
#pragma unroll
        for (int ai = 0; ai < 2; ++ai)
#pragma unroll
            for (int m = 0; m < 4; ++m) { bf16_t* rowp = O + (size_t)(row0 + ai * HALF + m * 16) * ldc + col0;
#pragma unroll
                for (int bj = 0; bj < 2; ++bj) { const f32x4 v0 = acc[ai][bj][m][0], v1 = acc[ai][bj][m][1];
                    u32x4 w; w.x = cvt_pk_bf16(v0[0], v0[1]); w.y = cvt_pk_bf16(v0[2], v0[3]); w.z = cvt_pk_bf16(v1[0], v1[1]); w.w = cvt_pk_bf16(v1[2], v1[3]);
                    *(u32x4*)(rowp + bj * HALF) = w; } }
    }
};
struct EpiGateMerge {
    static constexpr bool PERM = false;
    const float* bias; const bf16_t* br; bf16_t* merged;
    __device__ __forceinline__ void operator()(const f32x4 (&acc)[2][2][4][2], const Unit& u, int wr, int wc, int fr, int fq) const {
        const int row0 = u.pm * BM + wr * 64 + fr, d0 = u.pn * 64 + wc * 16 + 4 * fq;
        f32x4 bv[4];
#pragma unroll
        for (int k4 = 0; k4 < 4; ++k4) bv[k4] = *(const f32x4*)(bias + k4 * 1024 + d0);
#pragma unroll
        for (int ai = 0; ai < 2; ++ai)
#pragma unroll
            for (int m = 0; m < 4; ++m) {
                const size_t row = (size_t)(row0 + ai * HALF + m * 16);
                f32x4 s = (f32x4){0.f, 0.f, 0.f, 0.f};
#pragma unroll
                for (int k4 = 0; k4 < 4; ++k4) {
                    const u32x2 b2 = *(const u32x2*)(br + row * 4096 + k4 * 1024 + d0);
                    const f32x4 a = acc[ai][k4 >> 1][m][k4 & 1] * (1.0f / MG_SCALE) + bv[k4];
                    s[0] += sigmoidf_(a[0]) * __uint_as_float(b2.x << 16);
                    s[1] += sigmoidf_(a[1]) * __uint_as_float(b2.x & 0xffff0000u);
                    s[2] += sigmoidf_(a[2]) * __uint_as_float(b2.y << 16);
                    s[3] += sigmoidf_(a[3]) * __uint_as_float(b2.y & 0xffff0000u);
                }
                u32x2 w; w.x = cvt_pk_bf16(s[0], s[1]); w.y = cvt_pk_bf16(s[2], s[3]);
                *(u32x2*)(merged + row * D + d0) = w;
            }
    }
};
struct EpiAddF32 {
    static constexpr bool PERM = false;
    float* h;
    __device__ __forceinline__ void operator()(const f32x4 (&acc)[2][2][4][2], const Unit& u, int wr, int wc, int fr, int fq) const {
        const int row0 = u.pm * BM + wr * 64 + fr, col0 = u.pn * BM + wc * 32 + 4 * fq;
#pragma unroll
        for (int ai = 0; ai < 2; ++ai)
#pragma unroll
            for (int m = 0; m < 4; ++m) { float* rowp = h + (size_t)(row0 + ai * HALF + m * 16) * D + col0;
#pragma unroll
                for (int bj = 0; bj < 2; ++bj)
#pragma unroll
                    for (int n = 0; n < 2; ++n) { f32x4* p = (f32x4*)(rowp + bj * HALF + n * 16); *p = *p + acc[ai][bj][m][n]; } }
    }
};
struct EpiMoe1 {
    static constexpr bool PERM = false;
    unsigned char* hbuf;
    __device__ __forceinline__ void operator()(const f32x4 (&acc)[2][2][4][2], const Unit& u, int wr, int wc, int fr, int fq) const {
        const int row0 = u.pm * BM + wr * 64 + fr, h0 = u.pn * 128 + wc * 16 + 4 * fq;
        const float si = 1.0f / W13_SCALE;
#pragma unroll
        for (int ai = 0; ai < 2; ++ai)
#pragma unroll
            for (int m = 0; m < 4; ++m) { unsigned char* rowp = hbuf + (size_t)(row0 + ai * HALF + m * 16) * DEXP + h0;
#pragma unroll
                for (int bj = 0; bj < 2; ++bj) { const f32x4 a1 = acc[ai][bj][m][0] * si, a3 = acc[ai][bj][m][1] * (si * H_SCALE);
                    const unsigned w = pk4_fp8(a1[0] * sigmoidf_(a1[0]) * a3[0], a1[1] * sigmoidf_(a1[1]) * a3[1], a1[2] * sigmoidf_(a1[2]) * a3[2], a1[3] * sigmoidf_(a1[3]) * a3[3]);
                    *(unsigned*)(rowp + bj * 64) = w; } }
    }
};
struct EpiMoe2 {
    static constexpr bool PERM = true;
    bf16_t* ymoe; const LAS int* plan; const int* buf_ts; const float* buf_w;
    __device__ __forceinline__ void operator()(const f32x4 (&acc)[2][2][4][2], const Unit& u, int wr, int wc, int fr, int fq) const {
        const int e = plan[1 + u.pm], lb = plan[1 + MAXBLK + u.pm], ce = plan[321 + e];
        const int col0 = u.pn * BM + wc * 32 + 8 * fq;
#pragma unroll
        for (int ai = 0; ai < 2; ++ai)
#pragma unroll
            for (int m = 0; m < 4; ++m) {
                const int pos = lb * 256 + ai * HALF + wr * 64 + m * 16 + fr;
                if (pos < ce) {
                    const int ts = buf_ts[e * CAP + pos]; const float wt = buf_w[e * CAP + pos] * (1.0f / (W2_SCALE * H_SCALE));
                    bf16_t* rowp = ymoe + (size_t)ts * D + col0;
#pragma unroll
                    for (int bj = 0; bj < 2; ++bj) { const f32x4 v0 = acc[ai][bj][m][0] * wt, v1 = acc[ai][bj][m][1] * wt;
                        u32x4 w; w.x = cvt_pk_bf16(v0[0], v0[1]); w.y = cvt_pk_bf16(v0[2], v0[3]); w.z = cvt_pk_bf16(v1[0], v1[1]); w.w = cvt_pk_bf16(v1[2], v1[3]);
                        *(u32x4*)(rowp + bj * HALF) = w; }
                }
            }
    }
};

__device__ __forceinline__ void make_mix_args(MixArgs& A, const Args& args, unsigned char* ws, int l) {
    A.proj = (const bf16_t*)(ws + WS_PROJ); A.ys = (bf16_t*)(ws + WS_YS); A.tab = (const float*)(ws + WS_TAB + (size_t)l * MiB); A.sm = ws + WS_TAB + (size_t)l * MiB + SM_OFF; A.ws = ws;
    A.s5st = (float2*)(ws + WS_S5ST); A.lruS = (float2*)(ws + WS_LRUS);
    A.conv_a_w = args.in[3] + (size_t)l * 3 * W; A.pool_b = args.in[5] + (size_t)l * W; A.pool_scale = args.in[6] + (size_t)l * W;
    A.s5_d = args.in[14] + (size_t)l * W; A.glu_b = args.in[16] + (size_t)l * W;
    A.lconv_w = args.in[17] + (size_t)l * 4 * W; A.lconv_b = args.in[18] + (size_t)l * W; A.ba = args.in[20] + (size_t)l * W; A.bx = args.in[22] + (size_t)l * W;
}

__global__ void __launch_bounds__(NWAVES * 64, 2) mk_fwd(Args args) {
    extern __shared__ __attribute__((aligned(16))) unsigned char lds[];
    Frame F;
    F.lds = (LAS unsigned char*)lds; F.smem = lds;
    F.MISC = (volatile LAS unsigned*)(F.lds + MISC_OFF);
    F.tid = threadIdx.x; F.lane = F.tid & 63; F.wave = __builtin_amdgcn_readfirstlane(F.tid >> 6);
    F.G = gridDim.x; { const int bx = blockIdx.x; F.vcu = (F.G % 8 == 0) ? (bx % 8) * (F.G / 8) + bx / 8 : bx; }
    F.ws = args.ws; F.ctl = (unsigned*)(args.ws + WS_CTL);
    unsigned char* ws = args.ws; unsigned char* const args_ws_ = args.ws; (void)args_ws_;
    for (int u = F.tid; u < (LDS_BYTES - LDSCTL_OFF) / 4; u += NWAVES * 64) ((LAS unsigned*)(F.lds + LDSCTL_OFF))[u] = 0u;
    __syncthreads();
    XcdBarrier bar; bar.bar = F.ctl + CW_BAR; bar.x = 0; bar.st = nullptr;
    if (N_LAUNCHES == 1) bar = xcd_barrier_post(F.ctl + CW_BAR, F.MISC + 8);
    const int lo = args.ph_lo, hi = args.ph_hi;
    float* h = (float*)(ws + WS_H); bf16_t* xn = (bf16_t*)(ws + WS_XN); bf16_t* proj = (bf16_t*)(ws + WS_PROJ); bf16_t* ys = (bf16_t*)(ws + WS_YS);
    bf16_t* br = (bf16_t*)(ws + WS_R1); bf16_t* hbuf = (bf16_t*)(ws + WS_HBUF); bf16_t* ymoe = (bf16_t*)(ws + WS_YMOE); bf16_t* merged = (bf16_t*)(ws + WS_MERGED);
    int* buf_ts = (int*)(ws + WS_BUFTS); float* buf_w = (float*)(ws + WS_BUFW);

#ifndef KIND_MASK
#define KIND_MASK 0x7ff
#endif
#define PH_BEGIN(k, kind) if (lo <= (k) && (k) < hi && ((KIND_MASK >> (kind)) & 1)) { \
        { int t_ = threadIdx.x; asm volatile("" : "+v"(t_)); F.tid = t_; F.lane = t_ & 63; F.wave = __builtin_amdgcn_readfirstlane(t_ >> 6); } STAMP(2 * (k));
#ifdef PROBE_A
#define PH_END(k) __syncthreads(); STAMP(2 * (k) + 1); if ((k) + 1 < hi) xcd_barrier(bar); }
#else
#define PH_END(k) if ((k) + 1 < hi) xcd_barrier(bar); }
#endif

    PH_BEGIN(0, 0)
        prep_tables(F, args);
        conv_mixer_weights(F, args);
        conv_expert_weights(F, args, 0);
        norm_phase(F, args.in[0], nullptr, args.in[1], h, xn, nullptr, 0.0f, ws + WS_XN8);
    PH_END(0)

#ifdef PROBE_A
#ifndef PROBE_MODE
#define PROBE_MODE 0
#endif
#ifndef PROBE_SCALE
#define PROBE_SCALE 300
#endif
#ifndef PROBE_SHIFT
#define PROBE_SHIFT 0.0f
#endif
#define PROBE_REDUCE() { xcd_barrier(bar); \
        if (blockIdx.x == 0) { LAS float* red = (LAS float*)F.lds; const unsigned long long* dd = (const unsigned long long*)(g_dbg); \
            if (F.tid < 256) { const unsigned long long ta = __hip_atomic_load(dd + (size_t)F.tid * 64 + (PROBE_A), RLX_AGENT), tb = __hip_atomic_load(dd + (size_t)F.tid * 64 + (PROBE_B), RLX_AGENT), t00 = __hip_atomic_load(dd + (PROBE_A), RLX_AGENT); \
                red[F.tid] = (float)(long long)(tb - ta) * 0.01f; red[256 + F.tid] = (float)(long long)(ta - t00) * 0.01f; red[512 + F.tid] = (float)(long long)(tb - t00) * 0.01f; } \
            __syncthreads(); \
            if (F.tid == 0) { float sum = 0.f, mx = -1e30f, mna = 1e30f, mxb = -1e30f; for (int i = 0; i < 256; ++i) { sum += red[i]; mx = fmaxf(mx, red[i]); mna = fminf(mna, red[256 + i]); mxb = fmaxf(mxb, red[512 + i]); } \
                const float val = PROBE_MODE == 0 ? sum * (1.0f / 256.0f) : (PROBE_MODE == 1 ? mx : mxb - mna); \
                const float vq = val; \
                __hip_atomic_store((float*)((unsigned long long*)(g_dbg) + 256 * 64), vq, RLX_AGENT); } \
            __syncthreads(); } \
        xcd_barrier(bar); \
        oscale_ = __hip_atomic_load((float*)((unsigned long long*)(g_dbg) + 256 * 64), RLX_AGENT) * (1.0f / (float)(PROBE_SCALE)); }
#else
#define PROBE_REDUCE()
#endif
#define LAYER(l) { \
    const int pb = 1 + PH_PER_LAYER * (l); \
    const float* tab = (const float*)(ws + WS_TAB + (size_t)(l) * MiB); \
    const unsigned char* wmix = ws + WS_WMIX + (size_t)(l) * WMIX_STRIDE; \
    unsigned* cnt = F.ctl + CW_CNT + 2048 * (l); \
    PH_BEGIN(pb + 0, 1)   \
        DenseSched S; S.ord.init(T, IN_COLS, F.G, (int)blockIdx.x); S.A = (const char*)xn; S.Bt = (const char*)(wmix + WMIX_IN); S.lda = D; S.K = D; S.a_sh = 0; S.a_cs = 0; S.es = 2; \
        EpiStoreBf16 E{proj, IN_COLS}; \
        pg8::gemm_phase<EpiStoreBf16, DenseSched, true, true>(F.lds, F.tid, D, S, E); \
    PH_END(pb + 0) \
    PH_BEGIN(pb + 1, 2)   \
        MixArgs A; make_mix_args(A, args, ws, (l)); \
        for (int u = blockIdx.x; u < BATCH * NCHUNK; u += F.G) { int t_ = F.tid; asm volatile("" : "+v"(t_)); mix_unit<1>(A, F.lds, u, t_); } \
    PH_END(pb + 1) \
    PH_BEGIN(pb + 2, 3)   \
        MixArgs A; make_mix_args(A, args, ws, (l)); \
        for (int u = blockIdx.x; u < BATCH * NCHUNK; u += F.G) { int t_ = F.tid; asm volatile("" : "+v"(t_)); mix_unit<2>(A, F.lds, u, t_); } \
    PH_END(pb + 2) \
    PH_BEGIN(pb + 3, 4)   \
        DenseSched S; S.ord.init(T, 4096, F.G, (int)blockIdx.x); S.A = (const char*)ys; S.Bt = (const char*)(wmix + WMIX_BR); S.lda = 1024; S.K = 256; S.a_sh = 2; S.a_cs = 512; S.es = 2; \
        EpiStoreBf16 E{br, 4096}; \
        pg8::gemm_phase<EpiStoreBf16, DenseSched, true, true>(F.lds, F.tid, 256, S, E); \
    PH_END(pb + 3) \
    PH_BEGIN(pb + 4, 5)   \
        DenseSched S; S.ord.init(T, 4096, F.G, (int)blockIdx.x); S.A = (const char*)(ws + WS_XN8); S.Bt = (const char*)(wmix + WMIX_MG); S.lda = D; S.K = D; S.a_sh = 0; S.a_cs = 0; S.es = 1; \
        EpiGateMerge E{args.in[25] + (size_t)(l) * 4096, br, merged}; \
        pg8::gemm_phase<EpiGateMerge, DenseSched, true, true, true>(F.lds, F.tid, D, S, E); \
    PH_END(pb + 4) \
    PH_BEGIN(pb + 5, 6)   \
        DenseSched S; S.ord.init(T, D, F.G, (int)blockIdx.x); S.A = (const char*)merged; S.Bt = (const char*)(wmix + WMIX_OUT); S.lda = D; S.K = D; S.a_sh = 0; S.a_cs = 0; S.es = 2; \
        EpiAddF32 E{(args.flags & 1) ? (float*)(ws + WS_R1) : h}; \
        pg8::gemm_phase<EpiAddF32, DenseSched, true, true>(F.lds, F.tid, D, S, E); \
    PH_END(pb + 5) \
    PH_BEGIN(pb + 6, 7)   \
        if (args.flags & 1) router_phase(F, h, args.in[28] + (size_t)(l) * D, tab + TB_RW, args.in[30] + (size_t)(l) * 4, args.in[32] + (size_t)(l) * 32, xn, F.ctl + 16384, (int*)(ws + WS_END), (float*)(ws + WS_END + 2 * MiB)); \
        else router_phase(F, h, args.in[28] + (size_t)(l) * D, tab + TB_RW, args.in[30] + (size_t)(l) * 4, args.in[32] + (size_t)(l) * 32, xn, cnt, buf_ts, buf_w); \
    PH_END(pb + 6) \
    PH_BEGIN(pb + 7, 8)   \
        build_plan(F, cnt); \
        unsigned* rdy = F.ctl + CW_RDY + 4096 * (l); \
        { Moe1Sched S{(const char*)xn, (const char*)(ws + WS_WEXP), (const LAS int*)(F.lds + PLAN_OFF), buf_ts, F.G, F.vcu, D, rdy}; \
          EpiMoe1 E{(unsigned char*)hbuf}; \
          pg8::gemm_phase<EpiMoe1, Moe1Sched, true, true, true>(F.lds, F.tid, D, S, E); } \
        xcd_barrier(bar);     \
        { Moe2Sched S{(const char*)hbuf, (const char*)(ws + WS_WEXP + WEXP_W2), (const LAS int*)(F.lds + PLAN_OFF), F.G, F.G - 1 - F.vcu, DEXP, rdy, F.ctl + CW_TMO}; \
          EpiMoe2 E{ymoe, (const LAS int*)(F.lds + PLAN_OFF), buf_ts, buf_w}; \
          pg8::gemm_phase<EpiMoe2, Moe2Sched, true, true, true>(F.lds, F.tid, DEXP, S, E); } \
    PH_END(pb + 7) \
    PH_BEGIN(pb + 8, 9)   \
        if ((l) + 1 < DEPTH) { \
            conv_expert_weights(F, args, (l) + 1); \
            norm_phase(F, h, ymoe, args.in[1] + (size_t)((l) + 1) * D, (args.flags & 1) ? nullptr : h, xn, nullptr, 0.0f, ws + WS_XN8); \
        } else { \
            float oscale_ = 0.0f; \
            PROBE_REDUCE() \
            norm_phase(F, h, ymoe, args.in[36], nullptr, nullptr, args.out, oscale_); \
        } \
    PH_END(pb + 8) \
}
    LAYER(0)
    LAYER(1)
#undef LAYER
#undef PH_BEGIN
#undef PH_END
}
}

extern "C" void kernel_launch(void* const* d_in, const int* in_sizes, int n_in, void* d_out, int out_size, void* d_ws, size_t ws_size, hipStream_t stream) {
    static int grid = 0;
    if (grid == 0) {
        if (n_in != 37 || ws_size < WS_END) { fprintf(stderr, "kernel_launch: unexpected n_in %d or ws %zu\n", n_in, ws_size); grid = -1; return; }
        int dev = 0, cus = 0;
        if (hipGetDevice(&dev) != hipSuccess || hipDeviceGetAttribute(&cus, hipDeviceAttributeMultiprocessorCount, dev) != hipSuccess) { grid = -1; return; }
        if (hipFuncSetAttribute((const void*)mk_fwd, hipFuncAttributeMaxDynamicSharedMemorySize, LDS_BYTES) != hipSuccess) { fprintf(stderr, "kernel_launch: hipFuncSetAttribute failed\n"); grid = -1; return; }
        grid = cus;
    }
    if (grid < 0) return;
    (void)hipMemsetAsync((char*)d_ws + WS_CTL, 0, 1 * MiB, stream);
    Args a{};
    for (int i = 0; i < 37; ++i) a.in[i] = (const float*)d_in[i];
    a.out = (float*)d_out; a.ws = (unsigned char*)d_ws;
    if (N_LAUNCHES == 1) {
        a.ph_lo = 0; a.ph_hi = N_PHASES;
        hipLaunchKernelGGL(mk_fwd, dim3(grid), dim3(NWAVES * 64), LDS_BYTES, stream, a);
    } else {
#ifndef REP_MASK
#define REP_MASK 0
#endif
#ifndef REP_N
#define REP_N 2
#endif
        for (int p = 0; p < N_PHASES; ++p) { a.ph_lo = p; a.ph_hi = p + 1; const int kind = p == 0 ? 0 : 1 + (p - 1) % PH_PER_LAYER; const int nrep = ((REP_MASK >> kind) & 1) ? REP_N : 1;
            for (int r = 0; r < nrep; ++r) { a.flags = (r + 1 < nrep) ? 1 : 0; hipLaunchKernelGGL(mk_fwd, dim3(grid), dim3(NWAVES * 64), LDS_BYTES, stream, a); } }
    }
}
```

```cpp
#include <hip/hip_runtime.h>
#include <cstdint>
#include <cstdio>

#ifndef MK_N_LAUNCHES
#define MK_N_LAUNCHES 1
#endif

namespace pg8 {
#define PG8_LAS __attribute__((address_space(3)))
typedef unsigned short bf16_t;
typedef short bf16x8 __attribute__((ext_vector_type(8)));
typedef float f32x4 __attribute__((ext_vector_type(4)));
typedef unsigned u32x4 __attribute__((ext_vector_type(4)));
typedef unsigned u32x2 __attribute__((ext_vector_type(2)));
constexpr int BM = 256, BK = 64, HALF = 128, HTB = HALF * BK * 2, STAGE_BYTES = 8 * HTB, NXCD = 8, WGM = 8;

__host__ __device__ __forceinline__ int lds_byte(int r, int c) { const int st = (r >> 4) * 2 + (c >> 5), rr = r & 15, cc = c & 31, ob = rr * 64 + cc * 2; return st * 1024 + (ob ^ (((ob >> 9) & 1) << 5)); }
__host__ __device__ __forceinline__ void stage_rc(int b, int& R, int& C) { const int st = b / 1024, sb = b % 1024, swz = sb ^ (((sb >> 9) & 1) << 5); R = (st >> 1) * 16 + swz / 64; C = (st & 1) * 32 + (swz % 64) / 2; }
__host__ __device__ __forceinline__ int perm32(int rho) { const int n = rho >> 4, i = rho & 15; return 8 * (i >> 2) + 4 * n + (i & 3); }

struct Unit { int pm, pn; };

struct StaticOrder {
    int nM, nN, nwg, G, c;
    __host__ __device__ void init(int M, int N, int G_, int c_) { nM = M / BM; nN = N / BM; nwg = nM * nN; G = G_; c = c_; }
    __host__ __device__ bool next(int i, Unit& u) const {
        const long L = (long)i * G + c; if (L >= nwg) return false;
        int wgid = (int)L; { const int q = nwg / NXCD, r = nwg % NXCD, xcd = wgid % NXCD, off = wgid / NXCD; wgid = (xcd < r ? xcd * (q + 1) : r * (q + 1) + (xcd - r) * q) + off; }
        const int nig = WGM * nN, gid = wgid / nig, fm = gid * WGM, gsz = (nM - fm) < WGM ? (nM - fm) : WGM;
        u.pm = fm + ((wgid % nig) % gsz); u.pn = (wgid % nig) / gsz; return true;
    }
};

typedef int i32x8 __attribute__((ext_vector_type(8)));
typedef int i32x4 __attribute__((ext_vector_type(4)));
__device__ __forceinline__ i32x8 cat8(bf16x8 a, bf16x8 b) { const i32x4 x = __builtin_bit_cast(i32x4, a), y = __builtin_bit_cast(i32x4, b); return __builtin_shufflevector(x, y, 0, 1, 2, 3, 4, 5, 6, 7); }
__device__ __forceinline__ unsigned cvt_pk_bf16(float lo, float hi) { unsigned r; asm volatile("v_cvt_pk_bf16_f32 %0, %1, %2" : "=v"(r) : "v"(lo), "v"(hi)); return r; }

template <class Epi, class Sched, bool ALIGN_EPI, bool SP2, bool FP8 = false>
__device__ __forceinline__ void gemm_phase(PG8_LAS unsigned char* lds, const int tid, const int K, const Sched& S, const Epi& E) {
    const int wid = __builtin_amdgcn_readfirstlane(tid >> 6), lane = tid & 63, wr = wid >> 2, wc = wid & 3, fr = lane & 15, fq = lane >> 4;
    const int nt = FP8 ? K / 128 : K / BK;
    const int ES = FP8 ? 1 : 2;
    unsigned voffB[2]; int RA[2], CA[2];
#pragma unroll
    for (int i = 0; i < 2; ++i) { int R, C; stage_rc(tid * 16 + i * 8192, R, C); const int Rb = Epi::PERM ? ((R & ~31) + perm32(R & 31)) : R;
        voffB[i] = (unsigned)(Rb * K * ES + C * 2); RA[i] = R; CA[i] = C; }
    const size_t kstep = (size_t)(BK * 2);
    const size_t hstepB = (size_t)HALF * K * ES;
    const unsigned ldsw = (unsigned)wid * 1024u;
    const int aoff = lds_byte(wr * 64 + fr, fq * 8), boff = lds_byte(wc * 32 + fr, fq * 8);
#define PG8_SA(b, h) (((b) * 2 + (h)) * HTB)
#define PG8_SB(b, h) ((4 + (b) * 2 + (h)) * HTB)
#define PG8_STAGE(bufoff, gbase, voff) do { _Pragma("unroll") for (int _i = 0; _i < 2; ++_i) \
        __builtin_amdgcn_global_load_lds((const unsigned*)((const char*)(gbase) + (voff)[_i]), (PG8_LAS unsigned*)(lds + (bufoff) + ldsw + _i * 8192), 16, 0, 0); } while (0)
#define PG8_LDA(dst, b, h) do { _Pragma("unroll") for (int m = 0; m < 4; ++m) { if constexpr (FP8) { dst##8[m] = cat8(*(const PG8_LAS bf16x8*)(lds + PG8_SA(b, h) + aoff + m * 2048), *(const PG8_LAS bf16x8*)(lds + PG8_SA(b, h) + aoff + m * 2048 + 1024)); } \
        else { _Pragma("unroll") for (int k = 0; k < 2; ++k) dst[m][k] = *(const PG8_LAS bf16x8*)(lds + PG8_SA(b, h) + aoff + m * 2048 + k * 1024); } } } while (0)
#define PG8_LDB(dst, b, h) do { _Pragma("unroll") for (int n = 0; n < 2; ++n) { if constexpr (FP8) { dst##8[n] = cat8(*(const PG8_LAS bf16x8*)(lds + PG8_SB(b, h) + boff + n * 2048), *(const PG8_LAS bf16x8*)(lds + PG8_SB(b, h) + boff + n * 2048 + 1024)); } \
        else { _Pragma("unroll") for (int k = 0; k < 2; ++k) dst[n][k] = *(const PG8_LAS bf16x8*)(lds + PG8_SB(b, h) + boff + n * 2048 + k * 1024); } } } while (0)
#define PG8_MMA(ai, bj, At, Bt) do { __builtin_amdgcn_s_setprio(1); _Pragma("unroll") for (int m = 0; m < 4; ++m) _Pragma("unroll") for (int n = 0; n < 2; ++n) { \
        if constexpr (FP8) { asm volatile("v_mfma_scale_f32_16x16x128_f8f6f4 %0, %1, %2, %0, %3, %3 op_sel_hi:[0,0,0]" : "+v"(acc[ai][bj][m][n]) : "v"(Bt##8[n]), "v"(At##8[m]), "v"(one_scale));     } \
        else { _Pragma("unroll") for (int k = 0; k < 2; ++k) acc[ai][bj][m][n] = __builtin_amdgcn_mfma_f32_16x16x32_bf16(Bt[n][k], At[m][k], acc[ai][bj][m][n], 0, 0, 0); } } \
        if constexpr (FP8) asm volatile("s_nop 15\n\ts_nop 7" ::: "memory");     \
        __builtin_amdgcn_s_setprio(0); } while (0)
#define PG8_WAIT_V(n) asm volatile("s_waitcnt vmcnt(" #n ")" ::: "memory")
#define PG8_WAIT_L(n) asm volatile("s_waitcnt lgkmcnt(" #n ")" ::: "memory")
#define PG8_BAR __builtin_amdgcn_s_barrier()
#define PG8_SCHED __builtin_amdgcn_sched_barrier(0)
    Unit cur, nxt; int ui = 0;
    if (!S.next(0, cur)) return;
    bool has_next = S.next(1, nxt);
    unsigned offC[2][2], offN[2][2];
#pragma unroll
    for (int h = 0; h < 2; ++h)
#pragma unroll
        for (int i = 0; i < 2; ++i) {
            if constexpr (Sched::GATHER) { offC[h][i] = S.gather_off(cur, h * HALF + RA[i]) + (unsigned)CA[i] * 2u; offN[h][i] = has_next ? S.gather_off(nxt, h * HALF + RA[i]) + (unsigned)CA[i] * 2u : offC[h][i]; }
            else { offC[h][i] = (unsigned)((h * HALF + RA[i]) * S.lda * ES + CA[i] * 2); offN[h][i] = offC[h][i]; }
        }
    f32x4 acc[2][2][4][2];
#pragma unroll
    for (int a = 0; a < 2; ++a)
#pragma unroll
        for (int b = 0; b < 2; ++b)
#pragma unroll
            for (int m = 0; m < 4; ++m)
#pragma unroll
                for (int n = 0; n < 2; ++n) acc[a][b][m][n] = (f32x4){0.f, 0.f, 0.f, 0.f};
    int one_scale = 0x7f7f7f7f; asm volatile("" : "+v"(one_scale));
    bf16x8 At[4][2], B0[2][2], B1[2][2]; i32x8 At8[4], B08[2], B18[2]; (void)At; (void)B0; (void)B1; (void)At8; (void)B08; (void)B18;
    const char* cA = S.a_base(cur); const char* cB = S.b_base(cur);
    if constexpr (Sched::WAITS) S.a_ready(cur);
    if constexpr (SP2) {
        PG8_STAGE(PG8_SB(0, 0), cB, voffB); PG8_STAGE(PG8_SB(0, 1), cB + hstepB, voffB); PG8_STAGE(PG8_SA(0, 0), cA, offC[0]); PG8_STAGE(PG8_SA(0, 1), cA, offC[1]);
        if (wr == 1) PG8_BAR;
        PG8_WAIT_V(2); PG8_BAR;
        PG8_STAGE(PG8_SB(1, 0), cB + kstep, voffB); PG8_STAGE(PG8_SA(1, 0), cA + kstep, offC[0]); PG8_STAGE(PG8_SB(1, 1), cB + hstepB + kstep, voffB);
        PG8_WAIT_V(6); PG8_BAR;
    } else {
        PG8_STAGE(PG8_SB(0, 0), cB, voffB); PG8_STAGE(PG8_SA(0, 0), cA, offC[0]); PG8_STAGE(PG8_SB(0, 1), cB + hstepB, voffB); PG8_STAGE(PG8_SA(0, 1), cA, offC[1]);
        if (wr == 1) PG8_BAR;
        PG8_WAIT_V(4); PG8_BAR;
        PG8_STAGE(PG8_SB(1, 0), cB + kstep, voffB); PG8_STAGE(PG8_SA(1, 0), cA + kstep, offC[0]); PG8_STAGE(PG8_SB(1, 1), cB + hstepB + kstep, voffB);
        PG8_WAIT_V(6); PG8_BAR;
    }
    for (;;) {
        const char* nA = has_next ? S.a_base(nxt) : cA; const char* nB = has_next ? S.b_base(nxt) : cB;
        const bool full = !(Sched::HALF && __builtin_amdgcn_readfirstlane((int)S.half_only(cur)));
#pragma unroll 1
        for (int t = 0; t < nt; t += 2) {
            const bool last = (t == nt - 2);
            const char* a1 = cA + (size_t)(t + 1) * kstep;
            const char* a2 = last ? nA : cA + (size_t)(t + 2) * kstep; const char* b2 = last ? nB : cB + (size_t)(t + 2) * kstep;
            const char* a3 = a2 + kstep; const char* b3 = b2 + kstep;
            if constexpr (Sched::WAITS) { if (last && has_next) S.a_ready(nxt); }
            unsigned o2[2][2];
#pragma unroll
            for (int h = 0; h < 2; ++h)
#pragma unroll
                for (int i = 0; i < 2; ++i) o2[h][i] = (Sched::GATHER && last) ? offN[h][i] : offC[h][i];
            if constexpr (SP2) {
            PG8_LDB(B0, 0, 0); PG8_LDB(B1, 0, 1); PG8_SCHED; PG8_LDA(At, 0, 0); PG8_STAGE(PG8_SA(1, 1), a1, offC[1]);
            PG8_WAIT_V(8); PG8_WAIT_L(0); PG8_BAR; PG8_MMA(0, 0, At, B0); PG8_MMA(0, 1, At, B1); PG8_BAR; PG8_SCHED;
            PG8_LDA(At, 0, 1); PG8_STAGE(PG8_SB(0, 0), b2, voffB); PG8_STAGE(PG8_SB(0, 1), b2 + hstepB, voffB); PG8_STAGE(PG8_SA(0, 0), a2, o2[0]);
            PG8_WAIT_V(8); PG8_WAIT_L(0); PG8_BAR; if (full) { PG8_MMA(1, 0, At, B0); PG8_MMA(1, 1, At, B1); } PG8_BAR; PG8_SCHED;
            PG8_LDB(B0, 1, 0); PG8_LDB(B1, 1, 1); PG8_SCHED; PG8_LDA(At, 1, 0); PG8_STAGE(PG8_SA(0, 1), a2, o2[1]);
            PG8_WAIT_V(8); PG8_WAIT_L(0); PG8_BAR; PG8_MMA(0, 0, At, B0); PG8_MMA(0, 1, At, B1); PG8_BAR; PG8_SCHED;
            PG8_LDA(At, 1, 1); PG8_STAGE(PG8_SB(1, 0), b3, voffB); PG8_STAGE(PG8_SB(1, 1), b3 + hstepB, voffB); PG8_STAGE(PG8_SA(1, 0), a3, o2[0]);
            PG8_WAIT_V(8); PG8_WAIT_L(0); PG8_BAR; if (full) { PG8_MMA(1, 0, At, B0); PG8_MMA(1, 1, At, B1); } PG8_BAR; PG8_SCHED;
            } else {
            PG8_LDB(B0, 0, 0); PG8_SCHED; PG8_LDA(At, 0, 0); PG8_STAGE(PG8_SA(1, 1), a1, offC[1]);
            PG8_WAIT_L(8); PG8_BAR; PG8_WAIT_L(0); PG8_MMA(0, 0, At, B0); PG8_BAR; PG8_SCHED;
            PG8_LDB(B1, 0, 1); PG8_STAGE(PG8_SB(0, 0), b2, voffB);
            PG8_BAR; PG8_WAIT_L(0); PG8_MMA(0, 1, At, B1); PG8_BAR;
            PG8_LDA(At, 0, 1); PG8_STAGE(PG8_SA(0, 0), a2, o2[0]);
            PG8_BAR; PG8_WAIT_L(0); PG8_MMA(1, 0, At, B0); PG8_BAR; PG8_SCHED;
            PG8_STAGE(PG8_SB(0, 1), b2 + hstepB, voffB);
            PG8_WAIT_V(6); PG8_BAR; PG8_MMA(1, 1, At, B1); PG8_BAR;
            PG8_LDB(B0, 1, 0); PG8_SCHED; PG8_LDA(At, 1, 0); PG8_STAGE(PG8_SA(0, 1), a2, o2[1]);
            PG8_WAIT_L(8); PG8_BAR; PG8_WAIT_L(0); PG8_MMA(0, 0, At, B0); PG8_BAR; PG8_SCHED;
            PG8_LDB(B1, 1, 1); PG8_STAGE(PG8_SB(1, 0), b3, voffB);
            PG8_BAR; PG8_WAIT_L(0); PG8_MMA(0, 1, At, B1); PG8_BAR;
            PG8_LDA(At, 1, 1); PG8_STAGE(PG8_SA(1, 0), a3, o2[0]);
            PG8_BAR; PG8_WAIT_L(0); PG8_MMA(1, 0, At, B0); PG8_BAR; PG8_SCHED;
            PG8_STAGE(PG8_SB(1, 1), b3 + hstepB, voffB);
            PG8_WAIT_V(6); PG8_BAR; PG8_MMA(1, 1, At, B1); PG8_BAR;
            }
        }
        if constexpr (ALIGN_EPI) { if (wr == 0) PG8_BAR; }
        Unit nn; bool has_nn = false;
        if constexpr (Sched::GATHER) {
            has_nn = has_next && S.next(ui + 2, nn);
#pragma unroll
            for (int h = 0; h < 2; ++h)
#pragma unroll
                for (int i = 0; i < 2; ++i) { int R_, C_; stage_rc(tid * 16 + i * 8192, R_, C_); offC[h][i] = offN[h][i]; if (has_nn) offN[h][i] = S.gather_off(nn, h * HALF + R_) + (unsigned)C_ * 2u; }
        }
        E(acc, cur, wr, wc, fr, fq);
        if constexpr (Sched::PUBLISHES) S.done(cur);
        if (!has_next) break;
#pragma unroll
        for (int a = 0; a < 2; ++a)
#pragma unroll
            for (int b = 0; b < 2; ++b)
#pragma unroll
                for (int m = 0; m < 4; ++m)
#pragma unroll
                    for (int n = 0; n < 2; ++n) acc[a][b][m][n] = (f32x4){0.f, 0.f, 0.f, 0.f};
        cur = nxt; cA = nA; cB = nB; ++ui;
        if constexpr (Sched::GATHER) { has_next = has_nn; nxt = nn; }
        else { has_next = S.next(ui + 1, nxt); }
        if constexpr (ALIGN_EPI) { if (wr == 1) PG8_BAR; }
    }
    PG8_WAIT_V(0);
    if constexpr (!ALIGN_EPI) { if (wr == 0) PG8_BAR; }
    PG8_BAR;
#undef PG8_SA
#undef PG8_SB
#undef PG8_STAGE
#undef PG8_LDA
#undef PG8_LDB
#undef PG8_MMA
#undef PG8_WAIT_V
#undef PG8_WAIT_L
#undef PG8_BAR
#undef PG8_SCHED
}
}

namespace {
constexpr int NWAVES = 8;
constexpr int N_LAUNCHES = MK_N_LAUNCHES;
constexpr int D = 1024, BATCH = 8, SEQ = 2048, DEPTH = 2, T = BATCH * SEQ;
constexpr int W = 256, IN_COLS = 1792;
constexpr int NEXP = 32, DEXP = 512;
constexpr int CHUNK = 64, NCHUNK = SEQ / CHUNK;
constexpr int CAP = 16384;
constexpr int MAXBLK = 160;
constexpr float EPS = 1e-6f;
constexpr int PH_PER_LAYER = 9, N_PHASES = 1 + PH_PER_LAYER * DEPTH;

typedef unsigned short bf16_t;
typedef float f32x4 __attribute__((ext_vector_type(4)));
typedef unsigned v4u __attribute__((ext_vector_type(4)));
#define GAS __attribute__((address_space(1)))
#define LAS __attribute__((address_space(3)))
typedef GAS unsigned gu32;
#define RLX_AGENT __ATOMIC_RELAXED, __HIP_MEMORY_SCOPE_AGENT
#define LDS_WAIT() asm volatile("s_waitcnt lgkmcnt(0)" ::: "memory")

__device__ __forceinline__ float bf2f(bf16_t b) { return __uint_as_float(((unsigned)b) << 16); }
__device__ __forceinline__ unsigned f2bfu(float f) { unsigned u = __float_as_uint(f); return (u + 0x7fffu + ((u >> 16) & 1u)) >> 16; }
__device__ __forceinline__ bf16_t f2bf(float f) { return (bf16_t)f2bfu(f); }
__device__ __forceinline__ unsigned pk2(float lo, float hi) { return f2bfu(lo) | (f2bfu(hi) << 16); }
__device__ __forceinline__ float sigmoidf_(float x) { return 1.0f / (1.0f + __expf(-x)); }
__device__ __forceinline__ float gelu_tanh(float x) {
    const float z = 0.7978845608028654f * (x + 0.044715f * x * x * x);
    const float t = 1.0f - 2.0f / (__expf(2.0f * z) + 1.0f);
    return 0.5f * x * (1.0f + t);
}

constexpr size_t MiB = 1u << 20;
constexpr size_t WS_CTL = 0;
constexpr size_t WS_TAB = 1 * MiB;
constexpr size_t WS_H = 4 * MiB;
constexpr size_t WS_XN = 68 * MiB;
constexpr size_t WS_PROJ = 100 * MiB;
constexpr size_t WS_MERGED = WS_PROJ;
constexpr size_t WS_YS = 156 * MiB;
constexpr size_t WS_R1 = 188 * MiB;
constexpr size_t WS_HBUF = WS_R1;
constexpr size_t WS_YMOE = WS_R1 + 48 * MiB;
constexpr size_t WS_S5ST = 316 * MiB;
constexpr size_t WS_LRUA = 318 * MiB;
constexpr size_t WS_LRUH = 334 * MiB;
constexpr size_t WS_LRUS = 350 * MiB;
constexpr size_t WS_BUFTS = 351 * MiB;
constexpr size_t WS_BUFW = 353 * MiB;
constexpr size_t WS_WMIX = 356 * MiB;
constexpr size_t WMIX_IN = 0, WMIX_MG = (size_t)1792 * 1024 * 2, WMIX_BR = WMIX_MG + (size_t)4096 * 1024 * 2, WMIX_OUT = WMIX_BR + (size_t)4096 * 256 * 2, WMIX_STRIDE = 16 * MiB;
static_assert(WMIX_OUT + (size_t)1024 * 1024 * 2 <= WMIX_STRIDE, "mixer weights");
constexpr size_t WS_WEXP = 388 * MiB;
constexpr size_t WEXP_W2 = 32 * MiB;
constexpr float MG_SCALE = 32.0f;
constexpr float W13_SCALE = 32.0f, W2_SCALE = 16.0f, H_SCALE = 8.0f;
constexpr size_t WS_XN8 = 484 * MiB;
constexpr size_t WS_END = 500 * MiB;

constexpr int CW_CNT = 8192;
constexpr int CW_BAR = 4096;
constexpr int CW_TMO = 16;
constexpr int CW_RDY = 32768;

constexpr int TB_NLOG = 4096 + 32768, TB_RW = 4096 + 32768 + 256;
constexpr int SM_OFF = 512 * 1024;
constexpr int SM_POOLT = 0, SM_WAT = 32768, SM_WXT = 65536, SM_GLUT = 98304, SM_BRE = 229376, SM_BIM = 262144, SM_CMAT = 294912, SM_ATAB = 360448;


constexpr int RING_BYTES = 131072;
constexpr int LDSCTL_OFF = RING_BYTES, MISC_OFF = LDSCTL_OFF + 320;
constexpr int PLAN_OFF = MISC_OFF + 128;
constexpr int LDS_BYTES = 147456;
static_assert(PLAN_OFF + 4 * 360 <= LDS_BYTES, "LDS map");

#define XB_TMO      128
#define XB_XCNT(j)  (256  + 64 * (j))
#define XB_XSUB(j)  (1280 + 64 * (j))
#define XB_XGEN(j)  (2304 + 64 * (j))
#define XB_TOP      3328
#define XB_TOPGEN   3392
#define XCD_BAR_WORDS 3456
#define XB_SPIN_CAP (1u << 18)
__device__ __forceinline__ unsigned xb_ld(unsigned* p)              { return __hip_atomic_load(p, __ATOMIC_RELAXED, __HIP_MEMORY_SCOPE_AGENT); }
__device__ __forceinline__ unsigned xb_add(unsigned* p, unsigned v) { return __hip_atomic_fetch_add(p, v, __ATOMIC_RELAXED, __HIP_MEMORY_SCOPE_AGENT); }
__device__ __forceinline__ unsigned xb_xcc_id() { return (unsigned)__builtin_amdgcn_s_getreg((3 << 11) | 20) & 0xFu; }
#define XB_SPIN(cond, bar) do { unsigned _sp = 0; while (cond) { __builtin_amdgcn_s_sleep(1); \
    if ((++_sp & 255u) == 0u) { if (xb_ld(&(bar)[XB_TMO])) break; if (_sp > XB_SPIN_CAP) { atomicAdd(&(bar)[XB_TMO], 1u); break; } } } } while (0)
struct XcdBarrier { unsigned* bar; unsigned x; volatile LAS unsigned* st; };
__device__ __forceinline__ XcdBarrier xcd_barrier_post(unsigned* bar, volatile LAS unsigned* st) {
    XcdBarrier b; b.bar = bar; b.x = xb_xcc_id(); b.st = st;
    if (threadIdx.x == 0) (void)xb_add(&bar[XB_XCNT(b.x)], 1u);
    return b;
}
__device__ __forceinline__ void xcd_barrier_complete(unsigned* bar, unsigned x, unsigned& nloc, unsigned& nx) {
    const unsigned G = gridDim.x * gridDim.y * gridDim.z;
    unsigned sum, cnt, mine, sp = 0u;
    for (;;) {
        sum = 0u; cnt = 0u; mine = 0u;
#pragma unroll
        for (unsigned j = 0; j < 16; ++j) { const unsigned c = xb_ld(&bar[XB_XCNT(j)]); sum += c; cnt += (c > 0u) ? 1u : 0u; mine = (j == x) ? c : mine; }
        if (sum == G) break;
        __builtin_amdgcn_s_sleep(1);
        if ((++sp & 255u) == 0u) { if (xb_ld(&bar[XB_TMO])) break; if (sp > XB_SPIN_CAP) { atomicAdd(&bar[XB_TMO], 1u); break; } }
    }
    nloc = mine > 0u ? mine : 1u; nx = cnt > 0u ? cnt : 1u;
}
__device__ __forceinline__ void xcd_barrier(const XcdBarrier& b) {
    asm volatile("s_waitcnt vmcnt(0)" ::: "memory");
    __syncthreads();
    if (threadIdx.x == 0) {
        unsigned* bar = b.bar;
        __builtin_amdgcn_s_waitcnt(0);
        unsigned nloc = b.st[0], nx = b.st[1];
        if (nloc == 0u) { xcd_barrier_complete(bar, b.x, nloc, nx); b.st[0] = nloc; b.st[1] = nx; }
        const unsigned old = xb_add(&bar[XB_XSUB(b.x)], 1u);
        const unsigned gen = old / nloc;
        if (old + 1u == (gen + 1u) * nloc) {
            __builtin_amdgcn_fence(__ATOMIC_RELEASE, "agent");
            asm volatile("s_waitcnt vmcnt(0)" ::: "memory");
            const unsigned og = xb_add(&bar[XB_TOP], 1u);
            const unsigned tg = og / nx;
            if (og + 1u == (tg + 1u) * nx) xb_add(&bar[XB_TOPGEN], 1u);
            else XB_SPIN(xb_ld(&bar[XB_TOPGEN]) == tg, bar);
            __builtin_amdgcn_fence(__ATOMIC_ACQUIRE, "agent");
            xb_add(&bar[XB_XGEN(b.x)], 1u);
            asm volatile("s_waitcnt vmcnt(0)" ::: "memory");
        } else {
            XB_SPIN(xb_ld(&bar[XB_XGEN(b.x)]) == gen, bar);
            __builtin_amdgcn_fence(__ATOMIC_ACQUIRE, "agent");
            asm volatile("s_waitcnt vmcnt(0)" ::: "memory");
        }
    }
    __syncthreads();
}

#ifdef PROBE_A
#define STAMP(id) do { if (threadIdx.x == 0) ((unsigned long long*)(g_dbg))[(size_t)blockIdx.x * 64 + (id)] = __builtin_amdgcn_s_memrealtime(); } while (0)
#else
#define STAMP(id) do { } while (0)
#endif
#define g_dbg (F.ws + WS_END)

struct Args { const float* in[37]; float* out; unsigned char* ws; int ph_lo, ph_hi; int flags, pad; };

struct Frame {
    LAS unsigned char* lds;
    unsigned char* smem;
    volatile LAS unsigned* MISC;
    unsigned* ctl;
    int tid, lane, wave, vcu, G;
    unsigned char* ws;
};

struct MapNat { int off; __device__ __forceinline__ int operator()(int n) const { return off + n; } };
struct MapGate { __device__ __forceinline__ int operator()(int s) const {
    const int k4 = s >> 10, d = s & 1023, pn = d >> 6, dd = d & 63;
    return pn * 256 + 128 * (k4 >> 1) + 32 * (dd >> 4) + 16 * (k4 & 1) + 4 * ((dd >> 2) & 3) + (dd & 3); } };
struct MapMoe13 { int which; __device__ __forceinline__ int operator()(int hid) const {
    const int pn = hid >> 7, r = hid & 127;
    return pn * 256 + 128 * (r >> 6) + 32 * ((r >> 4) & 3) + 16 * which + 4 * ((r >> 2) & 3) + (r & 3); } };

template <class RowMap>
__device__ __forceinline__ void transpose_item(const float* W, int K, int N, bf16_t* WT, LAS float* scr, int item, int lane, const RowMap rm) {
    const int nblk = N / 32, kb = item / nblk, nb = item % nblk, k0 = 64 * kb, n0 = 32 * nb;
#pragma unroll 8
    for (int i = 0; i < 32; ++i) { const int kk = 2 * i + (lane >> 5); scr[kk * 33 + (lane & 31)] = W[(size_t)(k0 + kk) * N + n0 + (lane & 31)]; }
    LDS_WAIT(); asm volatile("" ::: "memory");
    const int c = lane & 7;
#pragma unroll
    for (int j = 0; j < 4; ++j) { const int n = (lane >> 3) + 8 * j; const LAS float* s = scr + (8 * c) * 33 + n;
        v4u o; o.x = pk2(s[0 * 33], s[1 * 33]); o.y = pk2(s[2 * 33], s[3 * 33]); o.z = pk2(s[4 * 33], s[5 * 33]); o.w = pk2(s[6 * 33], s[7 * 33]);
        *(GAS v4u*)(WT + (size_t)rm(n0 + n) * K + k0 + 8 * c) = o; }
    LDS_WAIT(); asm volatile("" ::: "memory");
}

__device__ __forceinline__ unsigned pk4_fp8(float a, float b, float c, float d) { int w = 0; w = __builtin_amdgcn_cvt_pk_fp8_f32(a, b, w, false); w = __builtin_amdgcn_cvt_pk_fp8_f32(c, d, w, true); return (unsigned)w; }
template <class RowMap>
__device__ __forceinline__ void transpose_item_fp8(const float* W, int K, int N, unsigned char* WT, LAS unsigned char* scr, int item, int lane, const RowMap rm, const float scl) {
    const int nblk = N / 32, kb = item / nblk, nb = item % nblk, k0 = 128 * kb, n0 = 32 * nb;
#pragma unroll 16
    for (int i = 0; i < 64; ++i) { const int kk = 2 * i + (lane >> 5); const float v = W[(size_t)(k0 + kk) * N + n0 + (lane & 31)] * scl;
        scr[(lane & 31) * 144 + kk] = (unsigned char)__builtin_amdgcn_cvt_pk_fp8_f32(v, 0.f, 0, false); }
    LDS_WAIT(); asm volatile("" ::: "memory");
    const int c = lane & 7;
#pragma unroll
    for (int j = 0; j < 4; ++j) { const int n = (lane >> 3) + 8 * j;
        *(GAS v4u*)(WT + (size_t)rm(n0 + n) * K + k0 + 16 * c) = *(const LAS v4u*)(scr + n * 144 + 16 * c); }
    LDS_WAIT(); asm volatile("" ::: "memory");
}

__device__ __forceinline__ void conv_mixer_weights(Frame& F, const Args& a) {
    LAS float* scr = (LAS float*)(F.lds + F.wave * 16384);
    const int gw = F.vcu * NWAVES + F.wave, NGW = F.G * NWAVES;
    constexpr int I_IN = 16 * 56, I_MG = 8 * 128, I_BR = 4 * 32, I_OUT = 16 * 32, PER_L = I_IN + I_MG + 4 * I_BR + I_OUT;
    for (int it = gw; it < DEPTH * PER_L; it += NGW) {
        const int l = it / PER_L; int r = it % PER_L;
        unsigned char* wb = F.ws + WS_WMIX + (size_t)l * WMIX_STRIDE;
        if (r < I_IN) { transpose_item(a.in[2] + (size_t)l * D * IN_COLS, D, IN_COLS, (bf16_t*)(wb + WMIX_IN), scr, r, F.lane, MapNat{0}); continue; } r -= I_IN;
        if (r < I_MG) { transpose_item_fp8(a.in[24] + (size_t)l * D * 4096, D, 4096, wb + WMIX_MG, (LAS unsigned char*)scr, r, F.lane, MapGate{}, MG_SCALE); continue; } r -= I_MG;
        if (r < 4 * I_BR) { const int k4 = r / I_BR; transpose_item(a.in[26] + ((size_t)l * 4 + k4) * W * D, W, D, (bf16_t*)(wb + WMIX_BR), scr, r % I_BR, F.lane, MapNat{k4 * 1024}); continue; } r -= 4 * I_BR;
        transpose_item(a.in[27] + (size_t)l * D * D, D, D, (bf16_t*)(wb + WMIX_OUT), scr, r, F.lane, MapNat{0});
    }
}
__device__ __forceinline__ void conv_expert_weights(Frame& F, const Args& a, int l) {
    LAS unsigned char* scr = F.lds + F.wave * 16384;
    const int gw = F.vcu * NWAVES + F.wave, NGW = F.G * NWAVES;
    constexpr int I_13 = 8 * 16, I_2 = 4 * 32, PER_E = 2 * I_13 + I_2;
    for (int it = gw; it < NEXP * PER_E; it += NGW) {
        const int e = it / PER_E; int r = it % PER_E;
        unsigned char* w13 = F.ws + WS_WEXP + (size_t)e * 1024 * 1024;
        unsigned char* w2t = F.ws + WS_WEXP + WEXP_W2 + (size_t)e * 1024 * 512;
        if (r < I_13) { transpose_item_fp8(a.in[33] + ((size_t)l * NEXP + e) * D * DEXP, D, DEXP, w13, scr, r, F.lane, MapMoe13{0}, W13_SCALE); continue; } r -= I_13;
        if (r < I_13) { transpose_item_fp8(a.in[34] + ((size_t)l * NEXP + e) * D * DEXP, D, DEXP, w13, scr, r, F.lane, MapMoe13{1}, W13_SCALE); continue; } r -= I_13;
        transpose_item_fp8(a.in[35] + ((size_t)l * NEXP + e) * DEXP * D, DEXP, D, w2t, scr, r, F.lane, MapNat{0}, W2_SCALE);
    }
}
__device__ __forceinline__ void prep_tables(Frame& F, const Args& a) {
    for (int idx = F.vcu * 512 + F.tid; idx < DEPTH * 65536; idx += F.G * 512) {
        const int l = idx >> 16, gid = idx & 65535;
        float* tab = (float*)(F.ws + WS_TAB + (size_t)l * MiB);
        unsigned char* sm = F.ws + WS_TAB + (size_t)l * MiB + SM_OFF;
        if (gid < 1024) {
            const int g = gid >> 6;
            const double lre = fmin((double)a.in[7][l * 1024 + gid], -1e-4);
            const double lim = (double)a.in[8][l * 1024 + gid];
            const double step = exp((double)a.in[9][l * 16 + g]);
            const double er = exp(lre * step), ar = er * cos(lim * step), ai = er * sin(lim * step);
            const double nr = ar - 1.0, ni = ai, den = lre * lre + lim * lim;
            const double cr = (nr * lre + ni * lim) / den, ci = (ni * lre - nr * lim) / den;
            float* at = (float*)(sm + SM_ATAB) + gid * 12;
            const double pw[5] = {1.0, 4.0, 8.0, 12.0, 64.0};
            for (int i = 0; i < 5; ++i) { const double e = exp(lre * step * pw[i]); at[2 * i] = (float)(e * cos(lim * step * pw[i])); at[2 * i + 1] = (float)(e * sin(lim * step * pw[i])); }
            at[10] = 0.f; at[11] = 0.f;
            for (int h = 0; h < 16; ++h) {
                const double br = (double)a.in[10][((size_t)l * 1024 + gid) * 16 + h], bi = (double)a.in[11][((size_t)l * 1024 + gid) * 16 + h];
                ((bf16_t*)(sm + SM_BRE))[gid * 16 + h] = f2bf((float)(cr * br - ci * bi));
                ((bf16_t*)(sm + SM_BIM))[gid * 16 + h] = f2bf((float)(cr * bi + ci * br));
            }
        }
        if (gid < 256) { const double lam = (double)a.in[23][l * 256 + gid]; tab[TB_NLOG + gid] = (float)(-8.0 * log1p(exp(-lam))); }
        if (gid < 49152) { const int o = gid >> 10, k = gid & 1023; const float gk = a.in[28][(size_t)l * 1024 + k];
            const float w = (o < 4) ? gk * a.in[29][((size_t)l * 1024 + k) * 4 + o] : (o < 36 ? gk * a.in[31][((size_t)l * 1024 + k) * 32 + (o - 4)] : 0.f);
            const bf16_t wh = f2bf(w); ((bf16_t*)(tab + TB_RW))[gid] = wh; ((bf16_t*)(tab + TB_RW))[49152 + gid] = f2bf(w - bf2f(wh)); }
        if (gid < 16384) { const int g = gid >> 12, d = (gid >> 6) & 63, cc = gid & 63; const size_t si = ((size_t)(l * 4 + g) * 64 + cc) * 64 + d;
            ((bf16_t*)(sm + SM_POOLT))[gid] = f2bf(a.in[4][si]); ((bf16_t*)(sm + SM_WAT))[gid] = f2bf(a.in[19][si]); ((bf16_t*)(sm + SM_WXT))[gid] = f2bf(a.in[21][si]); }
        if (gid < 32768) { const int g = gid >> 11, cc = (gid >> 7) & 15, k = gid & 127, p = k >> 1; const size_t si = ((size_t)(l * 16 + g) * 16 + cc) * 64 + p;
            ((bf16_t*)(sm + SM_CMAT))[gid] = f2bf((k & 1) ? -a.in[13][si] : a.in[12][si]); }
        { const int col = gid >> 8, k = gid & 255; ((bf16_t*)(sm + SM_GLUT))[gid] = f2bf(a.in[15][((size_t)l * 256 + k) * 256 + col]); }
    }
}

__device__ __forceinline__ void norm_phase(Frame& F, const float* hin, const bf16_t* y, const float* g, float* hout, bf16_t* xn, float* out, const float oadd = 0.0f, unsigned char* xn8 = nullptr) {
    const int gw = F.vcu * NWAVES + F.wave, NGW = F.G * NWAVES, lane = F.lane;
    f32x4 gg[4];
#pragma unroll
    for (int j = 0; j < 4; ++j) gg[j] = *(const f32x4*)(g + 4 * lane + 256 * j);
    for (int m0 = gw; m0 < T; m0 += 4 * NGW) {
        f32x4 v[4][4]; uint2 ya[4][4], yb[4][4];
#pragma unroll
        for (int i = 0; i < 4; ++i) {
            const int m = m0 + i * NGW;
            if (m < T) {
#pragma unroll
                for (int j = 0; j < 4; ++j) {
                    const int col = 4 * lane + 256 * j;
                    v[i][j] = *(const f32x4*)(hin + (size_t)m * D + col);
                    if (y) { ya[i][j] = *(const uint2*)(y + ((size_t)m * 2 + 0) * D + col); yb[i][j] = *(const uint2*)(y + ((size_t)m * 2 + 1) * D + col); }
                }
            }
        }
            __builtin_amdgcn_sched_barrier(0);
#pragma unroll
        for (int i = 0; i < 4; ++i) {
            const int m = m0 + i * NGW;
            if (m < T) {
                float s = 0.f;
#pragma unroll
                for (int j = 0; j < 4; ++j) {
                    if (y) {
                        v[i][j].x += __uint_as_float(ya[i][j].x << 16) + __uint_as_float(yb[i][j].x << 16);
                        v[i][j].y += __uint_as_float(ya[i][j].x & 0xffff0000u) + __uint_as_float(yb[i][j].x & 0xffff0000u);
                        v[i][j].z += __uint_as_float(ya[i][j].y << 16) + __uint_as_float(yb[i][j].y << 16);
                        v[i][j].w += __uint_as_float(ya[i][j].y & 0xffff0000u) + __uint_as_float(yb[i][j].y & 0xffff0000u);
                    }
                    s += v[i][j].x * v[i][j].x + v[i][j].y * v[i][j].y + v[i][j].z * v[i][j].z + v[i][j].w * v[i][j].w;
                }
#pragma unroll
                for (int o = 1; o < 64; o <<= 1) s += __shfl_xor(s, o);
                const float rstd = rsqrtf(s * (1.0f / D) + EPS);
#pragma unroll
                for (int j = 0; j < 4; ++j) {
                    const int col = 4 * lane + 256 * j;
                    if (hout) *(f32x4*)(hout + (size_t)m * D + col) = v[i][j];
                    const f32x4 o = v[i][j] * rstd * gg[j];
                    if (xn) { uint2 w; w.x = pk2(o.x, o.y); w.y = pk2(o.z, o.w); *(uint2*)(xn + (size_t)m * D + col) = w; }
                    if (xn8) *(unsigned*)(xn8 + (size_t)m * D + col) = pk4_fp8(o.x, o.y, o.z, o.w);
                    if (out) { f32x4 oo = o; if (m == 0 && col == 0) oo.x += oadd; *(f32x4*)(out + (size_t)m * D + col) = oo; }
                }
            }
        }
    }
}

constexpr int TROW = 528;
constexpr int TILE_BYTES = 64 * TROW;
constexpr int HROW = 272, HTILE = 16 * HROW;
constexpr int CARRY_OFF = 2 * TILE_BYTES + 8 * HTILE;

struct MixArgs {
    const bf16_t* proj; bf16_t* ys; const float* tab; const unsigned char* sm; unsigned char* ws;
    float2* s5st; float2* lruS;
    const float *conv_a_w, *pool_b, *pool_scale, *s5_d, *glu_b, *lconv_w, *lconv_b, *ba, *bx;
};

typedef short bf16x8 __attribute__((ext_vector_type(8)));
__device__ __forceinline__ f32x4 mma16(bf16x8 a, bf16x8 b, f32x4 c) { return __builtin_amdgcn_mfma_f32_16x16x32_bf16(a, b, c, 0, 0, 0); }
__device__ __forceinline__ void ld8(const bf16_t* p, float (&x)[8]) {
    const v4u v = *(const v4u*)p;
    x[0] = __uint_as_float(v.x << 16); x[1] = __uint_as_float(v.x & 0xffff0000u); x[2] = __uint_as_float(v.y << 16); x[3] = __uint_as_float(v.y & 0xffff0000u);
    x[4] = __uint_as_float(v.z << 16); x[5] = __uint_as_float(v.z & 0xffff0000u); x[6] = __uint_as_float(v.w << 16); x[7] = __uint_as_float(v.w & 0xffff0000u);
}
__device__ __forceinline__ void ldf8(const float* p, float (&x)[8]) { const f32x4 a = *(const f32x4*)p, b = *(const f32x4*)(p + 4); x[0] = a.x; x[1] = a.y; x[2] = a.z; x[3] = a.w; x[4] = b.x; x[5] = b.y; x[6] = b.z; x[7] = b.w; }
typedef unsigned v2u __attribute__((ext_vector_type(2)));
__device__ __forceinline__ v4u pack8(const float (&x)[8]) { v4u o; o.x = pk2(x[0], x[1]); o.y = pk2(x[2], x[3]); o.z = pk2(x[4], x[5]); o.w = pk2(x[6], x[7]); return o; }
template <int N> __device__ __forceinline__ float dpp_row_shr(float oldv, float src) {
    return __int_as_float(__builtin_amdgcn_update_dpp(__float_as_int(oldv), __float_as_int(src), 0x110 + N, 0xf, 0xf, false));
}

template <int PH>
__device__ __forceinline__ void mix_unit(const MixArgs& A, LAS unsigned char* lds, int unit, int tid) {
    const int lane = tid & 63, wave = __builtin_amdgcn_readfirstlane(tid >> 6), j = lane & 15, q = lane >> 4;
    const int b = unit >> 5, c = unit & 31;
    const size_t t0 = (size_t)b * SEQ + c * CHUNK;
    LAS unsigned char* T0 = lds; LAS unsigned char* T1 = lds + TILE_BYTES; LAS unsigned char* Hw = lds + 2 * TILE_BYTES + wave * HTILE;
    const int cg = tid & 31, tg = tid >> 5, tl0 = tg * 4, pos0 = c * CHUNK + tl0;
    const bf16_t* prow = A.proj + (t0 + tl0) * IN_COLS + cg * 8;
    const unsigned char* sm = A.sm;
    const struct { unsigned char* ws; } F = {A.ws}; (void)F;
    typedef float f32x2_ __attribute__((ext_vector_type(2)));
    LAS f32x2_* cS5 = (LAS f32x2_*)(lds + CARRY_OFF);
    LAS float* cLru = (LAS float*)(lds + CARRY_OFF + 8192);
    if (PH == 2) {
#pragma unroll
        for (int s2 = 0; s2 < 2; ++s2) {
            const int si = tid + 512 * s2;
            const float a64r = ((const float*)(sm + SM_ATAB))[si * 12 + 8], a64i = ((const float*)(sm + SM_ATAB))[si * 12 + 9];
            float hr_ = 0.f, hi_ = 0.f;
            for (int j0 = 0; j0 < c; j0 += 8) {
                float2 sv[8];
#pragma unroll
                for (int u = 0; u < 8; ++u) { const int jj = (j0 + u < c) ? j0 + u : c - 1; sv[u] = A.s5st[((size_t)b * NCHUNK + jj) * 1024 + si]; }
#pragma unroll
                for (int u = 0; u < 8; ++u) if (j0 + u < c) { const float nr = a64r * hr_ - a64i * hi_ + sv[u].x, ni = a64r * hi_ + a64i * hr_ + sv[u].y; hr_ = nr; hi_ = ni; }
            }
            cS5[si] = (f32x2_){hr_, hi_};
        }
        if (tid < 256) {
            float hin_ = 0.f;
            for (int j0 = 0; j0 < c; j0 += 8) {
                float2 sv[8];
#pragma unroll
                for (int u = 0; u < 8; ++u) { const int jj = (j0 + u < c) ? j0 + u : c - 1; sv[u] = A.lruS[((size_t)b * NCHUNK + jj) * 256 + tid]; }
#pragma unroll
                for (int u = 0; u < 8; ++u) if (j0 + u < c) hin_ = sv[u].x * hin_ + sv[u].y;
            }
            cLru[tid] = hin_;
        }
    }

    if (PH == 2) STAMP(52);
    if (PH == 2) {
        float w0[8], w1[8], w2[8];
        ldf8(A.conv_a_w + 0 * 256 + cg * 8, w0); ldf8(A.conv_a_w + 1 * 256 + cg * 8, w1); ldf8(A.conv_a_w + 2 * 256 + cg * 8, w2);
        float v[6][8];
#pragma unroll
        for (int i = 0; i < 6; ++i) {
            if (pos0 - 2 + i >= 0) { float ac[8], ax[8]; ld8(prow + (long)(i - 2) * IN_COLS + 256, ac); ld8(prow + (long)(i - 2) * IN_COLS + 512, ax);
#pragma unroll
                for (int e = 0; e < 8; ++e) v[i][e] = ac[e] * ax[e]; }
            else {
#pragma unroll
                for (int e = 0; e < 8; ++e) v[i][e] = 0.f; }
        }
#pragma unroll
        for (int n = 0; n < 4; ++n) {
            float ab[8], o[8]; ld8(prow + (long)n * IN_COLS, ab);
#pragma unroll
            for (int e = 0; e < 8; ++e) o[e] = ab[e] * (w0[e] * v[n][e] + w1[e] * v[n + 1][e] + w2[e] * v[n + 2][e]);
            *(v4u*)(A.ys + (t0 + tl0 + n) * 1024 + cg * 8) = pack8(o);
        }
    }
    if (PH == 2) {
        const int win = 2 << (cg >> 3);
        float S[8], x0[8];
#pragma unroll
        for (int e = 0; e < 8; ++e) S[e] = 0.f;
        ld8(prow + 768, x0);
#pragma unroll
        for (int e = 0; e < 8; ++e) S[e] = x0[e];
        for (int i = 1; i < win; ++i) if (pos0 - i >= 0) { float x[8]; ld8(prow - (long)i * IN_COLS + 768, x);
#pragma unroll
            for (int e = 0; e < 8; ++e) S[e] += x[e]; }
        {
            const int cnt = (pos0 + 1 < win) ? pos0 + 1 : win; const float inv = 1.0f / (float)cnt; float o[8];
#pragma unroll
            for (int e = 0; e < 8; ++e) o[e] = S[e] * inv - x0[e];
            *(LAS v4u*)(T0 + tl0 * TROW + cg * 16) = pack8(o);
        }
#pragma unroll 1
        for (int n = 1; n < 4; ++n) {
            float xn_[8]; ld8(prow + (long)n * IN_COLS + 768, xn_);
#pragma unroll
            for (int e = 0; e < 8; ++e) S[e] += xn_[e];
            if (pos0 + n - win >= 0) { float xo[8]; ld8(prow + (long)(n - win) * IN_COLS + 768, xo);
#pragma unroll
                for (int e = 0; e < 8; ++e) S[e] -= xo[e]; }
            const int cnt = (pos0 + n + 1 < win) ? pos0 + n + 1 : win; const float inv = 1.0f / (float)cnt; float o[8];
#pragma unroll
            for (int e = 0; e < 8; ++e) o[e] = S[e] * inv - xn_[e];
            *(LAS v4u*)(T0 + (tl0 + n) * TROW + cg * 16) = pack8(o);
        }
    }
    {
        float w0[8], w1[8], w2[8], w3[8], cb[8];
        ldf8(A.lconv_w + 0 * 256 + cg * 8, w0); ldf8(A.lconv_w + 1 * 256 + cg * 8, w1); ldf8(A.lconv_w + 2 * 256 + cg * 8, w2); ldf8(A.lconv_w + 3 * 256 + cg * 8, w3); ldf8(A.lconv_b + cg * 8, cb);
        float x[7][8];
#pragma unroll
        for (int i = 0; i < 7; ++i) {
            if (pos0 - 3 + i >= 0) ld8(prow + (long)(i - 3) * IN_COLS + 1280, x[i]);
            else {
#pragma unroll
                for (int e = 0; e < 8; ++e) x[i][e] = 0.f; }
        }
#pragma unroll
        for (int n = 0; n < 4; ++n) {
            float o[8];
#pragma unroll
            for (int e = 0; e < 8; ++e) o[e] = w0[e] * x[n][e] + w1[e] * x[n + 1][e] + w2[e] * x[n + 2][e] + w3[e] * x[n + 3][e] + cb[e];
            *(LAS v4u*)(T1 + (tl0 + n) * TROW + cg * 16) = pack8(o);
        }
    }
    __syncthreads();
    if (PH == 2) STAMP(53);

    const int hd = wave >> 1, dt0 = 2 * (wave & 1);
    if (PH == 2) {
        const bf16_t* WT = (const bf16_t*)(sm + SM_POOLT) + hd * 4096;
        f32x4 acc[2][4];
#pragma unroll
        for (int d = 0; d < 2; ++d)
#pragma unroll
            for (int tt = 0; tt < 4; ++tt) acc[d][tt] = (f32x4){0.f, 0.f, 0.f, 0.f};
#pragma unroll
        for (int ks = 0; ks < 2; ++ks) {
            bf16x8 wf[2];
#pragma unroll
            for (int d = 0; d < 2; ++d) wf[d] = *(const bf16x8*)(WT + ((dt0 + d) * 16 + j) * 64 + ks * 32 + 8 * q);
#pragma unroll
            for (int tt = 0; tt < 4; ++tt) { const bf16x8 xf = *(const LAS bf16x8*)(T0 + (tt * 16 + j) * TROW + (hd * 64 + ks * 32 + 8 * q) * 2);
#pragma unroll
                for (int d = 0; d < 2; ++d) acc[d][tt] = mma16(wf[d], xf, acc[d][tt]); }
        }
#pragma unroll
        for (int d = 0; d < 2; ++d) {
            const int ch0 = hd * 64 + (dt0 + d) * 16 + 4 * q;
            const f32x4 pb = *(const f32x4*)(A.pool_b + ch0), ps = *(const f32x4*)(A.pool_scale + ch0);
#pragma unroll
            for (int tt = 0; tt < 4; ++tt) { const f32x4 o = (acc[d][tt] + pb) * ps; v2u w; w.x = pk2(o.x, o.y); w.y = pk2(o.z, o.w);
                *(v2u*)(A.ys + (t0 + tt * 16 + j) * 1024 + 256 + ch0) = w; }
        }
    }
    if (PH == 2) STAMP(54);
    {
        const bf16_t* WA = (const bf16_t*)(sm + SM_WAT) + hd * 4096; const bf16_t* WX = (const bf16_t*)(sm + SM_WXT) + hd * 4096;
        f32x4 ga[2][4], gx[2][4];
#pragma unroll
        for (int d = 0; d < 2; ++d)
#pragma unroll
            for (int tt = 0; tt < 4; ++tt) { ga[d][tt] = (f32x4){0.f, 0.f, 0.f, 0.f}; gx[d][tt] = (f32x4){0.f, 0.f, 0.f, 0.f}; }
#pragma unroll
        for (int ks = 0; ks < 2; ++ks) {
            bf16x8 wa[2], wx[2];
#pragma unroll
            for (int d = 0; d < 2; ++d) { wa[d] = *(const bf16x8*)(WA + ((dt0 + d) * 16 + j) * 64 + ks * 32 + 8 * q); wx[d] = *(const bf16x8*)(WX + ((dt0 + d) * 16 + j) * 64 + ks * 32 + 8 * q); }
#pragma unroll
            for (int tt = 0; tt < 4; ++tt) { const bf16x8 xf = *(const LAS bf16x8*)(T1 + (tt * 16 + j) * TROW + (hd * 64 + ks * 32 + 8 * q) * 2);
#pragma unroll
                for (int d = 0; d < 2; ++d) { ga[d][tt] = mma16(wa[d], xf, ga[d][tt]); gx[d][tt] = mma16(wx[d], xf, gx[d][tt]); } }
        }
#pragma unroll
        for (int d = 0; d < 2; ++d) {
            const int ch0 = hd * 64 + (dt0 + d) * 16 + 4 * q;
            const f32x4 bav = *(const f32x4*)(A.ba + ch0), bxv = *(const f32x4*)(A.bx + ch0), nlg = *(const f32x4*)(A.tab + TB_NLOG + ch0);
            float hin[4] = {0.f, 0.f, 0.f, 0.f}, aprod[4] = {1.f, 1.f, 1.f, 1.f};
            if (PH == 2) {
#pragma unroll
                for (int r = 0; r < 4; ++r) hin[r] = cLru[ch0 + r];
            }
#pragma unroll
            for (int tt = 0; tt < 4; ++tt) {
                const v2u xcw = *(const LAS v2u*)(T1 + (tt * 16 + j) * TROW + ch0 * 2);
                const float xc[4] = {__uint_as_float(xcw.x << 16), __uint_as_float(xcw.x & 0xffff0000u), __uint_as_float(xcw.y << 16), __uint_as_float(xcw.y & 0xffff0000u)};
                float hv[4];
#pragma unroll
                for (int r = 0; r < 4; ++r) {
                    const float rg = sigmoidf_(ga[d][tt][r] + bav[r]), ig = sigmoidf_(gx[d][tt][r] + bxv[r]);
                    const float la = nlg[r] * rg; float av = __expf(la); const float mult = sqrtf(fmaxf(1.0f - av * av, 0.f));
                    float bv = mult * ig * xc[r];
                    { const float ap = dpp_row_shr<1>(1.f, av), bp = dpp_row_shr<1>(0.f, bv); bv = av * bp + bv; av = av * ap; }
                    { const float ap = dpp_row_shr<2>(1.f, av), bp = dpp_row_shr<2>(0.f, bv); bv = av * bp + bv; av = av * ap; }
                    { const float ap = dpp_row_shr<4>(1.f, av), bp = dpp_row_shr<4>(0.f, bv); bv = av * bp + bv; av = av * ap; }
                    { const float ap = dpp_row_shr<8>(1.f, av), bp = dpp_row_shr<8>(0.f, bv); bv = av * bp + bv; av = av * ap; }
                    const float h = bv + av * hin[r];
                    hv[r] = h;
                    hin[r] = __shfl(h, (lane & 48) | 15);
                    if (PH == 1) aprod[r] *= __shfl(av, (lane & 48) | 15);
                }
                if (PH == 2) {
                    const v2u gw = *(const v2u*)(A.proj + (t0 + tt * 16 + j) * IN_COLS + 1536 + ch0);
                    const float g0 = gelu_tanh(__uint_as_float(gw.x << 16)), g1 = gelu_tanh(__uint_as_float(gw.x & 0xffff0000u)), g2 = gelu_tanh(__uint_as_float(gw.y << 16)), g3 = gelu_tanh(__uint_as_float(gw.y & 0xffff0000u));
                    v2u w; w.x = pk2(hv[0] * g0, hv[1] * g1); w.y = pk2(hv[2] * g2, hv[3] * g3);
                    *(v2u*)(A.ys + (t0 + tt * 16 + j) * 1024 + 768 + ch0) = w;
                }
            }
            if (PH == 1 && j == 15) {
                float2* sp = A.lruS + ((size_t)b * NCHUNK + c) * 256 + ch0;
#pragma unroll
                for (int r = 0; r < 4; ++r) sp[r] = make_float2(aprod[r], hin[r]);
            }
        }
    }
    if (PH == 2) STAMP(55);
    __syncthreads();

#pragma unroll
    for (int n = 0; n < 4; ++n) *(LAS v4u*)(T0 + (tl0 + n) * TROW + cg * 16) = *(const v4u*)(prow + (long)n * IN_COLS + 1024);
    __syncthreads();
    const bf16x8 zf = (bf16x8){0, 0, 0, 0, 0, 0, 0, 0};
    if (PH == 2) STAMP(56);
#pragma unroll 1
    for (int gi = 0; gi < 2; ++gi) {
        const int g = wave * 2 + gi;
        float ar[4], ai[4], a4r[4], a4i[4], a8r[4], a8i[4], aqr[4], aqi[4], hr[4], hi[4];
        bf16x8 bref[4], bimf[4];
#pragma unroll
        for (int st = 0; st < 4; ++st) {
            const int si = g * 64 + st * 16 + j;
            const float* at = (const float*)(sm + SM_ATAB) + si * 12;
            const f32x4 t0v = *(const f32x4*)at, t1v = *(const f32x4*)(at + 4);
            ar[st] = t0v.x; ai[st] = t0v.y; a4r[st] = t0v.z; a4i[st] = t0v.w; a8r[st] = t1v.x; a8i[st] = t1v.y;
            aqr[st] = q == 0 ? 1.f : (q == 1 ? t0v.z : (q == 2 ? t1v.x : t1v.z));
            aqi[st] = q == 0 ? 0.f : (q == 1 ? t0v.w : (q == 2 ? t1v.y : t1v.w));
            hr[st] = 0.f; hi[st] = 0.f;
            if (PH == 2) { const f32x2_ cv = cS5[si]; hr[st] = cv.x; hi[st] = cv.y; }
            bref[st] = (q < 2) ? *(const bf16x8*)((const bf16_t*)(sm + SM_BRE) + si * 16 + 8 * q) : zf;
            bimf[st] = (q < 2) ? *(const bf16x8*)((const bf16_t*)(sm + SM_BIM) + si * 16 + 8 * q) : zf;
        }
        bf16x8 cf[4];
        if (PH == 2) {
#pragma unroll
            for (int ks = 0; ks < 4; ++ks) cf[ks] = *(const bf16x8*)((const bf16_t*)(sm + SM_CMAT) + (g * 16 + j) * 128 + ks * 32 + 8 * q);
        }
        const f32x4 dv = *(const f32x4*)(A.s5_d + g * 16 + 4 * q);
#pragma unroll 1
        for (int tt = 0; tt < 4; ++tt) {
            const bf16x8 uf = (q < 2) ? *(const LAS bf16x8*)(T0 + (tt * 16 + j) * TROW + (g * 16 + 8 * q) * 2) : zf;
#pragma unroll
            for (int st = 0; st < 4; ++st) {
                const f32x4 z4 = (f32x4){0.f, 0.f, 0.f, 0.f};
                const f32x4 dre = mma16(uf, bref[st], z4), dim = mma16(uf, bimf[st], z4);
                float er = dre[0], ei = dim[0];
#pragma unroll
                for (int r = 1; r < 4; ++r) { const float nr = ar[st] * er - ai[st] * ei + dre[r], ni = ar[st] * ei + ai[st] * er + dim[r]; er = nr; ei = ni; }
                float x1r = __shfl_up(er, 16), x1i = __shfl_up(ei, 16), x2r = __shfl_up(er, 32), x2i = __shfl_up(ei, 32), x3r = __shfl_up(er, 48), x3i = __shfl_up(ei, 48);
                if (q < 1) { x1r = 0.f; x1i = 0.f; } if (q < 2) { x2r = 0.f; x2i = 0.f; } if (q < 3) { x3r = 0.f; x3i = 0.f; }
                float pr = x1r + (a4r[st] * x2r - a4i[st] * x2i) + (a8r[st] * x3r - a8i[st] * x3i) + (aqr[st] * hr[st] - aqi[st] * hi[st]);
                float pi = x1i + (a4r[st] * x2i + a4i[st] * x2r) + (a8r[st] * x3i + a8i[st] * x3r) + (aqr[st] * hi[st] + aqi[st] * hr[st]);
#pragma unroll
                for (int r = 0; r < 4; ++r) {
                    const float nr = ar[st] * pr - ai[st] * pi + dre[r], ni = ar[st] * pi + ai[st] * pr + dim[r]; pr = nr; pi = ni;
                    if (PH == 2) *(LAS unsigned*)(Hw + (4 * q + r) * HROW + (st * 16 + j) * 4) = pk2(nr, ni);
                }
                hr[st] = __shfl(pr, 48 + j); hi[st] = __shfl(pi, 48 + j);
            }
            if (PH == 2) {
                f32x4 y = (f32x4){0.f, 0.f, 0.f, 0.f};
#pragma unroll
                for (int ks = 0; ks < 4; ++ks) { const bf16x8 hf = *(const LAS bf16x8*)(Hw + j * HROW + (ks * 32 + 8 * q) * 2); y = mma16(cf[ks], hf, y); }
                const v2u uw = *(const LAS v2u*)(T0 + (tt * 16 + j) * TROW + (g * 16 + 4 * q) * 2);
                const float y0 = gelu_tanh(y[0] + dv[0] * __uint_as_float(uw.x << 16)), y1 = gelu_tanh(y[1] + dv[1] * __uint_as_float(uw.x & 0xffff0000u));
                const float y2 = gelu_tanh(y[2] + dv[2] * __uint_as_float(uw.y << 16)), y3 = gelu_tanh(y[3] + dv[3] * __uint_as_float(uw.y & 0xffff0000u));
                v2u w; w.x = pk2(y0, y1); w.y = pk2(y2, y3);
                *(LAS v2u*)(T1 + (tt * 16 + j) * TROW + (g * 16 + 4 * q) * 2) = w;
            }
        }
        if (PH == 1 && q == 0) {
#pragma unroll
            for (int st = 0; st < 4; ++st) A.s5st[((size_t)b * NCHUNK + c) * 1024 + g * 64 + st * 16 + j] = make_float2(hr[st], hi[st]);
        }
    }
    if (PH == 2) {
        STAMP(57);
        __syncthreads();
        STAMP(58);
        const bf16_t* GT = (const bf16_t*)(sm + SM_GLUT);
        f32x4 acc[2][4];
#pragma unroll
        for (int d = 0; d < 2; ++d)
#pragma unroll
            for (int tt = 0; tt < 4; ++tt) acc[d][tt] = (f32x4){0.f, 0.f, 0.f, 0.f};
#pragma unroll 2
        for (int ks = 0; ks < 8; ++ks) {
            bf16x8 wf[2];
#pragma unroll
            for (int d = 0; d < 2; ++d) wf[d] = *(const bf16x8*)(GT + ((wave * 2 + d) * 16 + j) * 256 + ks * 32 + 8 * q);
#pragma unroll
            for (int tt = 0; tt < 4; ++tt) { const bf16x8 xf = *(const LAS bf16x8*)(T1 + (tt * 16 + j) * TROW + (ks * 32 + 8 * q) * 2);
#pragma unroll
                for (int d = 0; d < 2; ++d) acc[d][tt] = mma16(wf[d], xf, acc[d][tt]); }
        }
#pragma unroll
        for (int d = 0; d < 2; ++d) {
            const int col0 = (wave * 2 + d) * 16 + 4 * q;
            const f32x4 gb = *(const f32x4*)(A.glu_b + col0);
#pragma unroll
            for (int tt = 0; tt < 4; ++tt) {
                const v2u yw = *(const LAS v2u*)(T1 + (tt * 16 + j) * TROW + col0 * 2);
                const f32x4 s = acc[d][tt] + gb;
                v2u w; w.x = pk2(__uint_as_float(yw.x << 16) * sigmoidf_(s.x), __uint_as_float(yw.x & 0xffff0000u) * sigmoidf_(s.y));
                w.y = pk2(__uint_as_float(yw.y << 16) * sigmoidf_(s.z), __uint_as_float(yw.y & 0xffff0000u) * sigmoidf_(s.w));
                *(v2u*)(A.ys + (t0 + tt * 16 + j) * 1024 + 512 + col0) = w;
            }
        }
    }
    __syncthreads();
}

__device__ __forceinline__ void router_phase(Frame& F, const float* h, const float* g2, const float* Wp, const float* rgb, const float* reb,
                                             bf16_t* xn, unsigned* cnt, int* buf_ts, float* buf_w) {
    LAS float* part = (LAS float*)(F.lds);
    LAS float* lg = (LAS float*)(F.lds + 98304);
    LAS float* rs = (LAS float*)(F.lds + 98304 + 12288);
    const int lane = F.lane, wave = F.wave, tid = F.tid, j = lane & 15, q = lane >> 4;
    for (int blk = blockIdx.x; blk < T / 64; blk += F.G) {
        const int m0 = blk * 64;
        f32x4 v[8][4];
#pragma unroll
        for (int i = 0; i < 8; ++i)
#pragma unroll
            for (int jj = 0; jj < 4; ++jj) v[i][jj] = *(const f32x4*)(h + (size_t)(m0 + wave * 8 + i) * D + 4 * lane + 256 * jj);
        {
            f32x4 gg[4];
#pragma unroll
            for (int jj = 0; jj < 4; ++jj) gg[jj] = *(const f32x4*)(g2 + 4 * lane + 256 * jj);
            __builtin_amdgcn_sched_barrier(0);
#pragma unroll
            for (int i = 0; i < 8; ++i) {
                float s = 0.f;
#pragma unroll
                for (int jj = 0; jj < 4; ++jj) s += v[i][jj].x * v[i][jj].x + v[i][jj].y * v[i][jj].y + v[i][jj].z * v[i][jj].z + v[i][jj].w * v[i][jj].w;
#pragma unroll
                for (int o = 1; o < 64; o <<= 1) s += __shfl_xor(s, o);
                const float rstd = rsqrtf(s * (1.0f / D) + EPS);
                if (lane == 0) rs[wave * 8 + i] = rstd;
#pragma unroll
                for (int jj = 0; jj < 4; ++jj) {
                    const f32x4 o = v[i][jj] * rstd * gg[jj];
                    *(unsigned*)((unsigned char*)xn + (size_t)(m0 + wave * 8 + i) * D + 4 * lane + 256 * jj) = pk4_fp8(o.x, o.y, o.z, o.w);
                }
            }
        }
        STAMP(48);
        f32x4 acc[3][4];
#pragma unroll
        for (int ot = 0; ot < 3; ++ot)
#pragma unroll
            for (int tt = 0; tt < 4; ++tt) acc[ot][tt] = (f32x4){0.f, 0.f, 0.f, 0.f};
        LAS float* xq = (LAS float*)(F.lds);
        const bf16_t* WH = (const bf16_t*)Wp; const bf16_t* WL = WH + 49152;
#pragma unroll
        for (int kq = 0; kq < 4; ++kq) {
            bf16x8 wh[3], wl[3];
#pragma unroll
            for (int ot = 0; ot < 3; ++ot) { wh[ot] = *(const bf16x8*)(WH + (size_t)(ot * 16 + j) * 1024 + kq * 256 + wave * 32 + 8 * q); wl[ot] = *(const bf16x8*)(WL + (size_t)(ot * 16 + j) * 1024 + kq * 256 + wave * 32 + 8 * q); }
            if (kq) __syncthreads();
#pragma unroll
            for (int i = 0; i < 8; ++i) *(LAS f32x4*)(xq + (wave * 8 + i) * 260 + 4 * lane) = v[i][kq];
            __builtin_amdgcn_sched_barrier(0);
            __syncthreads();
#pragma unroll
            for (int tt = 0; tt < 4; ++tt) {
                const f32x4 x0 = *(const LAS f32x4*)(xq + (tt * 16 + j) * 260 + wave * 32 + 8 * q), x1 = *(const LAS f32x4*)(xq + (tt * 16 + j) * 260 + wave * 32 + 8 * q + 4);
                const float xv[8] = {x0.x, x0.y, x0.z, x0.w, x1.x, x1.y, x1.z, x1.w};
                unsigned hp[4], lp[4];
#pragma unroll
                for (int p = 0; p < 4; ++p) {
                    const unsigned h0 = f2bfu(xv[2 * p]), h1 = f2bfu(xv[2 * p + 1]);
                    hp[p] = h0 | (h1 << 16);
                    lp[p] = pk2(xv[2 * p] - __uint_as_float(h0 << 16), xv[2 * p + 1] - __uint_as_float(h1 << 16));
                }
                const bf16x8 xh = __builtin_bit_cast(bf16x8, (v4u){hp[0], hp[1], hp[2], hp[3]}), xl = __builtin_bit_cast(bf16x8, (v4u){lp[0], lp[1], lp[2], lp[3]});
#pragma unroll
                for (int ot = 0; ot < 3; ++ot) { acc[ot][tt] = mma16(wh[ot], xh, acc[ot][tt]); acc[ot][tt] = mma16(wh[ot], xl, acc[ot][tt]); acc[ot][tt] = mma16(wl[ot], xh, acc[ot][tt]); }
            }
        }
        __syncthreads();
#pragma unroll
        for (int ot = 0; ot < 3; ++ot)
#pragma unroll
            for (int tt = 0; tt < 4; ++tt) *(LAS f32x4*)(part + ((wave * 12 + ot * 4 + tt) * 64 + lane) * 4) = acc[ot][tt];
        STAMP(49);
        __syncthreads();
        STAMP(50);
        for (int idx = tid; idx < 12 * 256; idx += 512) {
            const int tile = idx >> 8, ln = (idx >> 2) & 63, r = idx & 3, ot = tile >> 2, tt = tile & 3;
            float s = 0.f;
#pragma unroll
            for (int w = 0; w < 8; ++w) s += part[(w * 12 + tile) * 256 + (idx & 255)];
            const int tok = tt * 16 + (ln & 15), o = ot * 16 + 4 * (ln >> 4) + r;
            lg[tok * 48 + o] = s * rs[tok];
        }
        __syncthreads();
        STAMP(51);
        if (tid < 64) {
            const int m = m0 + tid;
            float gl[4], mx = -1e30f; int gi = 0;
#pragma unroll
            for (int i = 0; i < 4; ++i) { gl[i] = lg[tid * 48 + i] + rgb[i]; if (gl[i] > mx) { mx = gl[i]; gi = i; } }
            float den = 0.f;
#pragma unroll
            for (int i = 0; i < 4; ++i) den += __expf(gl[i] - mx);
            const float gval = 1.0f / den;
            float v1 = -1e30f, v2 = -1e30f; int i1 = 0, i2 = 0;
            for (int i = 0; i < 8; ++i) { const float el = lg[tid * 48 + 4 + gi * 8 + i] + reb[gi * 8 + i]; if (el > v1) { v2 = v1; i2 = i1; v1 = el; i1 = i; } else if (el > v2) { v2 = el; i2 = i; } }
            const float e2 = __expf(v2 - v1), w1 = gval / (1.0f + e2), w2 = gval * e2 / (1.0f + e2);
            const int ex1 = gi * 8 + i1, ex2 = gi * 8 + i2;
            const unsigned r1 = atomicAdd(&cnt[ex1 * 64], 1u), r2 = atomicAdd(&cnt[ex2 * 64], 1u);
            buf_ts[ex1 * CAP + r1] = m * 2 + 0; buf_w[ex1 * CAP + r1] = w1;
            buf_ts[ex2 * CAP + r2] = m * 2 + 1; buf_w[ex2 * CAP + r2] = w2;
        }
        __syncthreads();
    }
}

__device__ __forceinline__ void build_plan(Frame& F, const unsigned* cnt) {
    LAS int* plan = (LAS int*)(F.lds + PLAN_OFF);
    if (F.tid < 64) {
        const int e = F.tid & 31;
        const int ce = (int)__hip_atomic_load(cnt + e * 64, RLX_AGENT);
        const int nf = ce >> 8, rem = ce & 255, big = rem > 128 ? 1 : 0, sml = (rem > 0 && rem <= 128) ? 1 : 0;
        int pf = nf, pb = big, ps = sml;
#pragma unroll
        for (int o = 1; o < 32; o <<= 1) { const int a = __shfl_up(pf, o, 32), b = __shfl_up(pb, o, 32), c = __shfl_up(ps, o, 32); if (e >= o) { pf += a; pb += b; ps += c; } }
        const int NF = __shfl(pf, 31, 32), NB = __shfl(pb, 31, 32), NS = __shfl(ps, 31, 32);
        if (F.tid < 32) {
            plan[321 + e] = ce;
            for (int jb = 0; jb < nf; ++jb) { const int p = pf - nf + jb; if (p < MAXBLK) { plan[1 + p] = e; plan[1 + MAXBLK + p] = jb; } }
            if (big) { const int p = NF + pb - 1; if (p < MAXBLK) { plan[1 + p] = e; plan[1 + MAXBLK + p] = nf; } }
            if (sml) { const int p = NF + NB + ps - 1; if (p < MAXBLK) { plan[1 + p] = e; plan[1 + MAXBLK + p] = nf; } }
            if (e == 0) { const int tot = NF + NB + NS; plan[0] = tot < MAXBLK ? tot : MAXBLK; }
        }
    }
    __syncthreads();
}

struct DenseSched {
    static constexpr bool GATHER = false, HALF = false, WAITS = false, PUBLISHES = false;
    pg8::StaticOrder ord; const char* A; const char* Bt; int lda, K; int a_sh, a_cs; int es;
    __device__ __forceinline__ bool next(int i, pg8::Unit& u) const { return ord.next(i, u); }
    __device__ __forceinline__ const char* a_base(const pg8::Unit& u) const { return A + (size_t)u.pm * 256 * lda * es + (size_t)((u.pn >> a_sh) * a_cs); }
    __device__ __forceinline__ const char* b_base(const pg8::Unit& u) const { return Bt + (size_t)u.pn * 256 * K * es; }
    __device__ __forceinline__ unsigned gather_off(const pg8::Unit&, int) const { return 0u; }
    __device__ __forceinline__ bool half_only(const pg8::Unit&) const { return false; }
};
struct Moe1Sched {
    static constexpr bool GATHER = true, HALF = true, WAITS = false, PUBLISHES = false;
    const char* xn; const char* w13; const LAS int* plan; const int* buf_ts; int G, c, lda; unsigned* ready;
    __device__ __forceinline__ void done(const pg8::Unit& u) const { asm volatile("s_waitcnt vmcnt(0)" ::: "memory"); if ((threadIdx.x & 63) == 0) __hip_atomic_fetch_add(ready + 16 * u.pm, 1u, RLX_AGENT); }
    __device__ __forceinline__ bool next(int i, pg8::Unit& u) const { const int L = i * G + c; if (L >= 4 * plan[0]) return false; u.pm = L >> 2; u.pn = L & 3; return true; }
    __device__ __forceinline__ const char* a_base(const pg8::Unit&) const { return xn; }
    __device__ __forceinline__ const char* b_base(const pg8::Unit& u) const { return w13 + (size_t)plan[1 + u.pm] * (1024 * 1024) + (size_t)u.pn * (256 * 1024); }
    __device__ __forceinline__ unsigned gather_off(const pg8::Unit& u, int r) const {
        const int e = plan[1 + u.pm], lb = plan[1 + MAXBLK + u.pm], ce = plan[321 + e];
        int pos = lb * 256 + r; pos = pos < ce ? pos : ce - 1;
        return (unsigned)(buf_ts[e * CAP + pos] >> 1) * (unsigned)D;
    }
    __device__ __forceinline__ bool half_only(const pg8::Unit& u) const { const int e = plan[1 + u.pm], lb = plan[1 + MAXBLK + u.pm]; return plan[321 + e] - lb * 256 <= 128; }
};
struct Moe2Sched {
    static constexpr bool GATHER = false, HALF = true, WAITS = false, PUBLISHES = false;
    const char* hbuf; const char* w2t; const LAS int* plan; int G, c, lda; const unsigned* ready; unsigned* tmo;
    __device__ __forceinline__ void a_ready(const pg8::Unit& u) const {
        if (threadIdx.x < 64) {
            const unsigned long long t0 = __builtin_amdgcn_s_memrealtime(); unsigned polls = 0;
            while ((unsigned)__builtin_amdgcn_readfirstlane(__hip_atomic_load(ready + 16 * u.pm, RLX_AGENT)) < 32u) {
                if ((++polls & 255u) == 0u && __builtin_amdgcn_readfirstlane(__hip_atomic_load(tmo, RLX_AGENT)) != 0u) break;
                if (__builtin_amdgcn_s_memrealtime() - t0 > 2000000ull) { if (threadIdx.x == 0) __hip_atomic_store(tmo, 1u, RLX_AGENT); break; }
                __builtin_amdgcn_s_sleep(2); }
            __builtin_amdgcn_fence(__ATOMIC_ACQUIRE, "agent");
            asm volatile("s_waitcnt vmcnt(0)" ::: "memory");
        }
        asm volatile("" ::: "memory"); __builtin_amdgcn_s_barrier(); asm volatile("" ::: "memory");
    }
    __device__ __forceinline__ bool next(int i, pg8::Unit& u) const { const int L = i * G + c; if (L >= 4 * plan[0]) return false; u.pm = L >> 2; u.pn = L & 3; return true; }
    __device__ __forceinline__ const char* a_base(const pg8::Unit& u) const { return hbuf + (size_t)u.pm * 256 * DEXP; }
    __device__ __forceinline__ const char* b_base(const pg8::Unit& u) const { return w2t + (size_t)plan[1 + u.pm] * (1024 * 512) + (size_t)u.pn * (256 * 512); }
    __device__ __forceinline__ unsigned gather_off(const pg8::Unit&, int) const { return 0u; }
    __device__ __forceinline__ bool half_only(const pg8::Unit& u) const { const int e = plan[1 + u.pm], lb = plan[1 + MAXBLK + u.pm]; return plan[321 + e] - lb * 256 <= 128; }
};

using pg8::f32x4; using pg8::u32x4; using pg8::u32x2; using pg8::cvt_pk_bf16; using pg8::Unit; using pg8::HALF; using pg8::BM;
struct EpiStoreBf16 {
    static constexpr bool PERM = true;
    bf16_t* O; int ldc;
    __device__ __forceinline__ void operator()(const f32x4 (&acc)[2][2][4][2], const Unit& u, int wr, int wc, int fr, int fq) const {
        const int row0 = u.pm * BM + wr * 64 + fr, col0 = u.pn * BM + wc * 32 + 8 * fq;
#pragma unroll
        for (int ai = 0; ai < 2; ++ai)
#pragma unroll
            for (int m = 0; m < 4; ++m) { bf16_t* rowp = O + (size_t)(row0 + ai * HALF + m * 16) * ldc + col0;
#pragma unroll
                for (int bj = 0; bj < 2; ++bj) { const f32x4 v0 = acc[ai][bj][m][0], v1 = acc[ai][bj][m][1];
                    u32x4 w; w.x = cvt_pk_bf16(v0[0], v0[1]); w.y = cvt_pk_bf16(v0[2], v0[3]); w.z = cvt_pk_bf16(v1[0], v1[1]); w.w = cvt_pk_bf16(v1[2], v1[3]);
                    *(u32x4*)(rowp + bj * HALF) = w; } }
    }
};
struct EpiGateMerge {
    static constexpr bool PERM = false;
    const float* bias; const bf16_t* br; bf16_t* merged;
    __device__ __forceinline__ void operator()(const f32x4 (&acc)[2][2][4][2], const Unit& u, int wr, int wc, int fr, int fq) const {
        const int row0 = u.pm * BM + wr * 64 + fr, d0 = u.pn * 64 + wc * 16 + 4 * fq;
        f32x4 bv[4];
#pragma unroll
        for (int k4 = 0; k4 < 4; ++k4) bv[k4] = *(const f32x4*)(bias + k4 * 1024 + d0);
#pragma unroll
        for (int ai = 0; ai < 2; ++ai)
#pragma unroll
            for (int m = 0; m < 4; ++m) {
                const size_t row = (size_t)(row0 + ai * HALF + m * 16);
                f32x4 s = (f32x4){0.f, 0.f, 0.f, 0.f};
#pragma unroll
                for (int k4 = 0; k4 < 4; ++k4) {
                    const u32x2 b2 = *(const u32x2*)(br + row * 4096 + k4 * 1024 + d0);
                    const f32x4 a = acc[ai][k4 >> 1][m][k4 & 1] * (1.0f / MG_SCALE) + bv[k4];
                    s[0] += sigmoidf_(a[0]) * __uint_as_float(b2.x << 16);
                    s[1] += sigmoidf_(a[1]) * __uint_as_float(b2.x & 0xffff0000u);
                    s[2] += sigmoidf_(a[2]) * __uint_as_float(b2.y << 16);
                    s[3] += sigmoidf_(a[3]) * __uint_as_float(b2.y & 0xffff0000u);
                }
                u32x2 w; w.x = cvt_pk_bf16(s[0], s[1]); w.y = cvt_pk_bf16(s[2], s[3]);
                *(u32x2*)(merged + row * D + d0) = w;
            }
    }
};
struct EpiAddF32 {
    static constexpr bool PERM = false;
    const float* hsrc; float* hdst;
    __device__ __forceinline__ void operator()(const f32x4 (&acc)[2][2][4][2], const Unit& u, int wr, int wc, int fr, int fq) const {
        const int row0 = u.pm * BM + wr * 64 + fr, col0 = u.pn * BM + wc * 32 + 4 * fq;
#pragma unroll
        for (int ai = 0; ai < 2; ++ai)
#pragma unroll
            for (int m = 0; m < 4; ++m) { const size_t ro = (size_t)(row0 + ai * HALF + m * 16) * D + col0;
#pragma unroll
                for (int bj = 0; bj < 2; ++bj)
#pragma unroll
                    for (int n = 0; n < 2; ++n) *(f32x4*)(hdst + ro + bj * HALF + n * 16) = *(const f32x4*)(hsrc + ro + bj * HALF + n * 16) + acc[ai][bj][m][n]; }
    }
};
struct EpiMoe1 {
    static constexpr bool PERM = false;
    unsigned char* hbuf;
    __device__ __forceinline__ void operator()(const f32x4 (&acc)[2][2][4][2], const Unit& u, int wr, int wc, int fr, int fq) const {
        const int row0 = u.pm * BM + wr * 64 + fr, h0 = u.pn * 128 + wc * 16 + 4 * fq;
        const float si = 1.0f / W13_SCALE;
#pragma unroll
        for (int ai = 0; ai < 2; ++ai)
#pragma unroll
            for (int m = 0; m < 4; ++m) { unsigned char* rowp = hbuf + (size_t)(row0 + ai * HALF + m * 16) * DEXP + h0;
#pragma unroll
                for (int bj = 0; bj < 2; ++bj) { const f32x4 a1 = acc[ai][bj][m][0] * si, a3 = acc[ai][bj][m][1] * (si * H_SCALE);
                    const unsigned w = pk4_fp8(a1[0] * sigmoidf_(a1[0]) * a3[0], a1[1] * sigmoidf_(a1[1]) * a3[1], a1[2] * sigmoidf_(a1[2]) * a3[2], a1[3] * sigmoidf_(a1[3]) * a3[3]);
                    *(unsigned*)(rowp + bj * 64) = w; } }
    }
};
struct EpiMoe2 {
    static constexpr bool PERM = true;
    bf16_t* ymoe; const LAS int* plan; const int* buf_ts; const float* buf_w;
    __device__ __forceinline__ void operator()(const f32x4 (&acc)[2][2][4][2], const Unit& u, int wr, int wc, int fr, int fq) const {
        const int e = plan[1 + u.pm], lb = plan[1 + MAXBLK + u.pm], ce = plan[321 + e];
        const int col0 = u.pn * BM + wc * 32 + 8 * fq;
        int ts[2][4]; float wt[2][4];
#pragma unroll
        for (int ai = 0; ai < 2; ++ai)
#pragma unroll
            for (int m = 0; m < 4; ++m) {
                const int pos = lb * 256 + ai * HALF + wr * 64 + m * 16 + fr; const int pc = pos < ce ? pos : ce - 1;
                ts[ai][m] = buf_ts[e * CAP + pc]; wt[ai][m] = buf_w[e * CAP + pc] * (1.0f / (W2_SCALE * H_SCALE));
                if (pos >= ce) ts[ai][m] = -1;
            }
        __builtin_amdgcn_sched_barrier(0);
#pragma unroll
        for (int ai = 0; ai < 2; ++ai)
#pragma unroll
            for (int m = 0; m < 4; ++m) {
                if (ts[ai][m] >= 0) {
                    bf16_t* rowp = ymoe + (size_t)ts[ai][m] * D + col0; const float w_ = wt[ai][m];
#pragma unroll
                    for (int bj = 0; bj < 2; ++bj) { const f32x4 v0 = acc[ai][bj][m][0] * w_, v1 = acc[ai][bj][m][1] * w_;
                        u32x4 w; w.x = cvt_pk_bf16(v0[0], v0[1]); w.y = cvt_pk_bf16(v0[2], v0[3]); w.z = cvt_pk_bf16(v1[0], v1[1]); w.w = cvt_pk_bf16(v1[2], v1[3]);
                        *(u32x4*)(rowp + bj * HALF) = w; }
                }
            }
    }
};

__device__ __forceinline__ void make_mix_args(MixArgs& A, const Args& args, unsigned char* ws, int l) {
    A.proj = (const bf16_t*)(ws + WS_PROJ); A.ys = (bf16_t*)(ws + WS_YS); A.tab = (const float*)(ws + WS_TAB + (size_t)l * MiB); A.sm = ws + WS_TAB + (size_t)l * MiB + SM_OFF; A.ws = ws;
    A.s5st = (float2*)(ws + WS_S5ST); A.lruS = (float2*)(ws + WS_LRUS);
    A.conv_a_w = args.in[3] + (size_t)l * 3 * W; A.pool_b = args.in[5] + (size_t)l * W; A.pool_scale = args.in[6] + (size_t)l * W;
    A.s5_d = args.in[14] + (size_t)l * W; A.glu_b = args.in[16] + (size_t)l * W;
    A.lconv_w = args.in[17] + (size_t)l * 4 * W; A.lconv_b = args.in[18] + (size_t)l * W; A.ba = args.in[20] + (size_t)l * W; A.bx = args.in[22] + (size_t)l * W;
}

__global__ void __launch_bounds__(NWAVES * 64, 2) mk_fwd(Args args) {
    extern __shared__ __attribute__((aligned(16))) unsigned char lds[];
    Frame F;
    F.lds = (LAS unsigned char*)lds; F.smem = lds;
    F.MISC = (volatile LAS unsigned*)(F.lds + MISC_OFF);
    F.tid = threadIdx.x; F.lane = F.tid & 63; F.wave = __builtin_amdgcn_readfirstlane(F.tid >> 6);
    F.G = gridDim.x; { const int bx = blockIdx.x; F.vcu = (F.G % 8 == 0) ? (bx % 8) * (F.G / 8) + bx / 8 : bx; }
    F.ws = args.ws; F.ctl = (unsigned*)(args.ws + WS_CTL);
    unsigned char* ws = args.ws; unsigned char* const args_ws_ = args.ws; (void)args_ws_;
    for (int u = F.tid; u < (LDS_BYTES - LDSCTL_OFF) / 4; u += NWAVES * 64) ((LAS unsigned*)(F.lds + LDSCTL_OFF))[u] = 0u;
    __syncthreads();
    XcdBarrier bar; bar.bar = F.ctl + CW_BAR; bar.x = 0; bar.st = nullptr;
    if (N_LAUNCHES == 1) bar = xcd_barrier_post(F.ctl + CW_BAR, F.MISC + 8);
    const int lo = args.ph_lo, hi = args.ph_hi;
    float* h = (float*)(ws + WS_H); bf16_t* xn = (bf16_t*)(ws + WS_XN); bf16_t* proj = (bf16_t*)(ws + WS_PROJ); bf16_t* ys = (bf16_t*)(ws + WS_YS);
    bf16_t* br = (bf16_t*)(ws + WS_R1); bf16_t* hbuf = (bf16_t*)(ws + WS_HBUF); bf16_t* ymoe = (bf16_t*)(ws + WS_YMOE); bf16_t* merged = (bf16_t*)(ws + WS_MERGED);
    int* buf_ts = (int*)(ws + WS_BUFTS); float* buf_w = (float*)(ws + WS_BUFW);

#ifndef KIND_MASK
#define KIND_MASK 0x7ff
#endif
#define PH_BEGIN(k, kind) if (lo <= (k) && (k) < hi && ((KIND_MASK >> (kind)) & 1)) { \
        { int t_ = threadIdx.x; asm volatile("" : "+v"(t_)); F.tid = t_; F.lane = t_ & 63; F.wave = __builtin_amdgcn_readfirstlane(t_ >> 6); } STAMP(2 * (k));
#ifdef PROBE_A
#define PH_END(k) __syncthreads(); STAMP(2 * (k) + 1); if ((k) + 1 < hi) xcd_barrier(bar); }
#else
#define PH_END(k) if ((k) + 1 < hi) xcd_barrier(bar); }
#endif

    PH_BEGIN(0, 0)
        prep_tables(F, args);
        conv_mixer_weights(F, args);
        conv_expert_weights(F, args, 0);
        norm_phase(F, args.in[0], nullptr, args.in[1], nullptr, xn, nullptr, 0.0f, ws + WS_XN8);
    PH_END(0)

#ifdef PROBE_A
#ifndef PROBE_MODE
#define PROBE_MODE 0
#endif
#ifndef PROBE_SCALE
#define PROBE_SCALE 300
#endif
#ifndef PROBE_SHIFT
#define PROBE_SHIFT 0.0f
#endif
#define PROBE_REDUCE() { xcd_barrier(bar); \
        if (blockIdx.x == 0) { LAS float* red = (LAS float*)F.lds; const unsigned long long* dd = (const unsigned long long*)(g_dbg); \
            if (F.tid < 256) { const unsigned long long ta = __hip_atomic_load(dd + (size_t)F.tid * 64 + (PROBE_A), RLX_AGENT), tb = __hip_atomic_load(dd + (size_t)F.tid * 64 + (PROBE_B), RLX_AGENT), t00 = __hip_atomic_load(dd + (PROBE_A), RLX_AGENT); \
                red[F.tid] = (float)(long long)(tb - ta) * 0.01f; red[256 + F.tid] = (float)(long long)(ta - t00) * 0.01f; red[512 + F.tid] = (float)(long long)(tb - t00) * 0.01f; } \
            __syncthreads(); \
            if (F.tid == 0) { float sum = 0.f, mx = -1e30f, mna = 1e30f, mxb = -1e30f; for (int i = 0; i < 256; ++i) { sum += red[i]; mx = fmaxf(mx, red[i]); mna = fminf(mna, red[256 + i]); mxb = fmaxf(mxb, red[512 + i]); } \
                const float val = PROBE_MODE == 0 ? sum * (1.0f / 256.0f) : (PROBE_MODE == 1 ? mx : mxb - mna); \
                const float vq = val; \
                __hip_atomic_store((float*)((unsigned long long*)(g_dbg) + 256 * 64), vq, RLX_AGENT); } \
            __syncthreads(); } \
        xcd_barrier(bar); \
        oscale_ = __hip_atomic_load((float*)((unsigned long long*)(g_dbg) + 256 * 64), RLX_AGENT) * (1.0f / (float)(PROBE_SCALE)); }
#else
#define PROBE_REDUCE()
#endif
#define LAYER(l) { \
    const int pb = 1 + PH_PER_LAYER * (l); \
    const float* tab = (const float*)(ws + WS_TAB + (size_t)(l) * MiB); \
    const unsigned char* wmix = ws + WS_WMIX + (size_t)(l) * WMIX_STRIDE; \
    unsigned* cnt = F.ctl + CW_CNT + 2048 * (l); \
    PH_BEGIN(pb + 0, 1)   \
        DenseSched S; S.ord.init(T, IN_COLS, F.G, (int)blockIdx.x); S.A = (const char*)xn; S.Bt = (const char*)(wmix + WMIX_IN); S.lda = D; S.K = D; S.a_sh = 0; S.a_cs = 0; S.es = 2; \
        EpiStoreBf16 E{proj, IN_COLS}; \
        pg8::gemm_phase<EpiStoreBf16, DenseSched, true, true>(F.lds, F.tid, D, S, E); \
    PH_END(pb + 0) \
    PH_BEGIN(pb + 1, 2)   \
        MixArgs A; make_mix_args(A, args, ws, (l)); \
        for (int u = blockIdx.x; u < BATCH * NCHUNK; u += F.G) { int t_ = F.tid; asm volatile("" : "+v"(t_)); mix_unit<1>(A, F.lds, u, t_); } \
    PH_END(pb + 1) \
    PH_BEGIN(pb + 2, 3)   \
        MixArgs A; make_mix_args(A, args, ws, (l)); \
        for (int u = blockIdx.x; u < BATCH * NCHUNK; u += F.G) { int t_ = F.tid; asm volatile("" : "+v"(t_)); mix_unit<2>(A, F.lds, u, t_); } \
    PH_END(pb + 2) \
    PH_BEGIN(pb + 3, 4)   \
        DenseSched S; S.ord.init(T, 4096, F.G, (int)blockIdx.x); S.A = (const char*)ys; S.Bt = (const char*)(wmix + WMIX_BR); S.lda = 1024; S.K = 256; S.a_sh = 2; S.a_cs = 512; S.es = 2; \
        EpiStoreBf16 E{br, 4096}; \
        pg8::gemm_phase<EpiStoreBf16, DenseSched, true, true>(F.lds, F.tid, 256, S, E); \
    PH_END(pb + 3) \
    PH_BEGIN(pb + 4, 5)   \
        DenseSched S; S.ord.init(T, 4096, F.G, (int)blockIdx.x); S.A = (const char*)(ws + WS_XN8); S.Bt = (const char*)(wmix + WMIX_MG); S.lda = D; S.K = D; S.a_sh = 0; S.a_cs = 0; S.es = 1; \
        EpiGateMerge E{args.in[25] + (size_t)(l) * 4096, br, merged}; \
        pg8::gemm_phase<EpiGateMerge, DenseSched, true, true, true>(F.lds, F.tid, D, S, E); \
    PH_END(pb + 4) \
    PH_BEGIN(pb + 5, 6)   \
        DenseSched S; S.ord.init(T, D, F.G, (int)blockIdx.x); S.A = (const char*)merged; S.Bt = (const char*)(wmix + WMIX_OUT); S.lda = D; S.K = D; S.a_sh = 0; S.a_cs = 0; S.es = 2; \
        EpiAddF32 E{(l) == 0 ? args.in[0] : h, (args.flags & 1) ? (float*)(ws + WS_R1) : h}; \
        pg8::gemm_phase<EpiAddF32, DenseSched, true, true>(F.lds, F.tid, D, S, E); \
    PH_END(pb + 5) \
    PH_BEGIN(pb + 6, 7)   \
        if (args.flags & 1) router_phase(F, h, args.in[28] + (size_t)(l) * D, tab + TB_RW, args.in[30] + (size_t)(l) * 4, args.in[32] + (size_t)(l) * 32, xn, F.ctl + 16384, (int*)(ws + WS_END), (float*)(ws + WS_END + 2 * MiB)); \
        else router_phase(F, h, args.in[28] + (size_t)(l) * D, tab + TB_RW, args.in[30] + (size_t)(l) * 4, args.in[32] + (size_t)(l) * 32, xn, cnt, buf_ts, buf_w); \
    PH_END(pb + 6) \
    PH_BEGIN(pb + 7, 8)   \
        build_plan(F, cnt); \
        unsigned* rdy = F.ctl + CW_RDY + 4096 * (l); \
        { Moe1Sched S{(const char*)xn, (const char*)(ws + WS_WEXP), (const LAS int*)(F.lds + PLAN_OFF), buf_ts, F.G, F.vcu, D, rdy}; \
          EpiMoe1 E{(unsigned char*)hbuf}; \
          pg8::gemm_phase<EpiMoe1, Moe1Sched, true, true, true>(F.lds, F.tid, D, S, E); } \
        xcd_barrier(bar);     \
        { Moe2Sched S{(const char*)hbuf, (const char*)(ws + WS_WEXP + WEXP_W2), (const LAS int*)(F.lds + PLAN_OFF), F.G, F.G - 1 - F.vcu, DEXP, rdy, F.ctl + CW_TMO}; \
          EpiMoe2 E{ymoe, (const LAS int*)(F.lds + PLAN_OFF), buf_ts, buf_w}; \
          pg8::gemm_phase<EpiMoe2, Moe2Sched, true, true, true>(F.lds, F.tid, DEXP, S, E); } \
    PH_END(pb + 7) \
    PH_BEGIN(pb + 8, 9)   \
        if ((l) + 1 < DEPTH) { \
            conv_expert_weights(F, args, (l) + 1); \
            norm_phase(F, h, ymoe, args.in[1] + (size_t)((l) + 1) * D, (args.flags & 1) ? nullptr : h, xn, nullptr, 0.0f, ws + WS_XN8); \
        } else { \
            float oscale_ = 0.0f; \
            PROBE_REDUCE() \
            norm_phase(F, h, ymoe, args.in[36], nullptr, nullptr, args.out, oscale_); \
        } \
    PH_END(pb + 8) \
}
    LAYER(0)
    LAYER(1)
#undef LAYER
#undef PH_BEGIN
#undef PH_END
}
}

extern "C" void kernel_launch(void* const* d_in, const int* in_sizes, int n_in, void* d_out, int out_size, void* d_ws, size_t ws_size, hipStream_t stream) {
    static int grid = 0;
    if (grid == 0) {
        if (n_in != 37 || ws_size < WS_END) { fprintf(stderr, "kernel_launch: unexpected n_in %d or ws %zu\n", n_in, ws_size); grid = -1; return; }
        int dev = 0, cus = 0;
        if (hipGetDevice(&dev) != hipSuccess || hipDeviceGetAttribute(&cus, hipDeviceAttributeMultiprocessorCount, dev) != hipSuccess) { grid = -1; return; }
        if (hipFuncSetAttribute((const void*)mk_fwd, hipFuncAttributeMaxDynamicSharedMemorySize, LDS_BYTES) != hipSuccess) { fprintf(stderr, "kernel_launch: hipFuncSetAttribute failed\n"); grid = -1; return; }
        grid = cus;
    }
    if (grid < 0) return;
    (void)hipMemsetAsync((char*)d_ws + WS_CTL, 0, 1 * MiB, stream);
    Args a{};
    for (int i = 0; i < 37; ++i) a.in[i] = (const float*)d_in[i];
    a.out = (float*)d_out; a.ws = (unsigned char*)d_ws;
    if (N_LAUNCHES == 1) {
        a.ph_lo = 0; a.ph_hi = N_PHASES;
        hipLaunchKernelGGL(mk_fwd, dim3(grid), dim3(NWAVES * 64), LDS_BYTES, stream, a);
    } else {
#ifndef REP_MASK
#define REP_MASK 0
#endif
#ifndef REP_N
#define REP_N 2
#endif
        for (int p = 0; p < N_PHASES; ++p) { a.ph_lo = p; a.ph_hi = p + 1; const int kind = p == 0 ? 0 : 1 + (p - 1) % PH_PER_LAYER; const int nrep = ((REP_MASK >> kind) & 1) ? REP_N : 1;
            for (int r = 0; r < nrep; ++r) { a.flags = (r + 1 < nrep) ? 1 : 0; hipLaunchKernelGGL(mk_fwd, dim3(grid), dim3(NWAVES * 64), LDS_BYTES, stream, a); } }
    }
}
```

```cpp
#include <hip/hip_runtime.h>
#include <cstdint>
#include <cstdio>

#ifndef MK_N_LAUNCHES
#define MK_N_LAUNCHES 1
#endif

namespace pg8 {
#define PG8_LAS __attribute__((address_space(3)))
typedef unsigned short bf16_t;
typedef short bf16x8 __attribute__((ext_vector_type(8)));
typedef float f32x4 __attribute__((ext_vector_type(4)));
typedef unsigned u32x4 __attribute__((ext_vector_type(4)));
typedef unsigned u32x2 __attribute__((ext_vector_type(2)));
constexpr int BM = 256, BK = 64, HALF = 128, HTB = HALF * BK * 2, STAGE_BYTES = 8 * HTB, NXCD = 8, WGM = 8;

__host__ __device__ __forceinline__ int lds_byte(int r, int c) { const int st = (r >> 4) * 2 + (c >> 5), rr = r & 15, cc = c & 31, ob = rr * 64 + cc * 2; return st * 1024 + (ob ^ (((ob >> 9) & 1) << 5)); }
__host__ __device__ __forceinline__ void stage_rc(int b, int& R, int& C) { const int st = b / 1024, sb = b % 1024, swz = sb ^ (((sb >> 9) & 1) << 5); R = (st >> 1) * 16 + swz / 64; C = (st & 1) * 32 + (swz % 64) / 2; }
__host__ __device__ __forceinline__ int perm32(int rho) { const int n = rho >> 4, i = rho & 15; return 8 * (i >> 2) + 4 * n + (i & 3); }

struct Unit { int pm, pn; };

struct StaticOrder {
    int nM, nN, nwg, G, c;
    __host__ __device__ void init(int M, int N, int G_, int c_) { nM = M / BM; nN = N / BM; nwg = nM * nN; G = G_; c = c_; }
    __host__ __device__ bool next(int i, Unit& u) const {
        const long L = (long)i * G + c; if (L >= nwg) return false;
        int wgid = (int)L; { const int q = nwg / NXCD, r = nwg % NXCD, xcd = wgid % NXCD, off = wgid / NXCD; wgid = (xcd < r ? xcd * (q + 1) : r * (q + 1) + (xcd - r) * q) + off; }
        const int nig = WGM * nN, gid = wgid / nig, fm = gid * WGM, gsz = (nM - fm) < WGM ? (nM - fm) : WGM;
        u.pm = fm + ((wgid % nig) % gsz); u.pn = (wgid % nig) / gsz; return true;
    }
};

typedef int i32x8 __attribute__((ext_vector_type(8)));
typedef int i32x4 __attribute__((ext_vector_type(4)));
__device__ __forceinline__ i32x8 cat8(bf16x8 a, bf16x8 b) { const i32x4 x = __builtin_bit_cast(i32x4, a), y = __builtin_bit_cast(i32x4, b); return __builtin_shufflevector(x, y, 0, 1, 2, 3, 4, 5, 6, 7); }
__device__ __forceinline__ unsigned cvt_pk_bf16(float lo, float hi) { unsigned r; asm volatile("v_cvt_pk_bf16_f32 %0, %1, %2" : "=v"(r) : "v"(lo), "v"(hi)); return r; }

template <class Epi, class Sched, bool ALIGN_EPI, bool SP2, bool FP8 = false>
__device__ __forceinline__ void gemm_phase(PG8_LAS unsigned char* lds, const int tid, const int K, const Sched& S, const Epi& E) {
    const int wid = __builtin_amdgcn_readfirstlane(tid >> 6), lane = tid & 63, wr = wid >> 2, wc = wid & 3, fr = lane & 15, fq = lane >> 4;
    const int nt = FP8 ? K / 128 : K / BK;
    const int ES = FP8 ? 1 : 2;
    unsigned voffB[2]; int RA[2], CA[2];
#pragma unroll
    for (int i = 0; i < 2; ++i) { int R, C; stage_rc(tid * 16 + i * 8192, R, C); const int Rb = Epi::PERM ? ((R & ~31) + perm32(R & 31)) : R;
        voffB[i] = (unsigned)(Rb * K * ES + C * 2); RA[i] = R; CA[i] = C; }
    const size_t kstep = (size_t)(BK * 2);
    const size_t hstepB = (size_t)HALF * K * ES;
    const unsigned ldsw = (unsigned)wid * 1024u;
    const int aoff = lds_byte(wr * 64 + fr, fq * 8), boff = lds_byte(wc * 32 + fr, fq * 8);
#define PG8_SA(b, h) (((b) * 2 + (h)) * HTB)
#define PG8_SB(b, h) ((4 + (b) * 2 + (h)) * HTB)
#define PG8_STAGE(bufoff, gbase, voff) do { _Pragma("unroll") for (int _i = 0; _i < 2; ++_i) \
        __builtin_amdgcn_global_load_lds((const unsigned*)((const char*)(gbase) + (voff)[_i]), (PG8_LAS unsigned*)(lds + (bufoff) + ldsw + _i * 8192), 16, 0, 0); } while (0)
#define PG8_LDA(dst, b, h) do { _Pragma("unroll") for (int m = 0; m < 4; ++m) { if constexpr (FP8) { dst##8[m] = cat8(*(const PG8_LAS bf16x8*)(lds + PG8_SA(b, h) + aoff + m * 2048), *(const PG8_LAS bf16x8*)(lds + PG8_SA(b, h) + aoff + m * 2048 + 1024)); } \
        else { _Pragma("unroll") for (int k = 0; k < 2; ++k) dst[m][k] = *(const PG8_LAS bf16x8*)(lds + PG8_SA(b, h) + aoff + m * 2048 + k * 1024); } } } while (0)
#define PG8_LDB(dst, b, h) do { _Pragma("unroll") for (int n = 0; n < 2; ++n) { if constexpr (FP8) { dst##8[n] = cat8(*(const PG8_LAS bf16x8*)(lds + PG8_SB(b, h) + boff + n * 2048), *(const PG8_LAS bf16x8*)(lds + PG8_SB(b, h) + boff + n * 2048 + 1024)); } \
        else { _Pragma("unroll") for (int k = 0; k < 2; ++k) dst[n][k] = *(const PG8_LAS bf16x8*)(lds + PG8_SB(b, h) + boff + n * 2048 + k * 1024); } } } while (0)
#define PG8_MMA(ai, bj, At, Bt) do { __builtin_amdgcn_s_setprio(1); _Pragma("unroll") for (int m = 0; m < 4; ++m) _Pragma("unroll") for (int n = 0; n < 2; ++n) { \
        if constexpr (FP8) { asm volatile("v_mfma_scale_f32_16x16x128_f8f6f4 %0, %1, %2, %0, %3, %3 op_sel_hi:[0,0,0]" : "+v"(acc[ai][bj][m][n]) : "v"(Bt##8[n]), "v"(At##8[m]), "v"(one_scale));     } \
        else { _Pragma("unroll") for (int k = 0; k < 2; ++k) acc[ai][bj][m][n] = __builtin_amdgcn_mfma_f32_16x16x32_bf16(Bt[n][k], At[m][k], acc[ai][bj][m][n], 0, 0, 0); } } \
        if constexpr (FP8) asm volatile("s_nop 15\n\ts_nop 7" ::: "memory");     \
        __builtin_amdgcn_s_setprio(0); } while (0)
#define PG8_WAIT_V(n) asm volatile("s_waitcnt vmcnt(" #n ")" ::: "memory")
#define PG8_WAIT_L(n) asm volatile("s_waitcnt lgkmcnt(" #n ")" ::: "memory")
#define PG8_BAR __builtin_amdgcn_s_barrier()
#define PG8_SCHED __builtin_amdgcn_sched_barrier(0)
    Unit cur, nxt; int ui = 0;
    if (!S.next(0, cur)) return;
    bool has_next = S.next(1, nxt);
    unsigned offC[2][2], offN[2][2];
#pragma unroll
    for (int h = 0; h < 2; ++h)
#pragma unroll
        for (int i = 0; i < 2; ++i) {
            if constexpr (Sched::GATHER) { offC[h][i] = S.gather_off(cur, h * HALF + RA[i]) + (unsigned)CA[i] * 2u; offN[h][i] = has_next ? S.gather_off(nxt, h * HALF + RA[i]) + (unsigned)CA[i] * 2u : offC[h][i]; }
            else { offC[h][i] = (unsigned)((h * HALF + RA[i]) * S.lda * ES + CA[i] * 2); offN[h][i] = offC[h][i]; }
        }
    f32x4 acc[2][2][4][2];
#pragma unroll
    for (int a = 0; a < 2; ++a)
#pragma unroll
        for (int b = 0; b < 2; ++b)
#pragma unroll
            for (int m = 0; m < 4; ++m)
#pragma unroll
                for (int n = 0; n < 2; ++n) acc[a][b][m][n] = (f32x4){0.f, 0.f, 0.f, 0.f};
    int one_scale = 0x7f7f7f7f; asm volatile("" : "+v"(one_scale));
    bf16x8 At[4][2], B0[2][2], B1[2][2]; i32x8 At8[4], B08[2], B18[2]; (void)At; (void)B0; (void)B1; (void)At8; (void)B08; (void)B18;
    const char* cA = S.a_base(cur); const char* cB = S.b_base(cur);
    if constexpr (Sched::WAITS) S.a_ready(cur);
    if constexpr (SP2) {
        PG8_STAGE(PG8_SB(0, 0), cB, voffB); PG8_STAGE(PG8_SB(0, 1), cB + hstepB, voffB); PG8_STAGE(PG8_SA(0, 0), cA, offC[0]); PG8_STAGE(PG8_SA(0, 1), cA, offC[1]);
        if (wr == 1) PG8_BAR;
        PG8_WAIT_V(2); PG8_BAR;
        PG8_STAGE(PG8_SB(1, 0), cB + kstep, voffB); PG8_STAGE(PG8_SA(1, 0), cA + kstep, offC[0]); PG8_STAGE(PG8_SB(1, 1), cB + hstepB + kstep, voffB);
        PG8_WAIT_V(6); PG8_BAR;
    } else {
        PG8_STAGE(PG8_SB(0, 0), cB, voffB); PG8_STAGE(PG8_SA(0, 0), cA, offC[0]); PG8_STAGE(PG8_SB(0, 1), cB + hstepB, voffB); PG8_STAGE(PG8_SA(0, 1), cA, offC[1]);
        if (wr == 1) PG8_BAR;
        PG8_WAIT_V(4); PG8_BAR;
        PG8_STAGE(PG8_SB(1, 0), cB + kstep, voffB); PG8_STAGE(PG8_SA(1, 0), cA + kstep, offC[0]); PG8_STAGE(PG8_SB(1, 1), cB + hstepB + kstep, voffB);
        PG8_WAIT_V(6); PG8_BAR;
    }
    for (;;) {
        const char* nA = has_next ? S.a_base(nxt) : cA; const char* nB = has_next ? S.b_base(nxt) : cB;
        const bool full = !(Sched::HALF && __builtin_amdgcn_readfirstlane((int)S.half_only(cur)));
#pragma unroll 1
        for (int t = 0; t < nt; t += 2) {
            const bool last = (t == nt - 2);
            const char* a1 = cA + (size_t)(t + 1) * kstep;
            const char* a2 = last ? nA : cA + (size_t)(t + 2) * kstep; const char* b2 = last ? nB : cB + (size_t)(t + 2) * kstep;
            const char* a3 = a2 + kstep; const char* b3 = b2 + kstep;
            if constexpr (Sched::WAITS) { if (last && has_next) S.a_ready(nxt); }
            unsigned o2[2][2];
#pragma unroll
            for (int h = 0; h < 2; ++h)
#pragma unroll
                for (int i = 0; i < 2; ++i) o2[h][i] = (Sched::GATHER && last) ? offN[h][i] : offC[h][i];
            if constexpr (SP2) {
            PG8_LDB(B0, 0, 0); PG8_LDB(B1, 0, 1); PG8_SCHED; PG8_LDA(At, 0, 0); PG8_STAGE(PG8_SA(1, 1), a1, offC[1]);
            PG8_WAIT_V(8); PG8_WAIT_L(0); PG8_BAR; PG8_MMA(0, 0, At, B0); PG8_MMA(0, 1, At, B1); PG8_BAR; PG8_SCHED;
            PG8_LDA(At, 0, 1); PG8_STAGE(PG8_SB(0, 0), b2, voffB); PG8_STAGE(PG8_SB(0, 1), b2 + hstepB, voffB); PG8_STAGE(PG8_SA(0, 0), a2, o2[0]);
            PG8_WAIT_V(8); PG8_WAIT_L(0); PG8_BAR; if (full) { PG8_MMA(1, 0, At, B0); PG8_MMA(1, 1, At, B1); } PG8_BAR; PG8_SCHED;
            PG8_LDB(B0, 1, 0); PG8_LDB(B1, 1, 1); PG8_SCHED; PG8_LDA(At, 1, 0); PG8_STAGE(PG8_SA(0, 1), a2, o2[1]);
            PG8_WAIT_V(8); PG8_WAIT_L(0); PG8_BAR; PG8_MMA(0, 0, At, B0); PG8_MMA(0, 1, At, B1); PG8_BAR; PG8_SCHED;
            PG8_LDA(At, 1, 1); PG8_STAGE(PG8_SB(1, 0), b3, voffB); PG8_STAGE(PG8_SB(1, 1), b3 + hstepB, voffB); PG8_STAGE(PG8_SA(1, 0), a3, o2[0]);
            PG8_WAIT_V(8); PG8_WAIT_L(0); PG8_BAR; if (full) { PG8_MMA(1, 0, At, B0); PG8_MMA(1, 1, At, B1); } PG8_BAR; PG8_SCHED;
            } else {
            PG8_LDB(B0, 0, 0); PG8_SCHED; PG8_LDA(At, 0, 0); PG8_STAGE(PG8_SA(1, 1), a1, offC[1]);
            PG8_WAIT_L(8); PG8_BAR; PG8_WAIT_L(0); PG8_MMA(0, 0, At, B0); PG8_BAR; PG8_SCHED;
            PG8_LDB(B1, 0, 1); PG8_STAGE(PG8_SB(0, 0), b2, voffB);
            PG8_BAR; PG8_WAIT_L(0); PG8_MMA(0, 1, At, B1); PG8_BAR;
            PG8_LDA(At, 0, 1); PG8_STAGE(PG8_SA(0, 0), a2, o2[0]);
            PG8_BAR; PG8_WAIT_L(0); PG8_MMA(1, 0, At, B0); PG8_BAR; PG8_SCHED;
            PG8_STAGE(PG8_SB(0, 1), b2 + hstepB, voffB);
            PG8_WAIT_V(6); PG8_BAR; PG8_MMA(1, 1, At, B1); PG8_BAR;
            PG8_LDB(B0, 1, 0); PG8_SCHED; PG8_LDA(At, 1, 0); PG8_STAGE(PG8_SA(0, 1), a2, o2[1]);
            PG8_WAIT_L(8); PG8_BAR; PG8_WAIT_L(0); PG8_MMA(0, 0, At, B0); PG8_BAR; PG8_SCHED;
            PG8_LDB(B1, 1, 1); PG8_STAGE(PG8_SB(1, 0), b3, voffB);
            PG8_BAR; PG8_WAIT_L(0); PG8_MMA(0, 1, At, B1); PG8_BAR;
            PG8_LDA(At, 1, 1); PG8_STAGE(PG8_SA(1, 0), a3, o2[0]);
            PG8_BAR; PG8_WAIT_L(0); PG8_MMA(1, 0, At, B0); PG8_BAR; PG8_SCHED;
            PG8_STAGE(PG8_SB(1, 1), b3 + hstepB, voffB);
            PG8_WAIT_V(6); PG8_BAR; PG8_MMA(1, 1, At, B1); PG8_BAR;
            }
        }
        if constexpr (ALIGN_EPI) { if (wr == 0) PG8_BAR; }
        Unit nn; bool has_nn = false;
        if constexpr (Sched::GATHER) {
            has_nn = has_next && S.next(ui + 2, nn);
#pragma unroll
            for (int h = 0; h < 2; ++h)
#pragma unroll
                for (int i = 0; i < 2; ++i) { int R_, C_; stage_rc(tid * 16 + i * 8192, R_, C_); offC[h][i] = offN[h][i]; if (has_nn) offN[h][i] = S.gather_off(nn, h * HALF + R_) + (unsigned)C_ * 2u; }
        }
        E(acc, cur, wr, wc, fr, fq);
        if constexpr (Sched::PUBLISHES) S.done(cur);
        if (!has_next) break;
#pragma unroll
        for (int a = 0; a < 2; ++a)
#pragma unroll
            for (int b = 0; b < 2; ++b)
#pragma unroll
                for (int m = 0; m < 4; ++m)
#pragma unroll
                    for (int n = 0; n < 2; ++n) acc[a][b][m][n] = (f32x4){0.f, 0.f, 0.f, 0.f};
        cur = nxt; cA = nA; cB = nB; ++ui;
        if constexpr (Sched::GATHER) { has_next = has_nn; nxt = nn; }
        else { has_next = S.next(ui + 1, nxt); }
        if constexpr (ALIGN_EPI) { if (wr == 1) PG8_BAR; }
    }
    PG8_WAIT_V(0);
    if constexpr (!ALIGN_EPI) { if (wr == 0) PG8_BAR; }
    PG8_BAR;
#undef PG8_SA
#undef PG8_SB
#undef PG8_STAGE
#undef PG8_LDA
#undef PG8_LDB
#undef PG8_MMA
#undef PG8_WAIT_V
#undef PG8_WAIT_L
#undef PG8_BAR
#undef PG8_SCHED
}
}

namespace {
constexpr int NWAVES = 8;
constexpr int N_LAUNCHES = MK_N_LAUNCHES;
constexpr int D = 1024, BATCH = 8, SEQ = 2048, DEPTH = 2, T = BATCH * SEQ;
constexpr int W = 256, IN_COLS = 1792;
constexpr int NEXP = 32, DEXP = 512;
constexpr int CHUNK = 64, NCHUNK = SEQ / CHUNK;
constexpr int CAP = 16384;
constexpr int MAXBLK = 160;
constexpr float EPS = 1e-6f;
constexpr int PH_PER_LAYER = 9, N_PHASES = 1 + PH_PER_LAYER * DEPTH;

typedef unsigned short bf16_t;
typedef float f32x4 __attribute__((ext_vector_type(4)));
typedef unsigned v4u __attribute__((ext_vector_type(4)));
#define GAS __attribute__((address_space(1)))
#define LAS __attribute__((address_space(3)))
typedef GAS unsigned gu32;
#define RLX_AGENT __ATOMIC_RELAXED, __HIP_MEMORY_SCOPE_AGENT
#define LDS_WAIT() asm volatile("s_waitcnt lgkmcnt(0)" ::: "memory")

__device__ __forceinline__ float bf2f(bf16_t b) { return __uint_as_float(((unsigned)b) << 16); }
__device__ __forceinline__ unsigned f2bfu(float f) { unsigned u = __float_as_uint(f); return (u + 0x7fffu + ((u >> 16) & 1u)) >> 16; }
__device__ __forceinline__ bf16_t f2bf(float f) { return (bf16_t)f2bfu(f); }
__device__ __forceinline__ unsigned pk2(float lo, float hi) { return f2bfu(lo) | (f2bfu(hi) << 16); }
__device__ __forceinline__ float sigmoidf_(float x) { return 1.0f / (1.0f + __expf(-x)); }
__device__ __forceinline__ float gelu_tanh(float x) {
    const float z = 0.7978845608028654f * (x + 0.044715f * x * x * x);
    const float t = 1.0f - 2.0f / (__expf(2.0f * z) + 1.0f);
    return 0.5f * x * (1.0f + t);
}

constexpr size_t MiB = 1u << 20;
constexpr size_t WS_CTL = 0;
constexpr size_t WS_TAB = 1 * MiB;
constexpr size_t WS_H = 4 * MiB;
constexpr size_t WS_XN = 68 * MiB;
constexpr size_t WS_PROJ = 100 * MiB;
constexpr size_t WS_MERGED = WS_PROJ;
constexpr size_t WS_YS = 156 * MiB;
constexpr size_t WS_R1 = 188 * MiB;
constexpr size_t WS_HBUF = WS_R1;
constexpr size_t WS_YMOE = WS_R1 + 48 * MiB;
constexpr size_t WS_S5ST = 316 * MiB;
constexpr size_t WS_LRUA = 318 * MiB;
constexpr size_t WS_LRUH = 334 * MiB;
constexpr size_t WS_LRUS = 350 * MiB;
constexpr size_t WS_BUFTS = 351 * MiB;
constexpr size_t WS_BUFW = 353 * MiB;
constexpr size_t WS_WMIX = 356 * MiB;
constexpr size_t WMIX_IN = 0, WMIX_MG = (size_t)1792 * 1024 * 2, WMIX_BR = WMIX_MG + (size_t)4096 * 1024 * 2, WMIX_OUT = WMIX_BR + (size_t)4096 * 256 * 2, WMIX_STRIDE = 16 * MiB;
static_assert(WMIX_OUT + (size_t)1024 * 1024 * 2 <= WMIX_STRIDE, "mixer weights");
constexpr size_t WS_WEXP = 388 * MiB;
constexpr size_t WEXP_W2 = 32 * MiB, WEXP_LAYER = 48 * MiB;
constexpr float MG_SCALE = 32.0f;
constexpr float W13_SCALE = 32.0f, W2_SCALE = 16.0f, H_SCALE = 8.0f;
constexpr size_t WS_XN8 = 484 * MiB;
constexpr size_t WS_END = 500 * MiB;

constexpr int CW_CNT = 8192;
constexpr int CW_BAR = 4096;
constexpr int CW_TMO = 16;
constexpr int CW_RDY = 32768;

constexpr int TB_NLOG = 4096 + 32768, TB_RW = 4096 + 32768 + 256;
constexpr int SM_OFF = 512 * 1024;
constexpr int SM_POOLT = 0, SM_WAT = 32768, SM_WXT = 65536, SM_GLUT = 98304, SM_BRE = 229376, SM_BIM = 262144, SM_CMAT = 294912, SM_ATAB = 360448;


constexpr int RING_BYTES = 131072;
constexpr int LDSCTL_OFF = RING_BYTES, MISC_OFF = LDSCTL_OFF + 320;
constexpr int PLAN_OFF = MISC_OFF + 128;
constexpr int LDS_BYTES = 147456;
static_assert(PLAN_OFF + 4 * 360 <= LDS_BYTES, "LDS map");

#define XB_TMO      128
#define XB_XCNT(j)  (256  + 64 * (j))
#define XB_XSUB(j)  (1280 + 64 * (j))
#define XB_XGEN(j)  (2304 + 64 * (j))
#define XB_TOP      3328
#define XB_TOPGEN   3392
#define XCD_BAR_WORDS 3456
#define XB_SPIN_CAP (1u << 18)
__device__ __forceinline__ unsigned xb_ld(unsigned* p)              { return __hip_atomic_load(p, __ATOMIC_RELAXED, __HIP_MEMORY_SCOPE_AGENT); }
__device__ __forceinline__ unsigned xb_add(unsigned* p, unsigned v) { return __hip_atomic_fetch_add(p, v, __ATOMIC_RELAXED, __HIP_MEMORY_SCOPE_AGENT); }
__device__ __forceinline__ unsigned xb_xcc_id() { return (unsigned)__builtin_amdgcn_s_getreg((3 << 11) | 20) & 0xFu; }
#define XB_SPIN(cond, bar) do { unsigned _sp = 0; while (cond) { __builtin_amdgcn_s_sleep(1); \
    if ((++_sp & 255u) == 0u) { if (xb_ld(&(bar)[XB_TMO])) break; if (_sp > XB_SPIN_CAP) { atomicAdd(&(bar)[XB_TMO], 1u); break; } } } } while (0)
struct XcdBarrier { unsigned* bar; unsigned x; volatile LAS unsigned* st; };
__device__ __forceinline__ XcdBarrier xcd_barrier_post(unsigned* bar, volatile LAS unsigned* st) {
    XcdBarrier b; b.bar = bar; b.x = xb_xcc_id(); b.st = st;
    if (threadIdx.x == 0) (void)xb_add(&bar[XB_XCNT(b.x)], 1u);
    return b;
}
__device__ __forceinline__ void xcd_barrier_complete(unsigned* bar, unsigned x, unsigned& nloc, unsigned& nx) {
    const unsigned G = gridDim.x * gridDim.y * gridDim.z;
    unsigned sum, cnt, mine, sp = 0u;
    for (;;) {
        sum = 0u; cnt = 0u; mine = 0u;
#pragma unroll
        for (unsigned j = 0; j < 16; ++j) { const unsigned c = xb_ld(&bar[XB_XCNT(j)]); sum += c; cnt += (c > 0u) ? 1u : 0u; mine = (j == x) ? c : mine; }
        if (sum == G) break;
        __builtin_amdgcn_s_sleep(1);
        if ((++sp & 255u) == 0u) { if (xb_ld(&bar[XB_TMO])) break; if (sp > XB_SPIN_CAP) { atomicAdd(&bar[XB_TMO], 1u); break; } }
    }
    nloc = mine > 0u ? mine : 1u; nx = cnt > 0u ? cnt : 1u;
}
__device__ __forceinline__ void xcd_barrier(const XcdBarrier& b) {
    asm volatile("s_waitcnt vmcnt(0)" ::: "memory");
    __syncthreads();
    if (threadIdx.x == 0) {
        unsigned* bar = b.bar;
        __builtin_amdgcn_s_waitcnt(0);
        unsigned nloc = b.st[0], nx = b.st[1];
        if (nloc == 0u) { xcd_barrier_complete(bar, b.x, nloc, nx); b.st[0] = nloc; b.st[1] = nx; }
        const unsigned old = xb_add(&bar[XB_XSUB(b.x)], 1u);
        const unsigned gen = old / nloc;
        if (old + 1u == (gen + 1u) * nloc) {
            __builtin_amdgcn_fence(__ATOMIC_RELEASE, "agent");
            asm volatile("s_waitcnt vmcnt(0)" ::: "memory");
            const unsigned og = xb_add(&bar[XB_TOP], 1u);
            const unsigned tg = og / nx;
            if (og + 1u == (tg + 1u) * nx) xb_add(&bar[XB_TOPGEN], 1u);
            else XB_SPIN(xb_ld(&bar[XB_TOPGEN]) == tg, bar);
            __builtin_amdgcn_fence(__ATOMIC_ACQUIRE, "agent");
            xb_add(&bar[XB_XGEN(b.x)], 1u);
            asm volatile("s_waitcnt vmcnt(0)" ::: "memory");
        } else {
            XB_SPIN(xb_ld(&bar[XB_XGEN(b.x)]) == gen, bar);
            __builtin_amdgcn_fence(__ATOMIC_ACQUIRE, "agent");
            asm volatile("s_waitcnt vmcnt(0)" ::: "memory");
        }
    }
    __syncthreads();
}

#ifdef PROBE_A
#define STAMP(id) do { if (threadIdx.x == 0) ((unsigned long long*)(g_dbg))[(size_t)blockIdx.x * 64 + (id)] = __builtin_amdgcn_s_memrealtime(); } while (0)
#else
#define STAMP(id) do { } while (0)
#endif
#define g_dbg (F.ws + WS_END)

struct Args { const float* in[37]; float* out; unsigned char* ws; int ph_lo, ph_hi; int flags, pad; };

struct Frame {
    LAS unsigned char* lds;
    unsigned char* smem;
    volatile LAS unsigned* MISC;
    unsigned* ctl;
    int tid, lane, wave, vcu, G;
    unsigned char* ws;
};

struct MapNat { int off; __device__ __forceinline__ int operator()(int n) const { return off + n; } };
struct MapGate { __device__ __forceinline__ int operator()(int s) const {
    const int k4 = s >> 10, d = s & 1023, pn = d >> 6, dd = d & 63;
    return pn * 256 + 128 * (k4 >> 1) + 32 * (dd >> 4) + 16 * (k4 & 1) + 4 * ((dd >> 2) & 3) + (dd & 3); } };
struct MapMoe13 { int which; __device__ __forceinline__ int operator()(int hid) const {
    const int pn = hid >> 7, r = hid & 127;
    return pn * 256 + 128 * (r >> 6) + 32 * ((r >> 4) & 3) + 16 * which + 4 * ((r >> 2) & 3) + (r & 3); } };

template <class RowMap>
__device__ __forceinline__ void transpose_item(const float* W, int K, int N, bf16_t* WT, LAS float* scr, int item, int lane, const RowMap rm) {
    const int nblk = N / 32, kb = item / nblk, nb = item % nblk, k0 = 64 * kb, n0 = 32 * nb;
#pragma unroll 8
    for (int i = 0; i < 32; ++i) { const int kk = 2 * i + (lane >> 5); scr[kk * 33 + (lane & 31)] = W[(size_t)(k0 + kk) * N + n0 + (lane & 31)]; }
    LDS_WAIT(); asm volatile("" ::: "memory");
    const int c = lane & 7;
#pragma unroll
    for (int j = 0; j < 4; ++j) { const int n = (lane >> 3) + 8 * j; const LAS float* s = scr + (8 * c) * 33 + n;
        v4u o; o.x = pk2(s[0 * 33], s[1 * 33]); o.y = pk2(s[2 * 33], s[3 * 33]); o.z = pk2(s[4 * 33], s[5 * 33]); o.w = pk2(s[6 * 33], s[7 * 33]);
        *(GAS v4u*)(WT + (size_t)rm(n0 + n) * K + k0 + 8 * c) = o; }
    LDS_WAIT(); asm volatile("" ::: "memory");
}

__device__ __forceinline__ unsigned pk4_fp8(float a, float b, float c, float d) { int w = 0; w = __builtin_amdgcn_cvt_pk_fp8_f32(a, b, w, false); w = __builtin_amdgcn_cvt_pk_fp8_f32(c, d, w, true); return (unsigned)w; }
template <class RowMap>
__device__ __forceinline__ void transpose_item_fp8(const float* W, int K, int N, unsigned char* WT, LAS unsigned char* scr, int item, int lane, const RowMap rm, const float scl) {
    const int nblk = N / 32, kb = item / nblk, nb = item % nblk, k0 = 128 * kb, n0 = 32 * nb;
#pragma unroll 16
    for (int i = 0; i < 64; ++i) { const int kk = 2 * i + (lane >> 5); const float v = W[(size_t)(k0 + kk) * N + n0 + (lane & 31)] * scl;
        scr[(lane & 31) * 144 + kk] = (unsigned char)__builtin_amdgcn_cvt_pk_fp8_f32(v, 0.f, 0, false); }
    LDS_WAIT(); asm volatile("" ::: "memory");
    const int c = lane & 7;
#pragma unroll
    for (int j = 0; j < 4; ++j) { const int n = (lane >> 3) + 8 * j;
        *(GAS v4u*)(WT + (size_t)rm(n0 + n) * K + k0 + 16 * c) = *(const LAS v4u*)(scr + n * 144 + 16 * c); }
    LDS_WAIT(); asm volatile("" ::: "memory");
}

__device__ __forceinline__ void conv_mixer_weights(Frame& F, const Args& a) {
    LAS float* scr = (LAS float*)(F.lds + F.wave * 16384);
    const int gw = F.vcu * NWAVES + F.wave, NGW = F.G * NWAVES;
    constexpr int I_IN = 16 * 56, I_MG = 8 * 128, I_BR = 4 * 32, I_OUT = 16 * 32, PER_L = I_IN + I_MG + 4 * I_BR + I_OUT;
    for (int it = gw; it < DEPTH * PER_L; it += NGW) {
        const int l = it / PER_L; int r = it % PER_L;
        unsigned char* wb = F.ws + WS_WMIX + (size_t)l * WMIX_STRIDE;
        if (r < I_IN) { transpose_item(a.in[2] + (size_t)l * D * IN_COLS, D, IN_COLS, (bf16_t*)(wb + WMIX_IN), scr, r, F.lane, MapNat{0}); continue; } r -= I_IN;
        if (r < I_MG) { transpose_item_fp8(a.in[24] + (size_t)l * D * 4096, D, 4096, wb + WMIX_MG, (LAS unsigned char*)scr, r, F.lane, MapGate{}, MG_SCALE); continue; } r -= I_MG;
        if (r < 4 * I_BR) { const int k4 = r / I_BR; transpose_item(a.in[26] + ((size_t)l * 4 + k4) * W * D, W, D, (bf16_t*)(wb + WMIX_BR), scr, r % I_BR, F.lane, MapNat{k4 * 1024}); continue; } r -= 4 * I_BR;
        transpose_item(a.in[27] + (size_t)l * D * D, D, D, (bf16_t*)(wb + WMIX_OUT), scr, r, F.lane, MapNat{0});
    }
}
constexpr int CONV_I13 = 8 * 16, CONV_I2 = 4 * 32, CONV_PER_E = 2 * CONV_I13 + CONV_I2, CONV_ITEMS = NEXP * CONV_PER_E;
constexpr int CONV_NA = 64 * NWAVES * 4, CONV_NB = 128 * NWAVES * 3;
__device__ __forceinline__ void conv_expert_item(Frame& F, const Args& a, int l, int it) {
    LAS unsigned char* scr = F.lds + F.wave * 16384;
    const int e = it / CONV_PER_E; int r = it % CONV_PER_E;
    unsigned char* w13 = F.ws + WS_WEXP + (size_t)l * WEXP_LAYER + (size_t)e * 1024 * 1024;
    unsigned char* w2t = F.ws + WS_WEXP + (size_t)l * WEXP_LAYER + WEXP_W2 + (size_t)e * 1024 * 512;
    if (r < CONV_I13) { transpose_item_fp8(a.in[33] + ((size_t)l * NEXP + e) * D * DEXP, D, DEXP, w13, scr, r, F.lane, MapMoe13{0}, W13_SCALE); return; } r -= CONV_I13;
    if (r < CONV_I13) { transpose_item_fp8(a.in[34] + ((size_t)l * NEXP + e) * D * DEXP, D, DEXP, w13, scr, r, F.lane, MapMoe13{1}, W13_SCALE); return; } r -= CONV_I13;
    transpose_item_fp8(a.in[35] + ((size_t)l * NEXP + e) * DEXP * D, DEXP, D, w2t, scr, r, F.lane, MapNat{0}, W2_SCALE);
}
__device__ __forceinline__ void conv_expert_weights(Frame& F, const Args& a, int l, int first) {
    const int gw = F.vcu * NWAVES + F.wave, NGW = F.G * NWAVES;
    for (int it = first + gw; it < CONV_ITEMS; it += NGW) conv_expert_item(F, a, l, it);
}
__device__ __forceinline__ void conv_expert_quota(Frame& F, const Args& a, int l, int first, int slot, int n) {
    for (int i = 0; i < n; ++i) conv_expert_item(F, a, l, first + slot * n + i);
}

__device__ __forceinline__ void prep_tables(Frame& F, const Args& a) {
    for (int idx = F.vcu * 512 + F.tid; idx < DEPTH * 65536; idx += F.G * 512) {
        const int l = idx >> 16, gid = idx & 65535;
        float* tab = (float*)(F.ws + WS_TAB + (size_t)l * MiB);
        unsigned char* sm = F.ws + WS_TAB + (size_t)l * MiB + SM_OFF;
        if (gid < 1024) {
            const int g = gid >> 6;
            const double lre = fmin((double)a.in[7][l * 1024 + gid], -1e-4);
            const double lim = (double)a.in[8][l * 1024 + gid];
            const double step = exp((double)a.in[9][l * 16 + g]);
            const double er = exp(lre * step), ar = er * cos(lim * step), ai = er * sin(lim * step);
            const double nr = ar - 1.0, ni = ai, den = lre * lre + lim * lim;
            const double cr = (nr * lre + ni * lim) / den, ci = (ni * lre - nr * lim) / den;
            float* at = (float*)(sm + SM_ATAB) + gid * 12;
            const double pw[5] = {1.0, 4.0, 8.0, 12.0, 64.0};
            for (int i = 0; i < 5; ++i) { const double e = exp(lre * step * pw[i]); at[2 * i] = (float)(e * cos(lim * step * pw[i])); at[2 * i + 1] = (float)(e * sin(lim * step * pw[i])); }
            at[10] = 0.f; at[11] = 0.f;
            for (int h = 0; h < 16; ++h) {
                const double br = (double)a.in[10][((size_t)l * 1024 + gid) * 16 + h], bi = (double)a.in[11][((size_t)l * 1024 + gid) * 16 + h];
                ((bf16_t*)(sm + SM_BRE))[gid * 16 + h] = f2bf((float)(cr * br - ci * bi));
                ((bf16_t*)(sm + SM_BIM))[gid * 16 + h] = f2bf((float)(cr * bi + ci * br));
            }
        }
        if (gid < 256) { const double lam = (double)a.in[23][l * 256 + gid]; tab[TB_NLOG + gid] = (float)(-8.0 * log1p(exp(-lam))); }
        if (gid < 49152) { const int o = gid >> 10, k = gid & 1023; const float gk = a.in[28][(size_t)l * 1024 + k];
            const float w = (o < 4) ? gk * a.in[29][((size_t)l * 1024 + k) * 4 + o] : (o < 36 ? gk * a.in[31][((size_t)l * 1024 + k) * 32 + (o - 4)] : 0.f);
            const bf16_t wh = f2bf(w); ((bf16_t*)(tab + TB_RW))[gid] = wh; ((bf16_t*)(tab + TB_RW))[49152 + gid] = f2bf(w - bf2f(wh)); }
        if (gid < 16384) { const int g = gid >> 12, d = (gid >> 6) & 63, cc = gid & 63; const size_t si = ((size_t)(l * 4 + g) * 64 + cc) * 64 + d;
            ((bf16_t*)(sm + SM_POOLT))[gid] = f2bf(a.in[4][si]); ((bf16_t*)(sm + SM_WAT))[gid] = f2bf(a.in[19][si]); ((bf16_t*)(sm + SM_WXT))[gid] = f2bf(a.in[21][si]); }
        if (gid < 32768) { const int g = gid >> 11, cc = (gid >> 7) & 15, k = gid & 127, p = k >> 1; const size_t si = ((size_t)(l * 16 + g) * 16 + cc) * 64 + p;
            ((bf16_t*)(sm + SM_CMAT))[gid] = f2bf((k & 1) ? -a.in[13][si] : a.in[12][si]); }
        { const int col = gid >> 8, k = gid & 255; ((bf16_t*)(sm + SM_GLUT))[gid] = f2bf(a.in[15][((size_t)l * 256 + k) * 256 + col]); }
    }
}

__device__ __forceinline__ void norm_phase(Frame& F, const float* hin, const bf16_t* y, const float* g, float* hout, bf16_t* xn, float* out, const float oadd = 0.0f, unsigned char* xn8 = nullptr) {
    const int gw = F.vcu * NWAVES + F.wave, NGW = F.G * NWAVES, lane = F.lane;
    f32x4 gg[4];
#pragma unroll
    for (int j = 0; j < 4; ++j) gg[j] = *(const f32x4*)(g + 4 * lane + 256 * j);
    for (int m0 = gw; m0 < T; m0 += 4 * NGW) {
        f32x4 v[4][4]; uint2 ya[4][4], yb[4][4];
#pragma unroll
        for (int i = 0; i < 4; ++i) {
            const int m = m0 + i * NGW;
            if (m < T) {
#pragma unroll
                for (int j = 0; j < 4; ++j) {
                    const int col = 4 * lane + 256 * j;
                    v[i][j] = *(const f32x4*)(hin + (size_t)m * D + col);
                    if (y) { ya[i][j] = *(const uint2*)(y + ((size_t)m * 2 + 0) * D + col); yb[i][j] = *(const uint2*)(y + ((size_t)m * 2 + 1) * D + col); }
                }
            }
        }
            __builtin_amdgcn_sched_barrier(0);
#pragma unroll
        for (int i = 0; i < 4; ++i) {
            const int m = m0 + i * NGW;
            if (m < T) {
                float s = 0.f;
#pragma unroll
                for (int j = 0; j < 4; ++j) {
                    if (y) {
                        v[i][j].x += __uint_as_float(ya[i][j].x << 16) + __uint_as_float(yb[i][j].x << 16);
                        v[i][j].y += __uint_as_float(ya[i][j].x & 0xffff0000u) + __uint_as_float(yb[i][j].x & 0xffff0000u);
                        v[i][j].z += __uint_as_float(ya[i][j].y << 16) + __uint_as_float(yb[i][j].y << 16);
                        v[i][j].w += __uint_as_float(ya[i][j].y & 0xffff0000u) + __uint_as_float(yb[i][j].y & 0xffff0000u);
                    }
                    s += v[i][j].x * v[i][j].x + v[i][j].y * v[i][j].y + v[i][j].z * v[i][j].z + v[i][j].w * v[i][j].w;
                }
#pragma unroll
                for (int o = 1; o < 64; o <<= 1) s += __shfl_xor(s, o);
                const float rstd = rsqrtf(s * (1.0f / D) + EPS);
#pragma unroll
                for (int j = 0; j < 4; ++j) {
                    const int col = 4 * lane + 256 * j;
                    if (hout) *(f32x4*)(hout + (size_t)m * D + col) = v[i][j];
                    const f32x4 o = v[i][j] * rstd * gg[j];
                    if (xn) { uint2 w; w.x = pk2(o.x, o.y); w.y = pk2(o.z, o.w); *(uint2*)(xn + (size_t)m * D + col) = w; }
                    if (xn8) *(unsigned*)(xn8 + (size_t)m * D + col) = pk4_fp8(o.x, o.y, o.z, o.w);
                    if (out) { f32x4 oo = o; if (m == 0 && col == 0) oo.x += oadd; *(f32x4*)(out + (size_t)m * D + col) = oo; }
                }
            }
        }
    }
}

constexpr int TROW = 528;
constexpr int TILE_BYTES = 64 * TROW;
constexpr int HROW = 272, HTILE = 16 * HROW;
constexpr int CARRY_OFF = 2 * TILE_BYTES + 8 * HTILE;

struct MixArgs {
    const bf16_t* proj; bf16_t* ys; const float* tab; const unsigned char* sm; unsigned char* ws;
    float2* s5st; float2* lruS; unsigned* lrup;
    const float *conv_a_w, *pool_b, *pool_scale, *s5_d, *glu_b, *lconv_w, *lconv_b, *ba, *bx;
};

typedef short bf16x8 __attribute__((ext_vector_type(8)));
__device__ __forceinline__ f32x4 mma16(bf16x8 a, bf16x8 b, f32x4 c) { return __builtin_amdgcn_mfma_f32_16x16x32_bf16(a, b, c, 0, 0, 0); }
__device__ __forceinline__ void ld8(const bf16_t* p, float (&x)[8]) {
    const v4u v = *(const v4u*)p;
    x[0] = __uint_as_float(v.x << 16); x[1] = __uint_as_float(v.x & 0xffff0000u); x[2] = __uint_as_float(v.y << 16); x[3] = __uint_as_float(v.y & 0xffff0000u);
    x[4] = __uint_as_float(v.z << 16); x[5] = __uint_as_float(v.z & 0xffff0000u); x[6] = __uint_as_float(v.w << 16); x[7] = __uint_as_float(v.w & 0xffff0000u);
}
__device__ __forceinline__ void ldf8(const float* p, float (&x)[8]) { const f32x4 a = *(const f32x4*)p, b = *(const f32x4*)(p + 4); x[0] = a.x; x[1] = a.y; x[2] = a.z; x[3] = a.w; x[4] = b.x; x[5] = b.y; x[6] = b.z; x[7] = b.w; }
typedef unsigned v2u __attribute__((ext_vector_type(2)));
__device__ __forceinline__ v4u pack8(const float (&x)[8]) { v4u o; o.x = pk2(x[0], x[1]); o.y = pk2(x[2], x[3]); o.z = pk2(x[4], x[5]); o.w = pk2(x[6], x[7]); return o; }
template <int N> __device__ __forceinline__ float dpp_row_shr(float oldv, float src) {
    return __int_as_float(__builtin_amdgcn_update_dpp(__float_as_int(oldv), __float_as_int(src), 0x110 + N, 0xf, 0xf, false));
}

template <int PH>
__device__ __forceinline__ void mix_unit(const MixArgs& A, LAS unsigned char* lds, int unit, int tid) {
    const int lane = tid & 63, wave = __builtin_amdgcn_readfirstlane(tid >> 6), j = lane & 15, q = lane >> 4;
    const int b = unit >> 5, c = unit & 31;
    const size_t t0 = (size_t)b * SEQ + c * CHUNK;
    LAS unsigned char* T0 = lds; LAS unsigned char* T1 = lds + TILE_BYTES; LAS unsigned char* Hw = lds + 2 * TILE_BYTES + wave * HTILE;
    const int cg = tid & 31, tg = tid >> 5, tl0 = tg * 4, pos0 = c * CHUNK + tl0;
    const bf16_t* prow = A.proj + (t0 + tl0) * IN_COLS + cg * 8;
    const unsigned char* sm = A.sm;
    const struct { unsigned char* ws; } F = {A.ws}; (void)F;
    typedef float f32x2_ __attribute__((ext_vector_type(2)));
    LAS f32x2_* cS5 = (LAS f32x2_*)(lds + CARRY_OFF);
    LAS float* cLru = (LAS float*)(lds + CARRY_OFF + 8192);
    if (PH == 2) {
#pragma unroll
        for (int s2 = 0; s2 < 2; ++s2) {
            const int si = tid + 512 * s2;
            const float a64r = ((const float*)(sm + SM_ATAB))[si * 12 + 8], a64i = ((const float*)(sm + SM_ATAB))[si * 12 + 9];
            float hr_ = 0.f, hi_ = 0.f;
            for (int j0 = 0; j0 < c; j0 += 8) {
                float2 sv[8];
#pragma unroll
                for (int u = 0; u < 8; ++u) { const int jj = (j0 + u < c) ? j0 + u : c - 1; sv[u] = A.s5st[((size_t)b * NCHUNK + jj) * 1024 + si]; }
#pragma unroll
                for (int u = 0; u < 8; ++u) if (j0 + u < c) { const float nr = a64r * hr_ - a64i * hi_ + sv[u].x, ni = a64r * hi_ + a64i * hr_ + sv[u].y; hr_ = nr; hi_ = ni; }
            }
            cS5[si] = (f32x2_){hr_, hi_};
        }
        if (tid < 256) {
            float hin_ = 0.f;
            for (int j0 = 0; j0 < c; j0 += 8) {
                float2 sv[8];
#pragma unroll
                for (int u = 0; u < 8; ++u) { const int jj = (j0 + u < c) ? j0 + u : c - 1; sv[u] = A.lruS[((size_t)b * NCHUNK + jj) * 256 + tid]; }
#pragma unroll
                for (int u = 0; u < 8; ++u) if (j0 + u < c) hin_ = sv[u].x * hin_ + sv[u].y;
            }
            cLru[tid] = hin_;
        }
    }

    if (PH == 2) STAMP(52);
    if (PH == 2) {
        float w0[8], w1[8], w2[8];
        ldf8(A.conv_a_w + 0 * 256 + cg * 8, w0); ldf8(A.conv_a_w + 1 * 256 + cg * 8, w1); ldf8(A.conv_a_w + 2 * 256 + cg * 8, w2);
        float v[6][8];
#pragma unroll
        for (int i = 0; i < 6; ++i) {
            if (pos0 - 2 + i >= 0) { float ac[8], ax[8]; ld8(prow + (long)(i - 2) * IN_COLS + 256, ac); ld8(prow + (long)(i - 2) * IN_COLS + 512, ax);
#pragma unroll
                for (int e = 0; e < 8; ++e) v[i][e] = ac[e] * ax[e]; }
            else {
#pragma unroll
                for (int e = 0; e < 8; ++e) v[i][e] = 0.f; }
        }
#pragma unroll
        for (int n = 0; n < 4; ++n) {
            float ab[8], o[8]; ld8(prow + (long)n * IN_COLS, ab);
#pragma unroll
            for (int e = 0; e < 8; ++e) o[e] = ab[e] * (w0[e] * v[n][e] + w1[e] * v[n + 1][e] + w2[e] * v[n + 2][e]);
            *(v4u*)(A.ys + (t0 + tl0 + n) * 1024 + cg * 8) = pack8(o);
        }
    }
    if (PH == 2) {
        const int win = 2 << (cg >> 3);
        float S[8], x0[8];
#pragma unroll
        for (int e = 0; e < 8; ++e) S[e] = 0.f;
        ld8(prow + 768, x0);
#pragma unroll
        for (int e = 0; e < 8; ++e) S[e] = x0[e];
        for (int i = 1; i < win; ++i) if (pos0 - i >= 0) { float x[8]; ld8(prow - (long)i * IN_COLS + 768, x);
#pragma unroll
            for (int e = 0; e < 8; ++e) S[e] += x[e]; }
        {
            const int cnt = (pos0 + 1 < win) ? pos0 + 1 : win; const float inv = 1.0f / (float)cnt; float o[8];
#pragma unroll
            for (int e = 0; e < 8; ++e) o[e] = S[e] * inv - x0[e];
            *(LAS v4u*)(T0 + tl0 * TROW + cg * 16) = pack8(o);
        }
#pragma unroll 1
        for (int n = 1; n < 4; ++n) {
            float xn_[8]; ld8(prow + (long)n * IN_COLS + 768, xn_);
#pragma unroll
            for (int e = 0; e < 8; ++e) S[e] += xn_[e];
            if (pos0 + n - win >= 0) { float xo[8]; ld8(prow + (long)(n - win) * IN_COLS + 768, xo);
#pragma unroll
                for (int e = 0; e < 8; ++e) S[e] -= xo[e]; }
            const int cnt = (pos0 + n + 1 < win) ? pos0 + n + 1 : win; const float inv = 1.0f / (float)cnt; float o[8];
#pragma unroll
            for (int e = 0; e < 8; ++e) o[e] = S[e] * inv - xn_[e];
            *(LAS v4u*)(T0 + (tl0 + n) * TROW + cg * 16) = pack8(o);
        }
    }
    if (PH == 1) {
        float w0[8], w1[8], w2[8], w3[8], cb[8];
        ldf8(A.lconv_w + 0 * 256 + cg * 8, w0); ldf8(A.lconv_w + 1 * 256 + cg * 8, w1); ldf8(A.lconv_w + 2 * 256 + cg * 8, w2); ldf8(A.lconv_w + 3 * 256 + cg * 8, w3); ldf8(A.lconv_b + cg * 8, cb);
        float x[7][8];
#pragma unroll
        for (int i = 0; i < 7; ++i) {
            if (pos0 - 3 + i >= 0) ld8(prow + (long)(i - 3) * IN_COLS + 1280, x[i]);
            else {
#pragma unroll
                for (int e = 0; e < 8; ++e) x[i][e] = 0.f; }
        }
#pragma unroll
        for (int n = 0; n < 4; ++n) {
            float o[8];
#pragma unroll
            for (int e = 0; e < 8; ++e) o[e] = w0[e] * x[n][e] + w1[e] * x[n + 1][e] + w2[e] * x[n + 2][e] + w3[e] * x[n + 3][e] + cb[e];
            *(LAS v4u*)(T1 + (tl0 + n) * TROW + cg * 16) = pack8(o);
        }
    }
    __syncthreads();
    if (PH == 2) STAMP(53);

    const int hd = wave >> 1, dt0 = 2 * (wave & 1);
    if (PH == 2) {
        const bf16_t* WT = (const bf16_t*)(sm + SM_POOLT) + hd * 4096;
        f32x4 acc[2][4];
#pragma unroll
        for (int d = 0; d < 2; ++d)
#pragma unroll
            for (int tt = 0; tt < 4; ++tt) acc[d][tt] = (f32x4){0.f, 0.f, 0.f, 0.f};
#pragma unroll
        for (int ks = 0; ks < 2; ++ks) {
            bf16x8 wf[2];
#pragma unroll
            for (int d = 0; d < 2; ++d) wf[d] = *(const bf16x8*)(WT + ((dt0 + d) * 16 + j) * 64 + ks * 32 + 8 * q);
#pragma unroll
            for (int tt = 0; tt < 4; ++tt) { const bf16x8 xf = *(const LAS bf16x8*)(T0 + (tt * 16 + j) * TROW + (hd * 64 + ks * 32 + 8 * q) * 2);
#pragma unroll
                for (int d = 0; d < 2; ++d) acc[d][tt] = mma16(wf[d], xf, acc[d][tt]); }
        }
#pragma unroll
        for (int d = 0; d < 2; ++d) {
            const int ch0 = hd * 64 + (dt0 + d) * 16 + 4 * q;
            const f32x4 pb = *(const f32x4*)(A.pool_b + ch0), ps = *(const f32x4*)(A.pool_scale + ch0);
#pragma unroll
            for (int tt = 0; tt < 4; ++tt) { const f32x4 o = (acc[d][tt] + pb) * ps; v2u w; w.x = pk2(o.x, o.y); w.y = pk2(o.z, o.w);
                *(v2u*)(A.ys + (t0 + tt * 16 + j) * 1024 + 256 + ch0) = w; }
        }
    }
    if (PH == 2) STAMP(54);
    if (PH == 1) {
        const bf16_t* WA = (const bf16_t*)(sm + SM_WAT) + hd * 4096; const bf16_t* WX = (const bf16_t*)(sm + SM_WXT) + hd * 4096;
        f32x4 ga[2][4], gx[2][4];
#pragma unroll
        for (int d = 0; d < 2; ++d)
#pragma unroll
            for (int tt = 0; tt < 4; ++tt) { ga[d][tt] = (f32x4){0.f, 0.f, 0.f, 0.f}; gx[d][tt] = (f32x4){0.f, 0.f, 0.f, 0.f}; }
#pragma unroll
        for (int ks = 0; ks < 2; ++ks) {
            bf16x8 wa[2], wx[2];
#pragma unroll
            for (int d = 0; d < 2; ++d) { wa[d] = *(const bf16x8*)(WA + ((dt0 + d) * 16 + j) * 64 + ks * 32 + 8 * q); wx[d] = *(const bf16x8*)(WX + ((dt0 + d) * 16 + j) * 64 + ks * 32 + 8 * q); }
#pragma unroll
            for (int tt = 0; tt < 4; ++tt) { const bf16x8 xf = *(const LAS bf16x8*)(T1 + (tt * 16 + j) * TROW + (hd * 64 + ks * 32 + 8 * q) * 2);
#pragma unroll
                for (int d = 0; d < 2; ++d) { ga[d][tt] = mma16(wa[d], xf, ga[d][tt]); gx[d][tt] = mma16(wx[d], xf, gx[d][tt]); } }
        }
#pragma unroll
        for (int d = 0; d < 2; ++d) {
            const int ch0 = hd * 64 + (dt0 + d) * 16 + 4 * q;
            const f32x4 bav = *(const f32x4*)(A.ba + ch0), bxv = *(const f32x4*)(A.bx + ch0), nlg = *(const f32x4*)(A.tab + TB_NLOG + ch0);
            float hin[4] = {0.f, 0.f, 0.f, 0.f}, aprod[4] = {1.f, 1.f, 1.f, 1.f};
#pragma unroll
            for (int tt = 0; tt < 4; ++tt) {
                const v2u xcw = *(const LAS v2u*)(T1 + (tt * 16 + j) * TROW + ch0 * 2);
                const float xc[4] = {__uint_as_float(xcw.x << 16), __uint_as_float(xcw.x & 0xffff0000u), __uint_as_float(xcw.y << 16), __uint_as_float(xcw.y & 0xffff0000u)};
                v4u pk;
#pragma unroll
                for (int r = 0; r < 4; ++r) {
                    const float rg = sigmoidf_(ga[d][tt][r] + bav[r]), ig = sigmoidf_(gx[d][tt][r] + bxv[r]);
                    const float la = nlg[r] * rg; float av = __expf(la); const float mult = sqrtf(fmaxf(1.0f - av * av, 0.f));
                    float bv = mult * ig * xc[r];
                    { const float ap = dpp_row_shr<1>(1.f, av), bp = dpp_row_shr<1>(0.f, bv); bv = av * bp + bv; av = av * ap; }
                    { const float ap = dpp_row_shr<2>(1.f, av), bp = dpp_row_shr<2>(0.f, bv); bv = av * bp + bv; av = av * ap; }
                    { const float ap = dpp_row_shr<4>(1.f, av), bp = dpp_row_shr<4>(0.f, bv); bv = av * bp + bv; av = av * ap; }
                    { const float ap = dpp_row_shr<8>(1.f, av), bp = dpp_row_shr<8>(0.f, bv); bv = av * bp + bv; av = av * ap; }
                    const float h = bv + av * hin[r], ac = av * aprod[r];
                    pk[r] = pk2(h, ac);
                    hin[r] = __shfl(h, (lane & 48) | 15); aprod[r] = __shfl(ac, (lane & 48) | 15);
                }
                *(v4u*)(A.lrup + (t0 + tt * 16 + j) * 256 + ch0) = pk;
            }
            if (j == 15) {
                float2* sp = A.lruS + ((size_t)b * NCHUNK + c) * 256 + ch0;
#pragma unroll
                for (int r = 0; r < 4; ++r) sp[r] = make_float2(aprod[r], hin[r]);
            }
        }
    }
    if (PH == 2) {
#pragma unroll
        for (int d = 0; d < 2; ++d) {
            const int ch0 = hd * 64 + (dt0 + d) * 16 + 4 * q;
            float hin[4];
#pragma unroll
            for (int r = 0; r < 4; ++r) hin[r] = cLru[ch0 + r];
            v4u pk[4]; v2u gw[4];
#pragma unroll
            for (int tt = 0; tt < 4; ++tt) { pk[tt] = *(const v4u*)(A.lrup + (t0 + tt * 16 + j) * 256 + ch0); gw[tt] = *(const v2u*)(A.proj + (t0 + tt * 16 + j) * IN_COLS + 1536 + ch0); }
#pragma unroll
            for (int tt = 0; tt < 4; ++tt) {
                const float g0 = gelu_tanh(__uint_as_float(gw[tt].x << 16)), g1 = gelu_tanh(__uint_as_float(gw[tt].x & 0xffff0000u)), g2 = gelu_tanh(__uint_as_float(gw[tt].y << 16)), g3 = gelu_tanh(__uint_as_float(gw[tt].y & 0xffff0000u));
                float hv[4];
#pragma unroll
                for (int r = 0; r < 4; ++r) hv[r] = __uint_as_float(pk[tt][r] << 16) + __uint_as_float(pk[tt][r] & 0xffff0000u) * hin[r];
                v2u w; w.x = pk2(hv[0] * g0, hv[1] * g1); w.y = pk2(hv[2] * g2, hv[3] * g3);
                *(v2u*)(A.ys + (t0 + tt * 16 + j) * 1024 + 768 + ch0) = w;
            }
        }
    }
    if (PH == 2) STAMP(55);
    __syncthreads();

#pragma unroll
    for (int n = 0; n < 4; ++n) *(LAS v4u*)(T0 + (tl0 + n) * TROW + cg * 16) = *(const v4u*)(prow + (long)n * IN_COLS + 1024);
    __syncthreads();
    const bf16x8 zf = (bf16x8){0, 0, 0, 0, 0, 0, 0, 0};
    if (PH == 2) STAMP(56);
#pragma unroll 1
    for (int gi = 0; gi < 2; ++gi) {
        const int g = wave * 2 + gi;
        float ar[4], ai[4], a4r[4], a4i[4], a8r[4], a8i[4], aqr[4], aqi[4], hr[4], hi[4];
        bf16x8 bref[4], bimf[4];
#pragma unroll
        for (int st = 0; st < 4; ++st) {
            const int si = g * 64 + st * 16 + j;
            const float* at = (const float*)(sm + SM_ATAB) + si * 12;
            const f32x4 t0v = *(const f32x4*)at, t1v = *(const f32x4*)(at + 4);
            ar[st] = t0v.x; ai[st] = t0v.y; a4r[st] = t0v.z; a4i[st] = t0v.w; a8r[st] = t1v.x; a8i[st] = t1v.y;
            aqr[st] = q == 0 ? 1.f : (q == 1 ? t0v.z : (q == 2 ? t1v.x : t1v.z));
            aqi[st] = q == 0 ? 0.f : (q == 1 ? t0v.w : (q == 2 ? t1v.y : t1v.w));
            hr[st] = 0.f; hi[st] = 0.f;
            if (PH == 2) { const f32x2_ cv = cS5[si]; hr[st] = cv.x; hi[st] = cv.y; }
            bref[st] = (q < 2) ? *(const bf16x8*)((const bf16_t*)(sm + SM_BRE) + si * 16 + 8 * q) : zf;
            bimf[st] = (q < 2) ? *(const bf16x8*)((const bf16_t*)(sm + SM_BIM) + si * 16 + 8 * q) : zf;
        }
        bf16x8 cf[4];
        if (PH == 2) {
#pragma unroll
            for (int ks = 0; ks < 4; ++ks) cf[ks] = *(const bf16x8*)((const bf16_t*)(sm + SM_CMAT) + (g * 16 + j) * 128 + ks * 32 + 8 * q);
        }
        const f32x4 dv = *(const f32x4*)(A.s5_d + g * 16 + 4 * q);
#pragma unroll 1
        for (int tt = 0; tt < 4; ++tt) {
            const bf16x8 uf = (q < 2) ? *(const LAS bf16x8*)(T0 + (tt * 16 + j) * TROW + (g * 16 + 8 * q) * 2) : zf;
#pragma unroll
            for (int st = 0; st < 4; ++st) {
                const f32x4 z4 = (f32x4){0.f, 0.f, 0.f, 0.f};
                const f32x4 dre = mma16(uf, bref[st], z4), dim = mma16(uf, bimf[st], z4);
                float er = dre[0], ei = dim[0];
#pragma unroll
                for (int r = 1; r < 4; ++r) { const float nr = ar[st] * er - ai[st] * ei + dre[r], ni = ar[st] * ei + ai[st] * er + dim[r]; er = nr; ei = ni; }
                float x1r = __shfl_up(er, 16), x1i = __shfl_up(ei, 16), x2r = __shfl_up(er, 32), x2i = __shfl_up(ei, 32), x3r = __shfl_up(er, 48), x3i = __shfl_up(ei, 48);
                if (q < 1) { x1r = 0.f; x1i = 0.f; } if (q < 2) { x2r = 0.f; x2i = 0.f; } if (q < 3) { x3r = 0.f; x3i = 0.f; }
                float pr = x1r + (a4r[st] * x2r - a4i[st] * x2i) + (a8r[st] * x3r - a8i[st] * x3i) + (aqr[st] * hr[st] - aqi[st] * hi[st]);
                float pi = x1i + (a4r[st] * x2i + a4i[st] * x2r) + (a8r[st] * x3i + a8i[st] * x3r) + (aqr[st] * hi[st] + aqi[st] * hr[st]);
#pragma unroll
                for (int r = 0; r < 4; ++r) {
                    const float nr = ar[st] * pr - ai[st] * pi + dre[r], ni = ar[st] * pi + ai[st] * pr + dim[r]; pr = nr; pi = ni;
                    if (PH == 2) *(LAS unsigned*)(Hw + (4 * q + r) * HROW + (st * 16 + j) * 4) = pk2(nr, ni);
                }
                hr[st] = __shfl(pr, 48 + j); hi[st] = __shfl(pi, 48 + j);
            }
            if (PH == 2) {
                f32x4 y = (f32x4){0.f, 0.f, 0.f, 0.f};
#pragma unroll
                for (int ks = 0; ks < 4; ++ks) { const bf16x8 hf = *(const LAS bf16x8*)(Hw + j * HROW + (ks * 32 + 8 * q) * 2); y = mma16(cf[ks], hf, y); }
                const v2u uw = *(const LAS v2u*)(T0 + (tt * 16 + j) * TROW + (g * 16 + 4 * q) * 2);
                const float y0 = gelu_tanh(y[0] + dv[0] * __uint_as_float(uw.x << 16)), y1 = gelu_tanh(y[1] + dv[1] * __uint_as_float(uw.x & 0xffff0000u));
                const float y2 = gelu_tanh(y[2] + dv[2] * __uint_as_float(uw.y << 16)), y3 = gelu_tanh(y[3] + dv[3] * __uint_as_float(uw.y & 0xffff0000u));
                v2u w; w.x = pk2(y0, y1); w.y = pk2(y2, y3);
                *(LAS v2u*)(T1 + (tt * 16 + j) * TROW + (g * 16 + 4 * q) * 2) = w;
            }
        }
        if (PH == 1 && q == 0) {
#pragma unroll
            for (int st = 0; st < 4; ++st) A.s5st[((size_t)b * NCHUNK + c) * 1024 + g * 64 + st * 16 + j] = make_float2(hr[st], hi[st]);
        }
    }
    if (PH == 2) {
        STAMP(57);
        __syncthreads();
        STAMP(58);
        const bf16_t* GT = (const bf16_t*)(sm + SM_GLUT);
        f32x4 acc[2][4];
#pragma unroll
        for (int d = 0; d < 2; ++d)
#pragma unroll
            for (int tt = 0; tt < 4; ++tt) acc[d][tt] = (f32x4){0.f, 0.f, 0.f, 0.f};
#pragma unroll 2
        for (int ks = 0; ks < 8; ++ks) {
            bf16x8 wf[2];
#pragma unroll
            for (int d = 0; d < 2; ++d) wf[d] = *(const bf16x8*)(GT + ((wave * 2 + d) * 16 + j) * 256 + ks * 32 + 8 * q);
#pragma unroll
            for (int tt = 0; tt < 4; ++tt) { const bf16x8 xf = *(const LAS bf16x8*)(T1 + (tt * 16 + j) * TROW + (ks * 32 + 8 * q) * 2);
#pragma unroll
                for (int d = 0; d < 2; ++d) acc[d][tt] = mma16(wf[d], xf, acc[d][tt]); }
        }
#pragma unroll
        for (int d = 0; d < 2; ++d) {
            const int col0 = (wave * 2 + d) * 16 + 4 * q;
            const f32x4 gb = *(const f32x4*)(A.glu_b + col0);
#pragma unroll
            for (int tt = 0; tt < 4; ++tt) {
                const v2u yw = *(const LAS v2u*)(T1 + (tt * 16 + j) * TROW + col0 * 2);
                const f32x4 s = acc[d][tt] + gb;
                v2u w; w.x = pk2(__uint_as_float(yw.x << 16) * sigmoidf_(s.x), __uint_as_float(yw.x & 0xffff0000u) * sigmoidf_(s.y));
                w.y = pk2(__uint_as_float(yw.y << 16) * sigmoidf_(s.z), __uint_as_float(yw.y & 0xffff0000u) * sigmoidf_(s.w));
                *(v2u*)(A.ys + (t0 + tt * 16 + j) * 1024 + 512 + col0) = w;
            }
        }
    }
    __syncthreads();
}

__device__ __forceinline__ void router_phase(Frame& F, const float* h, const float* g2, const float* Wp, const float* rgb, const float* reb,
                                             bf16_t* xn, unsigned* cnt, int* buf_ts, float* buf_w) {
    LAS float* part = (LAS float*)(F.lds);
    LAS float* lg = (LAS float*)(F.lds + 98304);
    LAS float* rs = (LAS float*)(F.lds + 98304 + 12288);
    const int lane = F.lane, wave = F.wave, tid = F.tid, j = lane & 15, q = lane >> 4;
    for (int blk = blockIdx.x; blk < T / 64; blk += F.G) {
        const int m0 = blk * 64;
        f32x4 v[8][4];
#pragma unroll
        for (int i = 0; i < 8; ++i)
#pragma unroll
            for (int jj = 0; jj < 4; ++jj) v[i][jj] = *(const f32x4*)(h + (size_t)(m0 + wave * 8 + i) * D + 4 * lane + 256 * jj);
        {
            f32x4 gg[4];
#pragma unroll
            for (int jj = 0; jj < 4; ++jj) gg[jj] = *(const f32x4*)(g2 + 4 * lane + 256 * jj);
            __builtin_amdgcn_sched_barrier(0);
#pragma unroll
            for (int i = 0; i < 8; ++i) {
                float s = 0.f;
#pragma unroll
                for (int jj = 0; jj < 4; ++jj) s += v[i][jj].x * v[i][jj].x + v[i][jj].y * v[i][jj].y + v[i][jj].z * v[i][jj].z + v[i][jj].w * v[i][jj].w;
#pragma unroll
                for (int o = 1; o < 64; o <<= 1) s += __shfl_xor(s, o);
                const float rstd = rsqrtf(s * (1.0f / D) + EPS);
                if (lane == 0) rs[wave * 8 + i] = rstd;
#pragma unroll
                for (int jj = 0; jj < 4; ++jj) {
                    const f32x4 o = v[i][jj] * rstd * gg[jj];
                    *(unsigned*)((unsigned char*)xn + (size_t)(m0 + wave * 8 + i) * D + 4 * lane + 256 * jj) = pk4_fp8(o.x, o.y, o.z, o.w);
                }
            }
        }
        STAMP(48);
        f32x4 acc[3][4];
#pragma unroll
        for (int ot = 0; ot < 3; ++ot)
#pragma unroll
            for (int tt = 0; tt < 4; ++tt) acc[ot][tt] = (f32x4){0.f, 0.f, 0.f, 0.f};
        LAS float* xq = (LAS float*)(F.lds);
        const bf16_t* WH = (const bf16_t*)Wp; const bf16_t* WL = WH + 49152;
#pragma unroll
        for (int kq = 0; kq < 4; ++kq) {
            bf16x8 wh[3], wl[3];
#pragma unroll
            for (int ot = 0; ot < 3; ++ot) { wh[ot] = *(const bf16x8*)(WH + (size_t)(ot * 16 + j) * 1024 + kq * 256 + wave * 32 + 8 * q); wl[ot] = *(const bf16x8*)(WL + (size_t)(ot * 16 + j) * 1024 + kq * 256 + wave * 32 + 8 * q); }
            if (kq) __syncthreads();
#pragma unroll
            for (int i = 0; i < 8; ++i) *(LAS f32x4*)(xq + (wave * 8 + i) * 260 + 4 * lane) = v[i][kq];
            __builtin_amdgcn_sched_barrier(0);
            __syncthreads();
#pragma unroll
            for (int tt = 0; tt < 4; ++tt) {
                const f32x4 x0 = *(const LAS f32x4*)(xq + (tt * 16 + j) * 260 + wave * 32 + 8 * q), x1 = *(const LAS f32x4*)(xq + (tt * 16 + j) * 260 + wave * 32 + 8 * q + 4);
                const float xv[8] = {x0.x, x0.y, x0.z, x0.w, x1.x, x1.y, x1.z, x1.w};
                unsigned hp[4], lp[4];
#pragma unroll
                for (int p = 0; p < 4; ++p) {
                    const unsigned h0 = f2bfu(xv[2 * p]), h1 = f2bfu(xv[2 * p + 1]);
                    hp[p] = h0 | (h1 << 16);
                    lp[p] = pk2(xv[2 * p] - __uint_as_float(h0 << 16), xv[2 * p + 1] - __uint_as_float(h1 << 16));
                }
                const bf16x8 xh = __builtin_bit_cast(bf16x8, (v4u){hp[0], hp[1], hp[2], hp[3]}), xl = __builtin_bit_cast(bf16x8, (v4u){lp[0], lp[1], lp[2], lp[3]});
#pragma unroll
                for (int ot = 0; ot < 3; ++ot) { acc[ot][tt] = mma16(wh[ot], xh, acc[ot][tt]); acc[ot][tt] = mma16(wh[ot], xl, acc[ot][tt]); acc[ot][tt] = mma16(wl[ot], xh, acc[ot][tt]); }
            }
        }
        __syncthreads();
#pragma unroll
        for (int ot = 0; ot < 3; ++ot)
#pragma unroll
            for (int tt = 0; tt < 4; ++tt) *(LAS f32x4*)(part + ((wave * 12 + ot * 4 + tt) * 64 + lane) * 4) = acc[ot][tt];
        STAMP(49);
        __syncthreads();
        STAMP(50);
        for (int idx = tid; idx < 12 * 256; idx += 512) {
            const int tile = idx >> 8, ln = (idx >> 2) & 63, r = idx & 3, ot = tile >> 2, tt = tile & 3;
            float s = 0.f;
#pragma unroll
            for (int w = 0; w < 8; ++w) s += part[(w * 12 + tile) * 256 + (idx & 255)];
            const int tok = tt * 16 + (ln & 15), o = ot * 16 + 4 * (ln >> 4) + r;
            lg[tok * 48 + o] = s * rs[tok];
        }
        __syncthreads();
        STAMP(51);
        if (tid < 64) {
            const int m = m0 + tid;
            float gl[4], mx = -1e30f; int gi = 0;
#pragma unroll
            for (int i = 0; i < 4; ++i) { gl[i] = lg[tid * 48 + i] + rgb[i]; if (gl[i] > mx) { mx = gl[i]; gi = i; } }
            float den = 0.f;
#pragma unroll
            for (int i = 0; i < 4; ++i) den += __expf(gl[i] - mx);
            const float gval = 1.0f / den;
            float v1 = -1e30f, v2 = -1e30f; int i1 = 0, i2 = 0;
            for (int i = 0; i < 8; ++i) { const float el = lg[tid * 48 + 4 + gi * 8 + i] + reb[gi * 8 + i]; if (el > v1) { v2 = v1; i2 = i1; v1 = el; i1 = i; } else if (el > v2) { v2 = el; i2 = i; } }
            const float e2 = __expf(v2 - v1), w1 = gval / (1.0f + e2), w2 = gval * e2 / (1.0f + e2);
            const int ex1 = gi * 8 + i1, ex2 = gi * 8 + i2;
            const unsigned r1 = atomicAdd(&cnt[ex1 * 64], 1u), r2 = atomicAdd(&cnt[ex2 * 64], 1u);
            buf_ts[ex1 * CAP + r1] = m * 2 + 0; buf_w[ex1 * CAP + r1] = w1;
            buf_ts[ex2 * CAP + r2] = m * 2 + 1; buf_w[ex2 * CAP + r2] = w2;
        }
        __syncthreads();
    }
}

__device__ __forceinline__ void build_plan(Frame& F, const unsigned* cnt) {
    LAS int* plan = (LAS int*)(F.lds + PLAN_OFF);
    if (F.tid < 64) {
        const int e = F.tid & 31;
        const int ce = (int)__hip_atomic_load(cnt + e * 64, RLX_AGENT);
        const int nf = ce >> 8, rem = ce & 255, big = rem > 128 ? 1 : 0, sml = (rem > 0 && rem <= 128) ? 1 : 0;
        int pf = nf, pb = big, ps = sml;
#pragma unroll
        for (int o = 1; o < 32; o <<= 1) { const int a = __shfl_up(pf, o, 32), b = __shfl_up(pb, o, 32), c = __shfl_up(ps, o, 32); if (e >= o) { pf += a; pb += b; ps += c; } }
        const int NF = __shfl(pf, 31, 32), NB = __shfl(pb, 31, 32), NS = __shfl(ps, 31, 32);
        if (F.tid < 32) {
            plan[321 + e] = ce;
            for (int jb = 0; jb < nf; ++jb) { const int p = pf - nf + jb; if (p < MAXBLK) { plan[1 + p] = e; plan[1 + MAXBLK + p] = jb; } }
            if (big) { const int p = NF + pb - 1; if (p < MAXBLK) { plan[1 + p] = e; plan[1 + MAXBLK + p] = nf; } }
            if (sml) { const int p = NF + NB + ps - 1; if (p < MAXBLK) { plan[1 + p] = e; plan[1 + MAXBLK + p] = nf; } }
            if (e == 0) { const int tot = NF + NB + NS; plan[0] = tot < MAXBLK ? tot : MAXBLK; }
        }
    }
    __syncthreads();
}

struct DenseSched {
    static constexpr bool GATHER = false, HALF = false, WAITS = false, PUBLISHES = false;
    pg8::StaticOrder ord; const char* A; const char* Bt; int lda, K; int a_sh, a_cs; int es;
    __device__ __forceinline__ bool next(int i, pg8::Unit& u) const { return ord.next(i, u); }
    __device__ __forceinline__ const char* a_base(const pg8::Unit& u) const { return A + (size_t)u.pm * 256 * lda * es + (size_t)((u.pn >> a_sh) * a_cs); }
    __device__ __forceinline__ const char* b_base(const pg8::Unit& u) const { return Bt + (size_t)u.pn * 256 * K * es; }
    __device__ __forceinline__ unsigned gather_off(const pg8::Unit&, int) const { return 0u; }
    __device__ __forceinline__ bool half_only(const pg8::Unit&) const { return false; }
};
struct Moe1Sched {
    static constexpr bool GATHER = true, HALF = true, WAITS = false, PUBLISHES = false;
    const char* xn; const char* w13; const LAS int* plan; const int* buf_ts; int G, c, lda; unsigned* ready;
    __device__ __forceinline__ void done(const pg8::Unit& u) const { asm volatile("s_waitcnt vmcnt(0)" ::: "memory"); if ((threadIdx.x & 63) == 0) __hip_atomic_fetch_add(ready + 16 * u.pm, 1u, RLX_AGENT); }
    __device__ __forceinline__ bool next(int i, pg8::Unit& u) const { const int L = i * G + c; if (L >= 4 * plan[0]) return false; u.pm = L >> 2; u.pn = L & 3; return true; }
    __device__ __forceinline__ const char* a_base(const pg8::Unit&) const { return xn; }
    __device__ __forceinline__ const char* b_base(const pg8::Unit& u) const { return w13 + (size_t)plan[1 + u.pm] * (1024 * 1024) + (size_t)u.pn * (256 * 1024); }
    __device__ __forceinline__ unsigned gather_off(const pg8::Unit& u, int r) const {
        const int e = plan[1 + u.pm], lb = plan[1 + MAXBLK + u.pm], ce = plan[321 + e];
        int pos = lb * 256 + r; pos = pos < ce ? pos : ce - 1;
        return (unsigned)(buf_ts[e * CAP + pos] >> 1) * (unsigned)D;
    }
    __device__ __forceinline__ bool half_only(const pg8::Unit& u) const { const int e = plan[1 + u.pm], lb = plan[1 + MAXBLK + u.pm]; return plan[321 + e] - lb * 256 <= 128; }
};
struct Moe2Sched {
    static constexpr bool GATHER = false, HALF = true, WAITS = false, PUBLISHES = false;
    const char* hbuf; const char* w2t; const LAS int* plan; int G, c, lda; const unsigned* ready; unsigned* tmo;
    __device__ __forceinline__ void a_ready(const pg8::Unit& u) const {
        if (threadIdx.x < 64) {
            const unsigned long long t0 = __builtin_amdgcn_s_memrealtime(); unsigned polls = 0;
            while ((unsigned)__builtin_amdgcn_readfirstlane(__hip_atomic_load(ready + 16 * u.pm, RLX_AGENT)) < 32u) {
                if ((++polls & 255u) == 0u && __builtin_amdgcn_readfirstlane(__hip_atomic_load(tmo, RLX_AGENT)) != 0u) break;
                if (__builtin_amdgcn_s_memrealtime() - t0 > 2000000ull) { if (threadIdx.x == 0) __hip_atomic_store(tmo, 1u, RLX_AGENT); break; }
                __builtin_amdgcn_s_sleep(2); }
            __builtin_amdgcn_fence(__ATOMIC_ACQUIRE, "agent");
            asm volatile("s_waitcnt vmcnt(0)" ::: "memory");
        }
        asm volatile("" ::: "memory"); __builtin_amdgcn_s_barrier(); asm volatile("" ::: "memory");
    }
    __device__ __forceinline__ bool next(int i, pg8::Unit& u) const { const int L = i * G + c; if (L >= 4 * plan[0]) return false; u.pm = L >> 2; u.pn = L & 3; return true; }
    __device__ __forceinline__ const char* a_base(const pg8::Unit& u) const { return hbuf + (size_t)u.pm * 256 * DEXP; }
    __device__ __forceinline__ const char* b_base(const pg8::Unit& u) const { return w2t + (size_t)plan[1 + u.pm] * (1024 * 512) + (size_t)u.pn * (256 * 512); }
    __device__ __forceinline__ unsigned gather_off(const pg8::Unit&, int) const { return 0u; }
    __device__ __forceinline__ bool half_only(const pg8::Unit& u) const { const int e = plan[1 + u.pm], lb = plan[1 + MAXBLK + u.pm]; return plan[321 + e] - lb * 256 <= 128; }
};

using pg8::f32x4; using pg8::u32x4; using pg8::u32x2; using pg8::cvt_pk_bf16; using pg8::Unit; using pg8::HALF; using pg8::BM;
struct EpiStoreBf16 {
    static constexpr bool PERM = true;
    bf16_t* O; int ldc;
    __device__ __forceinline__ void operator()(const f32x4 (&acc)[2][2][4][2], const Unit& u, int wr, int wc, int fr, int fq) const {
        const int row0 = u.pm * BM + wr * 64 + fr, col0 = u.pn * BM + wc * 32 + 8 * fq;
#pragma unroll
        for (int ai = 0; ai < 2; ++ai)
#pragma unroll
            for (int m = 0; m < 4; ++m) { bf16_t* rowp = O + (size_t)(row0 + ai * HALF + m * 16) * ldc + col0;
#pragma unroll
                for (int bj = 0; bj < 2; ++bj) { const f32x4 v0 = acc[ai][bj][m][0], v1 = acc[ai][bj][m][1];
                    u32x4 w; w.x = cvt_pk_bf16(v0[0], v0[1]); w.y = cvt_pk_bf16(v0[2], v0[3]); w.z = cvt_pk_bf16(v1[0], v1[1]); w.w = cvt_pk_bf16(v1[2], v1[3]);
                    *(u32x4*)(rowp + bj * HALF) = w; } }
    }
};
struct EpiGateMerge {
    static constexpr bool PERM = false;
    const float* bias; const bf16_t* br; bf16_t* merged;
    __device__ __forceinline__ void operator()(const f32x4 (&acc)[2][2][4][2], const Unit& u, int wr, int wc, int fr, int fq) const {
        const int row0 = u.pm * BM + wr * 64 + fr, d0 = u.pn * 64 + wc * 16 + 4 * fq;
        f32x4 bv[4];
#pragma unroll
        for (int k4 = 0; k4 < 4; ++k4) bv[k4] = *(const f32x4*)(bias + k4 * 1024 + d0);
#pragma unroll
        for (int ai = 0; ai < 2; ++ai)
#pragma unroll
            for (int m = 0; m < 4; ++m) {
                const size_t row = (size_t)(row0 + ai * HALF + m * 16);
                f32x4 s = (f32x4){0.f, 0.f, 0.f, 0.f};
#pragma unroll
                for (int k4 = 0; k4 < 4; ++k4) {
                    const u32x2 b2 = *(const u32x2*)(br + row * 4096 + k4 * 1024 + d0);
                    const f32x4 a = acc[ai][k4 >> 1][m][k4 & 1] * (1.0f / MG_SCALE) + bv[k4];
                    s[0] += sigmoidf_(a[0]) * __uint_as_float(b2.x << 16);
                    s[1] += sigmoidf_(a[1]) * __uint_as_float(b2.x & 0xffff0000u);
                    s[2] += sigmoidf_(a[2]) * __uint_as_float(b2.y << 16);
                    s[3] += sigmoidf_(a[3]) * __uint_as_float(b2.y & 0xffff0000u);
                }
                u32x2 w; w.x = cvt_pk_bf16(s[0], s[1]); w.y = cvt_pk_bf16(s[2], s[3]);
                *(u32x2*)(merged + row * D + d0) = w;
            }
    }
};
struct EpiAddF32 {
    static constexpr bool PERM = false;
    const float* hsrc; float* hdst;
    __device__ __forceinline__ void operator()(const f32x4 (&acc)[2][2][4][2], const Unit& u, int wr, int wc, int fr, int fq) const {
        const int row0 = u.pm * BM + wr * 64 + fr, col0 = u.pn * BM + wc * 32 + 4 * fq;
#pragma unroll
        for (int ai = 0; ai < 2; ++ai)
#pragma unroll
            for (int m = 0; m < 4; ++m) { const size_t ro = (size_t)(row0 + ai * HALF + m * 16) * D + col0;
#pragma unroll
                for (int bj = 0; bj < 2; ++bj)
#pragma unroll
                    for (int n = 0; n < 2; ++n) *(f32x4*)(hdst + ro + bj * HALF + n * 16) = *(const f32x4*)(hsrc + ro + bj * HALF + n * 16) + acc[ai][bj][m][n]; }
    }
};
struct EpiMoe1 {
    static constexpr bool PERM = false;
    unsigned char* hbuf;
    __device__ __forceinline__ void operator()(const f32x4 (&acc)[2][2][4][2], const Unit& u, int wr, int wc, int fr, int fq) const {
        const int row0 = u.pm * BM + wr * 64 + fr, h0 = u.pn * 128 + wc * 16 + 4 * fq;
        const float si = 1.0f / W13_SCALE;
#pragma unroll
        for (int ai = 0; ai < 2; ++ai)
#pragma unroll
            for (int m = 0; m < 4; ++m) { unsigned char* rowp = hbuf + (size_t)(row0 + ai * HALF + m * 16) * DEXP + h0;
#pragma unroll
                for (int bj = 0; bj < 2; ++bj) { const f32x4 a1 = acc[ai][bj][m][0] * si, a3 = acc[ai][bj][m][1] * (si * H_SCALE);
                    const unsigned w = pk4_fp8(a1[0] * sigmoidf_(a1[0]) * a3[0], a1[1] * sigmoidf_(a1[1]) * a3[1], a1[2] * sigmoidf_(a1[2]) * a3[2], a1[3] * sigmoidf_(a1[3]) * a3[3]);
                    *(unsigned*)(rowp + bj * 64) = w; } }
    }
};
struct EpiMoe2 {
    static constexpr bool PERM = true;
    bf16_t* ymoe; const LAS int* plan; const int* buf_ts; const float* buf_w;
    __device__ __forceinline__ void operator()(const f32x4 (&acc)[2][2][4][2], const Unit& u, int wr, int wc, int fr, int fq) const {
        const int e = plan[1 + u.pm], lb = plan[1 + MAXBLK + u.pm], ce = plan[321 + e];
        const int col0 = u.pn * BM + wc * 32 + 8 * fq;
        int ts[2][4]; float wt[2][4];
#pragma unroll
        for (int ai = 0; ai < 2; ++ai)
#pragma unroll
            for (int m = 0; m < 4; ++m) {
                const int pos = lb * 256 + ai * HALF + wr * 64 + m * 16 + fr; const int pc = pos < ce ? pos : ce - 1;
                ts[ai][m] = buf_ts[e * CAP + pc]; wt[ai][m] = buf_w[e * CAP + pc] * (1.0f / (W2_SCALE * H_SCALE));
                if (pos >= ce) ts[ai][m] = -1;
            }
        __builtin_amdgcn_sched_barrier(0);
#pragma unroll
        for (int ai = 0; ai < 2; ++ai)
#pragma unroll
            for (int m = 0; m < 4; ++m) {
                if (ts[ai][m] >= 0) {
                    bf16_t* rowp = ymoe + (size_t)ts[ai][m] * D + col0; const float w_ = wt[ai][m];
#pragma unroll
                    for (int bj = 0; bj < 2; ++bj) { const f32x4 v0 = acc[ai][bj][m][0] * w_, v1 = acc[ai][bj][m][1] * w_;
                        u32x4 w; w.x = cvt_pk_bf16(v0[0], v0[1]); w.y = cvt_pk_bf16(v0[2], v0[3]); w.z = cvt_pk_bf16(v1[0], v1[1]); w.w = cvt_pk_bf16(v1[2], v1[3]);
                        *(u32x4*)(rowp + bj * HALF) = w; }
                }
            }
    }
};

__device__ __forceinline__ void make_mix_args(MixArgs& A, const Args& args, unsigned char* ws, int l) {
    A.proj = (const bf16_t*)(ws + WS_PROJ); A.ys = (bf16_t*)(ws + WS_YS); A.tab = (const float*)(ws + WS_TAB + (size_t)l * MiB); A.sm = ws + WS_TAB + (size_t)l * MiB + SM_OFF; A.ws = ws;
    A.s5st = (float2*)(ws + WS_S5ST); A.lruS = (float2*)(ws + WS_LRUS); A.lrup = (unsigned*)(ws + WS_LRUA);
    A.conv_a_w = args.in[3] + (size_t)l * 3 * W; A.pool_b = args.in[5] + (size_t)l * W; A.pool_scale = args.in[6] + (size_t)l * W;
    A.s5_d = args.in[14] + (size_t)l * W; A.glu_b = args.in[16] + (size_t)l * W;
    A.lconv_w = args.in[17] + (size_t)l * 4 * W; A.lconv_b = args.in[18] + (size_t)l * W; A.ba = args.in[20] + (size_t)l * W; A.bx = args.in[22] + (size_t)l * W;
}

__global__ void __launch_bounds__(NWAVES * 64, 2) mk_fwd(Args args) {
    extern __shared__ __attribute__((aligned(16))) unsigned char lds[];
    Frame F;
    F.lds = (LAS unsigned char*)lds; F.smem = lds;
    F.MISC = (volatile LAS unsigned*)(F.lds + MISC_OFF);
    F.tid = threadIdx.x; F.lane = F.tid & 63; F.wave = __builtin_amdgcn_readfirstlane(F.tid >> 6);
    F.G = gridDim.x; { const int bx = blockIdx.x; F.vcu = (F.G % 8 == 0) ? (bx % 8) * (F.G / 8) + bx / 8 : bx; }
    F.ws = args.ws; F.ctl = (unsigned*)(args.ws + WS_CTL);
    unsigned char* ws = args.ws; unsigned char* const args_ws_ = args.ws; (void)args_ws_;
    for (int u = F.tid; u < (LDS_BYTES - LDSCTL_OFF) / 4; u += NWAVES * 64) ((LAS unsigned*)(F.lds + LDSCTL_OFF))[u] = 0u;
    __syncthreads();
    XcdBarrier bar; bar.bar = F.ctl + CW_BAR; bar.x = 0; bar.st = nullptr;
    if (N_LAUNCHES == 1) bar = xcd_barrier_post(F.ctl + CW_BAR, F.MISC + 8);
    const int lo = args.ph_lo, hi = args.ph_hi;
    float* h = (float*)(ws + WS_H); bf16_t* xn = (bf16_t*)(ws + WS_XN); bf16_t* proj = (bf16_t*)(ws + WS_PROJ); bf16_t* ys = (bf16_t*)(ws + WS_YS);
    bf16_t* br = (bf16_t*)(ws + WS_R1); bf16_t* hbuf = (bf16_t*)(ws + WS_HBUF); bf16_t* ymoe = (bf16_t*)(ws + WS_YMOE); bf16_t* merged = (bf16_t*)(ws + WS_MERGED);
    int* buf_ts = (int*)(ws + WS_BUFTS); float* buf_w = (float*)(ws + WS_BUFW);

#ifndef KIND_MASK
#define KIND_MASK 0x7ff
#endif
#define PH_BEGIN(k, kind) if (lo <= (k) && (k) < hi && ((KIND_MASK >> (kind)) & 1)) { \
        { int t_ = threadIdx.x; asm volatile("" : "+v"(t_)); F.tid = t_; F.lane = t_ & 63; F.wave = __builtin_amdgcn_readfirstlane(t_ >> 6); } STAMP(2 * (k));
#ifdef PROBE_A
#define PH_END(k) __syncthreads(); STAMP(2 * (k) + 1); if ((k) + 1 < hi) xcd_barrier(bar); }
#else
#define PH_END(k) if ((k) + 1 < hi) xcd_barrier(bar); }
#endif

    PH_BEGIN(0, 0)
        prep_tables(F, args);
        conv_mixer_weights(F, args);
        conv_expert_weights(F, args, 0, CONV_NA);
        norm_phase(F, args.in[0], nullptr, args.in[1], nullptr, xn, nullptr, 0.0f, ws + WS_XN8);
    PH_END(0)

#ifdef PROBE_A
#ifndef PROBE_MODE
#define PROBE_MODE 0
#endif
#ifndef PROBE_SCALE
#define PROBE_SCALE 300
#endif
#ifndef PROBE_SHIFT
#define PROBE_SHIFT 0.0f
#endif
#define PROBE_REDUCE() { xcd_barrier(bar); \
        if (blockIdx.x == 0) { LAS float* red = (LAS float*)F.lds; const unsigned long long* dd = (const unsigned long long*)(g_dbg); \
            if (F.tid < 256) { const unsigned long long ta = __hip_atomic_load(dd + (size_t)F.tid * 64 + (PROBE_A), RLX_AGENT), tb = __hip_atomic_load(dd + (size_t)F.tid * 64 + (PROBE_B), RLX_AGENT), t00 = __hip_atomic_load(dd + (PROBE_A), RLX_AGENT); \
                red[F.tid] = (float)(long long)(tb - ta) * 0.01f; red[256 + F.tid] = (float)(long long)(ta - t00) * 0.01f; red[512 + F.tid] = (float)(long long)(tb - t00) * 0.01f; } \
            __syncthreads(); \
            if (F.tid == 0) { float sum = 0.f, mx = -1e30f, mna = 1e30f, mxb = -1e30f; for (int i = 0; i < 256; ++i) { sum += red[i]; mx = fmaxf(mx, red[i]); mna = fminf(mna, red[256 + i]); mxb = fmaxf(mxb, red[512 + i]); } \
                const float val = PROBE_MODE == 0 ? sum * (1.0f / 256.0f) : (PROBE_MODE == 1 ? mx : mxb - mna); \
                const float vq = val; \
                __hip_atomic_store((float*)((unsigned long long*)(g_dbg) + 256 * 64), vq, RLX_AGENT); } \
            __syncthreads(); } \
        xcd_barrier(bar); \
        oscale_ = __hip_atomic_load((float*)((unsigned long long*)(g_dbg) + 256 * 64), RLX_AGENT) * (1.0f / (float)(PROBE_SCALE)); }
#else
#define PROBE_REDUCE()
#endif
#define LAYER(l) { \
    const int pb = 1 + PH_PER_LAYER * (l); \
    const float* tab = (const float*)(ws + WS_TAB + (size_t)(l) * MiB); \
    const unsigned char* wmix = ws + WS_WMIX + (size_t)(l) * WMIX_STRIDE; \
    unsigned* cnt = F.ctl + CW_CNT + 2048 * (l); \
    PH_BEGIN(pb + 0, 1)   \
        DenseSched S; S.ord.init(T, IN_COLS, F.G, (int)blockIdx.x); S.A = (const char*)xn; S.Bt = (const char*)(wmix + WMIX_IN); S.lda = D; S.K = D; S.a_sh = 0; S.a_cs = 0; S.es = 2; \
        EpiStoreBf16 E{proj, IN_COLS}; \
        pg8::gemm_phase<EpiStoreBf16, DenseSched, true, true>(F.lds, F.tid, D, S, E); \
        if (F.G == 256 && (int)blockIdx.x >= 192) conv_expert_quota(F, args, (l), 0, ((int)blockIdx.x - 192) * NWAVES + F.wave, 4); \
        else if (F.G != 256 && (int)blockIdx.x == 0) conv_expert_quota(F, args, (l), 0, F.wave, CONV_NA / NWAVES);     \
    PH_END(pb + 0) \
    PH_BEGIN(pb + 1, 2)   \
        MixArgs A; make_mix_args(A, args, ws, (l)); \
        for (int u = blockIdx.x; u < BATCH * NCHUNK; u += F.G) { int t_ = F.tid; asm volatile("" : "+v"(t_)); mix_unit<1>(A, F.lds, u, t_); } \
    PH_END(pb + 1) \
    PH_BEGIN(pb + 2, 3)   \
        MixArgs A; make_mix_args(A, args, ws, (l)); \
        for (int u = blockIdx.x; u < BATCH * NCHUNK; u += F.G) { int t_ = F.tid; asm volatile("" : "+v"(t_)); mix_unit<2>(A, F.lds, u, t_); } \
    PH_END(pb + 2) \
    PH_BEGIN(pb + 3, 4)   \
        DenseSched S; S.ord.init(T, 4096, F.G, (int)blockIdx.x); S.A = (const char*)ys; S.Bt = (const char*)(wmix + WMIX_BR); S.lda = 1024; S.K = 256; S.a_sh = 2; S.a_cs = 512; S.es = 2; \
        EpiStoreBf16 E{br, 4096}; \
        pg8::gemm_phase<EpiStoreBf16, DenseSched, true, true>(F.lds, F.tid, 256, S, E); \
    PH_END(pb + 3) \
    PH_BEGIN(pb + 4, 5)   \
        DenseSched S; S.ord.init(T, 4096, F.G, (int)blockIdx.x); S.A = (const char*)(ws + WS_XN8); S.Bt = (const char*)(wmix + WMIX_MG); S.lda = D; S.K = D; S.a_sh = 0; S.a_cs = 0; S.es = 1; \
        EpiGateMerge E{args.in[25] + (size_t)(l) * 4096, br, merged}; \
        pg8::gemm_phase<EpiGateMerge, DenseSched, true, true, true>(F.lds, F.tid, D, S, E); \
    PH_END(pb + 4) \
    PH_BEGIN(pb + 5, 6)   \
        DenseSched S; S.ord.init(T, D, F.G, (int)blockIdx.x); S.A = (const char*)merged; S.Bt = (const char*)(wmix + WMIX_OUT); S.lda = D; S.K = D; S.a_sh = 0; S.a_cs = 0; S.es = 2; \
        EpiAddF32 E{(l) == 0 ? args.in[0] : h, (args.flags & 1) ? (float*)(ws + WS_R1) : h}; \
        pg8::gemm_phase<EpiAddF32, DenseSched, true, true>(F.lds, F.tid, D, S, E); \
    PH_END(pb + 5) \
    PH_BEGIN(pb + 6, 7)   \
        if (args.flags & 1) router_phase(F, h, args.in[28] + (size_t)(l) * D, tab + TB_RW, args.in[30] + (size_t)(l) * 4, args.in[32] + (size_t)(l) * 32, xn, F.ctl + 16384, (int*)(ws + WS_END), (float*)(ws + WS_END + 2 * MiB)); \
        else router_phase(F, h, args.in[28] + (size_t)(l) * D, tab + TB_RW, args.in[30] + (size_t)(l) * 4, args.in[32] + (size_t)(l) * 32, xn, cnt, buf_ts, buf_w); \
    PH_END(pb + 6) \
    PH_BEGIN(pb + 7, 8)   \
        build_plan(F, cnt); \
        unsigned* rdy = F.ctl + CW_RDY + 4096 * (l); \
        { Moe1Sched S{(const char*)xn, (const char*)(ws + WS_WEXP + (size_t)(l) * WEXP_LAYER), (const LAS int*)(F.lds + PLAN_OFF), buf_ts, F.G, F.vcu, D, rdy}; \
          EpiMoe1 E{(unsigned char*)hbuf}; \
          pg8::gemm_phase<EpiMoe1, Moe1Sched, true, true, true>(F.lds, F.tid, D, S, E); } \
        if ((l) + 1 < DEPTH) { if (F.G == 256 && F.vcu >= 128) conv_expert_quota(F, args, (l) + 1, CONV_NA, (F.vcu - 128) * NWAVES + F.wave, 3); \
            else if (F.G != 256 && F.vcu == 0) conv_expert_quota(F, args, (l) + 1, CONV_NA, F.wave, CONV_NB / NWAVES); } \
        xcd_barrier(bar);     \
        { Moe2Sched S{(const char*)hbuf, (const char*)(ws + WS_WEXP + (size_t)(l) * WEXP_LAYER + WEXP_W2), (const LAS int*)(F.lds + PLAN_OFF), F.G, F.G - 1 - F.vcu, DEXP, rdy, F.ctl + CW_TMO}; \
          EpiMoe2 E{ymoe, (const LAS int*)(F.lds + PLAN_OFF), buf_ts, buf_w}; \
          pg8::gemm_phase<EpiMoe2, Moe2Sched, true, true, true>(F.lds, F.tid, DEXP, S, E); } \
    PH_END(pb + 7) \
    PH_BEGIN(pb + 8, 9)   \
        if ((l) + 1 < DEPTH) { \
            conv_expert_weights(F, args, (l) + 1, CONV_NA + CONV_NB); \
            norm_phase(F, h, ymoe, args.in[1] + (size_t)((l) + 1) * D, (args.flags & 1) ? nullptr : h, xn, nullptr, 0.0f, ws + WS_XN8); \
        } else { \
            float oscale_ = 0.0f; \
            PROBE_REDUCE() \
            norm_phase(F, h, ymoe, args.in[36], nullptr, nullptr, args.out, oscale_); \
        } \
    PH_END(pb + 8) \
}
    LAYER(0)
    LAYER(1)
#undef LAYER
#undef PH_BEGIN
#undef PH_END
}
}

extern "C" void kernel_launch(void* const* d_in, const int* in_sizes, int n_in, void* d_out, int out_size, void* d_ws, size_t ws_size, hipStream_t stream) {
    static int grid = 0;
    if (grid == 0) {
        if (n_in != 37 || ws_size < WS_END) { fprintf(stderr, "kernel_launch: unexpected n_in %d or ws %zu\n", n_in, ws_size); grid = -1; return; }
        int dev = 0, cus = 0;
        if (hipGetDevice(&dev) != hipSuccess || hipDeviceGetAttribute(&cus, hipDeviceAttributeMultiprocessorCount, dev) != hipSuccess) { grid = -1; return; }
        if (hipFuncSetAttribute((const void*)mk_fwd, hipFuncAttributeMaxDynamicSharedMemorySize, LDS_BYTES) != hipSuccess) { fprintf(stderr, "kernel_launch: hipFuncSetAttribute failed\n"); grid = -1; return; }
        grid = cus;
    }
    if (grid < 0) return;
    (void)hipMemsetAsync((char*)d_ws + WS_CTL, 0, 1 * MiB, stream);
    Args a{};
    for (int i = 0; i < 37; ++i) a.in[i] = (const float*)d_in[i];
    a.out = (float*)d_out; a.ws = (unsigned char*)d_ws;
    if (N_LAUNCHES == 1) {
        a.ph_lo = 0; a.ph_hi = N_PHASES;
        hipLaunchKernelGGL(mk_fwd, dim3(grid), dim3(NWAVES * 64), LDS_BYTES, stream, a);
    } else {
#ifndef REP_MASK
#define REP_MASK 0
#endif
#ifndef REP_N
#define REP_N 2
#endif
        for (int p = 0; p < N_PHASES; ++p) { a.ph_lo = p; a.ph_hi = p + 1; const int kind = p == 0 ? 0 : 1 + (p - 1) % PH_PER_LAYER; const int nrep = ((REP_MASK >> kind) & 1) ? REP_N : 1;
            for (int r = 0; r < nrep; ++r) { a.flags = (r + 1 < nrep) ? 1 : 0; hipLaunchKernelGGL(mk_fwd, dim3(grid), dim3(NWAVES * 64), LDS_BYTES, stream, a); } }
    }
}
```

```cpp
#include <hip/hip_runtime.h>
#include <cstdint>
#include <cstdio>

#ifndef MK_N_LAUNCHES
#define MK_N_LAUNCHES 1
#endif

namespace pg8 {
#define PG8_LAS __attribute__((address_space(3)))
typedef unsigned short bf16_t;
typedef short bf16x8 __attribute__((ext_vector_type(8)));
typedef float f32x4 __attribute__((ext_vector_type(4)));
typedef unsigned u32x4 __attribute__((ext_vector_type(4)));
typedef unsigned u32x2 __attribute__((ext_vector_type(2)));
constexpr int BM = 256, BK = 64, HALF = 128, HTB = HALF * BK * 2, STAGE_BYTES = 8 * HTB, NXCD = 8, WGM = 8;

__host__ __device__ __forceinline__ int lds_byte(int r, int c) { const int st = (r >> 4) * 2 + (c >> 5), rr = r & 15, cc = c & 31, ob = rr * 64 + cc * 2; return st * 1024 + (ob ^ (((ob >> 9) & 1) << 5)); }
__host__ __device__ __forceinline__ void stage_rc(int b, int& R, int& C) { const int st = b / 1024, sb = b % 1024, swz = sb ^ (((sb >> 9) & 1) << 5); R = (st >> 1) * 16 + swz / 64; C = (st & 1) * 32 + (swz % 64) / 2; }
__host__ __device__ __forceinline__ int perm32(int rho) { const int n = rho >> 4, i = rho & 15; return 8 * (i >> 2) + 4 * n + (i & 3); }

struct Unit { int pm, pn; };

struct StaticOrder {
    int nM, nN, nwg, G, c;
    __host__ __device__ void init(int M, int N, int G_, int c_) { nM = M / BM; nN = N / BM; nwg = nM * nN; G = G_; c = c_; }
    __host__ __device__ bool next(int i, Unit& u) const {
        const long L = (long)i * G + c; if (L >= nwg) return false;
        int wgid = (int)L; { const int q = nwg / NXCD, r = nwg % NXCD, xcd = wgid % NXCD, off = wgid / NXCD; wgid = (xcd < r ? xcd * (q + 1) : r * (q + 1) + (xcd - r) * q) + off; }
        const int nig = WGM * nN, gid = wgid / nig, fm = gid * WGM, gsz = (nM - fm) < WGM ? (nM - fm) : WGM;
        u.pm = fm + ((wgid % nig) % gsz); u.pn = (wgid % nig) / gsz; return true;
    }
};

typedef int i32x8 __attribute__((ext_vector_type(8)));
typedef int i32x4 __attribute__((ext_vector_type(4)));
__device__ __forceinline__ i32x8 cat8(bf16x8 a, bf16x8 b) { const i32x4 x = __builtin_bit_cast(i32x4, a), y = __builtin_bit_cast(i32x4, b); return __builtin_shufflevector(x, y, 0, 1, 2, 3, 4, 5, 6, 7); }
__device__ __forceinline__ unsigned cvt_pk_bf16(float lo, float hi) { unsigned r; asm volatile("v_cvt_pk_bf16_f32 %0, %1, %2" : "=v"(r) : "v"(lo), "v"(hi)); return r; }

template <class Epi, class Sched, bool ALIGN_EPI, bool SP2, bool FP8 = false>
__device__ __forceinline__ void gemm_phase(PG8_LAS unsigned char* lds, const int tid, const int K, const Sched& S, const Epi& E) {
    const int wid = __builtin_amdgcn_readfirstlane(tid >> 6), lane = tid & 63, wr = wid >> 2, wc = wid & 3, fr = lane & 15, fq = lane >> 4;
    const int nt = FP8 ? K / 128 : K / BK;
    const int ES = FP8 ? 1 : 2;
    unsigned voffB[2]; int RA[2], CA[2];
#pragma unroll
    for (int i = 0; i < 2; ++i) { int R, C; stage_rc(tid * 16 + i * 8192, R, C); const int Rb = Epi::PERM ? ((R & ~31) + perm32(R & 31)) : R;
        voffB[i] = (unsigned)(Rb * K * ES + C * 2); RA[i] = R; CA[i] = C; }
    const size_t kstep = (size_t)(BK * 2);
    const size_t hstepB = (size_t)HALF * K * ES;
    const unsigned ldsw = (unsigned)wid * 1024u;
    const int aoff = lds_byte(wr * 64 + fr, fq * 8), boff = lds_byte(wc * 32 + fr, fq * 8);
#define PG8_SA(b, h) (((b) * 2 + (h)) * HTB)
#define PG8_SB(b, h) ((4 + (b) * 2 + (h)) * HTB)
#define PG8_STAGE(bufoff, gbase, voff) do { _Pragma("unroll") for (int _i = 0; _i < 2; ++_i) \
        __builtin_amdgcn_global_load_lds((const unsigned*)((const char*)(gbase) + (voff)[_i]), (PG8_LAS unsigned*)(lds + (bufoff) + ldsw + _i * 8192), 16, 0, 0); } while (0)
#define PG8_LDA(dst, b, h) do { _Pragma("unroll") for (int m = 0; m < 4; ++m) { if constexpr (FP8) { dst##8[m] = cat8(*(const PG8_LAS bf16x8*)(lds + PG8_SA(b, h) + aoff + m * 2048), *(const PG8_LAS bf16x8*)(lds + PG8_SA(b, h) + aoff + m * 2048 + 1024)); } \
        else { _Pragma("unroll") for (int k = 0; k < 2; ++k) dst[m][k] = *(const PG8_LAS bf16x8*)(lds + PG8_SA(b, h) + aoff + m * 2048 + k * 1024); } } } while (0)
#define PG8_LDB(dst, b, h) do { _Pragma("unroll") for (int n = 0; n < 2; ++n) { if constexpr (FP8) { dst##8[n] = cat8(*(const PG8_LAS bf16x8*)(lds + PG8_SB(b, h) + boff + n * 2048), *(const PG8_LAS bf16x8*)(lds + PG8_SB(b, h) + boff + n * 2048 + 1024)); } \
        else { _Pragma("unroll") for (int k = 0; k < 2; ++k) dst[n][k] = *(const PG8_LAS bf16x8*)(lds + PG8_SB(b, h) + boff + n * 2048 + k * 1024); } } } while (0)
#define PG8_MMA(ai, bj, At, Bt) do { __builtin_amdgcn_s_setprio(1); _Pragma("unroll") for (int m = 0; m < 4; ++m) _Pragma("unroll") for (int n = 0; n < 2; ++n) { \
        if constexpr (FP8) { asm volatile("v_mfma_scale_f32_16x16x128_f8f6f4 %0, %1, %2, %0, %3, %3 op_sel_hi:[0,0,0]" : "+v"(acc[ai][bj][m][n]) : "v"(Bt##8[n]), "v"(At##8[m]), "v"(one_scale));     } \
        else { _Pragma("unroll") for (int k = 0; k < 2; ++k) acc[ai][bj][m][n] = __builtin_amdgcn_mfma_f32_16x16x32_bf16(Bt[n][k], At[m][k], acc[ai][bj][m][n], 0, 0, 0); } } \
        __builtin_amdgcn_s_setprio(0); } while (0)
#define PG8_WAIT_V(n) asm volatile("s_waitcnt vmcnt(" #n ")" ::: "memory")
#define PG8_WAIT_L(n) asm volatile("s_waitcnt lgkmcnt(" #n ")" ::: "memory")
#define PG8_BAR __builtin_amdgcn_s_barrier()
#define PG8_SCHED __builtin_amdgcn_sched_barrier(0)
    Unit cur, nxt; int ui = 0;
    if (!S.next(0, cur)) return;
    bool has_next = S.next(1, nxt);
    unsigned offC[2][2], offN[2][2];
#pragma unroll
    for (int h = 0; h < 2; ++h)
#pragma unroll
        for (int i = 0; i < 2; ++i) {
            if constexpr (Sched::GATHER) { offC[h][i] = S.gather_off(cur, h * HALF + RA[i]) + (unsigned)CA[i] * 2u; offN[h][i] = has_next ? S.gather_off(nxt, h * HALF + RA[i]) + (unsigned)CA[i] * 2u : offC[h][i]; }
            else { offC[h][i] = (unsigned)((h * HALF + RA[i]) * S.lda * ES + CA[i] * 2); offN[h][i] = offC[h][i]; }
        }
    f32x4 acc[2][2][4][2];
#pragma unroll
    for (int a = 0; a < 2; ++a)
#pragma unroll
        for (int b = 0; b < 2; ++b)
#pragma unroll
            for (int m = 0; m < 4; ++m)
#pragma unroll
                for (int n = 0; n < 2; ++n) acc[a][b][m][n] = (f32x4){0.f, 0.f, 0.f, 0.f};
    int one_scale = 0x7f7f7f7f; asm volatile("" : "+v"(one_scale));
    bf16x8 At[4][2], B0[2][2], B1[2][2]; i32x8 At8[4], B08[2], B18[2]; (void)At; (void)B0; (void)B1; (void)At8; (void)B08; (void)B18;
    const char* cA = S.a_base(cur); const char* cB = S.b_base(cur);
    if constexpr (Sched::WAITS) S.a_ready(cur);
    if constexpr (SP2) {
        PG8_STAGE(PG8_SB(0, 0), cB, voffB); PG8_STAGE(PG8_SB(0, 1), cB + hstepB, voffB); PG8_STAGE(PG8_SA(0, 0), cA, offC[0]); PG8_STAGE(PG8_SA(0, 1), cA, offC[1]);
        if (wr == 1) PG8_BAR;
        PG8_WAIT_V(2); PG8_BAR;
        PG8_STAGE(PG8_SB(1, 0), cB + kstep, voffB); PG8_STAGE(PG8_SA(1, 0), cA + kstep, offC[0]); PG8_STAGE(PG8_SB(1, 1), cB + hstepB + kstep, voffB);
        PG8_WAIT_V(6); PG8_BAR;
    } else {
        PG8_STAGE(PG8_SB(0, 0), cB, voffB); PG8_STAGE(PG8_SA(0, 0), cA, offC[0]); PG8_STAGE(PG8_SB(0, 1), cB + hstepB, voffB); PG8_STAGE(PG8_SA(0, 1), cA, offC[1]);
        if (wr == 1) PG8_BAR;
        PG8_WAIT_V(4); PG8_BAR;
        PG8_STAGE(PG8_SB(1, 0), cB + kstep, voffB); PG8_STAGE(PG8_SA(1, 0), cA + kstep, offC[0]); PG8_STAGE(PG8_SB(1, 1), cB + hstepB + kstep, voffB);
        PG8_WAIT_V(6); PG8_BAR;
    }
    for (;;) {
        const char* nA = has_next ? S.a_base(nxt) : cA; const char* nB = has_next ? S.b_base(nxt) : cB;
        const bool full = !(Sched::HALF && __builtin_amdgcn_readfirstlane((int)S.half_only(cur)));
#pragma unroll 1
        for (int t = 0; t < nt; t += 2) {
            const bool last = (t == nt - 2);
            const char* a1 = cA + (size_t)(t + 1) * kstep;
            const char* a2 = last ? nA : cA + (size_t)(t + 2) * kstep; const char* b2 = last ? nB : cB + (size_t)(t + 2) * kstep;
            const char* a3 = a2 + kstep; const char* b3 = b2 + kstep;
            if constexpr (Sched::WAITS) { if (last && has_next) S.a_ready(nxt); }
            unsigned o2[2][2];
#pragma unroll
            for (int h = 0; h < 2; ++h)
#pragma unroll
                for (int i = 0; i < 2; ++i) o2[h][i] = (Sched::GATHER && last) ? offN[h][i] : offC[h][i];
            if constexpr (SP2) {
            PG8_LDB(B0, 0, 0); PG8_LDB(B1, 0, 1); PG8_SCHED; PG8_LDA(At, 0, 0); PG8_STAGE(PG8_SA(1, 1), a1, offC[1]);
            PG8_WAIT_V(8); PG8_WAIT_L(0); PG8_BAR; PG8_MMA(0, 0, At, B0); PG8_MMA(0, 1, At, B1); PG8_BAR; PG8_SCHED;
            PG8_LDA(At, 0, 1); PG8_STAGE(PG8_SB(0, 0), b2, voffB); PG8_STAGE(PG8_SB(0, 1), b2 + hstepB, voffB); PG8_STAGE(PG8_SA(0, 0), a2, o2[0]);
            PG8_WAIT_V(8); PG8_WAIT_L(0); PG8_BAR; if (full) { PG8_MMA(1, 0, At, B0); PG8_MMA(1, 1, At, B1); } PG8_BAR; PG8_SCHED;
            PG8_LDB(B0, 1, 0); PG8_LDB(B1, 1, 1); PG8_SCHED; PG8_LDA(At, 1, 0); PG8_STAGE(PG8_SA(0, 1), a2, o2[1]);
            PG8_WAIT_V(8); PG8_WAIT_L(0); PG8_BAR; PG8_MMA(0, 0, At, B0); PG8_MMA(0, 1, At, B1); PG8_BAR; PG8_SCHED;
            PG8_LDA(At, 1, 1); PG8_STAGE(PG8_SB(1, 0), b3, voffB); PG8_STAGE(PG8_SB(1, 1), b3 + hstepB, voffB); PG8_STAGE(PG8_SA(1, 0), a3, o2[0]);
            PG8_WAIT_V(8); PG8_WAIT_L(0); PG8_BAR; if (full) { PG8_MMA(1, 0, At, B0); PG8_MMA(1, 1, At, B1); } PG8_BAR; PG8_SCHED;
            } else {
            PG8_LDB(B0, 0, 0); PG8_SCHED; PG8_LDA(At, 0, 0); PG8_STAGE(PG8_SA(1, 1), a1, offC[1]);
            PG8_WAIT_L(8); PG8_BAR; PG8_WAIT_L(0); PG8_MMA(0, 0, At, B0); PG8_BAR; PG8_SCHED;
            PG8_LDB(B1, 0, 1); PG8_STAGE(PG8_SB(0, 0), b2, voffB);
            PG8_BAR; PG8_WAIT_L(0); PG8_MMA(0, 1, At, B1); PG8_BAR;
            PG8_LDA(At, 0, 1); PG8_STAGE(PG8_SA(0, 0), a2, o2[0]);
            PG8_BAR; PG8_WAIT_L(0); PG8_MMA(1, 0, At, B0); PG8_BAR; PG8_SCHED;
            PG8_STAGE(PG8_SB(0, 1), b2 + hstepB, voffB);
            PG8_WAIT_V(6); PG8_BAR; PG8_MMA(1, 1, At, B1); PG8_BAR;
            PG8_LDB(B0, 1, 0); PG8_SCHED; PG8_LDA(At, 1, 0); PG8_STAGE(PG8_SA(0, 1), a2, o2[1]);
            PG8_WAIT_L(8); PG8_BAR; PG8_WAIT_L(0); PG8_MMA(0, 0, At, B0); PG8_BAR; PG8_SCHED;
            PG8_LDB(B1, 1, 1); PG8_STAGE(PG8_SB(1, 0), b3, voffB);
            PG8_BAR; PG8_WAIT_L(0); PG8_MMA(0, 1, At, B1); PG8_BAR;
            PG8_LDA(At, 1, 1); PG8_STAGE(PG8_SA(1, 0), a3, o2[0]);
            PG8_BAR; PG8_WAIT_L(0); PG8_MMA(1, 0, At, B0); PG8_BAR; PG8_SCHED;
            PG8_STAGE(PG8_SB(1, 1), b3 + hstepB, voffB);
            PG8_WAIT_V(6); PG8_BAR; PG8_MMA(1, 1, At, B1); PG8_BAR;
            }
        }
        if constexpr (FP8) asm volatile("s_nop 15\n\ts_nop 7" ::: "memory");
        if constexpr (ALIGN_EPI) { if (wr == 0) PG8_BAR; }
        Unit nn; bool has_nn = false;
        if constexpr (Sched::GATHER) {
            has_nn = has_next && S.next(ui + 2, nn);
#pragma unroll
            for (int h = 0; h < 2; ++h)
#pragma unroll
                for (int i = 0; i < 2; ++i) { int R_, C_; stage_rc(tid * 16 + i * 8192, R_, C_); offC[h][i] = offN[h][i]; if (has_nn) offN[h][i] = S.gather_off(nn, h * HALF + R_) + (unsigned)C_ * 2u; }
        }
        E(acc, cur, wr, wc, fr, fq);
        if constexpr (Sched::PUBLISHES) S.done(cur);
        if (!has_next) break;
#pragma unroll
        for (int a = 0; a < 2; ++a)
#pragma unroll
            for (int b = 0; b < 2; ++b)
#pragma unroll
                for (int m = 0; m < 4; ++m)
#pragma unroll
                    for (int n = 0; n < 2; ++n) acc[a][b][m][n] = (f32x4){0.f, 0.f, 0.f, 0.f};
        cur = nxt; cA = nA; cB = nB; ++ui;
        if constexpr (Sched::GATHER) { has_next = has_nn; nxt = nn; }
        else { has_next = S.next(ui + 1, nxt); }
        if constexpr (ALIGN_EPI) { if (wr == 1) PG8_BAR; }
    }
    PG8_WAIT_V(0);
    if constexpr (!ALIGN_EPI) { if (wr == 0) PG8_BAR; }
    PG8_BAR;
#undef PG8_SA
#undef PG8_SB
#undef PG8_STAGE
#undef PG8_LDA
#undef PG8_LDB
#undef PG8_MMA
#undef PG8_WAIT_V
#undef PG8_WAIT_L
#undef PG8_BAR
#undef PG8_SCHED
}
}

namespace {
constexpr int NWAVES = 8;
constexpr int N_LAUNCHES = MK_N_LAUNCHES;
constexpr int D = 1024, BATCH = 8, SEQ = 2048, DEPTH = 2, T = BATCH * SEQ;
constexpr int W = 256, IN_COLS = 1792;
constexpr int NEXP = 32, DEXP = 512;
constexpr int CHUNK = 64, NCHUNK = SEQ / CHUNK;
constexpr int CAP = 16384;
constexpr int MAXBLK = 160;
constexpr float EPS = 1e-6f;
constexpr int PH_PER_LAYER = 9, N_PHASES = 1 + PH_PER_LAYER * DEPTH;

typedef unsigned short bf16_t;
typedef float f32x4 __attribute__((ext_vector_type(4)));
typedef unsigned v4u __attribute__((ext_vector_type(4)));
#define GAS __attribute__((address_space(1)))
#define LAS __attribute__((address_space(3)))
typedef GAS unsigned gu32;
#define RLX_AGENT __ATOMIC_RELAXED, __HIP_MEMORY_SCOPE_AGENT
#define LDS_WAIT() asm volatile("s_waitcnt lgkmcnt(0)" ::: "memory")

__device__ __forceinline__ float bf2f(bf16_t b) { return __uint_as_float(((unsigned)b) << 16); }
__device__ __forceinline__ unsigned f2bfu(float f) { unsigned u = __float_as_uint(f); return (u + 0x7fffu + ((u >> 16) & 1u)) >> 16; }
__device__ __forceinline__ bf16_t f2bf(float f) { return (bf16_t)f2bfu(f); }
__device__ __forceinline__ unsigned pk2(float lo, float hi) { return f2bfu(lo) | (f2bfu(hi) << 16); }
__device__ __forceinline__ float sigmoidf_(float x) { return 1.0f / (1.0f + __expf(-x)); }
__device__ __forceinline__ float gelu_tanh(float x) {
    const float z = 0.7978845608028654f * (x + 0.044715f * x * x * x);
    const float t = 1.0f - 2.0f / (__expf(2.0f * z) + 1.0f);
    return 0.5f * x * (1.0f + t);
}

constexpr size_t MiB = 1u << 20;
constexpr size_t WS_CTL = 0;
constexpr size_t WS_TAB = 1 * MiB;
constexpr size_t WS_H = 4 * MiB;
constexpr size_t WS_XN = 68 * MiB;
constexpr size_t WS_PROJ = 100 * MiB;
constexpr size_t WS_MERGED = WS_PROJ;
constexpr size_t WS_YS = 156 * MiB;
constexpr size_t WS_R1 = 188 * MiB;
constexpr size_t WS_HBUF = WS_R1;
constexpr size_t WS_YMOE = WS_R1 + 48 * MiB;
constexpr size_t WS_S5ST = 316 * MiB;
constexpr size_t WS_LRUA = 318 * MiB;
constexpr size_t WS_LRUH = 334 * MiB;
constexpr size_t WS_LRUS = 350 * MiB;
constexpr size_t WS_BUFTS = 351 * MiB;
constexpr size_t WS_BUFW = 353 * MiB;
constexpr size_t WS_WMIX = 356 * MiB;
constexpr size_t WMIX_IN = 0, WMIX_MG = (size_t)1792 * 1024 * 2, WMIX_BR = WMIX_MG + (size_t)4096 * 1024 * 2, WMIX_OUT = WMIX_BR + (size_t)4096 * 256 * 2, WMIX_STRIDE = 16 * MiB;
static_assert(WMIX_OUT + (size_t)1024 * 1024 * 2 <= WMIX_STRIDE, "mixer weights");
constexpr size_t WS_WEXP = 388 * MiB;
constexpr size_t WEXP_W2 = 32 * MiB, WEXP_LAYER = 48 * MiB;
constexpr float MG_SCALE = 32.0f;
constexpr float W13_SCALE = 32.0f, W2_SCALE = 16.0f, H_SCALE = 8.0f;
constexpr size_t WS_XN8 = 484 * MiB;
constexpr size_t WS_END = 500 * MiB;

constexpr int CW_CNT = 8192;
constexpr int CW_BAR = 4096;
constexpr int CW_TMO = 16;
constexpr int CW_RDY = 32768;

constexpr int TB_NLOG = 4096 + 32768, TB_RW = 4096 + 32768 + 256;
constexpr int SM_OFF = 512 * 1024;
constexpr int SM_POOLT = 0, SM_WAT = 32768, SM_WXT = 65536, SM_GLUT = 98304, SM_BRE = 229376, SM_BIM = 262144, SM_CMAT = 294912, SM_ATAB = 360448;


constexpr int RING_BYTES = 131072;
constexpr int LDSCTL_OFF = RING_BYTES, MISC_OFF = LDSCTL_OFF + 320;
constexpr int PLAN_OFF = MISC_OFF + 128;
constexpr int LDS_BYTES = 147456;
static_assert(PLAN_OFF + 4 * 360 <= LDS_BYTES, "LDS map");

#define XB_TMO      128
#define XB_XCNT(j)  (256  + 64 * (j))
#define XB_XSUB(j)  (1280 + 64 * (j))
#define XB_XGEN(j)  (2304 + 64 * (j))
#define XB_TOP      3328
#define XB_TOPGEN   3392
#define XCD_BAR_WORDS 3456
#define XB_SPIN_CAP (1u << 18)
__device__ __forceinline__ unsigned xb_ld(unsigned* p)              { return __hip_atomic_load(p, __ATOMIC_RELAXED, __HIP_MEMORY_SCOPE_AGENT); }
__device__ __forceinline__ unsigned xb_add(unsigned* p, unsigned v) { return __hip_atomic_fetch_add(p, v, __ATOMIC_RELAXED, __HIP_MEMORY_SCOPE_AGENT); }
__device__ __forceinline__ unsigned xb_xcc_id() { return (unsigned)__builtin_amdgcn_s_getreg((3 << 11) | 20) & 0xFu; }
#define XB_SPIN(cond, bar) do { unsigned _sp = 0; while (cond) { __builtin_amdgcn_s_sleep(1); \
    if ((++_sp & 255u) == 0u) { if (xb_ld(&(bar)[XB_TMO])) break; if (_sp > XB_SPIN_CAP) { atomicAdd(&(bar)[XB_TMO], 1u); break; } } } } while (0)
struct XcdBarrier { unsigned* bar; unsigned x; volatile LAS unsigned* st; };
__device__ __forceinline__ XcdBarrier xcd_barrier_post(unsigned* bar, volatile LAS unsigned* st) {
    XcdBarrier b; b.bar = bar; b.x = xb_xcc_id(); b.st = st;
    if (threadIdx.x == 0) (void)xb_add(&bar[XB_XCNT(b.x)], 1u);
    return b;
}
__device__ __forceinline__ void xcd_barrier_complete(unsigned* bar, unsigned x, unsigned& nloc, unsigned& nx) {
    const unsigned G = gridDim.x * gridDim.y * gridDim.z;
    unsigned sum, cnt, mine, sp = 0u;
    for (;;) {
        sum = 0u; cnt = 0u; mine = 0u;
#pragma unroll
        for (unsigned j = 0; j < 16; ++j) { const unsigned c = xb_ld(&bar[XB_XCNT(j)]); sum += c; cnt += (c > 0u) ? 1u : 0u; mine = (j == x) ? c : mine; }
        if (sum == G) break;
        __builtin_amdgcn_s_sleep(1);
        if ((++sp & 255u) == 0u) { if (xb_ld(&bar[XB_TMO])) break; if (sp > XB_SPIN_CAP) { atomicAdd(&bar[XB_TMO], 1u); break; } }
    }
    nloc = mine > 0u ? mine : 1u; nx = cnt > 0u ? cnt : 1u;
}
__device__ __forceinline__ void xcd_barrier(const XcdBarrier& b) {
    asm volatile("s_waitcnt vmcnt(0)" ::: "memory");
    __syncthreads();
    if (threadIdx.x == 0) {
        unsigned* bar = b.bar;
        __builtin_amdgcn_s_waitcnt(0);
        unsigned nloc = b.st[0], nx = b.st[1];
        if (nloc == 0u) { xcd_barrier_complete(bar, b.x, nloc, nx); b.st[0] = nloc; b.st[1] = nx; }
        const unsigned old = xb_add(&bar[XB_XSUB(b.x)], 1u);
        const unsigned gen = old / nloc;
        if (old + 1u == (gen + 1u) * nloc) {
            __builtin_amdgcn_fence(__ATOMIC_RELEASE, "agent");
            asm volatile("s_waitcnt vmcnt(0)" ::: "memory");
            const unsigned og = xb_add(&bar[XB_TOP], 1u);
            const unsigned tg = og / nx;
            if (og + 1u == (tg + 1u) * nx) xb_add(&bar[XB_TOPGEN], 1u);
            else XB_SPIN(xb_ld(&bar[XB_TOPGEN]) == tg, bar);
            __builtin_amdgcn_fence(__ATOMIC_ACQUIRE, "agent");
            xb_add(&bar[XB_XGEN(b.x)], 1u);
            asm volatile("s_waitcnt vmcnt(0)" ::: "memory");
        } else {
            XB_SPIN(xb_ld(&bar[XB_XGEN(b.x)]) == gen, bar);
            __builtin_amdgcn_fence(__ATOMIC_ACQUIRE, "agent");
            asm volatile("s_waitcnt vmcnt(0)" ::: "memory");
        }
    }
    __syncthreads();
}

#ifdef PROBE_A
#define STAMP(id) do { if (threadIdx.x == 0) ((unsigned long long*)(g_dbg))[(size_t)blockIdx.x * 64 + (id)] = __builtin_amdgcn_s_memrealtime(); } while (0)
#else
#define STAMP(id) do { } while (0)
#endif
#define g_dbg (F.ws + WS_END)

struct Args { const float* in[37]; float* out; unsigned char* ws; int ph_lo, ph_hi; int flags, pad; };

struct Frame {
    LAS unsigned char* lds;
    unsigned char* smem;
    volatile LAS unsigned* MISC;
    unsigned* ctl;
    int tid, lane, wave, vcu, G;
    unsigned char* ws;
};

struct MapNat { int off; __device__ __forceinline__ int operator()(int n) const { return off + n; } };
struct MapGate { __device__ __forceinline__ int operator()(int s) const {
    const int k4 = s >> 10, d = s & 1023, pn = d >> 6, dd = d & 63;
    return pn * 256 + 128 * (k4 >> 1) + 32 * (dd >> 4) + 16 * (k4 & 1) + 4 * ((dd >> 2) & 3) + (dd & 3); } };
struct MapMoe13 { int which; __device__ __forceinline__ int operator()(int hid) const {
    const int pn = hid >> 7, r = hid & 127;
    return pn * 256 + 128 * (r >> 6) + 32 * ((r >> 4) & 3) + 16 * which + 4 * ((r >> 2) & 3) + (r & 3); } };

template <class RowMap>
__device__ __forceinline__ void transpose_item(const float* W, int K, int N, bf16_t* WT, LAS float* scr, int item, int lane, const RowMap rm) {
    const int nblk = N / 32, kb = item / nblk, nb = item % nblk, k0 = 64 * kb, n0 = 32 * nb;
#pragma unroll 8
    for (int i = 0; i < 32; ++i) { const int kk = 2 * i + (lane >> 5); scr[kk * 33 + (lane & 31)] = W[(size_t)(k0 + kk) * N + n0 + (lane & 31)]; }
    LDS_WAIT(); asm volatile("" ::: "memory");
    const int c = lane & 7;
#pragma unroll
    for (int j = 0; j < 4; ++j) { const int n = (lane >> 3) + 8 * j; const LAS float* s = scr + (8 * c) * 33 + n;
        v4u o; o.x = pk2(s[0 * 33], s[1 * 33]); o.y = pk2(s[2 * 33], s[3 * 33]); o.z = pk2(s[4 * 33], s[5 * 33]); o.w = pk2(s[6 * 33], s[7 * 33]);
        *(GAS v4u*)(WT + (size_t)rm(n0 + n) * K + k0 + 8 * c) = o; }
    LDS_WAIT(); asm volatile("" ::: "memory");
}

__device__ __forceinline__ unsigned pk4_fp8(float a, float b, float c, float d) { int w = 0; w = __builtin_amdgcn_cvt_pk_fp8_f32(a, b, w, false); w = __builtin_amdgcn_cvt_pk_fp8_f32(c, d, w, true); return (unsigned)w; }
template <class RowMap>
__device__ __forceinline__ void transpose_item_fp8(const float* W, int K, int N, unsigned char* WT, LAS unsigned char* scr, int item, int lane, const RowMap rm, const float scl) {
    const int nblk = N / 32, kb = item / nblk, nb = item % nblk, k0 = 128 * kb, n0 = 32 * nb;
#pragma unroll 16
    for (int i = 0; i < 64; ++i) { const int kk = 2 * i + (lane >> 5); const float v = W[(size_t)(k0 + kk) * N + n0 + (lane & 31)] * scl;
        scr[(lane & 31) * 144 + kk] = (unsigned char)__builtin_amdgcn_cvt_pk_fp8_f32(v, 0.f, 0, false); }
    LDS_WAIT(); asm volatile("" ::: "memory");
    const int c = lane & 7;
#pragma unroll
    for (int j = 0; j < 4; ++j) { const int n = (lane >> 3) + 8 * j;
        *(GAS v4u*)(WT + (size_t)rm(n0 + n) * K + k0 + 16 * c) = *(const LAS v4u*)(scr + n * 144 + 16 * c); }
    LDS_WAIT(); asm volatile("" ::: "memory");
}

__device__ __forceinline__ void conv_mixer_weights(Frame& F, const Args& a) {
    LAS float* scr = (LAS float*)(F.lds + F.wave * 16384);
    const int gw = F.vcu * NWAVES + F.wave, NGW = F.G * NWAVES;
    constexpr int I_IN = 16 * 56, I_MG = 8 * 128, I_BR = 4 * 32, I_OUT = 16 * 32, PER_L = I_IN + I_MG + 4 * I_BR + I_OUT;
    for (int it = gw; it < DEPTH * PER_L; it += NGW) {
        const int l = it / PER_L; int r = it % PER_L;
        unsigned char* wb = F.ws + WS_WMIX + (size_t)l * WMIX_STRIDE;
        if (r < I_IN) { transpose_item(a.in[2] + (size_t)l * D * IN_COLS, D, IN_COLS, (bf16_t*)(wb + WMIX_IN), scr, r, F.lane, MapNat{0}); continue; } r -= I_IN;
        if (r < I_MG) { transpose_item_fp8(a.in[24] + (size_t)l * D * 4096, D, 4096, wb + WMIX_MG, (LAS unsigned char*)scr, r, F.lane, MapGate{}, MG_SCALE); continue; } r -= I_MG;
        if (r < 4 * I_BR) { const int k4 = r / I_BR; transpose_item(a.in[26] + ((size_t)l * 4 + k4) * W * D, W, D, (bf16_t*)(wb + WMIX_BR), scr, r % I_BR, F.lane, MapNat{k4 * 1024}); continue; } r -= 4 * I_BR;
        transpose_item(a.in[27] + (size_t)l * D * D, D, D, (bf16_t*)(wb + WMIX_OUT), scr, r, F.lane, MapNat{0});
    }
}
constexpr int CONV_I13 = 8 * 16, CONV_I2 = 4 * 32, CONV_PER_E = 2 * CONV_I13 + CONV_I2, CONV_ITEMS = NEXP * CONV_PER_E;
constexpr int CONV_NA = 64 * NWAVES * 4, CONV_NB = 128 * NWAVES * 3;
__device__ __forceinline__ void conv_expert_item(Frame& F, const Args& a, int l, int it) {
    LAS unsigned char* scr = F.lds + F.wave * 16384;
    const int e = it / CONV_PER_E; int r = it % CONV_PER_E;
    unsigned char* w13 = F.ws + WS_WEXP + (size_t)l * WEXP_LAYER + (size_t)e * 1024 * 1024;
    unsigned char* w2t = F.ws + WS_WEXP + (size_t)l * WEXP_LAYER + WEXP_W2 + (size_t)e * 1024 * 512;
    if (r < CONV_I13) { transpose_item_fp8(a.in[33] + ((size_t)l * NEXP + e) * D * DEXP, D, DEXP, w13, scr, r, F.lane, MapMoe13{0}, W13_SCALE); return; } r -= CONV_I13;
    if (r < CONV_I13) { transpose_item_fp8(a.in[34] + ((size_t)l * NEXP + e) * D * DEXP, D, DEXP, w13, scr, r, F.lane, MapMoe13{1}, W13_SCALE); return; } r -= CONV_I13;
    transpose_item_fp8(a.in[35] + ((size_t)l * NEXP + e) * DEXP * D, DEXP, D, w2t, scr, r, F.lane, MapNat{0}, W2_SCALE);
}
__device__ __forceinline__ void conv_expert_weights(Frame& F, const Args& a, int l, int first) {
    const int gw = F.vcu * NWAVES + F.wave, NGW = F.G * NWAVES;
    for (int it = first + gw; it < CONV_ITEMS; it += NGW) conv_expert_item(F, a, l, it);
}
__device__ __forceinline__ void conv_expert_quota(Frame& F, const Args& a, int l, int first, int slot, int n) {
    for (int i = 0; i < n; ++i) conv_expert_item(F, a, l, first + slot * n + i);
}

__device__ __forceinline__ void prep_tables(Frame& F, const Args& a) {
    for (int idx = F.vcu * 512 + F.tid; idx < DEPTH * 65536; idx += F.G * 512) {
        const int l = idx >> 16, gid = idx & 65535;
        float* tab = (float*)(F.ws + WS_TAB + (size_t)l * MiB);
        unsigned char* sm = F.ws + WS_TAB + (size_t)l * MiB + SM_OFF;
        if (gid < 1024) {
            const int g = gid >> 6;
            const double lre = fmin((double)a.in[7][l * 1024 + gid], -1e-4);
            const double lim = (double)a.in[8][l * 1024 + gid];
            const double step = exp((double)a.in[9][l * 16 + g]);
            const double er = exp(lre * step), ar = er * cos(lim * step), ai = er * sin(lim * step);
            const double nr = ar - 1.0, ni = ai, den = lre * lre + lim * lim;
            const double cr = (nr * lre + ni * lim) / den, ci = (ni * lre - nr * lim) / den;
            float* at = (float*)(sm + SM_ATAB) + gid * 12;
            const double pw[5] = {1.0, 4.0, 8.0, 12.0, 64.0};
            for (int i = 0; i < 5; ++i) { const double e = exp(lre * step * pw[i]); at[2 * i] = (float)(e * cos(lim * step * pw[i])); at[2 * i + 1] = (float)(e * sin(lim * step * pw[i])); }
            at[10] = 0.f; at[11] = 0.f;
            for (int h = 0; h < 16; ++h) {
                const double br = (double)a.in[10][((size_t)l * 1024 + gid) * 16 + h], bi = (double)a.in[11][((size_t)l * 1024 + gid) * 16 + h];
                ((bf16_t*)(sm + SM_BRE))[gid * 16 + h] = f2bf((float)(cr * br - ci * bi));
                ((bf16_t*)(sm + SM_BIM))[gid * 16 + h] = f2bf((float)(cr * bi + ci * br));
            }
        }
        if (gid < 256) { const double lam = (double)a.in[23][l * 256 + gid]; tab[TB_NLOG + gid] = (float)(-8.0 * log1p(exp(-lam))); }
        if (gid < 49152) { const int o = gid >> 10, k = gid & 1023; const float gk = a.in[28][(size_t)l * 1024 + k];
            const float w = (o < 4) ? gk * a.in[29][((size_t)l * 1024 + k) * 4 + o] : (o < 36 ? gk * a.in[31][((size_t)l * 1024 + k) * 32 + (o - 4)] : 0.f);
            const bf16_t wh = f2bf(w); ((bf16_t*)(tab + TB_RW))[gid] = wh; ((bf16_t*)(tab + TB_RW))[49152 + gid] = f2bf(w - bf2f(wh)); }
        if (gid < 16384) { const int g = gid >> 12, d = (gid >> 6) & 63, cc = gid & 63; const size_t si = ((size_t)(l * 4 + g) * 64 + cc) * 64 + d;
            ((bf16_t*)(sm + SM_POOLT))[gid] = f2bf(a.in[4][si]); ((bf16_t*)(sm + SM_WAT))[gid] = f2bf(a.in[19][si]); ((bf16_t*)(sm + SM_WXT))[gid] = f2bf(a.in[21][si]); }
        if (gid < 32768) { const int g = gid >> 11, cc = (gid >> 7) & 15, k = gid & 127, p = k >> 1; const size_t si = ((size_t)(l * 16 + g) * 16 + cc) * 64 + p;
            ((bf16_t*)(sm + SM_CMAT))[gid] = f2bf((k & 1) ? -a.in[13][si] : a.in[12][si]); }
        { const int col = gid >> 8, k = gid & 255; ((bf16_t*)(sm + SM_GLUT))[gid] = f2bf(a.in[15][((size_t)l * 256 + k) * 256 + col]); }
    }
}

__device__ __forceinline__ void norm_phase(Frame& F, const float* hin, const bf16_t* y, const float* g, float* hout, bf16_t* xn, float* out, const float oadd = 0.0f, unsigned char* xn8 = nullptr) {
    const int gw = F.vcu * NWAVES + F.wave, NGW = F.G * NWAVES, lane = F.lane;
    f32x4 gg[4];
#pragma unroll
    for (int j = 0; j < 4; ++j) gg[j] = *(const f32x4*)(g + 4 * lane + 256 * j);
    for (int m0 = gw; m0 < T; m0 += 4 * NGW) {
        f32x4 v[4][4]; uint2 ya[4][4], yb[4][4];
#pragma unroll
        for (int i = 0; i < 4; ++i) {
            const int m = m0 + i * NGW;
            if (m < T) {
#pragma unroll
                for (int j = 0; j < 4; ++j) {
                    const int col = 4 * lane + 256 * j;
                    v[i][j] = *(const f32x4*)(hin + (size_t)m * D + col);
                    if (y) { ya[i][j] = *(const uint2*)(y + ((size_t)m * 2 + 0) * D + col); yb[i][j] = *(const uint2*)(y + ((size_t)m * 2 + 1) * D + col); }
                }
            }
        }
            __builtin_amdgcn_sched_barrier(0);
#pragma unroll
        for (int i = 0; i < 4; ++i) {
            const int m = m0 + i * NGW;
            if (m < T) {
                float s = 0.f;
#pragma unroll
                for (int j = 0; j < 4; ++j) {
                    if (y) {
                        v[i][j].x += __uint_as_float(ya[i][j].x << 16) + __uint_as_float(yb[i][j].x << 16);
                        v[i][j].y += __uint_as_float(ya[i][j].x & 0xffff0000u) + __uint_as_float(yb[i][j].x & 0xffff0000u);
                        v[i][j].z += __uint_as_float(ya[i][j].y << 16) + __uint_as_float(yb[i][j].y << 16);
                        v[i][j].w += __uint_as_float(ya[i][j].y & 0xffff0000u) + __uint_as_float(yb[i][j].y & 0xffff0000u);
                    }
                    s += v[i][j].x * v[i][j].x + v[i][j].y * v[i][j].y + v[i][j].z * v[i][j].z + v[i][j].w * v[i][j].w;
                }
#pragma unroll
                for (int o = 1; o < 64; o <<= 1) s += __shfl_xor(s, o);
                const float rstd = rsqrtf(s * (1.0f / D) + EPS);
#pragma unroll
                for (int j = 0; j < 4; ++j) {
                    const int col = 4 * lane + 256 * j;
                    if (hout) *(f32x4*)(hout + (size_t)m * D + col) = v[i][j];
                    const f32x4 o = v[i][j] * rstd * gg[j];
                    if (xn) { uint2 w; w.x = pk2(o.x, o.y); w.y = pk2(o.z, o.w); *(uint2*)(xn + (size_t)m * D + col) = w; }
                    if (xn8) *(unsigned*)(xn8 + (size_t)m * D + col) = pk4_fp8(o.x, o.y, o.z, o.w);
                    if (out) { f32x4 oo = o; if (m == 0 && col == 0) oo.x += oadd; *(f32x4*)(out + (size_t)m * D + col) = oo; }
                }
            }
        }
    }
}

constexpr int TROW = 528;
constexpr int TILE_BYTES = 64 * TROW;
constexpr int HROW = 272, HTILE = 16 * HROW;
constexpr int CARRY_OFF = 2 * TILE_BYTES + 8 * HTILE;

struct MixArgs {
    const bf16_t* proj; bf16_t* ys; const float* tab; const unsigned char* sm; unsigned char* ws;
    float2* s5st; float2* lruS; unsigned* lrup;
    const float *conv_a_w, *pool_b, *pool_scale, *s5_d, *glu_b, *lconv_w, *lconv_b, *ba, *bx;
};

typedef short bf16x8 __attribute__((ext_vector_type(8)));
__device__ __forceinline__ f32x4 mma16(bf16x8 a, bf16x8 b, f32x4 c) { return __builtin_amdgcn_mfma_f32_16x16x32_bf16(a, b, c, 0, 0, 0); }
__device__ __forceinline__ void ld8(const bf16_t* p, float (&x)[8]) {
    const v4u v = *(const v4u*)p;
    x[0] = __uint_as_float(v.x << 16); x[1] = __uint_as_float(v.x & 0xffff0000u); x[2] = __uint_as_float(v.y << 16); x[3] = __uint_as_float(v.y & 0xffff0000u);
    x[4] = __uint_as_float(v.z << 16); x[5] = __uint_as_float(v.z & 0xffff0000u); x[6] = __uint_as_float(v.w << 16); x[7] = __uint_as_float(v.w & 0xffff0000u);
}
__device__ __forceinline__ void ldf8(const float* p, float (&x)[8]) { const f32x4 a = *(const f32x4*)p, b = *(const f32x4*)(p + 4); x[0] = a.x; x[1] = a.y; x[2] = a.z; x[3] = a.w; x[4] = b.x; x[5] = b.y; x[6] = b.z; x[7] = b.w; }
typedef unsigned v2u __attribute__((ext_vector_type(2)));
__device__ __forceinline__ v4u pack8(const float (&x)[8]) { v4u o; o.x = pk2(x[0], x[1]); o.y = pk2(x[2], x[3]); o.z = pk2(x[4], x[5]); o.w = pk2(x[6], x[7]); return o; }
template <int N> __device__ __forceinline__ float dpp_row_shr(float oldv, float src) {
    return __int_as_float(__builtin_amdgcn_update_dpp(__float_as_int(oldv), __float_as_int(src), 0x110 + N, 0xf, 0xf, false));
}

template <int PH>
__device__ __forceinline__ void mix_unit(const MixArgs& A, LAS unsigned char* lds, int unit, int tid) {
    const int lane = tid & 63, wave = __builtin_amdgcn_readfirstlane(tid >> 6), j = lane & 15, q = lane >> 4;
    const int b = unit >> 5, c = unit & 31;
    const size_t t0 = (size_t)b * SEQ + c * CHUNK;
    LAS unsigned char* T0 = lds; LAS unsigned char* T1 = lds + TILE_BYTES; LAS unsigned char* Hw = lds + 2 * TILE_BYTES + wave * HTILE;
    const int cg = tid & 31, tg = tid >> 5, tl0 = tg * 4, pos0 = c * CHUNK + tl0;
    const bf16_t* prow = A.proj + (t0 + tl0) * IN_COLS + cg * 8;
    const unsigned char* sm = A.sm;
    const struct { unsigned char* ws; } F = {A.ws}; (void)F;
    typedef float f32x2_ __attribute__((ext_vector_type(2)));
    LAS f32x2_* cS5 = (LAS f32x2_*)(lds + CARRY_OFF);
    LAS float* cLru = (LAS float*)(lds + CARRY_OFF + 8192);
    if (PH == 2) {
#pragma unroll
        for (int s2 = 0; s2 < 2; ++s2) {
            const int si = tid + 512 * s2;
            const float a64r = ((const float*)(sm + SM_ATAB))[si * 12 + 8], a64i = ((const float*)(sm + SM_ATAB))[si * 12 + 9];
            float hr_ = 0.f, hi_ = 0.f;
            for (int j0 = 0; j0 < c; j0 += 8) {
                float2 sv[8];
#pragma unroll
                for (int u = 0; u < 8; ++u) { const int jj = (j0 + u < c) ? j0 + u : c - 1; sv[u] = A.s5st[((size_t)b * NCHUNK + jj) * 1024 + si]; }
#pragma unroll
                for (int u = 0; u < 8; ++u) if (j0 + u < c) { const float nr = a64r * hr_ - a64i * hi_ + sv[u].x, ni = a64r * hi_ + a64i * hr_ + sv[u].y; hr_ = nr; hi_ = ni; }
            }
            cS5[si] = (f32x2_){hr_, hi_};
        }
        if (tid < 256) {
            float hin_ = 0.f;
            for (int j0 = 0; j0 < c; j0 += 8) {
                float2 sv[8];
#pragma unroll
                for (int u = 0; u < 8; ++u) { const int jj = (j0 + u < c) ? j0 + u : c - 1; sv[u] = A.lruS[((size_t)b * NCHUNK + jj) * 256 + tid]; }
#pragma unroll
                for (int u = 0; u < 8; ++u) if (j0 + u < c) hin_ = sv[u].x * hin_ + sv[u].y;
            }
            cLru[tid] = hin_;
        }
    }

    if (PH == 2) STAMP(52);
    if (PH == 2) {
        float w0[8], w1[8], w2[8];
        ldf8(A.conv_a_w + 0 * 256 + cg * 8, w0); ldf8(A.conv_a_w + 1 * 256 + cg * 8, w1); ldf8(A.conv_a_w + 2 * 256 + cg * 8, w2);
        float v[6][8];
#pragma unroll
        for (int i = 0; i < 6; ++i) {
            if (pos0 - 2 + i >= 0) { float ac[8], ax[8]; ld8(prow + (long)(i - 2) * IN_COLS + 256, ac); ld8(prow + (long)(i - 2) * IN_COLS + 512, ax);
#pragma unroll
                for (int e = 0; e < 8; ++e) v[i][e] = ac[e] * ax[e]; }
            else {
#pragma unroll
                for (int e = 0; e < 8; ++e) v[i][e] = 0.f; }
        }
#pragma unroll
        for (int n = 0; n < 4; ++n) {
            float ab[8], o[8]; ld8(prow + (long)n * IN_COLS, ab);
#pragma unroll
            for (int e = 0; e < 8; ++e) o[e] = ab[e] * (w0[e] * v[n][e] + w1[e] * v[n + 1][e] + w2[e] * v[n + 2][e]);
            *(v4u*)(A.ys + (t0 + tl0 + n) * 1024 + cg * 8) = pack8(o);
        }
    }
    if (PH == 2) {
        const int win = 2 << (cg >> 3);
        float S[8], x0[8];
#pragma unroll
        for (int e = 0; e < 8; ++e) S[e] = 0.f;
        ld8(prow + 768, x0);
#pragma unroll
        for (int e = 0; e < 8; ++e) S[e] = x0[e];
        for (int i = 1; i < win; ++i) if (pos0 - i >= 0) { float x[8]; ld8(prow - (long)i * IN_COLS + 768, x);
#pragma unroll
            for (int e = 0; e < 8; ++e) S[e] += x[e]; }
        {
            const int cnt = (pos0 + 1 < win) ? pos0 + 1 : win; const float inv = 1.0f / (float)cnt; float o[8];
#pragma unroll
            for (int e = 0; e < 8; ++e) o[e] = S[e] * inv - x0[e];
            *(LAS v4u*)(T0 + tl0 * TROW + cg * 16) = pack8(o);
        }
#pragma unroll 1
        for (int n = 1; n < 4; ++n) {
            float xn_[8]; ld8(prow + (long)n * IN_COLS + 768, xn_);
#pragma unroll
            for (int e = 0; e < 8; ++e) S[e] += xn_[e];
            if (pos0 + n - win >= 0) { float xo[8]; ld8(prow + (long)(n - win) * IN_COLS + 768, xo);
#pragma unroll
                for (int e = 0; e < 8; ++e) S[e] -= xo[e]; }
            const int cnt = (pos0 + n + 1 < win) ? pos0 + n + 1 : win; const float inv = 1.0f / (float)cnt; float o[8];
#pragma unroll
            for (int e = 0; e < 8; ++e) o[e] = S[e] * inv - xn_[e];
            *(LAS v4u*)(T0 + (tl0 + n) * TROW + cg * 16) = pack8(o);
        }
    }
    if (PH == 1) {
        float w0[8], w1[8], w2[8], w3[8], cb[8];
        ldf8(A.lconv_w + 0 * 256 + cg * 8, w0); ldf8(A.lconv_w + 1 * 256 + cg * 8, w1); ldf8(A.lconv_w + 2 * 256 + cg * 8, w2); ldf8(A.lconv_w + 3 * 256 + cg * 8, w3); ldf8(A.lconv_b + cg * 8, cb);
        float x[7][8];
#pragma unroll
        for (int i = 0; i < 7; ++i) {
            if (pos0 - 3 + i >= 0) ld8(prow + (long)(i - 3) * IN_COLS + 1280, x[i]);
            else {
#pragma unroll
                for (int e = 0; e < 8; ++e) x[i][e] = 0.f; }
        }
#pragma unroll
        for (int n = 0; n < 4; ++n) {
            float o[8];
#pragma unroll
            for (int e = 0; e < 8; ++e) o[e] = w0[e] * x[n][e] + w1[e] * x[n + 1][e] + w2[e] * x[n + 2][e] + w3[e] * x[n + 3][e] + cb[e];
            *(LAS v4u*)(T1 + (tl0 + n) * TROW + cg * 16) = pack8(o);
        }
    }
    __syncthreads();
    if (PH == 2) STAMP(53);

    const int hd = wave >> 1, dt0 = 2 * (wave & 1);
    if (PH == 2) {
        const bf16_t* WT = (const bf16_t*)(sm + SM_POOLT) + hd * 4096;
        f32x4 acc[2][4];
#pragma unroll
        for (int d = 0; d < 2; ++d)
#pragma unroll
            for (int tt = 0; tt < 4; ++tt) acc[d][tt] = (f32x4){0.f, 0.f, 0.f, 0.f};
#pragma unroll
        for (int ks = 0; ks < 2; ++ks) {
            bf16x8 wf[2];
#pragma unroll
            for (int d = 0; d < 2; ++d) wf[d] = *(const bf16x8*)(WT + ((dt0 + d) * 16 + j) * 64 + ks * 32 + 8 * q);
#pragma unroll
            for (int tt = 0; tt < 4; ++tt) { const bf16x8 xf = *(const LAS bf16x8*)(T0 + (tt * 16 + j) * TROW + (hd * 64 + ks * 32 + 8 * q) * 2);
#pragma unroll
                for (int d = 0; d < 2; ++d) acc[d][tt] = mma16(wf[d], xf, acc[d][tt]); }
        }
#pragma unroll
        for (int d = 0; d < 2; ++d) {
            const int ch0 = hd * 64 + (dt0 + d) * 16 + 4 * q;
            const f32x4 pb = *(const f32x4*)(A.pool_b + ch0), ps = *(const f32x4*)(A.pool_scale + ch0);
#pragma unroll
            for (int tt = 0; tt < 4; ++tt) { const f32x4 o = (acc[d][tt] + pb) * ps; v2u w; w.x = pk2(o.x, o.y); w.y = pk2(o.z, o.w);
                *(v2u*)(A.ys + (t0 + tt * 16 + j) * 1024 + 256 + ch0) = w; }
        }
    }
    if (PH == 2) STAMP(54);
    if (PH == 1) {
        const bf16_t* WA = (const bf16_t*)(sm + SM_WAT) + hd * 4096; const bf16_t* WX = (const bf16_t*)(sm + SM_WXT) + hd * 4096;
        f32x4 ga[2][4], gx[2][4];
#pragma unroll
        for (int d = 0; d < 2; ++d)
#pragma unroll
            for (int tt = 0; tt < 4; ++tt) { ga[d][tt] = (f32x4){0.f, 0.f, 0.f, 0.f}; gx[d][tt] = (f32x4){0.f, 0.f, 0.f, 0.f}; }
#pragma unroll
        for (int ks = 0; ks < 2; ++ks) {
            bf16x8 wa[2], wx[2];
#pragma unroll
            for (int d = 0; d < 2; ++d) { wa[d] = *(const bf16x8*)(WA + ((dt0 + d) * 16 + j) * 64 + ks * 32 + 8 * q); wx[d] = *(const bf16x8*)(WX + ((dt0 + d) * 16 + j) * 64 + ks * 32 + 8 * q); }
#pragma unroll
            for (int tt = 0; tt < 4; ++tt) { const bf16x8 xf = *(const LAS bf16x8*)(T1 + (tt * 16 + j) * TROW + (hd * 64 + ks * 32 + 8 * q) * 2);
#pragma unroll
                for (int d = 0; d < 2; ++d) { ga[d][tt] = mma16(wa[d], xf, ga[d][tt]); gx[d][tt] = mma16(wx[d], xf, gx[d][tt]); } }
        }
#pragma unroll
        for (int d = 0; d < 2; ++d) {
            const int ch0 = hd * 64 + (dt0 + d) * 16 + 4 * q;
            const f32x4 bav = *(const f32x4*)(A.ba + ch0), bxv = *(const f32x4*)(A.bx + ch0), nlg = *(const f32x4*)(A.tab + TB_NLOG + ch0);
            float hin[4] = {0.f, 0.f, 0.f, 0.f}, aprod[4] = {1.f, 1.f, 1.f, 1.f};
#pragma unroll
            for (int tt = 0; tt < 4; ++tt) {
                const v2u xcw = *(const LAS v2u*)(T1 + (tt * 16 + j) * TROW + ch0 * 2);
                const float xc[4] = {__uint_as_float(xcw.x << 16), __uint_as_float(xcw.x & 0xffff0000u), __uint_as_float(xcw.y << 16), __uint_as_float(xcw.y & 0xffff0000u)};
                v4u pk;
#pragma unroll
                for (int r = 0; r < 4; ++r) {
                    const float rg = sigmoidf_(ga[d][tt][r] + bav[r]), ig = sigmoidf_(gx[d][tt][r] + bxv[r]);
                    const float la = nlg[r] * rg; float av = __expf(la); const float mult = sqrtf(fmaxf(1.0f - av * av, 0.f));
                    float bv = mult * ig * xc[r];
                    { const float ap = dpp_row_shr<1>(1.f, av), bp = dpp_row_shr<1>(0.f, bv); bv = av * bp + bv; av = av * ap; }
                    { const float ap = dpp_row_shr<2>(1.f, av), bp = dpp_row_shr<2>(0.f, bv); bv = av * bp + bv; av = av * ap; }
                    { const float ap = dpp_row_shr<4>(1.f, av), bp = dpp_row_shr<4>(0.f, bv); bv = av * bp + bv; av = av * ap; }
                    { const float ap = dpp_row_shr<8>(1.f, av), bp = dpp_row_shr<8>(0.f, bv); bv = av * bp + bv; av = av * ap; }
                    const float h = bv + av * hin[r], ac = av * aprod[r];
                    pk[r] = pk2(h, ac);
                    hin[r] = __shfl(h, (lane & 48) | 15); aprod[r] = __shfl(ac, (lane & 48) | 15);
                }
                *(v4u*)(A.lrup + (t0 + tt * 16 + j) * 256 + ch0) = pk;
            }
            if (j == 15) {
                float2* sp = A.lruS + ((size_t)b * NCHUNK + c) * 256 + ch0;
#pragma unroll
                for (int r = 0; r < 4; ++r) sp[r] = make_float2(aprod[r], hin[r]);
            }
        }
    }
    if (PH == 2) {
#pragma unroll
        for (int d = 0; d < 2; ++d) {
            const int ch0 = hd * 64 + (dt0 + d) * 16 + 4 * q;
            float hin[4];
#pragma unroll
            for (int r = 0; r < 4; ++r) hin[r] = cLru[ch0 + r];
            v4u pk[4]; v2u gw[4];
#pragma unroll
            for (int tt = 0; tt < 4; ++tt) { pk[tt] = *(const v4u*)(A.lrup + (t0 + tt * 16 + j) * 256 + ch0); gw[tt] = *(const v2u*)(A.proj + (t0 + tt * 16 + j) * IN_COLS + 1536 + ch0); }
#pragma unroll
            for (int tt = 0; tt < 4; ++tt) {
                const float g0 = gelu_tanh(__uint_as_float(gw[tt].x << 16)), g1 = gelu_tanh(__uint_as_float(gw[tt].x & 0xffff0000u)), g2 = gelu_tanh(__uint_as_float(gw[tt].y << 16)), g3 = gelu_tanh(__uint_as_float(gw[tt].y & 0xffff0000u));
                float hv[4];
#pragma unroll
                for (int r = 0; r < 4; ++r) hv[r] = __uint_as_float(pk[tt][r] << 16) + __uint_as_float(pk[tt][r] & 0xffff0000u) * hin[r];
                v2u w; w.x = pk2(hv[0] * g0, hv[1] * g1); w.y = pk2(hv[2] * g2, hv[3] * g3);
                *(v2u*)(A.ys + (t0 + tt * 16 + j) * 1024 + 768 + ch0) = w;
            }
        }
    }
    if (PH == 2) STAMP(55);
    __syncthreads();

#pragma unroll
    for (int n = 0; n < 4; ++n) *(LAS v4u*)(T0 + (tl0 + n) * TROW + cg * 16) = *(const v4u*)(prow + (long)n * IN_COLS + 1024);
    __syncthreads();
    const bf16x8 zf = (bf16x8){0, 0, 0, 0, 0, 0, 0, 0};
    if (PH == 2) STAMP(56);
#pragma unroll 1
    for (int gi = 0; gi < 2; ++gi) {
        const int g = wave * 2 + gi;
        float ar[4], ai[4], a4r[4], a4i[4], a8r[4], a8i[4], aqr[4], aqi[4], hr[4], hi[4];
        bf16x8 bref[4], bimf[4];
#pragma unroll
        for (int st = 0; st < 4; ++st) {
            const int si = g * 64 + st * 16 + j;
            const float* at = (const float*)(sm + SM_ATAB) + si * 12;
            const f32x4 t0v = *(const f32x4*)at, t1v = *(const f32x4*)(at + 4);
            ar[st] = t0v.x; ai[st] = t0v.y; a4r[st] = t0v.z; a4i[st] = t0v.w; a8r[st] = t1v.x; a8i[st] = t1v.y;
            aqr[st] = q == 0 ? 1.f : (q == 1 ? t0v.z : (q == 2 ? t1v.x : t1v.z));
            aqi[st] = q == 0 ? 0.f : (q == 1 ? t0v.w : (q == 2 ? t1v.y : t1v.w));
            hr[st] = 0.f; hi[st] = 0.f;
            if (PH == 2) { const f32x2_ cv = cS5[si]; hr[st] = cv.x; hi[st] = cv.y; }
            bref[st] = (q < 2) ? *(const bf16x8*)((const bf16_t*)(sm + SM_BRE) + si * 16 + 8 * q) : zf;
            bimf[st] = (q < 2) ? *(const bf16x8*)((const bf16_t*)(sm + SM_BIM) + si * 16 + 8 * q) : zf;
        }
        bf16x8 cf[4];
        if (PH == 2) {
#pragma unroll
            for (int ks = 0; ks < 4; ++ks) cf[ks] = *(const bf16x8*)((const bf16_t*)(sm + SM_CMAT) + (g * 16 + j) * 128 + ks * 32 + 8 * q);
        }
        const f32x4 dv = *(const f32x4*)(A.s5_d + g * 16 + 4 * q);
#pragma unroll 1
        for (int tt = 0; tt < 4; ++tt) {
            const bf16x8 uf = (q < 2) ? *(const LAS bf16x8*)(T0 + (tt * 16 + j) * TROW + (g * 16 + 8 * q) * 2) : zf;
#pragma unroll
            for (int st = 0; st < 4; ++st) {
                const f32x4 z4 = (f32x4){0.f, 0.f, 0.f, 0.f};
                const f32x4 dre = mma16(uf, bref[st], z4), dim = mma16(uf, bimf[st], z4);
                float er = dre[0], ei = dim[0];
#pragma unroll
                for (int r = 1; r < 4; ++r) { const float nr = ar[st] * er - ai[st] * ei + dre[r], ni = ar[st] * ei + ai[st] * er + dim[r]; er = nr; ei = ni; }
                float x1r = __shfl_up(er, 16), x1i = __shfl_up(ei, 16), x2r = __shfl_up(er, 32), x2i = __shfl_up(ei, 32), x3r = __shfl_up(er, 48), x3i = __shfl_up(ei, 48);
                if (q < 1) { x1r = 0.f; x1i = 0.f; } if (q < 2) { x2r = 0.f; x2i = 0.f; } if (q < 3) { x3r = 0.f; x3i = 0.f; }
                float pr = x1r + (a4r[st] * x2r - a4i[st] * x2i) + (a8r[st] * x3r - a8i[st] * x3i) + (aqr[st] * hr[st] - aqi[st] * hi[st]);
                float pi = x1i + (a4r[st] * x2i + a4i[st] * x2r) + (a8r[st] * x3i + a8i[st] * x3r) + (aqr[st] * hi[st] + aqi[st] * hr[st]);
#pragma unroll
                for (int r = 0; r < 4; ++r) {
                    const float nr = ar[st] * pr - ai[st] * pi + dre[r], ni = ar[st] * pi + ai[st] * pr + dim[r]; pr = nr; pi = ni;
                    if (PH == 2) *(LAS unsigned*)(Hw + (4 * q + r) * HROW + (st * 16 + j) * 4) = pk2(nr, ni);
                }
                hr[st] = __shfl(pr, 48 + j); hi[st] = __shfl(pi, 48 + j);
            }
            if (PH == 2) {
                f32x4 y = (f32x4){0.f, 0.f, 0.f, 0.f};
#pragma unroll
                for (int ks = 0; ks < 4; ++ks) { const bf16x8 hf = *(const LAS bf16x8*)(Hw + j * HROW + (ks * 32 + 8 * q) * 2); y = mma16(cf[ks], hf, y); }
                const v2u uw = *(const LAS v2u*)(T0 + (tt * 16 + j) * TROW + (g * 16 + 4 * q) * 2);
                const float y0 = gelu_tanh(y[0] + dv[0] * __uint_as_float(uw.x << 16)), y1 = gelu_tanh(y[1] + dv[1] * __uint_as_float(uw.x & 0xffff0000u));
                const float y2 = gelu_tanh(y[2] + dv[2] * __uint_as_float(uw.y << 16)), y3 = gelu_tanh(y[3] + dv[3] * __uint_as_float(uw.y & 0xffff0000u));
                v2u w; w.x = pk2(y0, y1); w.y = pk2(y2, y3);
                *(LAS v2u*)(T1 + (tt * 16 + j) * TROW + (g * 16 + 4 * q) * 2) = w;
            }
        }
        if (PH == 1 && q == 0) {
#pragma unroll
            for (int st = 0; st < 4; ++st) A.s5st[((size_t)b * NCHUNK + c) * 1024 + g * 64 + st * 16 + j] = make_float2(hr[st], hi[st]);
        }
    }
    if (PH == 2) {
        STAMP(57);
        __syncthreads();
        STAMP(58);
        const bf16_t* GT = (const bf16_t*)(sm + SM_GLUT);
        f32x4 acc[2][4];
#pragma unroll
        for (int d = 0; d < 2; ++d)
#pragma unroll
            for (int tt = 0; tt < 4; ++tt) acc[d][tt] = (f32x4){0.f, 0.f, 0.f, 0.f};
#pragma unroll 2
        for (int ks = 0; ks < 8; ++ks) {
            bf16x8 wf[2];
#pragma unroll
            for (int d = 0; d < 2; ++d) wf[d] = *(const bf16x8*)(GT + ((wave * 2 + d) * 16 + j) * 256 + ks * 32 + 8 * q);
#pragma unroll
            for (int tt = 0; tt < 4; ++tt) { const bf16x8 xf = *(const LAS bf16x8*)(T1 + (tt * 16 + j) * TROW + (ks * 32 + 8 * q) * 2);
#pragma unroll
                for (int d = 0; d < 2; ++d) acc[d][tt] = mma16(wf[d], xf, acc[d][tt]); }
        }
#pragma unroll
        for (int d = 0; d < 2; ++d) {
            const int col0 = (wave * 2 + d) * 16 + 4 * q;
            const f32x4 gb = *(const f32x4*)(A.glu_b + col0);
#pragma unroll
            for (int tt = 0; tt < 4; ++tt) {
                const v2u yw = *(const LAS v2u*)(T1 + (tt * 16 + j) * TROW + col0 * 2);
                const f32x4 s = acc[d][tt] + gb;
                v2u w; w.x = pk2(__uint_as_float(yw.x << 16) * sigmoidf_(s.x), __uint_as_float(yw.x & 0xffff0000u) * sigmoidf_(s.y));
                w.y = pk2(__uint_as_float(yw.y << 16) * sigmoidf_(s.z), __uint_as_float(yw.y & 0xffff0000u) * sigmoidf_(s.w));
                *(v2u*)(A.ys + (t0 + tt * 16 + j) * 1024 + 512 + col0) = w;
            }
        }
    }
    __syncthreads();
}

__device__ __forceinline__ void router_phase(Frame& F, const float* h, const float* g2, const float* Wp, const float* rgb, const float* reb,
                                             bf16_t* xn, unsigned* cnt, int* buf_ts, float* buf_w) {
    LAS float* part = (LAS float*)(F.lds);
    LAS float* lg = (LAS float*)(F.lds + 98304);
    LAS float* rs = (LAS float*)(F.lds + 98304 + 12288);
    const int lane = F.lane, wave = F.wave, tid = F.tid, j = lane & 15, q = lane >> 4;
    for (int blk = blockIdx.x; blk < T / 64; blk += F.G) {
        const int m0 = blk * 64;
        f32x4 v[8][4];
#pragma unroll
        for (int i = 0; i < 8; ++i)
#pragma unroll
            for (int jj = 0; jj < 4; ++jj) v[i][jj] = *(const f32x4*)(h + (size_t)(m0 + wave * 8 + i) * D + 4 * lane + 256 * jj);
        {
            f32x4 gg[4];
#pragma unroll
            for (int jj = 0; jj < 4; ++jj) gg[jj] = *(const f32x4*)(g2 + 4 * lane + 256 * jj);
            __builtin_amdgcn_sched_barrier(0);
#pragma unroll
            for (int i = 0; i < 8; ++i) {
                float s = 0.f;
#pragma unroll
                for (int jj = 0; jj < 4; ++jj) s += v[i][jj].x * v[i][jj].x + v[i][jj].y * v[i][jj].y + v[i][jj].z * v[i][jj].z + v[i][jj].w * v[i][jj].w;
#pragma unroll
                for (int o = 1; o < 64; o <<= 1) s += __shfl_xor(s, o);
                const float rstd = rsqrtf(s * (1.0f / D) + EPS);
                if (lane == 0) rs[wave * 8 + i] = rstd;
#pragma unroll
                for (int jj = 0; jj < 4; ++jj) {
                    const f32x4 o = v[i][jj] * rstd * gg[jj];
                    *(unsigned*)((unsigned char*)xn + (size_t)(m0 + wave * 8 + i) * D + 4 * lane + 256 * jj) = pk4_fp8(o.x, o.y, o.z, o.w);
                }
            }
        }
        STAMP(48);
        f32x4 acc[3][4];
#pragma unroll
        for (int ot = 0; ot < 3; ++ot)
#pragma unroll
            for (int tt = 0; tt < 4; ++tt) acc[ot][tt] = (f32x4){0.f, 0.f, 0.f, 0.f};
        LAS float* xq = (LAS float*)(F.lds);
        const bf16_t* WH = (const bf16_t*)Wp; const bf16_t* WL = WH + 49152;
#pragma unroll
        for (int kq = 0; kq < 4; ++kq) {
            bf16x8 wh[3], wl[3];
#pragma unroll
            for (int ot = 0; ot < 3; ++ot) { wh[ot] = *(const bf16x8*)(WH + (size_t)(ot * 16 + j) * 1024 + kq * 256 + wave * 32 + 8 * q); wl[ot] = *(const bf16x8*)(WL + (size_t)(ot * 16 + j) * 1024 + kq * 256 + wave * 32 + 8 * q); }
            if (kq) __syncthreads();
#pragma unroll
            for (int i = 0; i < 8; ++i) *(LAS f32x4*)(xq + (wave * 8 + i) * 260 + 4 * lane) = v[i][kq];
            __builtin_amdgcn_sched_barrier(0);
            __syncthreads();
#pragma unroll
            for (int tt = 0; tt < 4; ++tt) {
                const f32x4 x0 = *(const LAS f32x4*)(xq + (tt * 16 + j) * 260 + wave * 32 + 8 * q), x1 = *(const LAS f32x4*)(xq + (tt * 16 + j) * 260 + wave * 32 + 8 * q + 4);
                const float xv[8] = {x0.x, x0.y, x0.z, x0.w, x1.x, x1.y, x1.z, x1.w};
                unsigned hp[4], lp[4];
#pragma unroll
                for (int p = 0; p < 4; ++p) {
                    const unsigned h0 = f2bfu(xv[2 * p]), h1 = f2bfu(xv[2 * p + 1]);
                    hp[p] = h0 | (h1 << 16);
                    lp[p] = pk2(xv[2 * p] - __uint_as_float(h0 << 16), xv[2 * p + 1] - __uint_as_float(h1 << 16));
                }
                const bf16x8 xh = __builtin_bit_cast(bf16x8, (v4u){hp[0], hp[1], hp[2], hp[3]}), xl = __builtin_bit_cast(bf16x8, (v4u){lp[0], lp[1], lp[2], lp[3]});
#pragma unroll
                for (int ot = 0; ot < 3; ++ot) { acc[ot][tt] = mma16(wh[ot], xh, acc[ot][tt]); acc[ot][tt] = mma16(wh[ot], xl, acc[ot][tt]); acc[ot][tt] = mma16(wl[ot], xh, acc[ot][tt]); }
            }
        }
        __syncthreads();
#pragma unroll
        for (int ot = 0; ot < 3; ++ot)
#pragma unroll
            for (int tt = 0; tt < 4; ++tt) *(LAS f32x4*)(part + ((wave * 12 + ot * 4 + tt) * 64 + lane) * 4) = acc[ot][tt];
        STAMP(49);
        __syncthreads();
        STAMP(50);
        for (int idx = tid; idx < 12 * 256; idx += 512) {
            const int tile = idx >> 8, ln = (idx >> 2) & 63, r = idx & 3, ot = tile >> 2, tt = tile & 3;
            float s = 0.f;
#pragma unroll
            for (int w = 0; w < 8; ++w) s += part[(w * 12 + tile) * 256 + (idx & 255)];
            const int tok = tt * 16 + (ln & 15), o = ot * 16 + 4 * (ln >> 4) + r;
            lg[tok * 48 + o] = s * rs[tok];
        }
        __syncthreads();
        STAMP(51);
        if (tid < 64) {
            const int m = m0 + tid;
            float gl[4], mx = -1e30f; int gi = 0;
#pragma unroll
            for (int i = 0; i < 4; ++i) { gl[i] = lg[tid * 48 + i] + rgb[i]; if (gl[i] > mx) { mx = gl[i]; gi = i; } }
            float den = 0.f;
#pragma unroll
            for (int i = 0; i < 4; ++i) den += __expf(gl[i] - mx);
            const float gval = 1.0f / den;
            float v1 = -1e30f, v2 = -1e30f; int i1 = 0, i2 = 0;
            for (int i = 0; i < 8; ++i) { const float el = lg[tid * 48 + 4 + gi * 8 + i] + reb[gi * 8 + i]; if (el > v1) { v2 = v1; i2 = i1; v1 = el; i1 = i; } else if (el > v2) { v2 = el; i2 = i; } }
            const float e2 = __expf(v2 - v1), w1 = gval / (1.0f + e2), w2 = gval * e2 / (1.0f + e2);
            const int ex1 = gi * 8 + i1, ex2 = gi * 8 + i2;
            const unsigned r1 = atomicAdd(&cnt[ex1 * 64], 1u), r2 = atomicAdd(&cnt[ex2 * 64], 1u);
            buf_ts[ex1 * CAP + r1] = m * 2 + 0; buf_w[ex1 * CAP + r1] = w1;
            buf_ts[ex2 * CAP + r2] = m * 2 + 1; buf_w[ex2 * CAP + r2] = w2;
        }
        __syncthreads();
    }
}

__device__ __forceinline__ void build_plan(Frame& F, const unsigned* cnt) {
    LAS int* plan = (LAS int*)(F.lds + PLAN_OFF);
    if (F.tid < 64) {
        const int e = F.tid & 31;
        const int ce = (int)__hip_atomic_load(cnt + e * 64, RLX_AGENT);
        const int nf = ce >> 8, rem = ce & 255, big = rem > 128 ? 1 : 0, sml = (rem > 0 && rem <= 128) ? 1 : 0;
        int pf = nf, pb = big, ps = sml;
#pragma unroll
        for (int o = 1; o < 32; o <<= 1) { const int a = __shfl_up(pf, o, 32), b = __shfl_up(pb, o, 32), c = __shfl_up(ps, o, 32); if (e >= o) { pf += a; pb += b; ps += c; } }
        const int NF = __shfl(pf, 31, 32), NB = __shfl(pb, 31, 32), NS = __shfl(ps, 31, 32);
        if (F.tid < 32) {
            plan[321 + e] = ce;
            for (int jb = 0; jb < nf; ++jb) { const int p = pf - nf + jb; if (p < MAXBLK) { plan[1 + p] = e; plan[1 + MAXBLK + p] = jb; } }
            if (big) { const int p = NF + pb - 1; if (p < MAXBLK) { plan[1 + p] = e; plan[1 + MAXBLK + p] = nf; } }
            if (sml) { const int p = NF + NB + ps - 1; if (p < MAXBLK) { plan[1 + p] = e; plan[1 + MAXBLK + p] = nf; } }
            if (e == 0) { const int tot = NF + NB + NS; plan[0] = tot < MAXBLK ? tot : MAXBLK; }
        }
    }
    __syncthreads();
}

struct DenseSched {
    static constexpr bool GATHER = false, HALF = false, WAITS = false, PUBLISHES = false;
    pg8::StaticOrder ord; const char* A; const char* Bt; int lda, K; int a_sh, a_cs; int es;
    __device__ __forceinline__ bool next(int i, pg8::Unit& u) const { return ord.next(i, u); }
    __device__ __forceinline__ const char* a_base(const pg8::Unit& u) const { return A + (size_t)u.pm * 256 * lda * es + (size_t)((u.pn >> a_sh) * a_cs); }
    __device__ __forceinline__ const char* b_base(const pg8::Unit& u) const { return Bt + (size_t)u.pn * 256 * K * es; }
    __device__ __forceinline__ unsigned gather_off(const pg8::Unit&, int) const { return 0u; }
    __device__ __forceinline__ bool half_only(const pg8::Unit&) const { return false; }
};
struct Moe1Sched {
    static constexpr bool GATHER = true, HALF = true, WAITS = false, PUBLISHES = false;
    const char* xn; const char* w13; const LAS int* plan; const int* buf_ts; int G, c, lda; unsigned* ready;
    __device__ __forceinline__ void done(const pg8::Unit& u) const { asm volatile("s_waitcnt vmcnt(0)" ::: "memory"); if ((threadIdx.x & 63) == 0) __hip_atomic_fetch_add(ready + 16 * u.pm, 1u, RLX_AGENT); }
    __device__ __forceinline__ bool next(int i, pg8::Unit& u) const { const int L = i * G + c; if (L >= 4 * plan[0]) return false; u.pm = L >> 2; u.pn = L & 3; return true; }
    __device__ __forceinline__ const char* a_base(const pg8::Unit&) const { return xn; }
    __device__ __forceinline__ const char* b_base(const pg8::Unit& u) const { return w13 + (size_t)plan[1 + u.pm] * (1024 * 1024) + (size_t)u.pn * (256 * 1024); }
    __device__ __forceinline__ unsigned gather_off(const pg8::Unit& u, int r) const {
        const int e = plan[1 + u.pm], lb = plan[1 + MAXBLK + u.pm], ce = plan[321 + e];
        int pos = lb * 256 + r; pos = pos < ce ? pos : ce - 1;
        return (unsigned)(buf_ts[e * CAP + pos] >> 1) * (unsigned)D;
    }
    __device__ __forceinline__ bool half_only(const pg8::Unit& u) const { const int e = plan[1 + u.pm], lb = plan[1 + MAXBLK + u.pm]; return plan[321 + e] - lb * 256 <= 128; }
};
struct Moe2Sched {
    static constexpr bool GATHER = false, HALF = true, WAITS = false, PUBLISHES = false;
    const char* hbuf; const char* w2t; const LAS int* plan; int G, c, lda; const unsigned* ready; unsigned* tmo;
    __device__ __forceinline__ void a_ready(const pg8::Unit& u) const {
        if (threadIdx.x < 64) {
            const unsigned long long t0 = __builtin_amdgcn_s_memrealtime(); unsigned polls = 0;
            while ((unsigned)__builtin_amdgcn_readfirstlane(__hip_atomic_load(ready + 16 * u.pm, RLX_AGENT)) < 32u) {
                if ((++polls & 255u) == 0u && __builtin_amdgcn_readfirstlane(__hip_atomic_load(tmo, RLX_AGENT)) != 0u) break;
                if (__builtin_amdgcn_s_memrealtime() - t0 > 2000000ull) { if (threadIdx.x == 0) __hip_atomic_store(tmo, 1u, RLX_AGENT); break; }
                __builtin_amdgcn_s_sleep(2); }
            __builtin_amdgcn_fence(__ATOMIC_ACQUIRE, "agent");
            asm volatile("s_waitcnt vmcnt(0)" ::: "memory");
        }
        asm volatile("" ::: "memory"); __builtin_amdgcn_s_barrier(); asm volatile("" ::: "memory");
    }
    __device__ __forceinline__ bool next(int i, pg8::Unit& u) const { const int L = i * G + c; if (L >= 4 * plan[0]) return false; u.pm = L >> 2; u.pn = L & 3; return true; }
    __device__ __forceinline__ const char* a_base(const pg8::Unit& u) const { return hbuf + (size_t)u.pm * 256 * DEXP; }
    __device__ __forceinline__ const char* b_base(const pg8::Unit& u) const { return w2t + (size_t)plan[1 + u.pm] * (1024 * 512) + (size_t)u.pn * (256 * 512); }
    __device__ __forceinline__ unsigned gather_off(const pg8::Unit&, int) const { return 0u; }
    __device__ __forceinline__ bool half_only(const pg8::Unit& u) const { const int e = plan[1 + u.pm], lb = plan[1 + MAXBLK + u.pm]; return plan[321 + e] - lb * 256 <= 128; }
};

using pg8::f32x4; using pg8::u32x4; using pg8::u32x2; using pg8::cvt_pk_bf16; using pg8::Unit; using pg8::HALF; using pg8::BM;
struct EpiStoreBf16 {
    static constexpr bool PERM = true;
    bf16_t* O; int ldc;
    __device__ __forceinline__ void operator()(const f32x4 (&acc)[2][2][4][2], const Unit& u, int wr, int wc, int fr, int fq) const {
        const int row0 = u.pm * BM + wr * 64 + fr, col0 = u.pn * BM + wc * 32 + 8 * fq;
#pragma unroll
        for (int ai = 0; ai < 2; ++ai)
#pragma unroll
            for (int m = 0; m < 4; ++m) { bf16_t* rowp = O + (size_t)(row0 + ai * HALF + m * 16) * ldc + col0;
#pragma unroll
                for (int bj = 0; bj < 2; ++bj) { const f32x4 v0 = acc[ai][bj][m][0], v1 = acc[ai][bj][m][1];
                    u32x4 w; w.x = cvt_pk_bf16(v0[0], v0[1]); w.y = cvt_pk_bf16(v0[2], v0[3]); w.z = cvt_pk_bf16(v1[0], v1[1]); w.w = cvt_pk_bf16(v1[2], v1[3]);
                    *(u32x4*)(rowp + bj * HALF) = w; } }
    }
};
struct EpiGateMerge {
    static constexpr bool PERM = false;
    const float* bias; const bf16_t* br; bf16_t* merged;
    __device__ __forceinline__ void operator()(const f32x4 (&acc)[2][2][4][2], const Unit& u, int wr, int wc, int fr, int fq) const {
        const int row0 = u.pm * BM + wr * 64 + fr, d0 = u.pn * 64 + wc * 16 + 4 * fq;
        f32x4 bv[4];
#pragma unroll
        for (int k4 = 0; k4 < 4; ++k4) bv[k4] = *(const f32x4*)(bias + k4 * 1024 + d0);
#pragma unroll
        for (int ai = 0; ai < 2; ++ai)
#pragma unroll
            for (int m = 0; m < 4; ++m) {
                const size_t row = (size_t)(row0 + ai * HALF + m * 16);
                f32x4 s = (f32x4){0.f, 0.f, 0.f, 0.f};
#pragma unroll
                for (int k4 = 0; k4 < 4; ++k4) {
                    const u32x2 b2 = *(const u32x2*)(br + row * 4096 + k4 * 1024 + d0);
                    const f32x4 a = acc[ai][k4 >> 1][m][k4 & 1] * (1.0f / MG_SCALE) + bv[k4];
                    s[0] += sigmoidf_(a[0]) * __uint_as_float(b2.x << 16);
                    s[1] += sigmoidf_(a[1]) * __uint_as_float(b2.x & 0xffff0000u);
                    s[2] += sigmoidf_(a[2]) * __uint_as_float(b2.y << 16);
                    s[3] += sigmoidf_(a[3]) * __uint_as_float(b2.y & 0xffff0000u);
                }
                u32x2 w; w.x = cvt_pk_bf16(s[0], s[1]); w.y = cvt_pk_bf16(s[2], s[3]);
                *(u32x2*)(merged + row * D + d0) = w;
            }
    }
};
struct EpiAddF32 {
    static constexpr bool PERM = false;
    const float* hsrc; float* hdst;
    __device__ __forceinline__ void operator()(const f32x4 (&acc)[2][2][4][2], const Unit& u, int wr, int wc, int fr, int fq) const {
        const int row0 = u.pm * BM + wr * 64 + fr, col0 = u.pn * BM + wc * 32 + 4 * fq;
#pragma unroll
        for (int ai = 0; ai < 2; ++ai)
#pragma unroll
            for (int m = 0; m < 4; ++m) { const size_t ro = (size_t)(row0 + ai * HALF + m * 16) * D + col0;
#pragma unroll
                for (int bj = 0; bj < 2; ++bj)
#pragma unroll
                    for (int n = 0; n < 2; ++n) *(f32x4*)(hdst + ro + bj * HALF + n * 16) = *(const f32x4*)(hsrc + ro + bj * HALF + n * 16) + acc[ai][bj][m][n]; }
    }
};
struct EpiMoe1 {
    static constexpr bool PERM = false;
    unsigned char* hbuf;
    __device__ __forceinline__ void operator()(const f32x4 (&acc)[2][2][4][2], const Unit& u, int wr, int wc, int fr, int fq) const {
        const int row0 = u.pm * BM + wr * 64 + fr, h0 = u.pn * 128 + wc * 16 + 4 * fq;
        const float si = 1.0f / W13_SCALE;
#pragma unroll
        for (int ai = 0; ai < 2; ++ai)
#pragma unroll
            for (int m = 0; m < 4; ++m) { unsigned char* rowp = hbuf + (size_t)(row0 + ai * HALF + m * 16) * DEXP + h0;
#pragma unroll
                for (int bj = 0; bj < 2; ++bj) { const f32x4 a1 = acc[ai][bj][m][0] * si, a3 = acc[ai][bj][m][1] * (si * H_SCALE);
                    const unsigned w = pk4_fp8(a1[0] * sigmoidf_(a1[0]) * a3[0], a1[1] * sigmoidf_(a1[1]) * a3[1], a1[2] * sigmoidf_(a1[2]) * a3[2], a1[3] * sigmoidf_(a1[3]) * a3[3]);
                    *(unsigned*)(rowp + bj * 64) = w; } }
    }
};
struct EpiMoe2 {
    static constexpr bool PERM = true;
    bf16_t* ymoe; const LAS int* plan; const int* buf_ts; const float* buf_w;
    __device__ __forceinline__ void operator()(const f32x4 (&acc)[2][2][4][2], const Unit& u, int wr, int wc, int fr, int fq) const {
        const int e = plan[1 + u.pm], lb = plan[1 + MAXBLK + u.pm], ce = plan[321 + e];
        const int col0 = u.pn * BM + wc * 32 + 8 * fq;
        int ts[2][4]; float wt[2][4];
#pragma unroll
        for (int ai = 0; ai < 2; ++ai)
#pragma unroll
            for (int m = 0; m < 4; ++m) {
                const int pos = lb * 256 + ai * HALF + wr * 64 + m * 16 + fr; const int pc = pos < ce ? pos : ce - 1;
                ts[ai][m] = buf_ts[e * CAP + pc]; wt[ai][m] = buf_w[e * CAP + pc] * (1.0f / (W2_SCALE * H_SCALE));
                if (pos >= ce) ts[ai][m] = -1;
            }
        __builtin_amdgcn_sched_barrier(0);
#pragma unroll
        for (int ai = 0; ai < 2; ++ai)
#pragma unroll
            for (int m = 0; m < 4; ++m) {
                if (ts[ai][m] >= 0) {
                    bf16_t* rowp = ymoe + (size_t)ts[ai][m] * D + col0; const float w_ = wt[ai][m];
#pragma unroll
                    for (int bj = 0; bj < 2; ++bj) { const f32x4 v0 = acc[ai][bj][m][0] * w_, v1 = acc[ai][bj][m][1] * w_;
                        u32x4 w; w.x = cvt_pk_bf16(v0[0], v0[1]); w.y = cvt_pk_bf16(v0[2], v0[3]); w.z = cvt_pk_bf16(v1[0], v1[1]); w.w = cvt_pk_bf16(v1[2], v1[3]);
                        *(u32x4*)(rowp + bj * HALF) = w; }
                }
            }
    }
};

__device__ __forceinline__ void make_mix_args(MixArgs& A, const Args& args, unsigned char* ws, int l) {
    A.proj = (const bf16_t*)(ws + WS_PROJ); A.ys = (bf16_t*)(ws + WS_YS); A.tab = (const float*)(ws + WS_TAB + (size_t)l * MiB); A.sm = ws + WS_TAB + (size_t)l * MiB + SM_OFF; A.ws = ws;
    A.s5st = (float2*)(ws + WS_S5ST); A.lruS = (float2*)(ws + WS_LRUS); A.lrup = (unsigned*)(ws + WS_LRUA);
    A.conv_a_w = args.in[3] + (size_t)l * 3 * W; A.pool_b = args.in[5] + (size_t)l * W; A.pool_scale = args.in[6] + (size_t)l * W;
    A.s5_d = args.in[14] + (size_t)l * W; A.glu_b = args.in[16] + (size_t)l * W;
    A.lconv_w = args.in[17] + (size_t)l * 4 * W; A.lconv_b = args.in[18] + (size_t)l * W; A.ba = args.in[20] + (size_t)l * W; A.bx = args.in[22] + (size_t)l * W;
}

__global__ void __launch_bounds__(NWAVES * 64, 2) mk_fwd(Args args) {
    extern __shared__ __attribute__((aligned(16))) unsigned char lds[];
    Frame F;
    F.lds = (LAS unsigned char*)lds; F.smem = lds;
    F.MISC = (volatile LAS unsigned*)(F.lds + MISC_OFF);
    F.tid = threadIdx.x; F.lane = F.tid & 63; F.wave = __builtin_amdgcn_readfirstlane(F.tid >> 6);
    F.G = gridDim.x; { const int bx = blockIdx.x; F.vcu = (F.G % 8 == 0) ? (bx % 8) * (F.G / 8) + bx / 8 : bx; }
    F.ws = args.ws; F.ctl = (unsigned*)(args.ws + WS_CTL);
    unsigned char* ws = args.ws; unsigned char* const args_ws_ = args.ws; (void)args_ws_;
    for (int u = F.tid; u < (LDS_BYTES - LDSCTL_OFF) / 4; u += NWAVES * 64) ((LAS unsigned*)(F.lds + LDSCTL_OFF))[u] = 0u;
    __syncthreads();
    XcdBarrier bar; bar.bar = F.ctl + CW_BAR; bar.x = 0; bar.st = nullptr;
    if (N_LAUNCHES == 1) bar = xcd_barrier_post(F.ctl + CW_BAR, F.MISC + 8);
    const int lo = args.ph_lo, hi = args.ph_hi;
    float* h = (float*)(ws + WS_H); bf16_t* xn = (bf16_t*)(ws + WS_XN); bf16_t* proj = (bf16_t*)(ws + WS_PROJ); bf16_t* ys = (bf16_t*)(ws + WS_YS);
    bf16_t* br = (bf16_t*)(ws + WS_R1); bf16_t* hbuf = (bf16_t*)(ws + WS_HBUF); bf16_t* ymoe = (bf16_t*)(ws + WS_YMOE); bf16_t* merged = (bf16_t*)(ws + WS_MERGED);
    int* buf_ts = (int*)(ws + WS_BUFTS); float* buf_w = (float*)(ws + WS_BUFW);

#ifndef KIND_MASK
#define KIND_MASK 0x7ff
#endif
#define PH_BEGIN(k, kind) if (lo <= (k) && (k) < hi && ((KIND_MASK >> (kind)) & 1)) { \
        { int t_ = threadIdx.x; asm volatile("" : "+v"(t_)); F.tid = t_; F.lane = t_ & 63; F.wave = __builtin_amdgcn_readfirstlane(t_ >> 6); } STAMP(2 * (k));
#ifdef PROBE_A
#define PH_END(k) __syncthreads(); STAMP(2 * (k) + 1); if ((k) + 1 < hi) xcd_barrier(bar); }
#else
#define PH_END(k) if ((k) + 1 < hi) xcd_barrier(bar); }
#endif

    PH_BEGIN(0, 0)
        prep_tables(F, args);
        conv_mixer_weights(F, args);
        conv_expert_weights(F, args, 0, CONV_NA);
        norm_phase(F, args.in[0], nullptr, args.in[1], nullptr, xn, nullptr, 0.0f, ws + WS_XN8);
    PH_END(0)

#ifdef PROBE_A
#ifndef PROBE_MODE
#define PROBE_MODE 0
#endif
#ifndef PROBE_SCALE
#define PROBE_SCALE 300
#endif
#ifndef PROBE_SHIFT
#define PROBE_SHIFT 0.0f
#endif
#define PROBE_REDUCE() { xcd_barrier(bar); \
        if (blockIdx.x == 0) { LAS float* red = (LAS float*)F.lds; const unsigned long long* dd = (const unsigned long long*)(g_dbg); \
            if (F.tid < 256) { const unsigned long long ta = __hip_atomic_load(dd + (size_t)F.tid * 64 + (PROBE_A), RLX_AGENT), tb = __hip_atomic_load(dd + (size_t)F.tid * 64 + (PROBE_B), RLX_AGENT), t00 = __hip_atomic_load(dd + (PROBE_A), RLX_AGENT); \
                red[F.tid] = (float)(long long)(tb - ta) * 0.01f; red[256 + F.tid] = (float)(long long)(ta - t00) * 0.01f; red[512 + F.tid] = (float)(long long)(tb - t00) * 0.01f; } \
            __syncthreads(); \
            if (F.tid == 0) { float sum = 0.f, mx = -1e30f, mna = 1e30f, mxb = -1e30f; for (int i = 0; i < 256; ++i) { sum += red[i]; mx = fmaxf(mx, red[i]); mna = fminf(mna, red[256 + i]); mxb = fmaxf(mxb, red[512 + i]); } \
                const float val = PROBE_MODE == 0 ? sum * (1.0f / 256.0f) : (PROBE_MODE == 1 ? mx : mxb - mna); \
                const float vq = val; \
                __hip_atomic_store((float*)((unsigned long long*)(g_dbg) + 256 * 64), vq, RLX_AGENT); } \
            __syncthreads(); } \
        xcd_barrier(bar); \
        oscale_ = __hip_atomic_load((float*)((unsigned long long*)(g_dbg) + 256 * 64), RLX_AGENT) * (1.0f / (float)(PROBE_SCALE)); }
#else
#define PROBE_REDUCE()
#endif
#define LAYER(l) { \
    const int pb = 1 + PH_PER_LAYER * (l); \
    const float* tab = (const float*)(ws + WS_TAB + (size_t)(l) * MiB); \
    const unsigned char* wmix = ws + WS_WMIX + (size_t)(l) * WMIX_STRIDE; \
    unsigned* cnt = F.ctl + CW_CNT + 2048 * (l); \
    PH_BEGIN(pb + 0, 1)   \
        DenseSched S; S.ord.init(T, IN_COLS, F.G, (int)blockIdx.x); S.A = (const char*)xn; S.Bt = (const char*)(wmix + WMIX_IN); S.lda = D; S.K = D; S.a_sh = 0; S.a_cs = 0; S.es = 2; \
        EpiStoreBf16 E{proj, IN_COLS}; \
        pg8::gemm_phase<EpiStoreBf16, DenseSched, true, true>(F.lds, F.tid, D, S, E); \
        if (F.G == 256 && (int)blockIdx.x >= 192) conv_expert_quota(F, args, (l), 0, ((int)blockIdx.x - 192) * NWAVES + F.wave, 4); \
        else if (F.G != 256 && (int)blockIdx.x == 0) conv_expert_quota(F, args, (l), 0, F.wave, CONV_NA / NWAVES);     \
    PH_END(pb + 0) \
    PH_BEGIN(pb + 1, 2)   \
        MixArgs A; make_mix_args(A, args, ws, (l)); \
        for (int u = blockIdx.x; u < BATCH * NCHUNK; u += F.G) { int t_ = F.tid; asm volatile("" : "+v"(t_)); mix_unit<1>(A, F.lds, u, t_); } \
    PH_END(pb + 1) \
    PH_BEGIN(pb + 2, 3)   \
        MixArgs A; make_mix_args(A, args, ws, (l)); \
        for (int u = blockIdx.x; u < BATCH * NCHUNK; u += F.G) { int t_ = F.tid; asm volatile("" : "+v"(t_)); mix_unit<2>(A, F.lds, u, t_); } \
    PH_END(pb + 2) \
    PH_BEGIN(pb + 3, 4)   \
        DenseSched S; S.ord.init(T, 4096, F.G, (int)blockIdx.x); S.A = (const char*)ys; S.Bt = (const char*)(wmix + WMIX_BR); S.lda = 1024; S.K = 256; S.a_sh = 2; S.a_cs = 512; S.es = 2; \
        EpiStoreBf16 E{br, 4096}; \
        pg8::gemm_phase<EpiStoreBf16, DenseSched, true, true>(F.lds, F.tid, 256, S, E); \
    PH_END(pb + 3) \
    PH_BEGIN(pb + 4, 5)   \
        DenseSched S; S.ord.init(T, 4096, F.G, (int)blockIdx.x); S.A = (const char*)(ws + WS_XN8); S.Bt = (const char*)(wmix + WMIX_MG); S.lda = D; S.K = D; S.a_sh = 0; S.a_cs = 0; S.es = 1; \
        EpiGateMerge E{args.in[25] + (size_t)(l) * 4096, br, merged}; \
        pg8::gemm_phase<EpiGateMerge, DenseSched, true, true, true>(F.lds, F.tid, D, S, E); \
    PH_END(pb + 4) \
    PH_BEGIN(pb + 5, 6)   \
        DenseSched S; S.ord.init(T, D, F.G, (int)blockIdx.x); S.A = (const char*)merged; S.Bt = (const char*)(wmix + WMIX_OUT); S.lda = D; S.K = D; S.a_sh = 0; S.a_cs = 0; S.es = 2; \
        EpiAddF32 E{(l) == 0 ? args.in[0] : h, (args.flags & 1) ? (float*)(ws + WS_R1) : h}; \
        pg8::gemm_phase<EpiAddF32, DenseSched, true, true>(F.lds, F.tid, D, S, E); \
    PH_END(pb + 5) \
    PH_BEGIN(pb + 6, 7)   \
        if (args.flags & 1) router_phase(F, h, args.in[28] + (size_t)(l) * D, tab + TB_RW, args.in[30] + (size_t)(l) * 4, args.in[32] + (size_t)(l) * 32, xn, F.ctl + 16384, (int*)(ws + WS_END), (float*)(ws + WS_END + 2 * MiB)); \
        else router_phase(F, h, args.in[28] + (size_t)(l) * D, tab + TB_RW, args.in[30] + (size_t)(l) * 4, args.in[32] + (size_t)(l) * 32, xn, cnt, buf_ts, buf_w); \
    PH_END(pb + 6) \
    PH_BEGIN(pb + 7, 8)   \
        build_plan(F, cnt); \
        unsigned* rdy = F.ctl + CW_RDY + 4096 * (l); \
        { Moe1Sched S{(const char*)xn, (const char*)(ws + WS_WEXP + (size_t)(l) * WEXP_LAYER), (const LAS int*)(F.lds + PLAN_OFF), buf_ts, F.G, F.vcu, D, rdy}; \
          EpiMoe1 E{(unsigned char*)hbuf}; \
          pg8::gemm_phase<EpiMoe1, Moe1Sched, true, true, true>(F.lds, F.tid, D, S, E); } \
        if ((l) + 1 < DEPTH) { if (F.G == 256 && F.vcu >= 128) conv_expert_quota(F, args, (l) + 1, CONV_NA, (F.vcu - 128) * NWAVES + F.wave, 3); \
            else if (F.G != 256 && F.vcu == 0) conv_expert_quota(F, args, (l) + 1, CONV_NA, F.wave, CONV_NB / NWAVES); } \
        xcd_barrier(bar);     \
        { Moe2Sched S{(const char*)hbuf, (const char*)(ws + WS_WEXP + (size_t)(l) * WEXP_LAYER + WEXP_W2), (const LAS int*)(F.lds + PLAN_OFF), F.G, F.G - 1 - F.vcu, DEXP, rdy, F.ctl + CW_TMO}; \
          EpiMoe2 E{ymoe, (const LAS int*)(F.lds + PLAN_OFF), buf_ts, buf_w}; \
          pg8::gemm_phase<EpiMoe2, Moe2Sched, true, true, true>(F.lds, F.tid, DEXP, S, E); } \
    PH_END(pb + 7) \
    PH_BEGIN(pb + 8, 9)   \
        if ((l) + 1 < DEPTH) { \
            conv_expert_weights(F, args, (l) + 1, CONV_NA + CONV_NB); \
            norm_phase(F, h, ymoe, args.in[1] + (size_t)((l) + 1) * D, (args.flags & 1) ? nullptr : h, xn, nullptr, 0.0f, ws + WS_XN8); \
        } else { \
            float oscale_ = 0.0f; \
            PROBE_REDUCE() \
            norm_phase(F, h, ymoe, args.in[36], nullptr, nullptr, args.out, oscale_); \
        } \
    PH_END(pb + 8) \
}
    LAYER(0)
    LAYER(1)
#undef LAYER
#undef PH_BEGIN
#undef PH_END
}
}

extern "C" void kernel_launch(void* const* d_in, const int* in_sizes, int n_in, void* d_out, int out_size, void* d_ws, size_t ws_size, hipStream_t stream) {
    static int grid = 0;
    if (grid == 0) {
        if (n_in != 37 || ws_size < WS_END) { fprintf(stderr, "kernel_launch: unexpected n_in %d or ws %zu\n", n_in, ws_size); grid = -1; return; }
        int dev = 0, cus = 0;
        if (hipGetDevice(&dev) != hipSuccess || hipDeviceGetAttribute(&cus, hipDeviceAttributeMultiprocessorCount, dev) != hipSuccess) { grid = -1; return; }
        if (hipFuncSetAttribute((const void*)mk_fwd, hipFuncAttributeMaxDynamicSharedMemorySize, LDS_BYTES) != hipSuccess) { fprintf(stderr, "kernel_launch: hipFuncSetAttribute failed\n"); grid = -1; return; }
        grid = cus;
    }
    if (grid < 0) return;
    (void)hipMemsetAsync((char*)d_ws + WS_CTL, 0, 1 * MiB, stream);
    Args a{};
    for (int i = 0; i < 37; ++i) a.in[i] = (const float*)d_in[i];
    a.out = (float*)d_out; a.ws = (unsigned char*)d_ws;
    if (N_LAUNCHES == 1) {
        a.ph_lo = 0; a.ph_hi = N_PHASES;
        hipLaunchKernelGGL(mk_fwd, dim3(grid), dim3(NWAVES * 64), LDS_BYTES, stream, a);
    } else {
#ifndef REP_MASK
#define REP_MASK 0
#endif
#ifndef REP_N
#define REP_N 2
#endif
        for (int p = 0; p < N_PHASES; ++p) { a.ph_lo = p; a.ph_hi = p + 1; const int kind = p == 0 ? 0 : 1 + (p - 1) % PH_PER_LAYER; const int nrep = ((REP_MASK >> kind) & 1) ? REP_N : 1;
            for (int r = 0; r < nrep; ++r) { a.flags = (r + 1 < nrep) ? 1 : 0; hipLaunchKernelGGL(mk_fwd, dim3(grid), dim3(NWAVES * 64), LDS_BYTES, stream, a); } }
    }
}
```

```cpp
#include <hip/hip_runtime.h>
#include <cstdint>
#include <cstdio>

#ifndef MK_N_LAUNCHES
#define MK_N_LAUNCHES 1
#endif

namespace pg8 {
#define PG8_LAS __attribute__((address_space(3)))
typedef unsigned short bf16_t;
typedef short bf16x8 __attribute__((ext_vector_type(8)));
typedef float f32x4 __attribute__((ext_vector_type(4)));
typedef unsigned u32x4 __attribute__((ext_vector_type(4)));
typedef unsigned u32x2 __attribute__((ext_vector_type(2)));
constexpr int BM = 256, BK = 64, HALF = 128, HTB = HALF * BK * 2, STAGE_BYTES = 8 * HTB, NXCD = 8, WGM = 8;

__host__ __device__ __forceinline__ int lds_byte(int r, int c) { const int st = (r >> 4) * 2 + (c >> 5), rr = r & 15, cc = c & 31, ob = rr * 64 + cc * 2; return st * 1024 + (ob ^ (((ob >> 9) & 1) << 5)); }
__host__ __device__ __forceinline__ void stage_rc(int b, int& R, int& C) { const int st = b / 1024, sb = b % 1024, swz = sb ^ (((sb >> 9) & 1) << 5); R = (st >> 1) * 16 + swz / 64; C = (st & 1) * 32 + (swz % 64) / 2; }
__host__ __device__ __forceinline__ int perm32(int rho) { const int n = rho >> 4, i = rho & 15; return 8 * (i >> 2) + 4 * n + (i & 3); }

struct Unit { int pm, pn; };

struct StaticOrder {
    int nM, nN, nwg, G, c;
    __host__ __device__ void init(int M, int N, int G_, int c_) { nM = M / BM; nN = N / BM; nwg = nM * nN; G = G_; c = c_; }
    __host__ __device__ bool next(int i, Unit& u) const {
        const long L = (long)i * G + c; if (L >= nwg) return false;
        int wgid = (int)L; { const int q = nwg / NXCD, r = nwg % NXCD, xcd = wgid % NXCD, off = wgid / NXCD; wgid = (xcd < r ? xcd * (q + 1) : r * (q + 1) + (xcd - r) * q) + off; }
        const int nig = WGM * nN, gid = wgid / nig, fm = gid * WGM, gsz = (nM - fm) < WGM ? (nM - fm) : WGM;
        u.pm = fm + ((wgid % nig) % gsz); u.pn = (wgid % nig) / gsz; return true;
    }
};

typedef int i32x8 __attribute__((ext_vector_type(8)));
typedef int i32x4 __attribute__((ext_vector_type(4)));
__device__ __forceinline__ i32x8 cat8(bf16x8 a, bf16x8 b) { const i32x4 x = __builtin_bit_cast(i32x4, a), y = __builtin_bit_cast(i32x4, b); return __builtin_shufflevector(x, y, 0, 1, 2, 3, 4, 5, 6, 7); }
__device__ __forceinline__ unsigned cvt_pk_bf16(float lo, float hi) { unsigned r; asm volatile("v_cvt_pk_bf16_f32 %0, %1, %2" : "=v"(r) : "v"(lo), "v"(hi)); return r; }

template <class Epi, class Sched, bool ALIGN_EPI, bool SP2, bool FP8 = false>
__device__ __forceinline__ void gemm_phase(PG8_LAS unsigned char* lds, const int tid, const int K, const Sched& S, const Epi& E) {
    const int wid = __builtin_amdgcn_readfirstlane(tid >> 6), lane = tid & 63, wr = wid >> 2, wc = wid & 3, fr = lane & 15, fq = lane >> 4;
    const int nt = FP8 ? K / 128 : K / BK;
    const int ES = FP8 ? 1 : 2;
    unsigned voffB[2]; int RA[2], CA[2];
#pragma unroll
    for (int i = 0; i < 2; ++i) { int R, C; stage_rc(tid * 16 + i * 8192, R, C); const int Rb = Epi::PERM ? ((R & ~31) + perm32(R & 31)) : R;
        voffB[i] = (unsigned)(Rb * K * ES + C * 2); RA[i] = R; CA[i] = C; }
    const size_t kstep = (size_t)(BK * 2);
    const size_t hstepB = (size_t)HALF * K * ES;
    const unsigned ldsw = (unsigned)wid * 1024u;
    const int aoff = lds_byte(wr * 64 + fr, fq * 8), boff = lds_byte(wc * 32 + fr, fq * 8);
#define PG8_SA(b, h) (((b) * 2 + (h)) * HTB)
#define PG8_SB(b, h) ((4 + (b) * 2 + (h)) * HTB)
#define PG8_STAGE(bufoff, gbase, voff) do { _Pragma("unroll") for (int _i = 0; _i < 2; ++_i) \
        __builtin_amdgcn_global_load_lds((const unsigned*)((const char*)(gbase) + (voff)[_i]), (PG8_LAS unsigned*)(lds + (bufoff) + ldsw + _i * 8192), 16, 0, 0); } while (0)
#define PG8_LDA(dst, b, h) do { _Pragma("unroll") for (int m = 0; m < 4; ++m) { if constexpr (FP8) { dst##8[m] = cat8(*(const PG8_LAS bf16x8*)(lds + PG8_SA(b, h) + aoff + m * 2048), *(const PG8_LAS bf16x8*)(lds + PG8_SA(b, h) + aoff + m * 2048 + 1024)); } \
        else { _Pragma("unroll") for (int k = 0; k < 2; ++k) dst[m][k] = *(const PG8_LAS bf16x8*)(lds + PG8_SA(b, h) + aoff + m * 2048 + k * 1024); } } } while (0)
#define PG8_LDB(dst, b, h) do { _Pragma("unroll") for (int n = 0; n < 2; ++n) { if constexpr (FP8) { dst##8[n] = cat8(*(const PG8_LAS bf16x8*)(lds + PG8_SB(b, h) + boff + n * 2048), *(const PG8_LAS bf16x8*)(lds + PG8_SB(b, h) + boff + n * 2048 + 1024)); } \
        else { _Pragma("unroll") for (int k = 0; k < 2; ++k) dst[n][k] = *(const PG8_LAS bf16x8*)(lds + PG8_SB(b, h) + boff + n * 2048 + k * 1024); } } } while (0)
#define PG8_MMA(ai, bj, At, Bt) do { __builtin_amdgcn_s_setprio(1); _Pragma("unroll") for (int m = 0; m < 4; ++m) _Pragma("unroll") for (int n = 0; n < 2; ++n) { \
        if constexpr (FP8) { asm volatile("v_mfma_scale_f32_16x16x128_f8f6f4 %0, %1, %2, %0, %3, %3 op_sel_hi:[0,0,0]" : "+v"(acc[ai][bj][m][n]) : "v"(Bt##8[n]), "v"(At##8[m]), "v"(one_scale));     } \
        else { _Pragma("unroll") for (int k = 0; k < 2; ++k) acc[ai][bj][m][n] = __builtin_amdgcn_mfma_f32_16x16x32_bf16(Bt[n][k], At[m][k], acc[ai][bj][m][n], 0, 0, 0); } } \
        __builtin_amdgcn_s_setprio(0); } while (0)
#define PG8_WAIT_V(n) asm volatile("s_waitcnt vmcnt(" #n ")" ::: "memory")
#define PG8_WAIT_L(n) asm volatile("s_waitcnt lgkmcnt(" #n ")" ::: "memory")
#define PG8_BAR __builtin_amdgcn_s_barrier()
#define PG8_SCHED __builtin_amdgcn_sched_barrier(0)
    Unit cur, nxt; int ui = 0;
    if (!S.next(0, cur)) return;
    bool has_next = S.next(1, nxt);
    unsigned offC[2][2], offN[2][2];
#pragma unroll
    for (int h = 0; h < 2; ++h)
#pragma unroll
        for (int i = 0; i < 2; ++i) {
            if constexpr (Sched::GATHER) { offC[h][i] = S.gather_off(cur, h * HALF + RA[i]) + (unsigned)CA[i] * 2u; offN[h][i] = has_next ? S.gather_off(nxt, h * HALF + RA[i]) + (unsigned)CA[i] * 2u : offC[h][i]; }
            else { offC[h][i] = (unsigned)((h * HALF + RA[i]) * S.lda * ES + CA[i] * 2); offN[h][i] = offC[h][i]; }
        }
    f32x4 acc[2][2][4][2];
#pragma unroll
    for (int a = 0; a < 2; ++a)
#pragma unroll
        for (int b = 0; b < 2; ++b)
#pragma unroll
            for (int m = 0; m < 4; ++m)
#pragma unroll
                for (int n = 0; n < 2; ++n) acc[a][b][m][n] = (f32x4){0.f, 0.f, 0.f, 0.f};
    int one_scale = 0x7f7f7f7f; asm volatile("" : "+v"(one_scale));
    bf16x8 At[4][2], B0[2][2], B1[2][2]; i32x8 At8[4], B08[2], B18[2]; (void)At; (void)B0; (void)B1; (void)At8; (void)B08; (void)B18;
    const char* cA = S.a_base(cur); const char* cB = S.b_base(cur);
    if constexpr (Sched::WAITS) S.a_ready(cur);
    if constexpr (SP2) {
        PG8_STAGE(PG8_SB(0, 0), cB, voffB); PG8_STAGE(PG8_SB(0, 1), cB + hstepB, voffB); PG8_STAGE(PG8_SA(0, 0), cA, offC[0]); PG8_STAGE(PG8_SA(0, 1), cA, offC[1]);
        if (wr == 1) PG8_BAR;
        PG8_WAIT_V(2); PG8_BAR;
        PG8_STAGE(PG8_SB(1, 0), cB + kstep, voffB); PG8_STAGE(PG8_SA(1, 0), cA + kstep, offC[0]); PG8_STAGE(PG8_SB(1, 1), cB + hstepB + kstep, voffB);
        PG8_WAIT_V(6); PG8_BAR;
    } else {
        PG8_STAGE(PG8_SB(0, 0), cB, voffB); PG8_STAGE(PG8_SA(0, 0), cA, offC[0]); PG8_STAGE(PG8_SB(0, 1), cB + hstepB, voffB); PG8_STAGE(PG8_SA(0, 1), cA, offC[1]);
        if (wr == 1) PG8_BAR;
        PG8_WAIT_V(4); PG8_BAR;
        PG8_STAGE(PG8_SB(1, 0), cB + kstep, voffB); PG8_STAGE(PG8_SA(1, 0), cA + kstep, offC[0]); PG8_STAGE(PG8_SB(1, 1), cB + hstepB + kstep, voffB);
        PG8_WAIT_V(6); PG8_BAR;
    }
    for (;;) {
        const char* nA = has_next ? S.a_base(nxt) : cA; const char* nB = has_next ? S.b_base(nxt) : cB;
        const bool full = !(Sched::HALF && __builtin_amdgcn_readfirstlane((int)S.half_only(cur)));
#pragma unroll 1
        for (int t = 0; t < nt; t += 2) {
            const bool last = (t == nt - 2);
            const char* a1 = cA + (size_t)(t + 1) * kstep;
            const char* a2 = last ? nA : cA + (size_t)(t + 2) * kstep; const char* b2 = last ? nB : cB + (size_t)(t + 2) * kstep;
            const char* a3 = a2 + kstep; const char* b3 = b2 + kstep;
            if constexpr (Sched::WAITS) { if (last && has_next) S.a_ready(nxt); }
            unsigned o2[2][2];
#pragma unroll
            for (int h = 0; h < 2; ++h)
#pragma unroll
                for (int i = 0; i < 2; ++i) o2[h][i] = (Sched::GATHER && last) ? offN[h][i] : offC[h][i];
            if constexpr (SP2) {
            PG8_LDB(B0, 0, 0); PG8_LDB(B1, 0, 1); PG8_SCHED; PG8_LDA(At, 0, 0); PG8_STAGE(PG8_SA(1, 1), a1, offC[1]);
            PG8_WAIT_V(8); PG8_WAIT_L(0); PG8_BAR; PG8_MMA(0, 0, At, B0); PG8_MMA(0, 1, At, B1); PG8_BAR; PG8_SCHED;
            PG8_LDA(At, 0, 1); PG8_STAGE(PG8_SB(0, 0), b2, voffB); PG8_STAGE(PG8_SB(0, 1), b2 + hstepB, voffB); PG8_STAGE(PG8_SA(0, 0), a2, o2[0]);
            PG8_WAIT_V(8); PG8_WAIT_L(0); PG8_BAR; if (full) { PG8_MMA(1, 0, At, B0); PG8_MMA(1, 1, At, B1); } PG8_BAR; PG8_SCHED;
            PG8_LDB(B0, 1, 0); PG8_LDB(B1, 1, 1); PG8_SCHED; PG8_LDA(At, 1, 0); PG8_STAGE(PG8_SA(0, 1), a2, o2[1]);
            PG8_WAIT_V(8); PG8_WAIT_L(0); PG8_BAR; PG8_MMA(0, 0, At, B0); PG8_MMA(0, 1, At, B1); PG8_BAR; PG8_SCHED;
            PG8_LDA(At, 1, 1); PG8_STAGE(PG8_SB(1, 0), b3, voffB); PG8_STAGE(PG8_SB(1, 1), b3 + hstepB, voffB); PG8_STAGE(PG8_SA(1, 0), a3, o2[0]);
            PG8_WAIT_V(8); PG8_WAIT_L(0); PG8_BAR; if (full) { PG8_MMA(1, 0, At, B0); PG8_MMA(1, 1, At, B1); } PG8_BAR; PG8_SCHED;
            } else {
            PG8_LDB(B0, 0, 0); PG8_SCHED; PG8_LDA(At, 0, 0); PG8_STAGE(PG8_SA(1, 1), a1, offC[1]);
            PG8_WAIT_L(8); PG8_BAR; PG8_WAIT_L(0); PG8_MMA(0, 0, At, B0); PG8_BAR; PG8_SCHED;
            PG8_LDB(B1, 0, 1); PG8_STAGE(PG8_SB(0, 0), b2, voffB);
            PG8_BAR; PG8_WAIT_L(0); PG8_MMA(0, 1, At, B1); PG8_BAR;
            PG8_LDA(At, 0, 1); PG8_STAGE(PG8_SA(0, 0), a2, o2[0]);
            PG8_BAR; PG8_WAIT_L(0); PG8_MMA(1, 0, At, B0); PG8_BAR; PG8_SCHED;
            PG8_STAGE(PG8_SB(0, 1), b2 + hstepB, voffB);
            PG8_WAIT_V(6); PG8_BAR; PG8_MMA(1, 1, At, B1); PG8_BAR;
            PG8_LDB(B0, 1, 0); PG8_SCHED; PG8_LDA(At, 1, 0); PG8_STAGE(PG8_SA(0, 1), a2, o2[1]);
            PG8_WAIT_L(8); PG8_BAR; PG8_WAIT_L(0); PG8_MMA(0, 0, At, B0); PG8_BAR; PG8_SCHED;
            PG8_LDB(B1, 1, 1); PG8_STAGE(PG8_SB(1, 0), b3, voffB);
            PG8_BAR; PG8_WAIT_L(0); PG8_MMA(0, 1, At, B1); PG8_BAR;
            PG8_LDA(At, 1, 1); PG8_STAGE(PG8_SA(1, 0), a3, o2[0]);
            PG8_BAR; PG8_WAIT_L(0); PG8_MMA(1, 0, At, B0); PG8_BAR; PG8_SCHED;
            PG8_STAGE(PG8_SB(1, 1), b3 + hstepB, voffB);
            PG8_WAIT_V(6); PG8_BAR; PG8_MMA(1, 1, At, B1); PG8_BAR;
            }
        }
        if constexpr (FP8) asm volatile("s_nop 15\n\ts_nop 7" ::: "memory");
        if constexpr (ALIGN_EPI) { if (wr == 0) PG8_BAR; }
        Unit nn; bool has_nn = false;
        if constexpr (Sched::GATHER) {
            has_nn = has_next && S.next(ui + 2, nn);
#pragma unroll
            for (int h = 0; h < 2; ++h)
#pragma unroll
                for (int i = 0; i < 2; ++i) { int R_, C_; stage_rc(tid * 16 + i * 8192, R_, C_); offC[h][i] = offN[h][i]; if (has_nn) offN[h][i] = S.gather_off(nn, h * HALF + R_) + (unsigned)C_ * 2u; }
        }
        E(acc, cur, wr, wc, fr, fq);
        if constexpr (Sched::PUBLISHES) S.done(cur);
        if (!has_next) break;
#pragma unroll
        for (int a = 0; a < 2; ++a)
#pragma unroll
            for (int b = 0; b < 2; ++b)
#pragma unroll
                for (int m = 0; m < 4; ++m)
#pragma unroll
                    for (int n = 0; n < 2; ++n) acc[a][b][m][n] = (f32x4){0.f, 0.f, 0.f, 0.f};
        cur = nxt; cA = nA; cB = nB; ++ui;
        if constexpr (Sched::GATHER) { has_next = has_nn; nxt = nn; }
        else { has_next = S.next(ui + 1, nxt); }
        if constexpr (ALIGN_EPI) { if (wr == 1) PG8_BAR; }
    }
    PG8_WAIT_V(0);
    if constexpr (!ALIGN_EPI) { if (wr == 0) PG8_BAR; }
    PG8_BAR;
#undef PG8_SA
#undef PG8_SB
#undef PG8_STAGE
#undef PG8_LDA
#undef PG8_LDB
#undef PG8_MMA
#undef PG8_WAIT_V
#undef PG8_WAIT_L
#undef PG8_BAR
#undef PG8_SCHED
}
}

namespace {
constexpr int NWAVES = 8;
constexpr int N_LAUNCHES = MK_N_LAUNCHES;
constexpr int D = 1024, BATCH = 8, SEQ = 2048, DEPTH = 2, T = BATCH * SEQ;
constexpr int W = 256, IN_COLS = 1792;
constexpr int NEXP = 32, DEXP = 512;
constexpr int CHUNK = 64, NCHUNK = SEQ / CHUNK;
constexpr int CAP = 16384;
constexpr int MAXBLK = 160;
constexpr float EPS = 1e-6f;
constexpr int PH_PER_LAYER = 9, N_PHASES = 1 + PH_PER_LAYER * DEPTH;

typedef unsigned short bf16_t;
typedef float f32x4 __attribute__((ext_vector_type(4)));
typedef unsigned v4u __attribute__((ext_vector_type(4)));
#define GAS __attribute__((address_space(1)))
#define LAS __attribute__((address_space(3)))
typedef GAS unsigned gu32;
#define RLX_AGENT __ATOMIC_RELAXED, __HIP_MEMORY_SCOPE_AGENT
#define LDS_WAIT() asm volatile("s_waitcnt lgkmcnt(0)" ::: "memory")

__device__ __forceinline__ float bf2f(bf16_t b) { return __uint_as_float(((unsigned)b) << 16); }
__device__ __forceinline__ unsigned f2bfu(float f) { unsigned u = __float_as_uint(f); return (u + 0x7fffu + ((u >> 16) & 1u)) >> 16; }
__device__ __forceinline__ bf16_t f2bf(float f) { return (bf16_t)f2bfu(f); }
__device__ __forceinline__ unsigned pk2(float lo, float hi) { return f2bfu(lo) | (f2bfu(hi) << 16); }
__device__ __forceinline__ float sigmoidf_(float x) { return 1.0f / (1.0f + __expf(-x)); }
__device__ __forceinline__ float gelu_tanh(float x) {
    const float z = 0.7978845608028654f * (x + 0.044715f * x * x * x);
    const float t = 1.0f - 2.0f / (__expf(2.0f * z) + 1.0f);
    return 0.5f * x * (1.0f + t);
}

constexpr size_t MiB = 1u << 20;
constexpr size_t WS_CTL = 0;
constexpr size_t WS_TAB = 1 * MiB;
constexpr size_t WS_H = 4 * MiB;
constexpr size_t WS_XN = 68 * MiB;
constexpr size_t WS_PROJ = 100 * MiB;
constexpr size_t WS_MERGED = WS_PROJ;
constexpr size_t WS_YS = 156 * MiB;
constexpr size_t WS_R1 = 188 * MiB;
constexpr size_t WS_HBUF = WS_R1;
constexpr size_t WS_YMOE = WS_R1 + 48 * MiB;
constexpr size_t WS_S5ST = 316 * MiB;
constexpr size_t WS_LRUA = 318 * MiB;
constexpr size_t WS_LRUH = 334 * MiB;
constexpr size_t WS_LRUS = 350 * MiB;
constexpr size_t WS_BUFTS = 351 * MiB;
constexpr size_t WS_BUFW = 353 * MiB;
constexpr size_t WS_WMIX = 356 * MiB;
constexpr size_t WMIX_IN = 0, WMIX_MG = (size_t)1792 * 1024 * 2, WMIX_BR = WMIX_MG + (size_t)4096 * 1024 * 2, WMIX_OUT = WMIX_BR + (size_t)4096 * 256 * 2, WMIX_STRIDE = 16 * MiB;
static_assert(WMIX_OUT + (size_t)1024 * 1024 * 2 <= WMIX_STRIDE, "mixer weights");
constexpr size_t WS_WEXP = 388 * MiB;
constexpr size_t WEXP_W2 = 32 * MiB, WEXP_LAYER = 48 * MiB;
constexpr float MG_SCALE = 32.0f;
constexpr float W13_SCALE = 32.0f, W2_SCALE = 16.0f, H_SCALE = 8.0f;
constexpr size_t WS_XN8 = 484 * MiB;
constexpr size_t WS_END = 500 * MiB;

constexpr int CW_CNT = 8192;
constexpr int CW_BAR = 4096;
constexpr int CW_TMO = 16;
constexpr int CW_RDY = 32768;

constexpr int TB_NLOG = 4096 + 32768, TB_RW = 4096 + 32768 + 256;
constexpr int SM_OFF = 512 * 1024;
constexpr int SM_POOLT = 0, SM_WAT = 32768, SM_WXT = 65536, SM_GLUT = 98304, SM_BRE = 229376, SM_BIM = 262144, SM_CMAT = 294912, SM_ATAB = 360448;


constexpr int RING_BYTES = 131072;
constexpr int LDSCTL_OFF = RING_BYTES, MISC_OFF = LDSCTL_OFF + 320;
constexpr int PLAN_OFF = MISC_OFF + 128;
constexpr int LDS_BYTES = 147456;
static_assert(PLAN_OFF + 4 * 360 <= LDS_BYTES, "LDS map");

#define XB_TMO      128
#define XB_XCNT(j)  (256  + 64 * (j))
#define XB_XSUB(j)  (1280 + 64 * (j))
#define XB_XGEN(j)  (2304 + 64 * (j))
#define XB_TOP      3328
#define XB_TOPGEN   3392
#define XCD_BAR_WORDS 3456
#define XB_SPIN_CAP (1u << 18)
__device__ __forceinline__ unsigned xb_ld(unsigned* p)              { return __hip_atomic_load(p, __ATOMIC_RELAXED, __HIP_MEMORY_SCOPE_AGENT); }
__device__ __forceinline__ unsigned xb_add(unsigned* p, unsigned v) { return __hip_atomic_fetch_add(p, v, __ATOMIC_RELAXED, __HIP_MEMORY_SCOPE_AGENT); }
__device__ __forceinline__ unsigned xb_xcc_id() { return (unsigned)__builtin_amdgcn_s_getreg((3 << 11) | 20) & 0xFu; }
#define XB_SPIN(cond, bar) do { unsigned _sp = 0; while (cond) { __builtin_amdgcn_s_sleep(1); \
    if ((++_sp & 255u) == 0u) { if (xb_ld(&(bar)[XB_TMO])) break; if (_sp > XB_SPIN_CAP) { atomicAdd(&(bar)[XB_TMO], 1u); break; } } } } while (0)
struct XcdBarrier { unsigned* bar; unsigned x; volatile LAS unsigned* st; };
__device__ __forceinline__ XcdBarrier xcd_barrier_post(unsigned* bar, volatile LAS unsigned* st) {
    XcdBarrier b; b.bar = bar; b.x = xb_xcc_id(); b.st = st;
    if (threadIdx.x == 0) (void)xb_add(&bar[XB_XCNT(b.x)], 1u);
    return b;
}
__device__ __forceinline__ void xcd_barrier_complete(unsigned* bar, unsigned x, unsigned& nloc, unsigned& nx) {
    const unsigned G = gridDim.x * gridDim.y * gridDim.z;
    unsigned sum, cnt, mine, sp = 0u;
    for (;;) {
        sum = 0u; cnt = 0u; mine = 0u;
#pragma unroll
        for (unsigned j = 0; j < 16; ++j) { const unsigned c = xb_ld(&bar[XB_XCNT(j)]); sum += c; cnt += (c > 0u) ? 1u : 0u; mine = (j == x) ? c : mine; }
        if (sum == G) break;
        __builtin_amdgcn_s_sleep(1);
        if ((++sp & 255u) == 0u) { if (xb_ld(&bar[XB_TMO])) break; if (sp > XB_SPIN_CAP) { atomicAdd(&bar[XB_TMO], 1u); break; } }
    }
    nloc = mine > 0u ? mine : 1u; nx = cnt > 0u ? cnt : 1u;
}
__device__ __forceinline__ void xcd_barrier(const XcdBarrier& b) {
    asm volatile("s_waitcnt vmcnt(0)" ::: "memory");
    __syncthreads();
    if (threadIdx.x == 0) {
        unsigned* bar = b.bar;
        __builtin_amdgcn_s_waitcnt(0);
        unsigned nloc = b.st[0], nx = b.st[1];
        if (nloc == 0u) { xcd_barrier_complete(bar, b.x, nloc, nx); b.st[0] = nloc; b.st[1] = nx; }
        const unsigned old = xb_add(&bar[XB_XSUB(b.x)], 1u);
        const unsigned gen = old / nloc;
        if (old + 1u == (gen + 1u) * nloc) {
            __builtin_amdgcn_fence(__ATOMIC_RELEASE, "agent");
            asm volatile("s_waitcnt vmcnt(0)" ::: "memory");
            const unsigned og = xb_add(&bar[XB_TOP], 1u);
            const unsigned tg = og / nx;
            if (og + 1u == (tg + 1u) * nx) xb_add(&bar[XB_TOPGEN], 1u);
            else XB_SPIN(xb_ld(&bar[XB_TOPGEN]) == tg, bar);
            __builtin_amdgcn_fence(__ATOMIC_ACQUIRE, "agent");
            xb_add(&bar[XB_XGEN(b.x)], 1u);
            asm volatile("s_waitcnt vmcnt(0)" ::: "memory");
        } else {
            XB_SPIN(xb_ld(&bar[XB_XGEN(b.x)]) == gen, bar);
            __builtin_amdgcn_fence(__ATOMIC_ACQUIRE, "agent");
            asm volatile("s_waitcnt vmcnt(0)" ::: "memory");
        }
    }
    __syncthreads();
}

#ifdef PROBE_A
#define STAMP(id) do { if (threadIdx.x == 0) ((unsigned long long*)(g_dbg))[(size_t)blockIdx.x * 64 + (id)] = __builtin_amdgcn_s_memrealtime(); } while (0)
#else
#define STAMP(id) do { } while (0)
#endif
#define g_dbg (F.ws + WS_END)

struct Args { const float* in[37]; float* out; unsigned char* ws; int ph_lo, ph_hi; int flags, pad; };

struct Frame {
    LAS unsigned char* lds;
    unsigned char* smem;
    volatile LAS unsigned* MISC;
    unsigned* ctl;
    int tid, lane, wave, vcu, G;
    unsigned char* ws;
};

struct MapNat { int off; __device__ __forceinline__ int operator()(int n) const { return off + n; } };
struct MapGate { __device__ __forceinline__ int operator()(int s) const {
    const int k4 = s >> 10, d = s & 1023, pn = d >> 6, dd = d & 63;
    return pn * 256 + 128 * (k4 >> 1) + 32 * (dd >> 4) + 16 * (k4 & 1) + 4 * ((dd >> 2) & 3) + (dd & 3); } };
struct MapMoe13 { int which; __device__ __forceinline__ int operator()(int hid) const {
    const int pn = hid >> 7, r = hid & 127;
    return pn * 256 + 128 * (r >> 6) + 32 * ((r >> 4) & 3) + 16 * which + 4 * ((r >> 2) & 3) + (r & 3); } };

template <class RowMap>
__device__ __forceinline__ void transpose_item(const float* W, int K, int N, bf16_t* WT, LAS float* scr, int item, int lane, const RowMap rm) {
    const int nblk = N / 32, kb = item / nblk, nb = item % nblk, k0 = 64 * kb, n0 = 32 * nb;
#pragma unroll 8
    for (int i = 0; i < 32; ++i) { const int kk = 2 * i + (lane >> 5); scr[kk * 33 + (lane & 31)] = W[(size_t)(k0 + kk) * N + n0 + (lane & 31)]; }
    LDS_WAIT(); asm volatile("" ::: "memory");
    const int c = lane & 7;
#pragma unroll
    for (int j = 0; j < 4; ++j) { const int n = (lane >> 3) + 8 * j; const LAS float* s = scr + (8 * c) * 33 + n;
        v4u o; o.x = pk2(s[0 * 33], s[1 * 33]); o.y = pk2(s[2 * 33], s[3 * 33]); o.z = pk2(s[4 * 33], s[5 * 33]); o.w = pk2(s[6 * 33], s[7 * 33]);
        *(GAS v4u*)(WT + (size_t)rm(n0 + n) * K + k0 + 8 * c) = o; }
    LDS_WAIT(); asm volatile("" ::: "memory");
}

__device__ __forceinline__ unsigned pk4_fp8(float a, float b, float c, float d) { int w = 0; w = __builtin_amdgcn_cvt_pk_fp8_f32(a, b, w, false); w = __builtin_amdgcn_cvt_pk_fp8_f32(c, d, w, true); return (unsigned)w; }
template <class RowMap>
__device__ __forceinline__ void transpose_item_fp8(const float* W, int K, int N, unsigned char* WT, LAS unsigned char* scr, int item, int lane, const RowMap rm, const float scl) {
    const int nblk = N / 32, kb = item / nblk, nb = item % nblk, k0 = 128 * kb, n0 = 32 * nb;
#pragma unroll 16
    for (int i = 0; i < 64; ++i) { const int kk = 2 * i + (lane >> 5); const float v = W[(size_t)(k0 + kk) * N + n0 + (lane & 31)] * scl;
        scr[(lane & 31) * 144 + kk] = (unsigned char)__builtin_amdgcn_cvt_pk_fp8_f32(v, 0.f, 0, false); }
    LDS_WAIT(); asm volatile("" ::: "memory");
    const int c = lane & 7;
#pragma unroll
    for (int j = 0; j < 4; ++j) { const int n = (lane >> 3) + 8 * j;
        *(GAS v4u*)(WT + (size_t)rm(n0 + n) * K + k0 + 16 * c) = *(const LAS v4u*)(scr + n * 144 + 16 * c); }
    LDS_WAIT(); asm volatile("" ::: "memory");
}

__device__ __forceinline__ void conv_mixer_weights(Frame& F, const Args& a) {
    LAS float* scr = (LAS float*)(F.lds + F.wave * 16384);
    const int gw = F.vcu * NWAVES + F.wave, NGW = F.G * NWAVES;
    constexpr int I_IN = 16 * 56, I_MG = 8 * 128, I_BR = 4 * 32, I_OUT = 16 * 32, PER_L = I_IN + I_MG + 4 * I_BR + I_OUT;
    for (int it = gw; it < DEPTH * PER_L; it += NGW) {
        const int l = it / PER_L; int r = it % PER_L;
        unsigned char* wb = F.ws + WS_WMIX + (size_t)l * WMIX_STRIDE;
        if (r < I_IN) { transpose_item(a.in[2] + (size_t)l * D * IN_COLS, D, IN_COLS, (bf16_t*)(wb + WMIX_IN), scr, r, F.lane, MapNat{0}); continue; } r -= I_IN;
        if (r < I_MG) { transpose_item_fp8(a.in[24] + (size_t)l * D * 4096, D, 4096, wb + WMIX_MG, (LAS unsigned char*)scr, r, F.lane, MapGate{}, MG_SCALE); continue; } r -= I_MG;
        if (r < 4 * I_BR) { const int k4 = r / I_BR; transpose_item(a.in[26] + ((size_t)l * 4 + k4) * W * D, W, D, (bf16_t*)(wb + WMIX_BR), scr, r % I_BR, F.lane, MapNat{k4 * 1024}); continue; } r -= 4 * I_BR;
        transpose_item(a.in[27] + (size_t)l * D * D, D, D, (bf16_t*)(wb + WMIX_OUT), scr, r, F.lane, MapNat{0});
    }
}
constexpr int CONV_I13 = 8 * 16, CONV_I2 = 4 * 32, CONV_PER_E = 2 * CONV_I13 + CONV_I2, CONV_ITEMS = NEXP * CONV_PER_E;
constexpr int CONV_NA = 64 * NWAVES * 4, CONV_NB = 128 * NWAVES * 3;
__device__ __forceinline__ void conv_expert_item(Frame& F, const Args& a, int l, int it) {
    LAS unsigned char* scr = F.lds + F.wave * 16384;
    const int e = it / CONV_PER_E; int r = it % CONV_PER_E;
    unsigned char* w13 = F.ws + WS_WEXP + (size_t)l * WEXP_LAYER + (size_t)e * 1024 * 1024;
    unsigned char* w2t = F.ws + WS_WEXP + (size_t)l * WEXP_LAYER + WEXP_W2 + (size_t)e * 1024 * 512;
    if (r < CONV_I13) { transpose_item_fp8(a.in[33] + ((size_t)l * NEXP + e) * D * DEXP, D, DEXP, w13, scr, r, F.lane, MapMoe13{0}, W13_SCALE); return; } r -= CONV_I13;
    if (r < CONV_I13) { transpose_item_fp8(a.in[34] + ((size_t)l * NEXP + e) * D * DEXP, D, DEXP, w13, scr, r, F.lane, MapMoe13{1}, W13_SCALE); return; } r -= CONV_I13;
    transpose_item_fp8(a.in[35] + ((size_t)l * NEXP + e) * DEXP * D, DEXP, D, w2t, scr, r, F.lane, MapNat{0}, W2_SCALE);
}
__device__ __forceinline__ void conv_expert_weights(Frame& F, const Args& a, int l, int first) {
    const int gw = F.vcu * NWAVES + F.wave, NGW = F.G * NWAVES;
    for (int it = first + gw; it < CONV_ITEMS; it += NGW) conv_expert_item(F, a, l, it);
}
__device__ __forceinline__ void conv_expert_quota(Frame& F, const Args& a, int l, int first, int slot, int n) {
    for (int i = 0; i < n; ++i) conv_expert_item(F, a, l, first + slot * n + i);
}

__device__ __forceinline__ void prep_tables(Frame& F, const Args& a) {
    for (int sidx = F.vcu * NWAVES + F.wave; sidx < DEPTH * 1024; sidx += F.G * NWAVES) {
        const int l = sidx >> 10, gid = sidx & 1023, g = gid >> 6, lane = F.lane;
        unsigned char* sm = F.ws + WS_TAB + (size_t)l * MiB + SM_OFF;
        const double lre = fmin((double)a.in[7][l * 1024 + gid], -1e-4);
        const double lim = (double)a.in[8][l * 1024 + gid];
        const double step = exp((double)a.in[9][l * 16 + g]);
        const double pw = lane == 0 ? 1.0 : (lane == 1 ? 4.0 : (lane == 2 ? 8.0 : (lane == 3 ? 12.0 : (lane == 4 ? 64.0 : 1.0))));
        const double er = exp(lre * step * pw), pr = er * cos(lim * step * pw), pi = er * sin(lim * step * pw);
        float* at = (float*)(sm + SM_ATAB) + gid * 12;
        if (lane < 5) { at[2 * lane] = (float)pr; at[2 * lane + 1] = (float)pi; }
        if (lane == 5) { at[10] = 0.f; at[11] = 0.f; }
        const double ar = __shfl(pr, 0), ai = __shfl(pi, 0);
        const double nr = ar - 1.0, ni = ai, den = lre * lre + lim * lim;
        const double cr = (nr * lre + ni * lim) / den, ci = (ni * lre - nr * lim) / den;
        if (lane < 16) {
            const double br = (double)a.in[10][((size_t)l * 1024 + gid) * 16 + lane], bi = (double)a.in[11][((size_t)l * 1024 + gid) * 16 + lane];
            ((bf16_t*)(sm + SM_BRE))[gid * 16 + lane] = f2bf((float)(cr * br - ci * bi));
            ((bf16_t*)(sm + SM_BIM))[gid * 16 + lane] = f2bf((float)(cr * bi + ci * br));
        }
    }
    for (int idx = F.vcu * 512 + F.tid; idx < DEPTH * 65536; idx += F.G * 512) {
        const int l = idx >> 16, gid = idx & 65535;
        float* tab = (float*)(F.ws + WS_TAB + (size_t)l * MiB);
        unsigned char* sm = F.ws + WS_TAB + (size_t)l * MiB + SM_OFF;
        if (gid < 256) { const double lam = (double)a.in[23][l * 256 + gid]; tab[TB_NLOG + gid] = (float)(-8.0 * log1p(exp(-lam))); }
        if (gid < 49152) { const int o = gid >> 10, k = gid & 1023; const float gk = a.in[28][(size_t)l * 1024 + k];
            const float w = (o < 4) ? gk * a.in[29][((size_t)l * 1024 + k) * 4 + o] : (o < 36 ? gk * a.in[31][((size_t)l * 1024 + k) * 32 + (o - 4)] : 0.f);
            const bf16_t wh = f2bf(w); ((bf16_t*)(tab + TB_RW))[gid] = wh; ((bf16_t*)(tab + TB_RW))[49152 + gid] = f2bf(w - bf2f(wh)); }
        if (gid < 16384) { const int g = gid >> 12, d = (gid >> 6) & 63, cc = gid & 63; const size_t si = ((size_t)(l * 4 + g) * 64 + cc) * 64 + d;
            ((bf16_t*)(sm + SM_POOLT))[gid] = f2bf(a.in[4][si]); ((bf16_t*)(sm + SM_WAT))[gid] = f2bf(a.in[19][si]); ((bf16_t*)(sm + SM_WXT))[gid] = f2bf(a.in[21][si]); }
        if (gid < 32768) { const int g = gid >> 11, cc = (gid >> 7) & 15, k = gid & 127, p = k >> 1; const size_t si = ((size_t)(l * 16 + g) * 16 + cc) * 64 + p;
            ((bf16_t*)(sm + SM_CMAT))[gid] = f2bf((k & 1) ? -a.in[13][si] : a.in[12][si]); }
        { const int col = gid >> 8, k = gid & 255; ((bf16_t*)(sm + SM_GLUT))[gid] = f2bf(a.in[15][((size_t)l * 256 + k) * 256 + col]); }
    }
}

template <bool HBF>
__device__ __forceinline__ void norm_phase(Frame& F, const void* hin_, const bf16_t* y, const float* g, bf16_t* hout, bf16_t* xn, float* out, const float oadd = 0.0f, unsigned char* xn8 = nullptr) {
    const float* hin = (const float*)hin_; const bf16_t* hinb = (const bf16_t*)hin_;
    const int gw = F.vcu * NWAVES + F.wave, NGW = F.G * NWAVES, lane = F.lane;
    f32x4 gg[4];
#pragma unroll
    for (int j = 0; j < 4; ++j) gg[j] = *(const f32x4*)(g + 4 * lane + 256 * j);
    for (int m0 = gw; m0 < T; m0 += 4 * NGW) {
        f32x4 v[4][4]; uint2 ya[4][4], yb[4][4];
#pragma unroll
        for (int i = 0; i < 4; ++i) {
            const int m = m0 + i * NGW;
            if (m < T) {
#pragma unroll
                for (int j = 0; j < 4; ++j) {
                    const int col = 4 * lane + 256 * j;
                    if (HBF) { const uint2 hv = *(const uint2*)(hinb + (size_t)m * D + col);
                        v[i][j] = (f32x4){__uint_as_float(hv.x << 16), __uint_as_float(hv.x & 0xffff0000u), __uint_as_float(hv.y << 16), __uint_as_float(hv.y & 0xffff0000u)}; }
                    else v[i][j] = *(const f32x4*)(hin + (size_t)m * D + col);
                    if (y) { ya[i][j] = *(const uint2*)(y + ((size_t)m * 2 + 0) * D + col); yb[i][j] = *(const uint2*)(y + ((size_t)m * 2 + 1) * D + col); }
                }
            }
        }
            __builtin_amdgcn_sched_barrier(0);
#pragma unroll
        for (int i = 0; i < 4; ++i) {
            const int m = m0 + i * NGW;
            if (m < T) {
                float s = 0.f;
#pragma unroll
                for (int j = 0; j < 4; ++j) {
                    if (y) {
                        v[i][j].x += __uint_as_float(ya[i][j].x << 16) + __uint_as_float(yb[i][j].x << 16);
                        v[i][j].y += __uint_as_float(ya[i][j].x & 0xffff0000u) + __uint_as_float(yb[i][j].x & 0xffff0000u);
                        v[i][j].z += __uint_as_float(ya[i][j].y << 16) + __uint_as_float(yb[i][j].y << 16);
                        v[i][j].w += __uint_as_float(ya[i][j].y & 0xffff0000u) + __uint_as_float(yb[i][j].y & 0xffff0000u);
                    }
                    s += v[i][j].x * v[i][j].x + v[i][j].y * v[i][j].y + v[i][j].z * v[i][j].z + v[i][j].w * v[i][j].w;
                }
#pragma unroll
                for (int o = 1; o < 64; o <<= 1) s += __shfl_xor(s, o);
                const float rstd = rsqrtf(s * (1.0f / D) + EPS);
#pragma unroll
                for (int j = 0; j < 4; ++j) {
                    const int col = 4 * lane + 256 * j;
                    if (hout) { uint2 w; w.x = pk2(v[i][j].x, v[i][j].y); w.y = pk2(v[i][j].z, v[i][j].w); *(uint2*)(hout + (size_t)m * D + col) = w; }
                    const f32x4 o = v[i][j] * rstd * gg[j];
                    if (xn) { uint2 w; w.x = pk2(o.x, o.y); w.y = pk2(o.z, o.w); *(uint2*)(xn + (size_t)m * D + col) = w; }
                    if (xn8) *(unsigned*)(xn8 + (size_t)m * D + col) = pk4_fp8(o.x, o.y, o.z, o.w);
                    if (out) { f32x4 oo = o; if (m == 0 && col == 0) oo.x += oadd; *(f32x4*)(out + (size_t)m * D + col) = oo; }
                }
            }
        }
    }
}

constexpr int TROW = 528;
constexpr int TILE_BYTES = 64 * TROW;
constexpr int HROW = 272, HTILE = 16 * HROW;
constexpr int CARRY_OFF = 2 * TILE_BYTES + 8 * HTILE;

struct MixArgs {
    const bf16_t* proj; bf16_t* ys; const float* tab; const unsigned char* sm; unsigned char* ws;
    float2* s5st; float2* lruS; unsigned* lrup;
    const float *conv_a_w, *pool_b, *pool_scale, *s5_d, *glu_b, *lconv_w, *lconv_b, *ba, *bx;
};

typedef short bf16x8 __attribute__((ext_vector_type(8)));
__device__ __forceinline__ f32x4 mma16(bf16x8 a, bf16x8 b, f32x4 c) { return __builtin_amdgcn_mfma_f32_16x16x32_bf16(a, b, c, 0, 0, 0); }
__device__ __forceinline__ void ld8(const bf16_t* p, float (&x)[8]) {
    const v4u v = *(const v4u*)p;
    x[0] = __uint_as_float(v.x << 16); x[1] = __uint_as_float(v.x & 0xffff0000u); x[2] = __uint_as_float(v.y << 16); x[3] = __uint_as_float(v.y & 0xffff0000u);
    x[4] = __uint_as_float(v.z << 16); x[5] = __uint_as_float(v.z & 0xffff0000u); x[6] = __uint_as_float(v.w << 16); x[7] = __uint_as_float(v.w & 0xffff0000u);
}
__device__ __forceinline__ void ldf8(const float* p, float (&x)[8]) { const f32x4 a = *(const f32x4*)p, b = *(const f32x4*)(p + 4); x[0] = a.x; x[1] = a.y; x[2] = a.z; x[3] = a.w; x[4] = b.x; x[5] = b.y; x[6] = b.z; x[7] = b.w; }
typedef unsigned v2u __attribute__((ext_vector_type(2)));
__device__ __forceinline__ v4u pack8(const float (&x)[8]) { v4u o; o.x = pk2(x[0], x[1]); o.y = pk2(x[2], x[3]); o.z = pk2(x[4], x[5]); o.w = pk2(x[6], x[7]); return o; }
template <int N> __device__ __forceinline__ float dpp_row_shr(float oldv, float src) {
    return __int_as_float(__builtin_amdgcn_update_dpp(__float_as_int(oldv), __float_as_int(src), 0x110 + N, 0xf, 0xf, false));
}

template <int WIN>
__device__ __forceinline__ void pool_rows(const bf16_t* p, int pos0, LAS unsigned char* dst) {
    constexpr int NR = WIN + 3;
    v4u rp[NR];
#pragma unroll
    for (int k = 0; k < NR; ++k) { const int off = k - (WIN - 1); const int oc = (pos0 + off >= 0) ? off : -pos0; rp[k] = *(const v4u*)(p + (long)oc * IN_COLS); }
    __builtin_amdgcn_sched_barrier(0);
#pragma unroll
    for (int k = 0; k < WIN - 1; ++k) { if (pos0 + k - (WIN - 1) < 0) rp[k] = (v4u){0u, 0u, 0u, 0u}; }
    float S[8];
#pragma unroll
    for (int e = 0; e < 8; ++e) S[e] = 0.f;
#pragma unroll
    for (int k = 0; k < WIN - 1; ++k) {
        S[0] += __uint_as_float(rp[k].x << 16); S[1] += __uint_as_float(rp[k].x & 0xffff0000u); S[2] += __uint_as_float(rp[k].y << 16); S[3] += __uint_as_float(rp[k].y & 0xffff0000u);
        S[4] += __uint_as_float(rp[k].z << 16); S[5] += __uint_as_float(rp[k].z & 0xffff0000u); S[6] += __uint_as_float(rp[k].w << 16); S[7] += __uint_as_float(rp[k].w & 0xffff0000u);
    }
#pragma unroll
    for (int n = 0; n < 4; ++n) {
        const v4u xa = rp[n + WIN - 1];
        const float xn_[8] = {__uint_as_float(xa.x << 16), __uint_as_float(xa.x & 0xffff0000u), __uint_as_float(xa.y << 16), __uint_as_float(xa.y & 0xffff0000u),
                              __uint_as_float(xa.z << 16), __uint_as_float(xa.z & 0xffff0000u), __uint_as_float(xa.w << 16), __uint_as_float(xa.w & 0xffff0000u)};
#pragma unroll
        for (int e = 0; e < 8; ++e) S[e] += xn_[e];
        if (n > 0) { const v4u xo = rp[n - 1];
            S[0] -= __uint_as_float(xo.x << 16); S[1] -= __uint_as_float(xo.x & 0xffff0000u); S[2] -= __uint_as_float(xo.y << 16); S[3] -= __uint_as_float(xo.y & 0xffff0000u);
            S[4] -= __uint_as_float(xo.z << 16); S[5] -= __uint_as_float(xo.z & 0xffff0000u); S[6] -= __uint_as_float(xo.w << 16); S[7] -= __uint_as_float(xo.w & 0xffff0000u); }
        const int cnt = (pos0 + n + 1 < WIN) ? pos0 + n + 1 : WIN; const float inv = 1.0f / (float)cnt; float o[8];
#pragma unroll
        for (int e = 0; e < 8; ++e) o[e] = S[e] * inv - xn_[e];
        *(LAS v4u*)(dst + n * TROW) = pack8(o);
    }
}

template <int PH>
__device__ __forceinline__ void mix_unit(const MixArgs& A, LAS unsigned char* lds, int unit, int tid) {
    const int lane = tid & 63, wave = __builtin_amdgcn_readfirstlane(tid >> 6), j = lane & 15, q = lane >> 4;
    const int b = unit >> 5, c = unit & 31;
    const size_t t0 = (size_t)b * SEQ + c * CHUNK;
    LAS unsigned char* T0 = lds; LAS unsigned char* T1 = lds + TILE_BYTES; LAS unsigned char* Hw = lds + 2 * TILE_BYTES + wave * HTILE;
    const int cg = tid & 31, tg = tid >> 5, tl0 = tg * 4, pos0 = c * CHUNK + tl0;
    const bf16_t* prow = A.proj + (t0 + tl0) * IN_COLS + cg * 8;
    const unsigned char* sm = A.sm;
    const struct { unsigned char* ws; } F = {A.ws}; (void)F;
    typedef float f32x2_ __attribute__((ext_vector_type(2)));
    LAS f32x2_* cS5 = (LAS f32x2_*)(lds + CARRY_OFF);
    LAS float* cLru = (LAS float*)(lds + CARRY_OFF + 8192);
    if (PH == 2) {
        const float* atb = (const float*)(sm + SM_ATAB);
        const float a0r = atb[tid * 12 + 8], a0i = atb[tid * 12 + 9], a1r = atb[(tid + 512) * 12 + 8], a1i = atb[(tid + 512) * 12 + 9];
        float h0r = 0.f, h0i = 0.f, h1r = 0.f, h1i = 0.f, hl = 0.f;
        for (int j0 = 0; j0 < c; j0 += 16) {
            float2 s0[16], s1[16], sl[16];
#pragma unroll
            for (int u = 0; u < 16; ++u) { const int jj = (j0 + u < c) ? j0 + u : c - 1; const size_t cb = (size_t)b * NCHUNK + jj;
                s0[u] = A.s5st[cb * 1024 + tid]; s1[u] = A.s5st[cb * 1024 + 512 + tid]; sl[u] = A.lruS[cb * 256 + (tid & 255)]; }
            __builtin_amdgcn_sched_barrier(0);
#pragma unroll
            for (int u = 0; u < 16; ++u) if (j0 + u < c) {
                const float n0r = a0r * h0r - a0i * h0i + s0[u].x, n0i = a0r * h0i + a0i * h0r + s0[u].y; h0r = n0r; h0i = n0i;
                const float n1r = a1r * h1r - a1i * h1i + s1[u].x, n1i = a1r * h1i + a1i * h1r + s1[u].y; h1r = n1r; h1i = n1i;
                hl = sl[u].x * hl + sl[u].y; }
        }
        cS5[tid] = (f32x2_){h0r, h0i}; cS5[tid + 512] = (f32x2_){h1r, h1i};
        if (tid < 256) cLru[tid] = hl;
    }

    if (PH == 2) STAMP(52);
    if (PH == 2) {
        float w0[8], w1[8], w2[8];
        ldf8(A.conv_a_w + 0 * 256 + cg * 8, w0); ldf8(A.conv_a_w + 1 * 256 + cg * 8, w1); ldf8(A.conv_a_w + 2 * 256 + cg * 8, w2);
        float v[6][8];
#pragma unroll
        for (int i = 0; i < 6; ++i) {
            if (pos0 - 2 + i >= 0) { float ac[8], ax[8]; ld8(prow + (long)(i - 2) * IN_COLS + 256, ac); ld8(prow + (long)(i - 2) * IN_COLS + 512, ax);
#pragma unroll
                for (int e = 0; e < 8; ++e) v[i][e] = ac[e] * ax[e]; }
            else {
#pragma unroll
                for (int e = 0; e < 8; ++e) v[i][e] = 0.f; }
        }
#pragma unroll
        for (int n = 0; n < 4; ++n) {
            float ab[8], o[8]; ld8(prow + (long)n * IN_COLS, ab);
#pragma unroll
            for (int e = 0; e < 8; ++e) o[e] = ab[e] * (w0[e] * v[n][e] + w1[e] * v[n + 1][e] + w2[e] * v[n + 2][e]);
            *(v4u*)(A.ys + (t0 + tl0 + n) * 1024 + cg * 8) = pack8(o);
        }
    }
    if (PH == 2) {
        const int pg = wave & 3, pvec = lane & 7, ptl = ((lane >> 3) + 8 * (wave >> 2)) * 4, ppos = c * CHUNK + ptl;
        const bf16_t* pp = A.proj + (t0 + ptl) * IN_COLS + 768 + pg * 64 + pvec * 8;
        LAS unsigned char* pd = T0 + ptl * TROW + (pg * 64 + pvec * 8) * 2;
        if (pg == 0) pool_rows<2>(pp, ppos, pd); else if (pg == 1) pool_rows<4>(pp, ppos, pd); else if (pg == 2) pool_rows<8>(pp, ppos, pd); else pool_rows<16>(pp, ppos, pd);
    }
    if (PH == 1) {
        float w0[8], w1[8], w2[8], w3[8], cb[8];
        ldf8(A.lconv_w + 0 * 256 + cg * 8, w0); ldf8(A.lconv_w + 1 * 256 + cg * 8, w1); ldf8(A.lconv_w + 2 * 256 + cg * 8, w2); ldf8(A.lconv_w + 3 * 256 + cg * 8, w3); ldf8(A.lconv_b + cg * 8, cb);
        float x[7][8];
#pragma unroll
        for (int i = 0; i < 7; ++i) {
            if (pos0 - 3 + i >= 0) ld8(prow + (long)(i - 3) * IN_COLS + 1280, x[i]);
            else {
#pragma unroll
                for (int e = 0; e < 8; ++e) x[i][e] = 0.f; }
        }
#pragma unroll
        for (int n = 0; n < 4; ++n) {
            float o[8];
#pragma unroll
            for (int e = 0; e < 8; ++e) o[e] = w0[e] * x[n][e] + w1[e] * x[n + 1][e] + w2[e] * x[n + 2][e] + w3[e] * x[n + 3][e] + cb[e];
            *(LAS v4u*)(T1 + (tl0 + n) * TROW + cg * 16) = pack8(o);
        }
    }
    __syncthreads();
    if (PH == 2) STAMP(53);

    const int hd = wave >> 1, dt0 = 2 * (wave & 1);
    if (PH == 2) {
        const bf16_t* WT = (const bf16_t*)(sm + SM_POOLT) + hd * 4096;
        f32x4 acc[2][4];
#pragma unroll
        for (int d = 0; d < 2; ++d)
#pragma unroll
            for (int tt = 0; tt < 4; ++tt) acc[d][tt] = (f32x4){0.f, 0.f, 0.f, 0.f};
#pragma unroll
        for (int ks = 0; ks < 2; ++ks) {
            bf16x8 wf[2];
#pragma unroll
            for (int d = 0; d < 2; ++d) wf[d] = *(const bf16x8*)(WT + ((dt0 + d) * 16 + j) * 64 + ks * 32 + 8 * q);
#pragma unroll
            for (int tt = 0; tt < 4; ++tt) { const bf16x8 xf = *(const LAS bf16x8*)(T0 + (tt * 16 + j) * TROW + (hd * 64 + ks * 32 + 8 * q) * 2);
#pragma unroll
                for (int d = 0; d < 2; ++d) acc[d][tt] = mma16(wf[d], xf, acc[d][tt]); }
        }
#pragma unroll
        for (int d = 0; d < 2; ++d) {
            const int ch0 = hd * 64 + (dt0 + d) * 16 + 4 * q;
            const f32x4 pb = *(const f32x4*)(A.pool_b + ch0), ps = *(const f32x4*)(A.pool_scale + ch0);
#pragma unroll
            for (int tt = 0; tt < 4; ++tt) { const f32x4 o = (acc[d][tt] + pb) * ps; v2u w; w.x = pk2(o.x, o.y); w.y = pk2(o.z, o.w);
                *(v2u*)(A.ys + (t0 + tt * 16 + j) * 1024 + 256 + ch0) = w; }
        }
    }
    if (PH == 2) STAMP(54);
    if (PH == 1) {
        const bf16_t* WA = (const bf16_t*)(sm + SM_WAT) + hd * 4096; const bf16_t* WX = (const bf16_t*)(sm + SM_WXT) + hd * 4096;
        f32x4 ga[2][4], gx[2][4];
#pragma unroll
        for (int d = 0; d < 2; ++d)
#pragma unroll
            for (int tt = 0; tt < 4; ++tt) { ga[d][tt] = (f32x4){0.f, 0.f, 0.f, 0.f}; gx[d][tt] = (f32x4){0.f, 0.f, 0.f, 0.f}; }
#pragma unroll
        for (int ks = 0; ks < 2; ++ks) {
            bf16x8 wa[2], wx[2];
#pragma unroll
            for (int d = 0; d < 2; ++d) { wa[d] = *(const bf16x8*)(WA + ((dt0 + d) * 16 + j) * 64 + ks * 32 + 8 * q); wx[d] = *(const bf16x8*)(WX + ((dt0 + d) * 16 + j) * 64 + ks * 32 + 8 * q); }
#pragma unroll
            for (int tt = 0; tt < 4; ++tt) { const bf16x8 xf = *(const LAS bf16x8*)(T1 + (tt * 16 + j) * TROW + (hd * 64 + ks * 32 + 8 * q) * 2);
#pragma unroll
                for (int d = 0; d < 2; ++d) { ga[d][tt] = mma16(wa[d], xf, ga[d][tt]); gx[d][tt] = mma16(wx[d], xf, gx[d][tt]); } }
        }
#pragma unroll
        for (int d = 0; d < 2; ++d) {
            const int ch0 = hd * 64 + (dt0 + d) * 16 + 4 * q;
            const f32x4 bav = *(const f32x4*)(A.ba + ch0), bxv = *(const f32x4*)(A.bx + ch0), nlg = *(const f32x4*)(A.tab + TB_NLOG + ch0);
            float hin[4] = {0.f, 0.f, 0.f, 0.f}, aprod[4] = {1.f, 1.f, 1.f, 1.f};
#pragma unroll
            for (int tt = 0; tt < 4; ++tt) {
                const v2u xcw = *(const LAS v2u*)(T1 + (tt * 16 + j) * TROW + ch0 * 2);
                const float xc[4] = {__uint_as_float(xcw.x << 16), __uint_as_float(xcw.x & 0xffff0000u), __uint_as_float(xcw.y << 16), __uint_as_float(xcw.y & 0xffff0000u)};
                v4u pk;
#pragma unroll
                for (int r = 0; r < 4; ++r) {
                    const float rg = sigmoidf_(ga[d][tt][r] + bav[r]), ig = sigmoidf_(gx[d][tt][r] + bxv[r]);
                    const float la = nlg[r] * rg; float av = __expf(la); const float mult = sqrtf(fmaxf(1.0f - av * av, 0.f));
                    float bv = mult * ig * xc[r];
                    { const float ap = dpp_row_shr<1>(1.f, av), bp = dpp_row_shr<1>(0.f, bv); bv = av * bp + bv; av = av * ap; }
                    { const float ap = dpp_row_shr<2>(1.f, av), bp = dpp_row_shr<2>(0.f, bv); bv = av * bp + bv; av = av * ap; }
                    { const float ap = dpp_row_shr<4>(1.f, av), bp = dpp_row_shr<4>(0.f, bv); bv = av * bp + bv; av = av * ap; }
                    { const float ap = dpp_row_shr<8>(1.f, av), bp = dpp_row_shr<8>(0.f, bv); bv = av * bp + bv; av = av * ap; }
                    const float h = bv + av * hin[r], ac = av * aprod[r];
                    pk[r] = pk2(h, ac);
                    hin[r] = __shfl(h, (lane & 48) | 15); aprod[r] = __shfl(ac, (lane & 48) | 15);
                }
                *(v4u*)(A.lrup + (t0 + tt * 16 + j) * 256 + ch0) = pk;
            }
            if (j == 15) {
                float2* sp = A.lruS + ((size_t)b * NCHUNK + c) * 256 + ch0;
#pragma unroll
                for (int r = 0; r < 4; ++r) sp[r] = make_float2(aprod[r], hin[r]);
            }
        }
    }
    if (PH == 2) {
#pragma unroll
        for (int d = 0; d < 2; ++d) {
            const int ch0 = hd * 64 + (dt0 + d) * 16 + 4 * q;
            float hin[4];
#pragma unroll
            for (int r = 0; r < 4; ++r) hin[r] = cLru[ch0 + r];
            v4u pk[4]; v2u gw[4];
#pragma unroll
            for (int tt = 0; tt < 4; ++tt) { pk[tt] = *(const v4u*)(A.lrup + (t0 + tt * 16 + j) * 256 + ch0); gw[tt] = *(const v2u*)(A.proj + (t0 + tt * 16 + j) * IN_COLS + 1536 + ch0); }
#pragma unroll
            for (int tt = 0; tt < 4; ++tt) {
                const float g0 = gelu_tanh(__uint_as_float(gw[tt].x << 16)), g1 = gelu_tanh(__uint_as_float(gw[tt].x & 0xffff0000u)), g2 = gelu_tanh(__uint_as_float(gw[tt].y << 16)), g3 = gelu_tanh(__uint_as_float(gw[tt].y & 0xffff0000u));
                float hv[4];
#pragma unroll
                for (int r = 0; r < 4; ++r) hv[r] = __uint_as_float(pk[tt][r] << 16) + __uint_as_float(pk[tt][r] & 0xffff0000u) * hin[r];
                v2u w; w.x = pk2(hv[0] * g0, hv[1] * g1); w.y = pk2(hv[2] * g2, hv[3] * g3);
                *(v2u*)(A.ys + (t0 + tt * 16 + j) * 1024 + 768 + ch0) = w;
            }
        }
    }
    if (PH == 2) STAMP(55);
    __syncthreads();

#pragma unroll
    for (int n = 0; n < 4; ++n) *(LAS v4u*)(T0 + (tl0 + n) * TROW + cg * 16) = *(const v4u*)(prow + (long)n * IN_COLS + 1024);
    __syncthreads();
    const bf16x8 zf = (bf16x8){0, 0, 0, 0, 0, 0, 0, 0};
    if (PH == 2) STAMP(56);
#pragma unroll 1
    for (int gi = 0; gi < 2; ++gi) {
        const int g = wave * 2 + gi;
        float ar[4], ai[4], a4r[4], a4i[4], a8r[4], a8i[4], aqr[4], aqi[4], hr[4], hi[4];
        bf16x8 bref[4], bimf[4];
#pragma unroll
        for (int st = 0; st < 4; ++st) {
            const int si = g * 64 + st * 16 + j;
            const float* at = (const float*)(sm + SM_ATAB) + si * 12;
            const f32x4 t0v = *(const f32x4*)at, t1v = *(const f32x4*)(at + 4);
            ar[st] = t0v.x; ai[st] = t0v.y; a4r[st] = t0v.z; a4i[st] = t0v.w; a8r[st] = t1v.x; a8i[st] = t1v.y;
            aqr[st] = q == 0 ? 1.f : (q == 1 ? t0v.z : (q == 2 ? t1v.x : t1v.z));
            aqi[st] = q == 0 ? 0.f : (q == 1 ? t0v.w : (q == 2 ? t1v.y : t1v.w));
            hr[st] = 0.f; hi[st] = 0.f;
            if (PH == 2) { const f32x2_ cv = cS5[si]; hr[st] = cv.x; hi[st] = cv.y; }
            bref[st] = (q < 2) ? *(const bf16x8*)((const bf16_t*)(sm + SM_BRE) + si * 16 + 8 * q) : zf;
            bimf[st] = (q < 2) ? *(const bf16x8*)((const bf16_t*)(sm + SM_BIM) + si * 16 + 8 * q) : zf;
        }
        bf16x8 cf[4];
        if (PH == 2) {
#pragma unroll
            for (int ks = 0; ks < 4; ++ks) cf[ks] = *(const bf16x8*)((const bf16_t*)(sm + SM_CMAT) + (g * 16 + j) * 128 + ks * 32 + 8 * q);
        }
        const f32x4 dv = *(const f32x4*)(A.s5_d + g * 16 + 4 * q);
#pragma unroll 1
        for (int tt = 0; tt < 4; ++tt) {
            const bf16x8 uf = (q < 2) ? *(const LAS bf16x8*)(T0 + (tt * 16 + j) * TROW + (g * 16 + 8 * q) * 2) : zf;
#pragma unroll
            for (int st = 0; st < 4; ++st) {
                const f32x4 z4 = (f32x4){0.f, 0.f, 0.f, 0.f};
                const f32x4 dre = mma16(uf, bref[st], z4), dim = mma16(uf, bimf[st], z4);
                float er = dre[0], ei = dim[0];
#pragma unroll
                for (int r = 1; r < 4; ++r) { const float nr = ar[st] * er - ai[st] * ei + dre[r], ni = ar[st] * ei + ai[st] * er + dim[r]; er = nr; ei = ni; }
                float x1r = __shfl_up(er, 16), x1i = __shfl_up(ei, 16), x2r = __shfl_up(er, 32), x2i = __shfl_up(ei, 32), x3r = __shfl_up(er, 48), x3i = __shfl_up(ei, 48);
                if (q < 1) { x1r = 0.f; x1i = 0.f; } if (q < 2) { x2r = 0.f; x2i = 0.f; } if (q < 3) { x3r = 0.f; x3i = 0.f; }
                float pr = x1r + (a4r[st] * x2r - a4i[st] * x2i) + (a8r[st] * x3r - a8i[st] * x3i) + (aqr[st] * hr[st] - aqi[st] * hi[st]);
                float pi = x1i + (a4r[st] * x2i + a4i[st] * x2r) + (a8r[st] * x3i + a8i[st] * x3r) + (aqr[st] * hi[st] + aqi[st] * hr[st]);
#pragma unroll
                for (int r = 0; r < 4; ++r) {
                    const float nr = ar[st] * pr - ai[st] * pi + dre[r], ni = ar[st] * pi + ai[st] * pr + dim[r]; pr = nr; pi = ni;
                    if (PH == 2) *(LAS unsigned*)(Hw + (4 * q + r) * HROW + (st * 16 + j) * 4) = pk2(nr, ni);
                }
                hr[st] = __shfl(pr, 48 + j); hi[st] = __shfl(pi, 48 + j);
            }
            if (PH == 2) {
                f32x4 y = (f32x4){0.f, 0.f, 0.f, 0.f};
#pragma unroll
                for (int ks = 0; ks < 4; ++ks) { const bf16x8 hf = *(const LAS bf16x8*)(Hw + j * HROW + (ks * 32 + 8 * q) * 2); y = mma16(cf[ks], hf, y); }
                const v2u uw = *(const LAS v2u*)(T0 + (tt * 16 + j) * TROW + (g * 16 + 4 * q) * 2);
                const float y0 = gelu_tanh(y[0] + dv[0] * __uint_as_float(uw.x << 16)), y1 = gelu_tanh(y[1] + dv[1] * __uint_as_float(uw.x & 0xffff0000u));
                const float y2 = gelu_tanh(y[2] + dv[2] * __uint_as_float(uw.y << 16)), y3 = gelu_tanh(y[3] + dv[3] * __uint_as_float(uw.y & 0xffff0000u));
                v2u w; w.x = pk2(y0, y1); w.y = pk2(y2, y3);
                *(LAS v2u*)(T1 + (tt * 16 + j) * TROW + (g * 16 + 4 * q) * 2) = w;
            }
        }
        if (PH == 1 && q == 0) {
#pragma unroll
            for (int st = 0; st < 4; ++st) A.s5st[((size_t)b * NCHUNK + c) * 1024 + g * 64 + st * 16 + j] = make_float2(hr[st], hi[st]);
        }
    }
    if (PH == 2) {
        STAMP(57);
        __syncthreads();
        STAMP(58);
        const bf16_t* GT = (const bf16_t*)(sm + SM_GLUT);
        f32x4 acc[2][4];
#pragma unroll
        for (int d = 0; d < 2; ++d)
#pragma unroll
            for (int tt = 0; tt < 4; ++tt) acc[d][tt] = (f32x4){0.f, 0.f, 0.f, 0.f};
#pragma unroll 2
        for (int ks = 0; ks < 8; ++ks) {
            bf16x8 wf[2];
#pragma unroll
            for (int d = 0; d < 2; ++d) wf[d] = *(const bf16x8*)(GT + ((wave * 2 + d) * 16 + j) * 256 + ks * 32 + 8 * q);
#pragma unroll
            for (int tt = 0; tt < 4; ++tt) { const bf16x8 xf = *(const LAS bf16x8*)(T1 + (tt * 16 + j) * TROW + (ks * 32 + 8 * q) * 2);
#pragma unroll
                for (int d = 0; d < 2; ++d) acc[d][tt] = mma16(wf[d], xf, acc[d][tt]); }
        }
#pragma unroll
        for (int d = 0; d < 2; ++d) {
            const int col0 = (wave * 2 + d) * 16 + 4 * q;
            const f32x4 gb = *(const f32x4*)(A.glu_b + col0);
#pragma unroll
            for (int tt = 0; tt < 4; ++tt) {
                const v2u yw = *(const LAS v2u*)(T1 + (tt * 16 + j) * TROW + col0 * 2);
                const f32x4 s = acc[d][tt] + gb;
                v2u w; w.x = pk2(__uint_as_float(yw.x << 16) * sigmoidf_(s.x), __uint_as_float(yw.x & 0xffff0000u) * sigmoidf_(s.y));
                w.y = pk2(__uint_as_float(yw.y << 16) * sigmoidf_(s.z), __uint_as_float(yw.y & 0xffff0000u) * sigmoidf_(s.w));
                *(v2u*)(A.ys + (t0 + tt * 16 + j) * 1024 + 512 + col0) = w;
            }
        }
    }
    __syncthreads();
}

__device__ __forceinline__ void router_phase(Frame& F, const bf16_t* h, const float* g2, const float* Wp, const float* rgb, const float* reb,
                                             bf16_t* xn, unsigned* cnt, int* buf_ts, float* buf_w) {
    LAS float* part = (LAS float*)(F.lds);
    LAS float* lg = (LAS float*)(F.lds + 98304);
    LAS float* rs = (LAS float*)(F.lds + 98304 + 12288);
    const int lane = F.lane, wave = F.wave, tid = F.tid, j = lane & 15, q = lane >> 4;
    for (int blk = blockIdx.x; blk < T / 64; blk += F.G) {
        const int m0 = blk * 64;
        f32x4 v[8][4];
#pragma unroll
        for (int i = 0; i < 8; ++i)
#pragma unroll
            for (int jj = 0; jj < 4; ++jj) { const uint2 hv = *(const uint2*)(h + (size_t)(m0 + wave * 8 + i) * D + 4 * lane + 256 * jj);
                v[i][jj] = (f32x4){__uint_as_float(hv.x << 16), __uint_as_float(hv.x & 0xffff0000u), __uint_as_float(hv.y << 16), __uint_as_float(hv.y & 0xffff0000u)}; }
        {
            f32x4 gg[4];
#pragma unroll
            for (int jj = 0; jj < 4; ++jj) gg[jj] = *(const f32x4*)(g2 + 4 * lane + 256 * jj);
            __builtin_amdgcn_sched_barrier(0);
#pragma unroll
            for (int i = 0; i < 8; ++i) {
                float s = 0.f;
#pragma unroll
                for (int jj = 0; jj < 4; ++jj) s += v[i][jj].x * v[i][jj].x + v[i][jj].y * v[i][jj].y + v[i][jj].z * v[i][jj].z + v[i][jj].w * v[i][jj].w;
#pragma unroll
                for (int o = 1; o < 64; o <<= 1) s += __shfl_xor(s, o);
                const float rstd = rsqrtf(s * (1.0f / D) + EPS);
                if (lane == 0) rs[wave * 8 + i] = rstd;
#pragma unroll
                for (int jj = 0; jj < 4; ++jj) {
                    const f32x4 o = v[i][jj] * rstd * gg[jj];
                    *(unsigned*)((unsigned char*)xn + (size_t)(m0 + wave * 8 + i) * D + 4 * lane + 256 * jj) = pk4_fp8(o.x, o.y, o.z, o.w);
                }
            }
        }
        STAMP(48);
        f32x4 acc[3][4];
#pragma unroll
        for (int ot = 0; ot < 3; ++ot)
#pragma unroll
            for (int tt = 0; tt < 4; ++tt) acc[ot][tt] = (f32x4){0.f, 0.f, 0.f, 0.f};
        LAS float* xq = (LAS float*)(F.lds);
        const bf16_t* WH = (const bf16_t*)Wp; const bf16_t* WL = WH + 49152;
#pragma unroll
        for (int kq = 0; kq < 4; ++kq) {
            bf16x8 wh[3], wl[3];
#pragma unroll
            for (int ot = 0; ot < 3; ++ot) { wh[ot] = *(const bf16x8*)(WH + (size_t)(ot * 16 + j) * 1024 + kq * 256 + wave * 32 + 8 * q); wl[ot] = *(const bf16x8*)(WL + (size_t)(ot * 16 + j) * 1024 + kq * 256 + wave * 32 + 8 * q); }
            if (kq) __syncthreads();
#pragma unroll
            for (int i = 0; i < 8; ++i) *(LAS f32x4*)(xq + (wave * 8 + i) * 260 + 4 * lane) = v[i][kq];
            __builtin_amdgcn_sched_barrier(0);
            __syncthreads();
#pragma unroll
            for (int tt = 0; tt < 4; ++tt) {
                const f32x4 x0 = *(const LAS f32x4*)(xq + (tt * 16 + j) * 260 + wave * 32 + 8 * q), x1 = *(const LAS f32x4*)(xq + (tt * 16 + j) * 260 + wave * 32 + 8 * q + 4);
                const float xv[8] = {x0.x, x0.y, x0.z, x0.w, x1.x, x1.y, x1.z, x1.w};
                unsigned hp[4], lp[4];
#pragma unroll
                for (int p = 0; p < 4; ++p) {
                    const unsigned h0 = f2bfu(xv[2 * p]), h1 = f2bfu(xv[2 * p + 1]);
                    hp[p] = h0 | (h1 << 16);
                    lp[p] = pk2(xv[2 * p] - __uint_as_float(h0 << 16), xv[2 * p + 1] - __uint_as_float(h1 << 16));
                }
                const bf16x8 xh = __builtin_bit_cast(bf16x8, (v4u){hp[0], hp[1], hp[2], hp[3]}), xl = __builtin_bit_cast(bf16x8, (v4u){lp[0], lp[1], lp[2], lp[3]});
#pragma unroll
                for (int ot = 0; ot < 3; ++ot) { acc[ot][tt] = mma16(wh[ot], xh, acc[ot][tt]); acc[ot][tt] = mma16(wh[ot], xl, acc[ot][tt]); acc[ot][tt] = mma16(wl[ot], xh, acc[ot][tt]); }
            }
        }
        __syncthreads();
#pragma unroll
        for (int ot = 0; ot < 3; ++ot)
#pragma unroll
            for (int tt = 0; tt < 4; ++tt) *(LAS f32x4*)(part + ((wave * 12 + ot * 4 + tt) * 64 + lane) * 4) = acc[ot][tt];
        STAMP(49);
        __syncthreads();
        STAMP(50);
        for (int idx = tid; idx < 12 * 256; idx += 512) {
            const int tile = idx >> 8, ln = (idx >> 2) & 63, r = idx & 3, ot = tile >> 2, tt = tile & 3;
            float s = 0.f;
#pragma unroll
            for (int w = 0; w < 8; ++w) s += part[(w * 12 + tile) * 256 + (idx & 255)];
            const int tok = tt * 16 + (ln & 15), o = ot * 16 + 4 * (ln >> 4) + r;
            lg[tok * 48 + o] = s * rs[tok];
        }
        __syncthreads();
        STAMP(51);
        if (tid < 64) {
            const int m = m0 + tid;
            float gl[4], mx = -1e30f; int gi = 0;
#pragma unroll
            for (int i = 0; i < 4; ++i) { gl[i] = lg[tid * 48 + i] + rgb[i]; if (gl[i] > mx) { mx = gl[i]; gi = i; } }
            float den = 0.f;
#pragma unroll
            for (int i = 0; i < 4; ++i) den += __expf(gl[i] - mx);
            const float gval = 1.0f / den;
            float v1 = -1e30f, v2 = -1e30f; int i1 = 0, i2 = 0;
            for (int i = 0; i < 8; ++i) { const float el = lg[tid * 48 + 4 + gi * 8 + i] + reb[gi * 8 + i]; if (el > v1) { v2 = v1; i2 = i1; v1 = el; i1 = i; } else if (el > v2) { v2 = el; i2 = i; } }
            const float e2 = __expf(v2 - v1), w1 = gval / (1.0f + e2), w2 = gval * e2 / (1.0f + e2);
            const int ex1 = gi * 8 + i1, ex2 = gi * 8 + i2;
            const unsigned r1 = atomicAdd(&cnt[ex1 * 64], 1u), r2 = atomicAdd(&cnt[ex2 * 64], 1u);
            buf_ts[ex1 * CAP + r1] = m * 2 + 0; buf_w[ex1 * CAP + r1] = w1;
            buf_ts[ex2 * CAP + r2] = m * 2 + 1; buf_w[ex2 * CAP + r2] = w2;
        }
        __syncthreads();
    }
}

__device__ __forceinline__ void build_plan(Frame& F, const unsigned* cnt) {
    LAS int* plan = (LAS int*)(F.lds + PLAN_OFF);
    if (F.tid < 64) {
        const int e = F.tid & 31;
        const int ce = (int)__hip_atomic_load(cnt + e * 64, RLX_AGENT);
        const int nf = ce >> 8, rem = ce & 255, big = rem > 128 ? 1 : 0, sml = (rem > 0 && rem <= 128) ? 1 : 0;
        int pf = nf, pb = big, ps = sml;
#pragma unroll
        for (int o = 1; o < 32; o <<= 1) { const int a = __shfl_up(pf, o, 32), b = __shfl_up(pb, o, 32), c = __shfl_up(ps, o, 32); if (e >= o) { pf += a; pb += b; ps += c; } }
        const int NF = __shfl(pf, 31, 32), NB = __shfl(pb, 31, 32), NS = __shfl(ps, 31, 32);
        if (F.tid < 32) {
            plan[321 + e] = ce;
            for (int jb = 0; jb < nf; ++jb) { const int p = pf - nf + jb; if (p < MAXBLK) { plan[1 + p] = e; plan[1 + MAXBLK + p] = jb; } }
            if (big) { const int p = NF + pb - 1; if (p < MAXBLK) { plan[1 + p] = e; plan[1 + MAXBLK + p] = nf; } }
            if (sml) { const int p = NF + NB + ps - 1; if (p < MAXBLK) { plan[1 + p] = e; plan[1 + MAXBLK + p] = nf; } }
            if (e == 0) { const int tot = NF + NB + NS; plan[0] = tot < MAXBLK ? tot : MAXBLK; }
        }
    }
    __syncthreads();
}

struct DenseSched {
    static constexpr bool GATHER = false, HALF = false, WAITS = false, PUBLISHES = false;
    pg8::StaticOrder ord; const char* A; const char* Bt; int lda, K; int a_sh, a_cs; int es;
    __device__ __forceinline__ bool next(int i, pg8::Unit& u) const { return ord.next(i, u); }
    __device__ __forceinline__ const char* a_base(const pg8::Unit& u) const { return A + (size_t)u.pm * 256 * lda * es + (size_t)((u.pn >> a_sh) * a_cs); }
    __device__ __forceinline__ const char* b_base(const pg8::Unit& u) const { return Bt + (size_t)u.pn * 256 * K * es; }
    __device__ __forceinline__ unsigned gather_off(const pg8::Unit&, int) const { return 0u; }
    __device__ __forceinline__ bool half_only(const pg8::Unit&) const { return false; }
};
struct Moe1Sched {
    static constexpr bool GATHER = true, HALF = true, WAITS = false, PUBLISHES = false;
    const char* xn; const char* w13; const LAS int* plan; const int* buf_ts; int G, c, lda; unsigned* ready;
    __device__ __forceinline__ void done(const pg8::Unit& u) const { asm volatile("s_waitcnt vmcnt(0)" ::: "memory"); if ((threadIdx.x & 63) == 0) __hip_atomic_fetch_add(ready + 16 * u.pm, 1u, RLX_AGENT); }
    __device__ __forceinline__ bool next(int i, pg8::Unit& u) const { const int L = i * G + c; if (L >= 4 * plan[0]) return false; u.pm = L >> 2; u.pn = L & 3; return true; }
    __device__ __forceinline__ const char* a_base(const pg8::Unit&) const { return xn; }
    __device__ __forceinline__ const char* b_base(const pg8::Unit& u) const { return w13 + (size_t)plan[1 + u.pm] * (1024 * 1024) + (size_t)u.pn * (256 * 1024); }
    __device__ __forceinline__ unsigned gather_off(const pg8::Unit& u, int r) const {
        const int e = plan[1 + u.pm], lb = plan[1 + MAXBLK + u.pm], ce = plan[321 + e];
        int pos = lb * 256 + r; pos = pos < ce ? pos : ce - 1;
        return (unsigned)(buf_ts[e * CAP + pos] >> 1) * (unsigned)D;
    }
    __device__ __forceinline__ bool half_only(const pg8::Unit& u) const { const int e = plan[1 + u.pm], lb = plan[1 + MAXBLK + u.pm]; return plan[321 + e] - lb * 256 <= 128; }
};
struct Moe2Sched {
    static constexpr bool GATHER = false, HALF = true, WAITS = false, PUBLISHES = false;
    const char* hbuf; const char* w2t; const LAS int* plan; int G, c, lda; const unsigned* ready; unsigned* tmo;
    __device__ __forceinline__ void a_ready(const pg8::Unit& u) const {
        if (threadIdx.x < 64) {
            const unsigned long long t0 = __builtin_amdgcn_s_memrealtime(); unsigned polls = 0;
            while ((unsigned)__builtin_amdgcn_readfirstlane(__hip_atomic_load(ready + 16 * u.pm, RLX_AGENT)) < 32u) {
                if ((++polls & 255u) == 0u && __builtin_amdgcn_readfirstlane(__hip_atomic_load(tmo, RLX_AGENT)) != 0u) break;
                if (__builtin_amdgcn_s_memrealtime() - t0 > 2000000ull) { if (threadIdx.x == 0) __hip_atomic_store(tmo, 1u, RLX_AGENT); break; }
                __builtin_amdgcn_s_sleep(2); }
            __builtin_amdgcn_fence(__ATOMIC_ACQUIRE, "agent");
            asm volatile("s_waitcnt vmcnt(0)" ::: "memory");
        }
        asm volatile("" ::: "memory"); __builtin_amdgcn_s_barrier(); asm volatile("" ::: "memory");
    }
    __device__ __forceinline__ bool next(int i, pg8::Unit& u) const { const int L = i * G + c; if (L >= 4 * plan[0]) return false; u.pm = L >> 2; u.pn = L & 3; return true; }
    __device__ __forceinline__ const char* a_base(const pg8::Unit& u) const { return hbuf + (size_t)u.pm * 256 * DEXP; }
    __device__ __forceinline__ const char* b_base(const pg8::Unit& u) const { return w2t + (size_t)plan[1 + u.pm] * (1024 * 512) + (size_t)u.pn * (256 * 512); }
    __device__ __forceinline__ unsigned gather_off(const pg8::Unit&, int) const { return 0u; }
    __device__ __forceinline__ bool half_only(const pg8::Unit& u) const { const int e = plan[1 + u.pm], lb = plan[1 + MAXBLK + u.pm]; return plan[321 + e] - lb * 256 <= 128; }
};

using pg8::f32x4; using pg8::u32x4; using pg8::u32x2; using pg8::cvt_pk_bf16; using pg8::Unit; using pg8::HALF; using pg8::BM;
struct EpiStoreBf16 {
    static constexpr bool PERM = true;
    bf16_t* O; int ldc;
    __device__ __forceinline__ void operator()(const f32x4 (&acc)[2][2][4][2], const Unit& u, int wr, int wc, int fr, int fq) const {
        const int row0 = u.pm * BM + wr * 64 + fr, col0 = u.pn * BM + wc * 32 + 8 * fq;
#pragma unroll
        for (int ai = 0; ai < 2; ++ai)
#pragma unroll
            for (int m = 0; m < 4; ++m) { bf16_t* rowp = O + (size_t)(row0 + ai * HALF + m * 16) * ldc + col0;
#pragma unroll
                for (int bj = 0; bj < 2; ++bj) { const f32x4 v0 = acc[ai][bj][m][0], v1 = acc[ai][bj][m][1];
                    u32x4 w; w.x = cvt_pk_bf16(v0[0], v0[1]); w.y = cvt_pk_bf16(v0[2], v0[3]); w.z = cvt_pk_bf16(v1[0], v1[1]); w.w = cvt_pk_bf16(v1[2], v1[3]);
                    *(u32x4*)(rowp + bj * HALF) = w; } }
    }
};
struct EpiGateMerge {
    static constexpr bool PERM = false;
    const float* bias; const bf16_t* br; bf16_t* merged;
    __device__ __forceinline__ void operator()(const f32x4 (&acc)[2][2][4][2], const Unit& u, int wr, int wc, int fr, int fq) const {
        const int row0 = u.pm * BM + wr * 64 + fr, d0 = u.pn * 64 + wc * 16 + 4 * fq;
        f32x4 bv[4];
#pragma unroll
        for (int k4 = 0; k4 < 4; ++k4) bv[k4] = *(const f32x4*)(bias + k4 * 1024 + d0);
#pragma unroll
        for (int ai = 0; ai < 2; ++ai)
#pragma unroll
            for (int m = 0; m < 4; ++m) {
                const size_t row = (size_t)(row0 + ai * HALF + m * 16);
                f32x4 s = (f32x4){0.f, 0.f, 0.f, 0.f};
#pragma unroll
                for (int k4 = 0; k4 < 4; ++k4) {
                    const u32x2 b2 = *(const u32x2*)(br + row * 4096 + k4 * 1024 + d0);
                    const f32x4 a = acc[ai][k4 >> 1][m][k4 & 1] * (1.0f / MG_SCALE) + bv[k4];
                    s[0] += sigmoidf_(a[0]) * __uint_as_float(b2.x << 16);
                    s[1] += sigmoidf_(a[1]) * __uint_as_float(b2.x & 0xffff0000u);
                    s[2] += sigmoidf_(a[2]) * __uint_as_float(b2.y << 16);
                    s[3] += sigmoidf_(a[3]) * __uint_as_float(b2.y & 0xffff0000u);
                }
                u32x2 w; w.x = cvt_pk_bf16(s[0], s[1]); w.y = cvt_pk_bf16(s[2], s[3]);
                *(u32x2*)(merged + row * D + d0) = w;
            }
    }
};
template <bool SRC_F32>
struct EpiAddH {
    static constexpr bool PERM = true;
    const void* hsrc; bf16_t* hdst;
    __device__ __forceinline__ void operator()(const f32x4 (&acc)[2][2][4][2], const Unit& u, int wr, int wc, int fr, int fq) const {
        const int row0 = u.pm * BM + wr * 64 + fr, col0 = u.pn * BM + wc * 32 + 8 * fq;
#pragma unroll
        for (int ai = 0; ai < 2; ++ai)
#pragma unroll
            for (int m = 0; m < 4; ++m) { const size_t ro = (size_t)(row0 + ai * HALF + m * 16) * D + col0;
#pragma unroll
                for (int bj = 0; bj < 2; ++bj) {
                    f32x4 r0, r1;
                    if (SRC_F32) { r0 = *(const f32x4*)((const float*)hsrc + ro + bj * HALF); r1 = *(const f32x4*)((const float*)hsrc + ro + bj * HALF + 4); }
                    else { const u32x4 hv = *(const u32x4*)((const bf16_t*)hsrc + ro + bj * HALF);
                        r0 = (f32x4){__uint_as_float(hv.x << 16), __uint_as_float(hv.x & 0xffff0000u), __uint_as_float(hv.y << 16), __uint_as_float(hv.y & 0xffff0000u)};
                        r1 = (f32x4){__uint_as_float(hv.z << 16), __uint_as_float(hv.z & 0xffff0000u), __uint_as_float(hv.w << 16), __uint_as_float(hv.w & 0xffff0000u)}; }
                    const f32x4 v0 = acc[ai][bj][m][0] + r0, v1 = acc[ai][bj][m][1] + r1;
                    u32x4 w; w.x = cvt_pk_bf16(v0[0], v0[1]); w.y = cvt_pk_bf16(v0[2], v0[3]); w.z = cvt_pk_bf16(v1[0], v1[1]); w.w = cvt_pk_bf16(v1[2], v1[3]);
                    *(u32x4*)(hdst + ro + bj * HALF) = w; } }
    }
};
struct EpiMoe1 {
    static constexpr bool PERM = false;
    unsigned char* hbuf;
    __device__ __forceinline__ void operator()(const f32x4 (&acc)[2][2][4][2], const Unit& u, int wr, int wc, int fr, int fq) const {
        const int row0 = u.pm * BM + wr * 64 + fr, h0 = u.pn * 128 + wc * 16 + 4 * fq;
        const float si = 1.0f / W13_SCALE;
#pragma unroll
        for (int ai = 0; ai < 2; ++ai)
#pragma unroll
            for (int m = 0; m < 4; ++m) { unsigned char* rowp = hbuf + (size_t)(row0 + ai * HALF + m * 16) * DEXP + h0;
#pragma unroll
                for (int bj = 0; bj < 2; ++bj) { const f32x4 a1 = acc[ai][bj][m][0] * si, a3 = acc[ai][bj][m][1] * (si * H_SCALE);
                    const unsigned w = pk4_fp8(a1[0] * sigmoidf_(a1[0]) * a3[0], a1[1] * sigmoidf_(a1[1]) * a3[1], a1[2] * sigmoidf_(a1[2]) * a3[2], a1[3] * sigmoidf_(a1[3]) * a3[3]);
                    *(unsigned*)(rowp + bj * 64) = w; } }
    }
};
struct EpiMoe2 {
    static constexpr bool PERM = true;
    bf16_t* ymoe; const LAS int* plan; const int* buf_ts; const float* buf_w;
    __device__ __forceinline__ void operator()(const f32x4 (&acc)[2][2][4][2], const Unit& u, int wr, int wc, int fr, int fq) const {
        const int e = plan[1 + u.pm], lb = plan[1 + MAXBLK + u.pm], ce = plan[321 + e];
        const int col0 = u.pn * BM + wc * 32 + 8 * fq;
        int ts[2][4]; float wt[2][4];
#pragma unroll
        for (int ai = 0; ai < 2; ++ai)
#pragma unroll
            for (int m = 0; m < 4; ++m) {
                const int pos = lb * 256 + ai * HALF + wr * 64 + m * 16 + fr; const int pc = pos < ce ? pos : ce - 1;
                ts[ai][m] = buf_ts[e * CAP + pc]; wt[ai][m] = buf_w[e * CAP + pc] * (1.0f / (W2_SCALE * H_SCALE));
                if (pos >= ce) ts[ai][m] = -1;
            }
        __builtin_amdgcn_sched_barrier(0);
#pragma unroll
        for (int ai = 0; ai < 2; ++ai)
#pragma unroll
            for (int m = 0; m < 4; ++m) {
                if (ts[ai][m] >= 0) {
                    bf16_t* rowp = ymoe + (size_t)ts[ai][m] * D + col0; const float w_ = wt[ai][m];
#pragma unroll
                    for (int bj = 0; bj < 2; ++bj) { const f32x4 v0 = acc[ai][bj][m][0] * w_, v1 = acc[ai][bj][m][1] * w_;
                        u32x4 w; w.x = cvt_pk_bf16(v0[0], v0[1]); w.y = cvt_pk_bf16(v0[2], v0[3]); w.z = cvt_pk_bf16(v1[0], v1[1]); w.w = cvt_pk_bf16(v1[2], v1[3]);
                        *(u32x4*)(rowp + bj * HALF) = w; }
                }
            }
    }
};

__device__ __forceinline__ void make_mix_args(MixArgs& A, const Args& args, unsigned char* ws, int l) {
    A.proj = (const bf16_t*)(ws + WS_PROJ); A.ys = (bf16_t*)(ws + WS_YS); A.tab = (const float*)(ws + WS_TAB + (size_t)l * MiB); A.sm = ws + WS_TAB + (size_t)l * MiB + SM_OFF; A.ws = ws;
    A.s5st = (float2*)(ws + WS_S5ST); A.lruS = (float2*)(ws + WS_LRUS); A.lrup = (unsigned*)(ws + WS_LRUA);
    A.conv_a_w = args.in[3] + (size_t)l * 3 * W; A.pool_b = args.in[5] + (size_t)l * W; A.pool_scale = args.in[6] + (size_t)l * W;
    A.s5_d = args.in[14] + (size_t)l * W; A.glu_b = args.in[16] + (size_t)l * W;
    A.lconv_w = args.in[17] + (size_t)l * 4 * W; A.lconv_b = args.in[18] + (size_t)l * W; A.ba = args.in[20] + (size_t)l * W; A.bx = args.in[22] + (size_t)l * W;
}

__global__ void __launch_bounds__(NWAVES * 64, 2) mk_fwd(Args args) {
    extern __shared__ __attribute__((aligned(16))) unsigned char lds[];
    Frame F;
    F.lds = (LAS unsigned char*)lds; F.smem = lds;
    F.MISC = (volatile LAS unsigned*)(F.lds + MISC_OFF);
    F.tid = threadIdx.x; F.lane = F.tid & 63; F.wave = __builtin_amdgcn_readfirstlane(F.tid >> 6);
    F.G = gridDim.x; { const int bx = blockIdx.x; F.vcu = (F.G % 8 == 0) ? (bx % 8) * (F.G / 8) + bx / 8 : bx; }
    F.ws = args.ws; F.ctl = (unsigned*)(args.ws + WS_CTL);
    unsigned char* ws = args.ws; unsigned char* const args_ws_ = args.ws; (void)args_ws_;
    for (int u = F.tid; u < (LDS_BYTES - LDSCTL_OFF) / 4; u += NWAVES * 64) ((LAS unsigned*)(F.lds + LDSCTL_OFF))[u] = 0u;
    __syncthreads();
    XcdBarrier bar; bar.bar = F.ctl + CW_BAR; bar.x = 0; bar.st = nullptr;
    if (N_LAUNCHES == 1) bar = xcd_barrier_post(F.ctl + CW_BAR, F.MISC + 8);
    const int lo = args.ph_lo, hi = args.ph_hi;
    bf16_t* h = (bf16_t*)(ws + WS_H); bf16_t* xn = (bf16_t*)(ws + WS_XN); bf16_t* proj = (bf16_t*)(ws + WS_PROJ); bf16_t* ys = (bf16_t*)(ws + WS_YS);
    bf16_t* br = (bf16_t*)(ws + WS_R1); bf16_t* hbuf = (bf16_t*)(ws + WS_HBUF); bf16_t* ymoe = (bf16_t*)(ws + WS_YMOE); bf16_t* merged = (bf16_t*)(ws + WS_MERGED);
    int* buf_ts = (int*)(ws + WS_BUFTS); float* buf_w = (float*)(ws + WS_BUFW);

#ifndef KIND_MASK
#define KIND_MASK 0x7ff
#endif
#define PH_BEGIN(k, kind) if (lo <= (k) && (k) < hi && ((KIND_MASK >> (kind)) & 1)) { \
        { int t_ = threadIdx.x; asm volatile("" : "+v"(t_)); F.tid = t_; F.lane = t_ & 63; F.wave = __builtin_amdgcn_readfirstlane(t_ >> 6); } STAMP(2 * (k));
#ifdef PROBE_A
#define PH_END(k) __syncthreads(); STAMP(2 * (k) + 1); if ((k) + 1 < hi) xcd_barrier(bar); }
#else
#define PH_END(k) if ((k) + 1 < hi) xcd_barrier(bar); }
#endif

    PH_BEGIN(0, 0)
        prep_tables(F, args);
        conv_mixer_weights(F, args);
        conv_expert_weights(F, args, 0, CONV_NA);
        norm_phase<false>(F, args.in[0], nullptr, args.in[1], nullptr, xn, nullptr, 0.0f, ws + WS_XN8);
    PH_END(0)

#ifdef PROBE_A
#ifndef PROBE_MODE
#define PROBE_MODE 0
#endif
#ifndef PROBE_SCALE
#define PROBE_SCALE 300
#endif
#ifndef PROBE_SHIFT
#define PROBE_SHIFT 0.0f
#endif
#define PROBE_REDUCE() { xcd_barrier(bar); \
        if (blockIdx.x == 0) { LAS float* red = (LAS float*)F.lds; const unsigned long long* dd = (const unsigned long long*)(g_dbg); \
            if (F.tid < 256) { const unsigned long long ta = __hip_atomic_load(dd + (size_t)F.tid * 64 + (PROBE_A), RLX_AGENT), tb = __hip_atomic_load(dd + (size_t)F.tid * 64 + (PROBE_B), RLX_AGENT), t00 = __hip_atomic_load(dd + (PROBE_A), RLX_AGENT); \
                red[F.tid] = (float)(long long)(tb - ta) * 0.01f; red[256 + F.tid] = (float)(long long)(ta - t00) * 0.01f; red[512 + F.tid] = (float)(long long)(tb - t00) * 0.01f; } \
            __syncthreads(); \
            if (F.tid == 0) { float sum = 0.f, mx = -1e30f, mna = 1e30f, mxb = -1e30f, mxa = -1e30f, mnb = 1e30f; for (int i = 0; i < 256; ++i) { sum += red[i]; mx = fmaxf(mx, red[i]); mna = fminf(mna, red[256 + i]); mxb = fmaxf(mxb, red[512 + i]); mxa = fmaxf(mxa, red[256 + i]); mnb = fminf(mnb, red[512 + i]); } \
                const float val = PROBE_MODE == 0 ? sum * (1.0f / 256.0f) : (PROBE_MODE == 1 ? mx : (PROBE_MODE == 2 ? mxb - mna : mnb - mxa)); \
                const float vq = val; \
                __hip_atomic_store((float*)((unsigned long long*)(g_dbg) + 256 * 64), vq, RLX_AGENT); } \
            __syncthreads(); } \
        xcd_barrier(bar); \
        oscale_ = __hip_atomic_load((float*)((unsigned long long*)(g_dbg) + 256 * 64), RLX_AGENT) * (1.0f / (float)(PROBE_SCALE)); }
#else
#define PROBE_REDUCE()
#endif
#define LAYER(l) { \
    const int pb = 1 + PH_PER_LAYER * (l); \
    const float* tab = (const float*)(ws + WS_TAB + (size_t)(l) * MiB); \
    const unsigned char* wmix = ws + WS_WMIX + (size_t)(l) * WMIX_STRIDE; \
    unsigned* cnt = F.ctl + CW_CNT + 2048 * (l); \
    PH_BEGIN(pb + 0, 1)   \
        DenseSched S; S.ord.init(T, IN_COLS, F.G, (int)blockIdx.x); S.A = (const char*)xn; S.Bt = (const char*)(wmix + WMIX_IN); S.lda = D; S.K = D; S.a_sh = 0; S.a_cs = 0; S.es = 2; \
        EpiStoreBf16 E{proj, IN_COLS}; \
        pg8::gemm_phase<EpiStoreBf16, DenseSched, true, true>(F.lds, F.tid, D, S, E); \
        if (F.G == 256 && (int)blockIdx.x >= 192) conv_expert_quota(F, args, (l), 0, ((int)blockIdx.x - 192) * NWAVES + F.wave, 4); \
        else if (F.G != 256 && (int)blockIdx.x == 0) conv_expert_quota(F, args, (l), 0, F.wave, CONV_NA / NWAVES);     \
    PH_END(pb + 0) \
    PH_BEGIN(pb + 1, 2)   \
        MixArgs A; make_mix_args(A, args, ws, (l)); \
        for (int u = blockIdx.x; u < BATCH * NCHUNK; u += F.G) { int t_ = F.tid; asm volatile("" : "+v"(t_)); mix_unit<1>(A, F.lds, u, t_); } \
    PH_END(pb + 1) \
    PH_BEGIN(pb + 2, 3)   \
        MixArgs A; make_mix_args(A, args, ws, (l)); \
        for (int u = blockIdx.x; u < BATCH * NCHUNK; u += F.G) { int t_ = F.tid; asm volatile("" : "+v"(t_)); mix_unit<2>(A, F.lds, u, t_); } \
    PH_END(pb + 2) \
    PH_BEGIN(pb + 3, 4)   \
        DenseSched S; S.ord.init(T, 4096, F.G, (int)blockIdx.x); S.A = (const char*)ys; S.Bt = (const char*)(wmix + WMIX_BR); S.lda = 1024; S.K = 256; S.a_sh = 2; S.a_cs = 512; S.es = 2; \
        EpiStoreBf16 E{br, 4096}; \
        pg8::gemm_phase<EpiStoreBf16, DenseSched, true, true>(F.lds, F.tid, 256, S, E); \
    PH_END(pb + 3) \
    PH_BEGIN(pb + 4, 5)   \
        DenseSched S; S.ord.init(T, 4096, F.G, (int)blockIdx.x); S.A = (const char*)(ws + WS_XN8); S.Bt = (const char*)(wmix + WMIX_MG); S.lda = D; S.K = D; S.a_sh = 0; S.a_cs = 0; S.es = 1; \
        EpiGateMerge E{args.in[25] + (size_t)(l) * 4096, br, merged}; \
        pg8::gemm_phase<EpiGateMerge, DenseSched, true, true, true>(F.lds, F.tid, D, S, E); \
    PH_END(pb + 4) \
    PH_BEGIN(pb + 5, 6)   \
        DenseSched S; S.ord.init(T, D, F.G, (int)blockIdx.x); S.A = (const char*)merged; S.Bt = (const char*)(wmix + WMIX_OUT); S.lda = D; S.K = D; S.a_sh = 0; S.a_cs = 0; S.es = 2; \
        bf16_t* hd_ = (args.flags & 1) ? (bf16_t*)(ws + WS_R1) : h; \
        if ((l) == 0) { EpiAddH<true> E{args.in[0], hd_}; pg8::gemm_phase<EpiAddH<true>, DenseSched, true, true>(F.lds, F.tid, D, S, E); } \
        else { EpiAddH<false> E{h, hd_}; pg8::gemm_phase<EpiAddH<false>, DenseSched, true, true>(F.lds, F.tid, D, S, E); } \
    PH_END(pb + 5) \
    PH_BEGIN(pb + 6, 7)   \
        if (args.flags & 1) router_phase(F, h, args.in[28] + (size_t)(l) * D, tab + TB_RW, args.in[30] + (size_t)(l) * 4, args.in[32] + (size_t)(l) * 32, xn, F.ctl + 16384, (int*)(ws + WS_END), (float*)(ws + WS_END + 2 * MiB)); \
        else router_phase(F, h, args.in[28] + (size_t)(l) * D, tab + TB_RW, args.in[30] + (size_t)(l) * 4, args.in[32] + (size_t)(l) * 32, xn, cnt, buf_ts, buf_w); \
    PH_END(pb + 6) \
    PH_BEGIN(pb + 7, 8)   \
        build_plan(F, cnt); \
        unsigned* rdy = F.ctl + CW_RDY + 4096 * (l); \
        { Moe1Sched S{(const char*)xn, (const char*)(ws + WS_WEXP + (size_t)(l) * WEXP_LAYER), (const LAS int*)(F.lds + PLAN_OFF), buf_ts, F.G, F.vcu, D, rdy}; \
          EpiMoe1 E{(unsigned char*)hbuf}; \
          pg8::gemm_phase<EpiMoe1, Moe1Sched, true, true, true>(F.lds, F.tid, D, S, E); } \
        if ((l) + 1 < DEPTH) { if (F.G == 256 && F.vcu >= 128) conv_expert_quota(F, args, (l) + 1, CONV_NA, (F.vcu - 128) * NWAVES + F.wave, 3); \
            else if (F.G != 256 && F.vcu == 0) conv_expert_quota(F, args, (l) + 1, CONV_NA, F.wave, CONV_NB / NWAVES); } \
        xcd_barrier(bar);     \
        { Moe2Sched S{(const char*)hbuf, (const char*)(ws + WS_WEXP + (size_t)(l) * WEXP_LAYER + WEXP_W2), (const LAS int*)(F.lds + PLAN_OFF), F.G, F.G - 1 - F.vcu, DEXP, rdy, F.ctl + CW_TMO}; \
          EpiMoe2 E{ymoe, (const LAS int*)(F.lds + PLAN_OFF), buf_ts, buf_w}; \
          pg8::gemm_phase<EpiMoe2, Moe2Sched, true, true, true>(F.lds, F.tid, DEXP, S, E); } \
    PH_END(pb + 7) \
    PH_BEGIN(pb + 8, 9)   \
        if ((l) + 1 < DEPTH) { \
            conv_expert_weights(F, args, (l) + 1, CONV_NA + CONV_NB); \
            norm_phase<true>(F, h, ymoe, args.in[1] + (size_t)((l) + 1) * D, (args.flags & 1) ? nullptr : h, xn, nullptr, 0.0f, ws + WS_XN8); \
        } else { \
            float oscale_ = 0.0f; \
            PROBE_REDUCE() \
            norm_phase<true>(F, h, ymoe, args.in[36], nullptr, nullptr, args.out, oscale_); \
        } \
    PH_END(pb + 8) \
}
    LAYER(0)
    LAYER(1)
#undef LAYER
#undef PH_BEGIN
#undef PH_END
}
}

extern "C" void kernel_launch(void* const* d_in, const int* in_sizes, int n_in, void* d_out, int out_size, void* d_ws, size_t ws_size, hipStream_t stream) {
    static int grid = 0;
    if (grid == 0) {
        if (n_in != 37 || ws_size < WS_END) { fprintf(stderr, "kernel_launch: unexpected n_in %d or ws %zu\n", n_in, ws_size); grid = -1; return; }
        int dev = 0, cus = 0;
        if (hipGetDevice(&dev) != hipSuccess || hipDeviceGetAttribute(&cus, hipDeviceAttributeMultiprocessorCount, dev) != hipSuccess) { grid = -1; return; }
        if (hipFuncSetAttribute((const void*)mk_fwd, hipFuncAttributeMaxDynamicSharedMemorySize, LDS_BYTES) != hipSuccess) { fprintf(stderr, "kernel_launch: hipFuncSetAttribute failed\n"); grid = -1; return; }
        grid = cus;
    }
    if (grid < 0) return;
    (void)hipMemsetAsync((char*)d_ws + WS_CTL, 0, 1 * MiB, stream);
    Args a{};
    for (int i = 0; i < 37; ++i) a.in[i] = (const float*)d_in[i];
    a.out = (float*)d_out; a.ws = (unsigned char*)d_ws;
    if (N_LAUNCHES == 1) {
        a.ph_lo = 0; a.ph_hi = N_PHASES;
        hipLaunchKernelGGL(mk_fwd, dim3(grid), dim3(NWAVES * 64), LDS_BYTES, stream, a);
    } else {
#ifndef REP_MASK
#define REP_MASK 0
#endif
#ifndef REP_N
#define REP_N 2
#endif
        for (int p = 0; p < N_PHASES; ++p) { a.ph_lo = p; a.ph_hi = p + 1; const int kind = p == 0 ? 0 : 1 + (p - 1) % PH_PER_LAYER; const int nrep = ((REP_MASK >> kind) & 1) ? REP_N : 1;
            for (int r = 0; r < nrep; ++r) { a.flags = (r + 1 < nrep) ? 1 : 0; hipLaunchKernelGGL(mk_fwd, dim3(grid), dim3(NWAVES * 64), LDS_BYTES, stream, a); } }
    }
}
```

```cpp
#include <hip/hip_runtime.h>
#include <cstdint>
#include <cstdio>

#ifndef MK_N_LAUNCHES
#define MK_N_LAUNCHES 1
#endif

namespace pg8 {
#define PG8_LAS __attribute__((address_space(3)))
typedef unsigned short bf16_t;
typedef short bf16x8 __attribute__((ext_vector_type(8)));
typedef float f32x4 __attribute__((ext_vector_type(4)));
typedef unsigned u32x4 __attribute__((ext_vector_type(4)));
typedef unsigned u32x2 __attribute__((ext_vector_type(2)));
constexpr int BM = 256, BK = 64, HALF = 128, HTB = HALF * BK * 2, STAGE_BYTES = 8 * HTB, NXCD = 8, WGM = 8;

__host__ __device__ __forceinline__ int lds_byte(int r, int c) { const int st = (r >> 4) * 2 + (c >> 5), rr = r & 15, cc = c & 31, ob = rr * 64 + cc * 2; return st * 1024 + (ob ^ (((ob >> 9) & 1) << 5)); }
__host__ __device__ __forceinline__ void stage_rc(int b, int& R, int& C) { const int st = b / 1024, sb = b % 1024, swz = sb ^ (((sb >> 9) & 1) << 5); R = (st >> 1) * 16 + swz / 64; C = (st & 1) * 32 + (swz % 64) / 2; }
__host__ __device__ __forceinline__ int perm32(int rho) { const int n = rho >> 4, i = rho & 15; return 8 * (i >> 2) + 4 * n + (i & 3); }

struct Unit { int pm, pn; };

struct StaticOrder {
    int nM, nN, nwg, G, c;
    __host__ __device__ void init(int M, int N, int G_, int c_) { nM = M / BM; nN = N / BM; nwg = nM * nN; G = G_; c = c_; }
    __host__ __device__ bool next(int i, Unit& u) const {
        const long L = (long)i * G + c; if (L >= nwg) return false;
        int wgid = (int)L; { const int q = nwg / NXCD, r = nwg % NXCD, xcd = wgid % NXCD, off = wgid / NXCD; wgid = (xcd < r ? xcd * (q + 1) : r * (q + 1) + (xcd - r) * q) + off; }
        const int nig = WGM * nN, gid = wgid / nig, fm = gid * WGM, gsz = (nM - fm) < WGM ? (nM - fm) : WGM;
        u.pm = fm + ((wgid % nig) % gsz); u.pn = (wgid % nig) / gsz; return true;
    }
};

typedef int i32x8 __attribute__((ext_vector_type(8)));
typedef int i32x4 __attribute__((ext_vector_type(4)));
__device__ __forceinline__ i32x8 cat8(bf16x8 a, bf16x8 b) { const i32x4 x = __builtin_bit_cast(i32x4, a), y = __builtin_bit_cast(i32x4, b); return __builtin_shufflevector(x, y, 0, 1, 2, 3, 4, 5, 6, 7); }
__device__ __forceinline__ unsigned cvt_pk_bf16(float lo, float hi) { unsigned r; asm volatile("v_cvt_pk_bf16_f32 %0, %1, %2" : "=v"(r) : "v"(lo), "v"(hi)); return r; }

template <class Epi, class Sched, bool ALIGN_EPI, bool SP2, bool FP8 = false>
__device__ __forceinline__ void gemm_phase(PG8_LAS unsigned char* lds, const int tid, const int K, const Sched& S, const Epi& E) {
    const int wid = __builtin_amdgcn_readfirstlane(tid >> 6), lane = tid & 63, wr = wid >> 2, wc = wid & 3, fr = lane & 15, fq = lane >> 4;
    const int nt = FP8 ? K / 128 : K / BK;
    const int ES = FP8 ? 1 : 2;
    unsigned voffB[2]; int RA[2], CA[2];
#pragma unroll
    for (int i = 0; i < 2; ++i) { int R, C; stage_rc(tid * 16 + i * 8192, R, C); const int Rb = Epi::PERM ? ((R & ~31) + perm32(R & 31)) : R;
        voffB[i] = (unsigned)(Rb * K * ES + C * 2); RA[i] = R; CA[i] = C; }
    const size_t kstep = (size_t)(BK * 2);
    const size_t hstepB = (size_t)HALF * K * ES;
    const unsigned ldsw = (unsigned)wid * 1024u;
    const int aoff = lds_byte(wr * 64 + fr, fq * 8), boff = lds_byte(wc * 32 + fr, fq * 8);
#define PG8_SA(b, h) (((b) * 2 + (h)) * HTB)
#define PG8_SB(b, h) ((4 + (b) * 2 + (h)) * HTB)
#define PG8_STAGE(bufoff, gbase, voff) do { _Pragma("unroll") for (int _i = 0; _i < 2; ++_i) \
        __builtin_amdgcn_global_load_lds((const unsigned*)((const char*)(gbase) + (voff)[_i]), (PG8_LAS unsigned*)(lds + (bufoff) + ldsw + _i * 8192), 16, 0, 0); } while (0)
#define PG8_LDA(dst, b, h) do { _Pragma("unroll") for (int m = 0; m < 4; ++m) { if constexpr (FP8) { dst##8[m] = cat8(*(const PG8_LAS bf16x8*)(lds + PG8_SA(b, h) + aoff + m * 2048), *(const PG8_LAS bf16x8*)(lds + PG8_SA(b, h) + aoff + m * 2048 + 1024)); } \
        else { _Pragma("unroll") for (int k = 0; k < 2; ++k) dst[m][k] = *(const PG8_LAS bf16x8*)(lds + PG8_SA(b, h) + aoff + m * 2048 + k * 1024); } } } while (0)
#define PG8_LDB(dst, b, h) do { _Pragma("unroll") for (int n = 0; n < 2; ++n) { if constexpr (FP8) { dst##8[n] = cat8(*(const PG8_LAS bf16x8*)(lds + PG8_SB(b, h) + boff + n * 2048), *(const PG8_LAS bf16x8*)(lds + PG8_SB(b, h) + boff + n * 2048 + 1024)); } \
        else { _Pragma("unroll") for (int k = 0; k < 2; ++k) dst[n][k] = *(const PG8_LAS bf16x8*)(lds + PG8_SB(b, h) + boff + n * 2048 + k * 1024); } } } while (0)
#define PG8_MMA(ai, bj, At, Bt) do { __builtin_amdgcn_s_setprio(1); _Pragma("unroll") for (int m = 0; m < 4; ++m) _Pragma("unroll") for (int n = 0; n < 2; ++n) { \
        if constexpr (FP8) { asm volatile("v_mfma_scale_f32_16x16x128_f8f6f4 %0, %1, %2, %0, %3, %3 op_sel_hi:[0,0,0]" : "+v"(acc[ai][bj][m][n]) : "v"(Bt##8[n]), "v"(At##8[m]), "v"(one_scale));     } \
        else { _Pragma("unroll") for (int k = 0; k < 2; ++k) acc[ai][bj][m][n] = __builtin_amdgcn_mfma_f32_16x16x32_bf16(Bt[n][k], At[m][k], acc[ai][bj][m][n], 0, 0, 0); } } \
        __builtin_amdgcn_s_setprio(0); } while (0)
#define PG8_WAIT_V(n) asm volatile("s_waitcnt vmcnt(" #n ")" ::: "memory")
#define PG8_WAIT_L(n) asm volatile("s_waitcnt lgkmcnt(" #n ")" ::: "memory")
#define PG8_BAR __builtin_amdgcn_s_barrier()
#define PG8_SCHED __builtin_amdgcn_sched_barrier(0)
    Unit cur, nxt; int ui = 0;
    if (!S.next(0, cur)) return;
    bool has_next = S.next(1, nxt);
    unsigned offC[2][2], offN[2][2];
#pragma unroll
    for (int h = 0; h < 2; ++h)
#pragma unroll
        for (int i = 0; i < 2; ++i) {
            if constexpr (Sched::GATHER) { offC[h][i] = S.gather_off(cur, h * HALF + RA[i]) + (unsigned)CA[i] * 2u; offN[h][i] = has_next ? S.gather_off(nxt, h * HALF + RA[i]) + (unsigned)CA[i] * 2u : offC[h][i]; }
            else { offC[h][i] = (unsigned)((h * HALF + RA[i]) * S.lda * ES + CA[i] * 2); offN[h][i] = offC[h][i]; }
        }
    f32x4 acc[2][2][4][2];
#pragma unroll
    for (int a = 0; a < 2; ++a)
#pragma unroll
        for (int b = 0; b < 2; ++b)
#pragma unroll
            for (int m = 0; m < 4; ++m)
#pragma unroll
                for (int n = 0; n < 2; ++n) acc[a][b][m][n] = (f32x4){0.f, 0.f, 0.f, 0.f};
    int one_scale = 0x7f7f7f7f; asm volatile("" : "+v"(one_scale));
    bf16x8 At[4][2], B0[2][2], B1[2][2]; i32x8 At8[4], B08[2], B18[2]; (void)At; (void)B0; (void)B1; (void)At8; (void)B08; (void)B18;
    const char* cA = S.a_base(cur); const char* cB = S.b_base(cur);
    if constexpr (Sched::WAITS) S.a_ready(cur);
    if constexpr (SP2) {
        PG8_STAGE(PG8_SB(0, 0), cB, voffB); PG8_STAGE(PG8_SB(0, 1), cB + hstepB, voffB); PG8_STAGE(PG8_SA(0, 0), cA, offC[0]); PG8_STAGE(PG8_SA(0, 1), cA, offC[1]);
        if (wr == 1) PG8_BAR;
        PG8_WAIT_V(2); PG8_BAR;
        PG8_STAGE(PG8_SB(1, 0), cB + kstep, voffB); PG8_STAGE(PG8_SA(1, 0), cA + kstep, offC[0]); PG8_STAGE(PG8_SB(1, 1), cB + hstepB + kstep, voffB);
        PG8_WAIT_V(6); PG8_BAR;
    } else {
        PG8_STAGE(PG8_SB(0, 0), cB, voffB); PG8_STAGE(PG8_SA(0, 0), cA, offC[0]); PG8_STAGE(PG8_SB(0, 1), cB + hstepB, voffB); PG8_STAGE(PG8_SA(0, 1), cA, offC[1]);
        if (wr == 1) PG8_BAR;
        PG8_WAIT_V(4); PG8_BAR;
        PG8_STAGE(PG8_SB(1, 0), cB + kstep, voffB); PG8_STAGE(PG8_SA(1, 0), cA + kstep, offC[0]); PG8_STAGE(PG8_SB(1, 1), cB + hstepB + kstep, voffB);
        PG8_WAIT_V(6); PG8_BAR;
    }
    for (;;) {
        const char* nA = has_next ? S.a_base(nxt) : cA; const char* nB = has_next ? S.b_base(nxt) : cB;
        const bool full = !(Sched::HALF && __builtin_amdgcn_readfirstlane((int)S.half_only(cur)));
#pragma unroll 1
        for (int t = 0; t < nt; t += 2) {
            const bool last = (t == nt - 2);
            const char* a1 = cA + (size_t)(t + 1) * kstep;
            const char* a2 = last ? nA : cA + (size_t)(t + 2) * kstep; const char* b2 = last ? nB : cB + (size_t)(t + 2) * kstep;
            const char* a3 = a2 + kstep; const char* b3 = b2 + kstep;
            if constexpr (Sched::WAITS) { if (last && has_next) S.a_ready(nxt); }
            unsigned o2[2][2];
#pragma unroll
            for (int h = 0; h < 2; ++h)
#pragma unroll
                for (int i = 0; i < 2; ++i) o2[h][i] = (Sched::GATHER && last) ? offN[h][i] : offC[h][i];
            if constexpr (SP2) {
            PG8_LDB(B0, 0, 0); PG8_LDB(B1, 0, 1); PG8_SCHED; PG8_LDA(At, 0, 0); PG8_STAGE(PG8_SA(1, 1), a1, offC[1]);
            PG8_WAIT_V(8); PG8_WAIT_L(0); PG8_BAR; PG8_MMA(0, 0, At, B0); PG8_MMA(0, 1, At, B1); PG8_BAR; PG8_SCHED;
            PG8_LDA(At, 0, 1); PG8_STAGE(PG8_SB(0, 0), b2, voffB); PG8_STAGE(PG8_SB(0, 1), b2 + hstepB, voffB); PG8_STAGE(PG8_SA(0, 0), a2, o2[0]);
            PG8_WAIT_V(8); PG8_WAIT_L(0); PG8_BAR; if (full) { PG8_MMA(1, 0, At, B0); PG8_MMA(1, 1, At, B1); } PG8_BAR; PG8_SCHED;
            PG8_LDB(B0, 1, 0); PG8_LDB(B1, 1, 1); PG8_SCHED; PG8_LDA(At, 1, 0); PG8_STAGE(PG8_SA(0, 1), a2, o2[1]);
            PG8_WAIT_V(8); PG8_WAIT_L(0); PG8_BAR; PG8_MMA(0, 0, At, B0); PG8_MMA(0, 1, At, B1); PG8_BAR; PG8_SCHED;
            PG8_LDA(At, 1, 1); PG8_STAGE(PG8_SB(1, 0), b3, voffB); PG8_STAGE(PG8_SB(1, 1), b3 + hstepB, voffB); PG8_STAGE(PG8_SA(1, 0), a3, o2[0]);
            PG8_WAIT_V(8); PG8_WAIT_L(0); PG8_BAR; if (full) { PG8_MMA(1, 0, At, B0); PG8_MMA(1, 1, At, B1); } PG8_BAR; PG8_SCHED;
            } else {
            PG8_LDB(B0, 0, 0); PG8_SCHED; PG8_LDA(At, 0, 0); PG8_STAGE(PG8_SA(1, 1), a1, offC[1]);
            PG8_WAIT_L(8); PG8_BAR; PG8_WAIT_L(0); PG8_MMA(0, 0, At, B0); PG8_BAR; PG8_SCHED;
            PG8_LDB(B1, 0, 1); PG8_STAGE(PG8_SB(0, 0), b2, voffB);
            PG8_BAR; PG8_WAIT_L(0); PG8_MMA(0, 1, At, B1); PG8_BAR;
            PG8_LDA(At, 0, 1); PG8_STAGE(PG8_SA(0, 0), a2, o2[0]);
            PG8_BAR; PG8_WAIT_L(0); PG8_MMA(1, 0, At, B0); PG8_BAR; PG8_SCHED;
            PG8_STAGE(PG8_SB(0, 1), b2 + hstepB, voffB);
            PG8_WAIT_V(6); PG8_BAR; PG8_MMA(1, 1, At, B1); PG8_BAR;
            PG8_LDB(B0, 1, 0); PG8_SCHED; PG8_LDA(At, 1, 0); PG8_STAGE(PG8_SA(0, 1), a2, o2[1]);
            PG8_WAIT_L(8); PG8_BAR; PG8_WAIT_L(0); PG8_MMA(0, 0, At, B0); PG8_BAR; PG8_SCHED;
            PG8_LDB(B1, 1, 1); PG8_STAGE(PG8_SB(1, 0), b3, voffB);
            PG8_BAR; PG8_WAIT_L(0); PG8_MMA(0, 1, At, B1); PG8_BAR;
            PG8_LDA(At, 1, 1); PG8_STAGE(PG8_SA(1, 0), a3, o2[0]);
            PG8_BAR; PG8_WAIT_L(0); PG8_MMA(1, 0, At, B0); PG8_BAR; PG8_SCHED;
            PG8_STAGE(PG8_SB(1, 1), b3 + hstepB, voffB);
            PG8_WAIT_V(6); PG8_BAR; PG8_MMA(1, 1, At, B1); PG8_BAR;
            }
        }
        if constexpr (FP8) asm volatile("s_nop 15\n\ts_nop 7" ::: "memory");
        if constexpr (ALIGN_EPI) { if (wr == 0) PG8_BAR; }
        Unit nn; bool has_nn = false;
        if constexpr (Sched::GATHER) {
            has_nn = has_next && S.next(ui + 2, nn);
#pragma unroll
            for (int h = 0; h < 2; ++h)
#pragma unroll
                for (int i = 0; i < 2; ++i) { int R_, C_; stage_rc(tid * 16 + i * 8192, R_, C_); offC[h][i] = offN[h][i]; if (has_nn) offN[h][i] = S.gather_off(nn, h * HALF + R_) + (unsigned)C_ * 2u; }
        }
        E(acc, cur, wr, wc, fr, fq);
        if constexpr (Sched::PUBLISHES) S.done(cur);
        if (!has_next) break;
#pragma unroll
        for (int a = 0; a < 2; ++a)
#pragma unroll
            for (int b = 0; b < 2; ++b)
#pragma unroll
                for (int m = 0; m < 4; ++m)
#pragma unroll
                    for (int n = 0; n < 2; ++n) acc[a][b][m][n] = (f32x4){0.f, 0.f, 0.f, 0.f};
        cur = nxt; cA = nA; cB = nB; ++ui;
        if constexpr (Sched::GATHER) { has_next = has_nn; nxt = nn; }
        else { has_next = S.next(ui + 1, nxt); }
        if constexpr (ALIGN_EPI) { if (wr == 1) PG8_BAR; }
    }
    PG8_WAIT_V(0);
    if constexpr (!ALIGN_EPI) { if (wr == 0) PG8_BAR; }
    PG8_BAR;
#undef PG8_SA
#undef PG8_SB
#undef PG8_STAGE
#undef PG8_LDA
#undef PG8_LDB
#undef PG8_MMA
#undef PG8_WAIT_V
#undef PG8_WAIT_L
#undef PG8_BAR
#undef PG8_SCHED
}
}

namespace {
constexpr int NWAVES = 8;
constexpr int N_LAUNCHES = MK_N_LAUNCHES;
constexpr int D = 1024, BATCH = 8, SEQ = 2048, DEPTH = 2, T = BATCH * SEQ;
constexpr int W = 256, IN_COLS = 1792;
constexpr int NEXP = 32, DEXP = 512;
constexpr int CHUNK = 64, NCHUNK = SEQ / CHUNK;
constexpr int CAP = 16384;
constexpr int MAXBLK = 160;
constexpr float EPS = 1e-6f;
constexpr int PH_PER_LAYER = 8, N_PHASES = 1 + PH_PER_LAYER * DEPTH;

typedef unsigned short bf16_t;
typedef float f32x4 __attribute__((ext_vector_type(4)));
typedef unsigned v4u __attribute__((ext_vector_type(4)));
#define GAS __attribute__((address_space(1)))
#define LAS __attribute__((address_space(3)))
typedef GAS unsigned gu32;
#define RLX_AGENT __ATOMIC_RELAXED, __HIP_MEMORY_SCOPE_AGENT
#define LDS_WAIT() asm volatile("s_waitcnt lgkmcnt(0)" ::: "memory")

__device__ __forceinline__ float bf2f(bf16_t b) { return __uint_as_float(((unsigned)b) << 16); }
__device__ __forceinline__ unsigned f2bfu(float f) { unsigned u = __float_as_uint(f); return (u + 0x7fffu + ((u >> 16) & 1u)) >> 16; }
__device__ __forceinline__ bf16_t f2bf(float f) { return (bf16_t)f2bfu(f); }
__device__ __forceinline__ unsigned pk2(float lo, float hi) { unsigned r; asm("v_cvt_pk_bf16_f32 %0, %1, %2" : "=v"(r) : "v"(lo), "v"(hi)); return r; }
__device__ __forceinline__ float sigmoidf_(float x) { return __builtin_amdgcn_rcpf(1.0f + __builtin_amdgcn_exp2f(x * -1.4426950408889634f)); }
__device__ __forceinline__ float gelu_tanh(float x) {
    const float z = 0.7978845608028654f * (x + 0.044715f * x * x * x);
    const float t = 1.0f - 2.0f * __builtin_amdgcn_rcpf(__builtin_amdgcn_exp2f(z * 2.8853900817779268f) + 1.0f);
    return 0.5f * x * (1.0f + t);
}

constexpr size_t MiB = 1u << 20;
constexpr size_t WS_CTL = 0;
constexpr size_t WS_TAB = 1 * MiB;
constexpr size_t WS_H = 4 * MiB;
constexpr size_t WS_XN = 68 * MiB;
constexpr size_t WS_PROJ = 100 * MiB;
constexpr size_t WS_MERGED = WS_PROJ;
constexpr size_t WS_YS = 156 * MiB;
constexpr size_t WS_R1 = 188 * MiB;
constexpr size_t WS_HBUF = WS_R1;
constexpr size_t WS_YMOE = WS_R1 + 48 * MiB;
constexpr size_t WS_S5ST = 316 * MiB;
constexpr size_t WS_LRUA = 318 * MiB;
constexpr size_t WS_LRUH = 334 * MiB;
constexpr size_t WS_LRUS = 350 * MiB;
constexpr size_t WS_BUFTS = 351 * MiB;
constexpr size_t WS_BUFW = 353 * MiB;
constexpr size_t WS_WMIX = 356 * MiB;
constexpr size_t WMIX_IN = 0, WMIX_MG = (size_t)1792 * 1024 * 2, WMIX_BR = WMIX_MG + (size_t)4096 * 1024 * 2, WMIX_OUT = WMIX_BR + (size_t)4096 * 256 * 2, WMIX_STRIDE = 16 * MiB;
static_assert(WMIX_OUT + (size_t)1024 * 1024 * 2 <= WMIX_STRIDE, "mixer weights");
constexpr size_t WS_WEXP = 388 * MiB;
constexpr size_t WEXP_W2 = 32 * MiB, WEXP_LAYER = 48 * MiB;
constexpr float MG_SCALE = 32.0f;
constexpr float W13_SCALE = 32.0f, W2_SCALE = 16.0f, H_SCALE = 8.0f;
constexpr size_t WS_XN8 = 484 * MiB;
constexpr size_t WS_END = 500 * MiB;

constexpr int CW_CNT = 8192;
constexpr int CW_BAR = 4096;
constexpr int CW_TMO = 16;
constexpr int CW_RDY = 32768;

constexpr int TB_NLOG = 4096 + 32768, TB_RW = 4096 + 32768 + 256;
constexpr int SM_OFF = 512 * 1024;
constexpr int SM_POOLT = 0, SM_WAT = 32768, SM_WXT = 65536, SM_GLUT = 98304, SM_BRE = 229376, SM_BIM = 262144, SM_CMAT = 294912, SM_ATAB = 360448;


constexpr int RING_BYTES = 131072;
constexpr int LDSCTL_OFF = RING_BYTES, MISC_OFF = LDSCTL_OFF + 320;
constexpr int PLAN_OFF = MISC_OFF + 128;
constexpr int LDS_BYTES = 147456;
static_assert(PLAN_OFF + 4 * 360 <= LDS_BYTES, "LDS map");

#define XB_TMO      128
#define XB_XCNT(j)  (256  + 64 * (j))
#define XB_XSUB(j)  (1280 + 64 * (j))
#define XB_XGEN(j)  (2304 + 64 * (j))
#define XB_TOP      3328
#define XB_TOPGEN   3392
#define XCD_BAR_WORDS 3456
#define XB_SPIN_CAP (1u << 18)
__device__ __forceinline__ unsigned xb_ld(unsigned* p)              { return __hip_atomic_load(p, __ATOMIC_RELAXED, __HIP_MEMORY_SCOPE_AGENT); }
__device__ __forceinline__ unsigned xb_add(unsigned* p, unsigned v) { return __hip_atomic_fetch_add(p, v, __ATOMIC_RELAXED, __HIP_MEMORY_SCOPE_AGENT); }
__device__ __forceinline__ unsigned xb_xcc_id() { return (unsigned)__builtin_amdgcn_s_getreg((3 << 11) | 20) & 0xFu; }
#define XB_SPIN(cond, bar) do { unsigned _sp = 0; while (cond) { __builtin_amdgcn_s_sleep(1); \
    if ((++_sp & 255u) == 0u) { if (xb_ld(&(bar)[XB_TMO])) break; if (_sp > XB_SPIN_CAP) { atomicAdd(&(bar)[XB_TMO], 1u); break; } } } } while (0)
struct XcdBarrier { unsigned* bar; unsigned x; volatile LAS unsigned* st; };
__device__ __forceinline__ XcdBarrier xcd_barrier_post(unsigned* bar, volatile LAS unsigned* st) {
    XcdBarrier b; b.bar = bar; b.x = xb_xcc_id(); b.st = st;
    if (threadIdx.x == 0) (void)xb_add(&bar[XB_XCNT(b.x)], 1u);
    return b;
}
__device__ __forceinline__ void xcd_barrier_complete(unsigned* bar, unsigned x, unsigned& nloc, unsigned& nx) {
    const unsigned G = gridDim.x * gridDim.y * gridDim.z;
    unsigned sum, cnt, mine, sp = 0u;
    for (;;) {
        sum = 0u; cnt = 0u; mine = 0u;
#pragma unroll
        for (unsigned j = 0; j < 16; ++j) { const unsigned c = xb_ld(&bar[XB_XCNT(j)]); sum += c; cnt += (c > 0u) ? 1u : 0u; mine = (j == x) ? c : mine; }
        if (sum == G) break;
        __builtin_amdgcn_s_sleep(1);
        if ((++sp & 255u) == 0u) { if (xb_ld(&bar[XB_TMO])) break; if (sp > XB_SPIN_CAP) { atomicAdd(&bar[XB_TMO], 1u); break; } }
    }
    nloc = mine > 0u ? mine : 1u; nx = cnt > 0u ? cnt : 1u;
}
__device__ __forceinline__ void xcd_barrier(const XcdBarrier& b) {
    asm volatile("s_waitcnt vmcnt(0)" ::: "memory");
    __syncthreads();
    if (threadIdx.x == 0) {
        unsigned* bar = b.bar;
        __builtin_amdgcn_s_waitcnt(0);
        unsigned nloc = b.st[0], nx = b.st[1];
        if (nloc == 0u) { xcd_barrier_complete(bar, b.x, nloc, nx); b.st[0] = nloc; b.st[1] = nx; }
        const unsigned old = xb_add(&bar[XB_XSUB(b.x)], 1u);
        const unsigned gen = old / nloc;
        if (old + 1u == (gen + 1u) * nloc) {
            __builtin_amdgcn_fence(__ATOMIC_RELEASE, "agent");
            asm volatile("s_waitcnt vmcnt(0)" ::: "memory");
            const unsigned og = xb_add(&bar[XB_TOP], 1u);
            const unsigned tg = og / nx;
            if (og + 1u == (tg + 1u) * nx) xb_add(&bar[XB_TOPGEN], 1u);
            else XB_SPIN(xb_ld(&bar[XB_TOPGEN]) == tg, bar);
            __builtin_amdgcn_fence(__ATOMIC_ACQUIRE, "agent");
            xb_add(&bar[XB_XGEN(b.x)], 1u);
            asm volatile("s_waitcnt vmcnt(0)" ::: "memory");
        } else {
            XB_SPIN(xb_ld(&bar[XB_XGEN(b.x)]) == gen, bar);
            __builtin_amdgcn_fence(__ATOMIC_ACQUIRE, "agent");
            asm volatile("s_waitcnt vmcnt(0)" ::: "memory");
        }
    }
    __syncthreads();
}

#ifdef PROBE_A
#define STAMP(id) do { if (threadIdx.x == 0) ((unsigned long long*)(g_dbg))[(size_t)blockIdx.x * 64 + (id)] = __builtin_amdgcn_s_memrealtime(); } while (0)
#else
#define STAMP(id) do { } while (0)
#endif
#define g_dbg (F.ws + WS_END)

struct Args { const float* in[37]; float* out; unsigned char* ws; int ph_lo, ph_hi; int flags, pad; };

struct Frame {
    LAS unsigned char* lds;
    unsigned char* smem;
    volatile LAS unsigned* MISC;
    unsigned* ctl;
    int tid, lane, wave, vcu, G;
    unsigned char* ws;
};

struct MapNat { int off; __device__ __forceinline__ int operator()(int n) const { return off + n; } };
struct MapGate { __device__ __forceinline__ int operator()(int s) const {
    const int k4 = s >> 10, d = s & 1023, pn = d >> 6, dd = d & 63;
    return pn * 256 + 128 * (k4 >> 1) + 32 * (dd >> 4) + 16 * (k4 & 1) + 4 * ((dd >> 2) & 3) + (dd & 3); } };
struct MapMoe13 { int which; __device__ __forceinline__ int operator()(int hid) const {
    const int pn = hid >> 7, r = hid & 127;
    return pn * 256 + 128 * (r >> 6) + 32 * ((r >> 4) & 3) + 16 * which + 4 * ((r >> 2) & 3) + (r & 3); } };

template <class RowMap>
__device__ __forceinline__ void transpose_item(const float* W, int K, int N, bf16_t* WT, LAS float* scr_, int item, int lane, const RowMap rm) {
    LAS unsigned char* scr = (LAS unsigned char*)scr_;
    const int nblk = N / 32, kb = item / nblk, nb = item % nblk, k0 = 64 * kb, n0 = 32 * nb, r = lane >> 3, c = lane & 7;
    f32x4 v[8];
#pragma unroll
    for (int i = 0; i < 8; ++i) v[i] = *(const f32x4*)(W + (size_t)(k0 + 16 * (i >> 1) + 2 * r + (i & 1)) * N + n0 + 4 * c);
    __builtin_amdgcn_sched_barrier(0);
#pragma unroll
    for (int g = 0; g < 4; ++g)
#pragma unroll
        for (int j = 0; j < 4; ++j) *(LAS unsigned*)(scr + (4 * c + j) * 144 + 32 * g + 4 * r) = pk2(v[2 * g][j], v[2 * g + 1][j]);
    LDS_WAIT(); asm volatile("" ::: "memory");
#pragma unroll
    for (int j = 0; j < 4; ++j) { const int n = r + 8 * j;
        *(GAS v4u*)(WT + (size_t)rm(n0 + n) * K + k0 + 8 * c) = *(const LAS v4u*)(scr + n * 144 + 16 * c); }
    LDS_WAIT(); asm volatile("" ::: "memory");
}

__device__ __forceinline__ unsigned pk4_fp8(float a, float b, float c, float d) { int w = 0; w = __builtin_amdgcn_cvt_pk_fp8_f32(a, b, w, false); w = __builtin_amdgcn_cvt_pk_fp8_f32(c, d, w, true); return (unsigned)w; }
template <class RowMap>
__device__ __forceinline__ void transpose_item_fp8(const float* W, int K, int N, unsigned char* WT, LAS unsigned char* scr, int item, int lane, const RowMap rm, const float scl) {
    const int nblk = N / 32, kb = item / nblk, nb = item % nblk, k0 = 128 * kb, n0 = 32 * nb, r = lane >> 3, c = lane & 7;
    f32x4 v[16];
#pragma unroll
    for (int i = 0; i < 16; ++i) v[i] = *(const f32x4*)(W + (size_t)(k0 + 32 * (i >> 2) + 4 * r + (i & 3)) * N + n0 + 4 * c);
    __builtin_amdgcn_sched_barrier(0);
#pragma unroll
    for (int g = 0; g < 4; ++g)
#pragma unroll
        for (int j = 0; j < 4; ++j) *(LAS unsigned*)(scr + (4 * c + j) * 144 + 32 * g + 4 * r) = pk4_fp8(v[4 * g][j] * scl, v[4 * g + 1][j] * scl, v[4 * g + 2][j] * scl, v[4 * g + 3][j] * scl);
    LDS_WAIT(); asm volatile("" ::: "memory");
#pragma unroll
    for (int j = 0; j < 4; ++j) { const int n = r + 8 * j;
        *(GAS v4u*)(WT + (size_t)rm(n0 + n) * K + k0 + 16 * c) = *(const LAS v4u*)(scr + n * 144 + 16 * c); }
    LDS_WAIT(); asm volatile("" ::: "memory");
}

__device__ __forceinline__ void conv_mixer_weights(Frame& F, const Args& a, const int l, const int gw, const int NGW) {
    LAS float* scr = (LAS float*)(F.lds + F.wave * 16384);
    constexpr int I_IN = 16 * 56, I_MG = 8 * 128, I_BR = 4 * 32, I_OUT = 16 * 32, PER_L = I_IN + I_MG + 4 * I_BR + I_OUT;
    for (int it = gw; it < PER_L; it += NGW) {
        int r = it;
        unsigned char* wb = F.ws + WS_WMIX + (size_t)l * WMIX_STRIDE;
        if (r < I_IN) { transpose_item(a.in[2] + (size_t)l * D * IN_COLS, D, IN_COLS, (bf16_t*)(wb + WMIX_IN), scr, r, F.lane, MapNat{0}); continue; } r -= I_IN;
        if (r < I_MG) { transpose_item_fp8(a.in[24] + (size_t)l * D * 4096, D, 4096, wb + WMIX_MG, (LAS unsigned char*)scr, r, F.lane, MapGate{}, MG_SCALE); continue; } r -= I_MG;
        if (r < 4 * I_BR) { const int k4 = r / I_BR; transpose_item(a.in[26] + ((size_t)l * 4 + k4) * W * D, W, D, (bf16_t*)(wb + WMIX_BR), scr, r % I_BR, F.lane, MapNat{k4 * 1024}); continue; } r -= 4 * I_BR;
        transpose_item(a.in[27] + (size_t)l * D * D, D, D, (bf16_t*)(wb + WMIX_OUT), scr, r, F.lane, MapNat{0});
    }
}
constexpr int CONV_I13 = 8 * 16, CONV_I2 = 4 * 32, CONV_PER_E = 2 * CONV_I13 + CONV_I2, CONV_ITEMS = NEXP * CONV_PER_E;
constexpr int CONV_NA = 64 * NWAVES * 5, CONV_NB = 128 * NWAVES * 3, CONV_NC = 128 * NWAVES * 2, CONV_NM = 4 * 256 * NWAVES;
struct ConvD { const float* W; unsigned char* WT; int N, K, k0, n0, kind; };
__device__ __forceinline__ ConvD conv_desc_p(const float* in33, const float* in34, const float* in35, unsigned char* ws, int l, int it);
__device__ __forceinline__ ConvD conv_desc(const Args& a, unsigned char* ws, int l, int it) { return conv_desc_p(a.in[33], a.in[34], a.in[35], ws, l, it); }
__device__ __forceinline__ ConvD conv_desc_p(const float* in33, const float* in34, const float* in35, unsigned char* ws, int l, int it) {
    const int e = it / CONV_PER_E; int r = it % CONV_PER_E; ConvD d;
    unsigned char* w13 = ws + WS_WEXP + (size_t)l * WEXP_LAYER + (size_t)e * 1024 * 1024;
    unsigned char* w2t = ws + WS_WEXP + (size_t)l * WEXP_LAYER + WEXP_W2 + (size_t)e * 1024 * 512;
    if (r < CONV_I13) { d.W = in33 + ((size_t)l * NEXP + e) * D * DEXP; d.N = DEXP; d.K = D; d.WT = w13; d.kind = 0; }
    else if (r < 2 * CONV_I13) { r -= CONV_I13; d.W = in34 + ((size_t)l * NEXP + e) * D * DEXP; d.N = DEXP; d.K = D; d.WT = w13; d.kind = 1; }
    else { r -= 2 * CONV_I13; d.W = in35 + ((size_t)l * NEXP + e) * DEXP * D; d.N = D; d.K = DEXP; d.WT = w2t; d.kind = 2; }
    const int nblk = d.N / 32, kb = r / nblk, nb = r % nblk; d.k0 = 128 * kb; d.n0 = 32 * nb; return d;
}
__device__ __forceinline__ void conv_load(const ConvD& d, int lane, f32x4 (&v)[16]) {
    const int r = lane >> 3, c = lane & 7;
#pragma unroll
    for (int i = 0; i < 16; ++i) v[i] = *(const f32x4*)(d.W + (size_t)(d.k0 + 32 * (i >> 2) + 4 * r + (i & 3)) * d.N + d.n0 + 4 * c);
}
__device__ __forceinline__ void conv_finish(const ConvD& d, const f32x4 (&v)[16], LAS unsigned char* scr, int lane) {
    const int r = lane >> 3, c = lane & 7; const float scl = d.kind == 2 ? W2_SCALE : W13_SCALE;
#pragma unroll
    for (int g = 0; g < 4; ++g)
#pragma unroll
        for (int j = 0; j < 4; ++j) *(LAS unsigned*)(scr + (4 * c + j) * 144 + 32 * g + 4 * r) = pk4_fp8(v[4 * g][j] * scl, v[4 * g + 1][j] * scl, v[4 * g + 2][j] * scl, v[4 * g + 3][j] * scl);
    LDS_WAIT(); asm volatile("" ::: "memory");
#pragma unroll
    for (int j = 0; j < 4; ++j) { const int n = d.n0 + r + 8 * j; const int row = d.kind == 2 ? n : MapMoe13{d.kind}(n);
        *(GAS v4u*)(d.WT + (size_t)row * d.K + d.k0 + 16 * c) = *(const LAS v4u*)(scr + (r + 8 * j) * 144 + 16 * c); }
    LDS_WAIT(); asm volatile("" ::: "memory");
}
__device__ __forceinline__ void conv_finish_small(const ConvD& d, const f32x4 (&v)[16], LAS unsigned char* scr, int lane) {
    const int r = lane >> 3, c = lane & 7; const float scl = d.kind == 2 ? W2_SCALE : W13_SCALE;
#pragma unroll
    for (int hf = 0; hf < 2; ++hf) {
        if ((c >> 2) == hf) {
#pragma unroll
            for (int g = 0; g < 4; ++g)
#pragma unroll
                for (int j = 0; j < 4; ++j) *(LAS unsigned*)(scr + (4 * (c & 3) + j) * 144 + 32 * g + 4 * r) = pk4_fp8(v[4 * g][j] * scl, v[4 * g + 1][j] * scl, v[4 * g + 2][j] * scl, v[4 * g + 3][j] * scl);
        }
        LDS_WAIT(); asm volatile("" ::: "memory");
#pragma unroll
        for (int j = 0; j < 2; ++j) { const int nl = r + 8 * j, n = d.n0 + 16 * hf + nl; const int row = d.kind == 2 ? n : MapMoe13{d.kind}(n);
            *(GAS v4u*)(d.WT + (size_t)row * d.K + d.k0 + 16 * c) = *(const LAS v4u*)(scr + nl * 144 + 16 * c); }
        LDS_WAIT(); asm volatile("" ::: "memory");
    }
}
__device__ __forceinline__ void conv_expert_range(Frame& F, const Args& a, int l, int first, int count, int slot, int nslots) {
    LAS unsigned char* scr = F.lds + F.wave * 16384;
    int it = first + slot; const int end = first + count;
    if (it >= end) return;
    ConvD d = conv_desc(a, F.ws, l, it); f32x4 v[16]; conv_load(d, F.lane, v);
    for (;;) {
        const int nx = it + nslots; const bool more = nx < end;
        ConvD dn = d; f32x4 vn[16];
        if (more) { dn = conv_desc(a, F.ws, l, nx); conv_load(dn, F.lane, vn); }
        conv_finish(d, v, scr, F.lane);
        if (!more) break;
        d = dn; it = nx;
#pragma unroll
        for (int i = 0; i < 16; ++i) v[i] = vn[i];
    }
}

__device__ __forceinline__ void prep_tables(Frame& F, const Args& a) {
    for (int sidx = F.vcu * NWAVES + F.wave; sidx < DEPTH * 1024; sidx += F.G * NWAVES) {
        const int l = sidx >> 10, gid = sidx & 1023, g = gid >> 6, lane = F.lane;
        unsigned char* sm = F.ws + WS_TAB + (size_t)l * MiB + SM_OFF;
        const double lre = fmin((double)a.in[7][l * 1024 + gid], -1e-4);
        const double lim = (double)a.in[8][l * 1024 + gid];
        const double step = exp((double)a.in[9][l * 16 + g]);
        const double pw = lane == 0 ? 1.0 : (lane == 1 ? 4.0 : (lane == 2 ? 8.0 : (lane == 3 ? 12.0 : (lane == 4 ? 64.0 : 1.0))));
        const double er = exp(lre * step * pw), pr = er * cos(lim * step * pw), pi = er * sin(lim * step * pw);
        float* at = (float*)(sm + SM_ATAB) + gid * 12;
        if (lane < 5) { at[2 * lane] = (float)pr; at[2 * lane + 1] = (float)pi; }
        if (lane == 5) { at[10] = 0.f; at[11] = 0.f; }
        const double ar = __shfl(pr, 0), ai = __shfl(pi, 0);
        const double nr = ar - 1.0, ni = ai, den = lre * lre + lim * lim;
        const double cr = (nr * lre + ni * lim) / den, ci = (ni * lre - nr * lim) / den;
        if (lane < 16) {
            const double br = (double)a.in[10][((size_t)l * 1024 + gid) * 16 + lane], bi = (double)a.in[11][((size_t)l * 1024 + gid) * 16 + lane];
            ((bf16_t*)(sm + SM_BRE))[gid * 16 + lane] = f2bf((float)(cr * br - ci * bi));
            ((bf16_t*)(sm + SM_BIM))[gid * 16 + lane] = f2bf((float)(cr * bi + ci * br));
        }
    }
    for (int idx = F.vcu * 512 + F.tid; idx < DEPTH * 65536; idx += F.G * 512) {
        const int l = idx >> 16, gid = idx & 65535;
        float* tab = (float*)(F.ws + WS_TAB + (size_t)l * MiB);
        unsigned char* sm = F.ws + WS_TAB + (size_t)l * MiB + SM_OFF;
        if (gid < 256) { const double lam = (double)a.in[23][l * 256 + gid]; tab[TB_NLOG + gid] = (float)(-8.0 * log1p(exp(-lam))); }
        if (gid < 49152) { const int o = gid >> 10, k = gid & 1023; const float gk = a.in[28][(size_t)l * 1024 + k];
            const float w = (o < 4) ? gk * a.in[29][((size_t)l * 1024 + k) * 4 + o] : (o < 36 ? gk * a.in[31][((size_t)l * 1024 + k) * 32 + (o - 4)] : 0.f);
            const bf16_t wh = f2bf(w); ((bf16_t*)(tab + TB_RW))[gid] = wh; ((bf16_t*)(tab + TB_RW))[49152 + gid] = f2bf(w - bf2f(wh)); }
        if (gid < 16384) { const int g = gid >> 12, d = (gid >> 6) & 63, cc = gid & 63; const size_t si = ((size_t)(l * 4 + g) * 64 + cc) * 64 + d;
            ((bf16_t*)(sm + SM_POOLT))[gid] = f2bf(a.in[4][si]); ((bf16_t*)(sm + SM_WAT))[gid] = f2bf(a.in[19][si]); ((bf16_t*)(sm + SM_WXT))[gid] = f2bf(a.in[21][si]); }
        if (gid < 32768) { const int g = gid >> 11, cc = (gid >> 7) & 15, k = gid & 127, p = k >> 1; const size_t si = ((size_t)(l * 16 + g) * 16 + cc) * 64 + p;
            ((bf16_t*)(sm + SM_CMAT))[gid] = f2bf((k & 1) ? -a.in[13][si] : a.in[12][si]); }
        { const int col = gid >> 8, k = gid & 255; ((bf16_t*)(sm + SM_GLUT))[gid] = f2bf(a.in[15][((size_t)l * 256 + k) * 256 + col]); }
    }
}

template <bool HBF>
__device__ __forceinline__ void norm_phase(Frame& F, const void* hin_, const bf16_t* y, const float* g, bf16_t* hout, bf16_t* xn, float* out, const float oadd = 0.0f, unsigned char* xn8 = nullptr) {
    const float* hin = (const float*)hin_; const bf16_t* hinb = (const bf16_t*)hin_;
    const int gw = F.vcu * NWAVES + F.wave, NGW = F.G * NWAVES, lane = F.lane;
    f32x4 gg[4];
#pragma unroll
    for (int j = 0; j < 4; ++j) gg[j] = *(const f32x4*)(g + 4 * lane + 256 * j);
    for (int m0 = gw; m0 < T; m0 += 4 * NGW) {
        f32x4 v[4][4]; uint2 ya[4][4], yb[4][4];
#pragma unroll
        for (int i = 0; i < 4; ++i) {
            const int m = m0 + i * NGW;
            if (m < T) {
#pragma unroll
                for (int j = 0; j < 4; ++j) {
                    const int col = 4 * lane + 256 * j;
                    if (HBF) { const uint2 hv = *(const uint2*)(hinb + (size_t)m * D + col);
                        v[i][j] = (f32x4){__uint_as_float(hv.x << 16), __uint_as_float(hv.x & 0xffff0000u), __uint_as_float(hv.y << 16), __uint_as_float(hv.y & 0xffff0000u)}; }
                    else v[i][j] = *(const f32x4*)(hin + (size_t)m * D + col);
                    if (y) { ya[i][j] = *(const uint2*)(y + ((size_t)m * 2 + 0) * D + col); yb[i][j] = *(const uint2*)(y + ((size_t)m * 2 + 1) * D + col); }
                }
            }
        }
            __builtin_amdgcn_sched_barrier(0);
#pragma unroll
        for (int i = 0; i < 4; ++i) {
            const int m = m0 + i * NGW;
            if (m < T) {
                float s = 0.f;
#pragma unroll
                for (int j = 0; j < 4; ++j) {
                    if (y) {
                        v[i][j].x += __uint_as_float(ya[i][j].x << 16) + __uint_as_float(yb[i][j].x << 16);
                        v[i][j].y += __uint_as_float(ya[i][j].x & 0xffff0000u) + __uint_as_float(yb[i][j].x & 0xffff0000u);
                        v[i][j].z += __uint_as_float(ya[i][j].y << 16) + __uint_as_float(yb[i][j].y << 16);
                        v[i][j].w += __uint_as_float(ya[i][j].y & 0xffff0000u) + __uint_as_float(yb[i][j].y & 0xffff0000u);
                    }
                    s += v[i][j].x * v[i][j].x + v[i][j].y * v[i][j].y + v[i][j].z * v[i][j].z + v[i][j].w * v[i][j].w;
                }
#pragma unroll
                for (int o = 1; o < 64; o <<= 1) s += __shfl_xor(s, o);
                const float rstd = rsqrtf(s * (1.0f / D) + EPS);
#pragma unroll
                for (int j = 0; j < 4; ++j) {
                    const int col = 4 * lane + 256 * j;
                    if (hout) { uint2 w; w.x = pk2(v[i][j].x, v[i][j].y); w.y = pk2(v[i][j].z, v[i][j].w); *(uint2*)(hout + (size_t)m * D + col) = w; }
                    const f32x4 o = v[i][j] * rstd * gg[j];
                    if (xn) { uint2 w; w.x = pk2(o.x, o.y); w.y = pk2(o.z, o.w); *(uint2*)(xn + (size_t)m * D + col) = w; }
                    if (xn8) *(unsigned*)(xn8 + (size_t)m * D + col) = pk4_fp8(o.x, o.y, o.z, o.w);
                    if (out) { f32x4 oo = o; if (m == 0 && col == 0) oo.x += oadd; *(f32x4*)(out + (size_t)m * D + col) = oo; }
                }
            }
        }
    }
}

constexpr int TROW = 528;
constexpr int TILE_BYTES = 64 * TROW;
constexpr int HROW = 272, HTILE = 16 * HROW;
constexpr int CARRY_OFF = 2 * TILE_BYTES + 8 * HTILE;

struct MixArgs {
    const bf16_t* proj; bf16_t* ys; const float* tab; const unsigned char* sm; unsigned char* ws;
    float2* s5st; float2* lruS; unsigned* lrup;
    const float *conv_a_w, *pool_b, *pool_scale, *s5_d, *glu_b, *lconv_w, *lconv_b, *ba, *bx;
    const float *cw1, *cw3, *cw2; int cl, cbase;
};

typedef short bf16x8 __attribute__((ext_vector_type(8)));
__device__ __forceinline__ f32x4 mma16(bf16x8 a, bf16x8 b, f32x4 c) { return __builtin_amdgcn_mfma_f32_16x16x32_bf16(a, b, c, 0, 0, 0); }
__device__ __forceinline__ void ld8(const bf16_t* p, float (&x)[8]) {
    const v4u v = *(const v4u*)p;
    x[0] = __uint_as_float(v.x << 16); x[1] = __uint_as_float(v.x & 0xffff0000u); x[2] = __uint_as_float(v.y << 16); x[3] = __uint_as_float(v.y & 0xffff0000u);
    x[4] = __uint_as_float(v.z << 16); x[5] = __uint_as_float(v.z & 0xffff0000u); x[6] = __uint_as_float(v.w << 16); x[7] = __uint_as_float(v.w & 0xffff0000u);
}
__device__ __forceinline__ void ldf8(const float* p, float (&x)[8]) { const f32x4 a = *(const f32x4*)p, b = *(const f32x4*)(p + 4); x[0] = a.x; x[1] = a.y; x[2] = a.z; x[3] = a.w; x[4] = b.x; x[5] = b.y; x[6] = b.z; x[7] = b.w; }
typedef unsigned v2u __attribute__((ext_vector_type(2)));
__device__ __forceinline__ v4u pack8(const float (&x)[8]) { v4u o; o.x = pk2(x[0], x[1]); o.y = pk2(x[2], x[3]); o.z = pk2(x[4], x[5]); o.w = pk2(x[6], x[7]); return o; }
template <int N> __device__ __forceinline__ float dpp_row_shr(float oldv, float src) {
    return __int_as_float(__builtin_amdgcn_update_dpp(__float_as_int(oldv), __float_as_int(src), 0x110 + N, 0xf, 0xf, false));
}

template <int WIN>
__device__ __forceinline__ void pool_rows(const bf16_t* p, int pos0, LAS unsigned char* dst) {
    constexpr int NR = WIN + 3;
    v4u rp[NR];
#pragma unroll
    for (int k = 0; k < NR; ++k) { const int off = k - (WIN - 1); const int oc = (pos0 + off >= 0) ? off : -pos0; rp[k] = *(const v4u*)(p + (long)oc * IN_COLS); }
    __builtin_amdgcn_sched_barrier(0);
#pragma unroll
    for (int k = 0; k < WIN - 1; ++k) { if (pos0 + k - (WIN - 1) < 0) rp[k] = (v4u){0u, 0u, 0u, 0u}; }
    float S[8];
#pragma unroll
    for (int e = 0; e < 8; ++e) S[e] = 0.f;
#pragma unroll
    for (int k = 0; k < WIN - 1; ++k) {
        S[0] += __uint_as_float(rp[k].x << 16); S[1] += __uint_as_float(rp[k].x & 0xffff0000u); S[2] += __uint_as_float(rp[k].y << 16); S[3] += __uint_as_float(rp[k].y & 0xffff0000u);
        S[4] += __uint_as_float(rp[k].z << 16); S[5] += __uint_as_float(rp[k].z & 0xffff0000u); S[6] += __uint_as_float(rp[k].w << 16); S[7] += __uint_as_float(rp[k].w & 0xffff0000u);
    }
#pragma unroll
    for (int n = 0; n < 4; ++n) {
        const v4u xa = rp[n + WIN - 1];
        const float xn_[8] = {__uint_as_float(xa.x << 16), __uint_as_float(xa.x & 0xffff0000u), __uint_as_float(xa.y << 16), __uint_as_float(xa.y & 0xffff0000u),
                              __uint_as_float(xa.z << 16), __uint_as_float(xa.z & 0xffff0000u), __uint_as_float(xa.w << 16), __uint_as_float(xa.w & 0xffff0000u)};
#pragma unroll
        for (int e = 0; e < 8; ++e) S[e] += xn_[e];
        if (n > 0) { const v4u xo = rp[n - 1];
            S[0] -= __uint_as_float(xo.x << 16); S[1] -= __uint_as_float(xo.x & 0xffff0000u); S[2] -= __uint_as_float(xo.y << 16); S[3] -= __uint_as_float(xo.y & 0xffff0000u);
            S[4] -= __uint_as_float(xo.z << 16); S[5] -= __uint_as_float(xo.z & 0xffff0000u); S[6] -= __uint_as_float(xo.w << 16); S[7] -= __uint_as_float(xo.w & 0xffff0000u); }
        const int cnt = (pos0 + n + 1 < WIN) ? pos0 + n + 1 : WIN; const float inv = 1.0f / (float)cnt; float o[8];
#pragma unroll
        for (int e = 0; e < 8; ++e) o[e] = S[e] * inv - xn_[e];
        *(LAS v4u*)(dst + n * TROW) = pack8(o);
    }
}

template <int PH>
__device__ __forceinline__ void mix_unit(const MixArgs& A, LAS unsigned char* lds, int unit, int tid) {
    const int lane = tid & 63, wave = __builtin_amdgcn_readfirstlane(tid >> 6), j = lane & 15, q = lane >> 4;
    const int b = unit >> 5, c = unit & 31;
    const size_t t0 = (size_t)b * SEQ + c * CHUNK;
    LAS unsigned char* T0 = lds; LAS unsigned char* T1 = lds + TILE_BYTES; LAS unsigned char* Hw = lds + 2 * TILE_BYTES + wave * HTILE;
    const int cg = tid & 31, tg = tid >> 5, tl0 = tg * 4, pos0 = c * CHUNK + tl0;
    const bf16_t* prow = A.proj + (t0 + tl0) * IN_COLS + cg * 8;
    const unsigned char* sm = A.sm;
    const struct { unsigned char* ws; } F = {A.ws}; (void)F;
    typedef float f32x2_ __attribute__((ext_vector_type(2)));
    const bool cdo = A.cbase >= 0; ConvD cd = {}; f32x4 cv[16];
    if (cdo) cd = conv_desc_p(A.cw1, A.cw3, A.cw2, A.ws, A.cl, A.cbase + (unit * NWAVES + wave) * 2);
    LAS f32x2_* cS5 = (LAS f32x2_*)(lds + CARRY_OFF);
    LAS float* cLru = (LAS float*)(lds + CARRY_OFF + 8192);
    if (PH == 2) {
        const float* atb = (const float*)(sm + SM_ATAB);
        const float a0r = atb[tid * 12 + 8], a0i = atb[tid * 12 + 9], a1r = atb[(tid + 512) * 12 + 8], a1i = atb[(tid + 512) * 12 + 9];
        float h0r = 0.f, h0i = 0.f, h1r = 0.f, h1i = 0.f, hl = 0.f;
        for (int j0 = 0; j0 < c; j0 += 16) {
            float2 s0[16], s1[16], sl[16];
#pragma unroll
            for (int u = 0; u < 16; ++u) { const int jj = (j0 + u < c) ? j0 + u : c - 1; const size_t cb = (size_t)b * NCHUNK + jj;
                s0[u] = A.s5st[cb * 1024 + tid]; s1[u] = A.s5st[cb * 1024 + 512 + tid]; sl[u] = A.lruS[cb * 256 + (tid & 255)]; }
            __builtin_amdgcn_sched_barrier(0);
#pragma unroll
            for (int u = 0; u < 16; ++u) if (j0 + u < c) {
                const float n0r = a0r * h0r - a0i * h0i + s0[u].x, n0i = a0r * h0i + a0i * h0r + s0[u].y; h0r = n0r; h0i = n0i;
                const float n1r = a1r * h1r - a1i * h1i + s1[u].x, n1i = a1r * h1i + a1i * h1r + s1[u].y; h1r = n1r; h1i = n1i;
                hl = sl[u].x * hl + sl[u].y; }
        }
        cS5[tid] = (f32x2_){h0r, h0i}; cS5[tid + 512] = (f32x2_){h1r, h1i};
        if (tid < 256) cLru[tid] = hl;
    }

    if (PH == 2) STAMP(52);
    v4u su_[4];
    v4u lpk_[2][4]; v2u lgw_[2][4];
    if (PH == 2) {
#pragma unroll
        for (int d = 0; d < 2; ++d)
#pragma unroll
            for (int tt = 0; tt < 4; ++tt) { const int ch0 = (wave >> 1) * 64 + (2 * (wave & 1) + d) * 16 + 4 * q;
                lpk_[d][tt] = *(const v4u*)(A.lrup + (t0 + tt * 16 + j) * 256 + ch0); lgw_[d][tt] = *(const v2u*)(A.proj + (t0 + tt * 16 + j) * IN_COLS + 1536 + ch0); }
    }
#pragma unroll
    for (int n = 0; n < 4; ++n) su_[n] = *(const v4u*)(prow + (long)n * IN_COLS + 1024);
    const int hd = wave >> 1, dt0 = 2 * (wave & 1);
    bf16x8 pwf_[2][2], waf_[2][2], wxf_[2][2]; f32x4 pb_[2], ps_[2], bav_[2], bxv_[2], nlg_[2];
    if (PH == 2) {
#pragma unroll
        for (int ks = 0; ks < 2; ++ks)
#pragma unroll
            for (int d = 0; d < 2; ++d) pwf_[ks][d] = *(const bf16x8*)((const bf16_t*)(sm + SM_POOLT) + hd * 4096 + ((dt0 + d) * 16 + j) * 64 + ks * 32 + 8 * q);
#pragma unroll
        for (int d = 0; d < 2; ++d) { const int ch0 = hd * 64 + (dt0 + d) * 16 + 4 * q; pb_[d] = *(const f32x4*)(A.pool_b + ch0); ps_[d] = *(const f32x4*)(A.pool_scale + ch0); }
    }
    if (PH == 1) {
#pragma unroll
        for (int ks = 0; ks < 2; ++ks)
#pragma unroll
            for (int d = 0; d < 2; ++d) { waf_[ks][d] = *(const bf16x8*)((const bf16_t*)(sm + SM_WAT) + hd * 4096 + ((dt0 + d) * 16 + j) * 64 + ks * 32 + 8 * q);
                wxf_[ks][d] = *(const bf16x8*)((const bf16_t*)(sm + SM_WXT) + hd * 4096 + ((dt0 + d) * 16 + j) * 64 + ks * 32 + 8 * q); }
#pragma unroll
        for (int d = 0; d < 2; ++d) { const int ch0 = hd * 64 + (dt0 + d) * 16 + 4 * q; bav_[d] = *(const f32x4*)(A.ba + ch0); bxv_[d] = *(const f32x4*)(A.bx + ch0); nlg_[d] = *(const f32x4*)(A.tab + TB_NLOG + ch0); }
    }
    if (PH == 2) {
        float w0[8], w1[8], w2[8];
        ldf8(A.conv_a_w + 0 * 256 + cg * 8, w0); ldf8(A.conv_a_w + 1 * 256 + cg * 8, w1); ldf8(A.conv_a_w + 2 * 256 + cg * 8, w2);
        float v[6][8];
#pragma unroll
        for (int i = 0; i < 6; ++i) {
            if (pos0 - 2 + i >= 0) { float ac[8], ax[8]; ld8(prow + (long)(i - 2) * IN_COLS + 256, ac); ld8(prow + (long)(i - 2) * IN_COLS + 512, ax);
#pragma unroll
                for (int e = 0; e < 8; ++e) v[i][e] = ac[e] * ax[e]; }
            else {
#pragma unroll
                for (int e = 0; e < 8; ++e) v[i][e] = 0.f; }
        }
#pragma unroll
        for (int n = 0; n < 4; ++n) {
            float ab[8], o[8]; ld8(prow + (long)n * IN_COLS, ab);
#pragma unroll
            for (int e = 0; e < 8; ++e) o[e] = ab[e] * (w0[e] * v[n][e] + w1[e] * v[n + 1][e] + w2[e] * v[n + 2][e]);
            *(v4u*)(A.ys + (t0 + tl0 + n) * 1024 + cg * 8) = pack8(o);
        }
    }
    if (PH == 2) {
        const int pg = wave & 3, pvec = lane & 7, ptl = ((lane >> 3) + 8 * (wave >> 2)) * 4, ppos = c * CHUNK + ptl;
        const bf16_t* pp = A.proj + (t0 + ptl) * IN_COLS + 768 + pg * 64 + pvec * 8;
        LAS unsigned char* pd = T0 + ptl * TROW + (pg * 64 + pvec * 8) * 2;
        if (pg == 0) pool_rows<2>(pp, ppos, pd); else if (pg == 1) pool_rows<4>(pp, ppos, pd); else if (pg == 2) pool_rows<8>(pp, ppos, pd); else pool_rows<16>(pp, ppos, pd);
    }
    if (PH == 1) {
        float w0[8], w1[8], w2[8], w3[8], cb[8];
        ldf8(A.lconv_w + 0 * 256 + cg * 8, w0); ldf8(A.lconv_w + 1 * 256 + cg * 8, w1); ldf8(A.lconv_w + 2 * 256 + cg * 8, w2); ldf8(A.lconv_w + 3 * 256 + cg * 8, w3); ldf8(A.lconv_b + cg * 8, cb);
        float x[7][8];
#pragma unroll
        for (int i = 0; i < 7; ++i) {
            if (pos0 - 3 + i >= 0) ld8(prow + (long)(i - 3) * IN_COLS + 1280, x[i]);
            else {
#pragma unroll
                for (int e = 0; e < 8; ++e) x[i][e] = 0.f; }
        }
#pragma unroll
        for (int n = 0; n < 4; ++n) {
            float o[8];
#pragma unroll
            for (int e = 0; e < 8; ++e) o[e] = w0[e] * x[n][e] + w1[e] * x[n + 1][e] + w2[e] * x[n + 2][e] + w3[e] * x[n + 3][e] + cb[e];
            *(LAS v4u*)(T1 + (tl0 + n) * TROW + cg * 16) = pack8(o);
        }
    }
    __syncthreads();
    if (PH == 2) STAMP(53);

    if (PH == 2) {
        f32x4 acc[2][4];
#pragma unroll
        for (int d = 0; d < 2; ++d)
#pragma unroll
            for (int tt = 0; tt < 4; ++tt) acc[d][tt] = (f32x4){0.f, 0.f, 0.f, 0.f};
#pragma unroll
        for (int ks = 0; ks < 2; ++ks) {
#pragma unroll
            for (int tt = 0; tt < 4; ++tt) { const bf16x8 xf = *(const LAS bf16x8*)(T0 + (tt * 16 + j) * TROW + (hd * 64 + ks * 32 + 8 * q) * 2);
#pragma unroll
                for (int d = 0; d < 2; ++d) acc[d][tt] = mma16(pwf_[ks][d], xf, acc[d][tt]); }
        }
#pragma unroll
        for (int d = 0; d < 2; ++d) {
            const int ch0 = hd * 64 + (dt0 + d) * 16 + 4 * q;
            const f32x4 pb = pb_[d], ps = ps_[d];
#pragma unroll
            for (int tt = 0; tt < 4; ++tt) { const f32x4 o = (acc[d][tt] + pb) * ps; v2u w; w.x = pk2(o.x, o.y); w.y = pk2(o.z, o.w);
                *(v2u*)(A.ys + (t0 + tt * 16 + j) * 1024 + 256 + ch0) = w; }
        }
    }
    if (PH == 2) STAMP(54);
    if (PH == 1) {
        f32x4 ga[2][4], gx[2][4];
#pragma unroll
        for (int d = 0; d < 2; ++d)
#pragma unroll
            for (int tt = 0; tt < 4; ++tt) { ga[d][tt] = (f32x4){0.f, 0.f, 0.f, 0.f}; gx[d][tt] = (f32x4){0.f, 0.f, 0.f, 0.f}; }
#pragma unroll
        for (int ks = 0; ks < 2; ++ks) {
#pragma unroll
            for (int tt = 0; tt < 4; ++tt) { const bf16x8 xf = *(const LAS bf16x8*)(T1 + (tt * 16 + j) * TROW + (hd * 64 + ks * 32 + 8 * q) * 2);
#pragma unroll
                for (int d = 0; d < 2; ++d) { ga[d][tt] = mma16(waf_[ks][d], xf, ga[d][tt]); gx[d][tt] = mma16(wxf_[ks][d], xf, gx[d][tt]); } }
        }
#pragma unroll
        for (int d = 0; d < 2; ++d) {
            const int ch0 = hd * 64 + (dt0 + d) * 16 + 4 * q;
            const f32x4 bav = bav_[d], bxv = bxv_[d], nlg = nlg_[d];
            float hin[4] = {0.f, 0.f, 0.f, 0.f}, aprod[4] = {1.f, 1.f, 1.f, 1.f};
#pragma unroll
            for (int tt = 0; tt < 4; ++tt) {
                const v2u xcw = *(const LAS v2u*)(T1 + (tt * 16 + j) * TROW + ch0 * 2);
                const float xc[4] = {__uint_as_float(xcw.x << 16), __uint_as_float(xcw.x & 0xffff0000u), __uint_as_float(xcw.y << 16), __uint_as_float(xcw.y & 0xffff0000u)};
                v4u pk;
#pragma unroll
                for (int r = 0; r < 4; ++r) {
                    const float rg = sigmoidf_(ga[d][tt][r] + bav[r]), ig = sigmoidf_(gx[d][tt][r] + bxv[r]);
                    const float la = nlg[r] * rg; float av = __expf(la); const float mult = __builtin_amdgcn_sqrtf(fmaxf(1.0f - av * av, 0.f));
                    float bv = mult * ig * xc[r];
                    { const float ap = dpp_row_shr<1>(1.f, av), bp = dpp_row_shr<1>(0.f, bv); bv = av * bp + bv; av = av * ap; }
                    { const float ap = dpp_row_shr<2>(1.f, av), bp = dpp_row_shr<2>(0.f, bv); bv = av * bp + bv; av = av * ap; }
                    { const float ap = dpp_row_shr<4>(1.f, av), bp = dpp_row_shr<4>(0.f, bv); bv = av * bp + bv; av = av * ap; }
                    { const float ap = dpp_row_shr<8>(1.f, av), bp = dpp_row_shr<8>(0.f, bv); bv = av * bp + bv; av = av * ap; }
                    const float h = bv + av * hin[r], ac = av * aprod[r];
                    pk[r] = pk2(h, ac);
                    hin[r] = __shfl(h, (lane & 48) | 15); aprod[r] = __shfl(ac, (lane & 48) | 15);
                }
                *(v4u*)(A.lrup + (t0 + tt * 16 + j) * 256 + ch0) = pk;
            }
            if (j == 15) {
                float2* sp = A.lruS + ((size_t)b * NCHUNK + c) * 256 + ch0;
#pragma unroll
                for (int r = 0; r < 4; ++r) sp[r] = make_float2(aprod[r], hin[r]);
            }
        }
    }
    if (PH == 2) {
#pragma unroll
        for (int d = 0; d < 2; ++d) {
            const int ch0 = hd * 64 + (dt0 + d) * 16 + 4 * q;
            float hin[4];
#pragma unroll
            for (int r = 0; r < 4; ++r) hin[r] = cLru[ch0 + r];
            v4u pk[4]; v2u gw[4];
#pragma unroll
            for (int tt = 0; tt < 4; ++tt) { pk[tt] = lpk_[d][tt]; gw[tt] = lgw_[d][tt]; }
#pragma unroll
            for (int tt = 0; tt < 4; ++tt) {
                const float g0 = gelu_tanh(__uint_as_float(gw[tt].x << 16)), g1 = gelu_tanh(__uint_as_float(gw[tt].x & 0xffff0000u)), g2 = gelu_tanh(__uint_as_float(gw[tt].y << 16)), g3 = gelu_tanh(__uint_as_float(gw[tt].y & 0xffff0000u));
                float hv[4];
#pragma unroll
                for (int r = 0; r < 4; ++r) hv[r] = __uint_as_float(pk[tt][r] << 16) + __uint_as_float(pk[tt][r] & 0xffff0000u) * hin[r];
                v2u w; w.x = pk2(hv[0] * g0, hv[1] * g1); w.y = pk2(hv[2] * g2, hv[3] * g3);
                *(v2u*)(A.ys + (t0 + tt * 16 + j) * 1024 + 768 + ch0) = w;
            }
        }
    }
    if (PH == 2) STAMP(55);
    __syncthreads();

#pragma unroll
    for (int n = 0; n < 4; ++n) *(LAS v4u*)(T0 + (tl0 + n) * TROW + cg * 16) = su_[n];
    __syncthreads();
    const bf16x8 zf = (bf16x8){0, 0, 0, 0, 0, 0, 0, 0};
    if (PH == 2) STAMP(56);
#pragma unroll 1
    for (int gi = 0; gi < 2; ++gi) {
        const int g = wave * 2 + gi;
        float ar[4], ai[4], a4r[4], a4i[4], a8r[4], a8i[4], aqr[4], aqi[4], hr[4], hi[4];
        bf16x8 bref[4], bimf[4];
#pragma unroll
        for (int st = 0; st < 4; ++st) {
            const int si = g * 64 + st * 16 + j;
            const float* at = (const float*)(sm + SM_ATAB) + si * 12;
            const f32x4 t0v = *(const f32x4*)at, t1v = *(const f32x4*)(at + 4);
            ar[st] = t0v.x; ai[st] = t0v.y; a4r[st] = t0v.z; a4i[st] = t0v.w; a8r[st] = t1v.x; a8i[st] = t1v.y;
            aqr[st] = q == 0 ? 1.f : (q == 1 ? t0v.z : (q == 2 ? t1v.x : t1v.z));
            aqi[st] = q == 0 ? 0.f : (q == 1 ? t0v.w : (q == 2 ? t1v.y : t1v.w));
            hr[st] = 0.f; hi[st] = 0.f;
            if (PH == 2) { const f32x2_ cv = cS5[si]; hr[st] = cv.x; hi[st] = cv.y; }
            bref[st] = (q < 2) ? *(const bf16x8*)((const bf16_t*)(sm + SM_BRE) + si * 16 + 8 * q) : zf;
            bimf[st] = (q < 2) ? *(const bf16x8*)((const bf16_t*)(sm + SM_BIM) + si * 16 + 8 * q) : zf;
        }
        bf16x8 cf[4];
        if (PH == 2) {
#pragma unroll
            for (int ks = 0; ks < 4; ++ks) cf[ks] = *(const bf16x8*)((const bf16_t*)(sm + SM_CMAT) + (g * 16 + j) * 128 + ks * 32 + 8 * q);
        }
        const f32x4 dv = *(const f32x4*)(A.s5_d + g * 16 + 4 * q);
        if (cdo) {
            asm volatile("" :: "v"(dv));
            if (gi == 1) { conv_finish_small(cd, cv, lds + CARRY_OFF + 10240 + 2304 * wave, lane); cd = conv_desc_p(A.cw1, A.cw3, A.cw2, A.ws, A.cl, A.cbase + (unit * NWAVES + wave) * 2 + 1); }
            conv_load(cd, lane, cv);
        }
#pragma unroll 1
        for (int tt = 0; tt < 4; ++tt) {
            const bf16x8 uf = (q < 2) ? *(const LAS bf16x8*)(T0 + (tt * 16 + j) * TROW + (g * 16 + 8 * q) * 2) : zf;
#pragma unroll
            for (int st = 0; st < 4; ++st) {
                const f32x4 z4 = (f32x4){0.f, 0.f, 0.f, 0.f};
                const f32x4 dre = mma16(uf, bref[st], z4), dim = mma16(uf, bimf[st], z4);
                float er = dre[0], ei = dim[0];
#pragma unroll
                for (int r = 1; r < 4; ++r) { const float nr = ar[st] * er - ai[st] * ei + dre[r], ni = ar[st] * ei + ai[st] * er + dim[r]; er = nr; ei = ni; }
                float x1r = __shfl_up(er, 16), x1i = __shfl_up(ei, 16), x2r = __shfl_up(er, 32), x2i = __shfl_up(ei, 32), x3r = __shfl_up(er, 48), x3i = __shfl_up(ei, 48);
                if (q < 1) { x1r = 0.f; x1i = 0.f; } if (q < 2) { x2r = 0.f; x2i = 0.f; } if (q < 3) { x3r = 0.f; x3i = 0.f; }
                float pr = x1r + (a4r[st] * x2r - a4i[st] * x2i) + (a8r[st] * x3r - a8i[st] * x3i) + (aqr[st] * hr[st] - aqi[st] * hi[st]);
                float pi = x1i + (a4r[st] * x2i + a4i[st] * x2r) + (a8r[st] * x3i + a8i[st] * x3r) + (aqr[st] * hi[st] + aqi[st] * hr[st]);
#pragma unroll
                for (int r = 0; r < 4; ++r) {
                    const float nr = ar[st] * pr - ai[st] * pi + dre[r], ni = ar[st] * pi + ai[st] * pr + dim[r]; pr = nr; pi = ni;
                    if (PH == 2) *(LAS unsigned*)(Hw + (4 * q + r) * HROW + (st * 16 + j) * 4) = pk2(nr, ni);
                }
                hr[st] = __shfl(pr, 48 + j); hi[st] = __shfl(pi, 48 + j);
            }
            if (PH == 2) {
                f32x4 y = (f32x4){0.f, 0.f, 0.f, 0.f};
#pragma unroll
                for (int ks = 0; ks < 4; ++ks) { const bf16x8 hf = *(const LAS bf16x8*)(Hw + j * HROW + (ks * 32 + 8 * q) * 2); y = mma16(cf[ks], hf, y); }
                const v2u uw = *(const LAS v2u*)(T0 + (tt * 16 + j) * TROW + (g * 16 + 4 * q) * 2);
                const float y0 = gelu_tanh(y[0] + dv[0] * __uint_as_float(uw.x << 16)), y1 = gelu_tanh(y[1] + dv[1] * __uint_as_float(uw.x & 0xffff0000u));
                const float y2 = gelu_tanh(y[2] + dv[2] * __uint_as_float(uw.y << 16)), y3 = gelu_tanh(y[3] + dv[3] * __uint_as_float(uw.y & 0xffff0000u));
                v2u w; w.x = pk2(y0, y1); w.y = pk2(y2, y3);
                *(LAS v2u*)(T1 + (tt * 16 + j) * TROW + (g * 16 + 4 * q) * 2) = w;
            }
        }
        if (PH == 1 && q == 0) {
#pragma unroll
            for (int st = 0; st < 4; ++st) A.s5st[((size_t)b * NCHUNK + c) * 1024 + g * 64 + st * 16 + j] = make_float2(hr[st], hi[st]);
        }
    }
    if (PH == 2) {
        STAMP(57);
        const bf16_t* GT = (const bf16_t*)(sm + SM_GLUT);
        bf16x8 gwf[8][2];
#pragma unroll
        for (int ks = 0; ks < 8; ++ks)
#pragma unroll
            for (int d = 0; d < 2; ++d) gwf[ks][d] = *(const bf16x8*)(GT + ((wave * 2 + d) * 16 + j) * 256 + ks * 32 + 8 * q);
        f32x4 gb_[2];
#pragma unroll
        for (int d = 0; d < 2; ++d) gb_[d] = *(const f32x4*)(A.glu_b + (wave * 2 + d) * 16 + 4 * q);
        __syncthreads();
        STAMP(58);
        f32x4 acc[2][4];
#pragma unroll
        for (int d = 0; d < 2; ++d)
#pragma unroll
            for (int tt = 0; tt < 4; ++tt) acc[d][tt] = (f32x4){0.f, 0.f, 0.f, 0.f};
#pragma unroll
        for (int ks = 0; ks < 8; ++ks) {
#pragma unroll
            for (int tt = 0; tt < 4; ++tt) { const bf16x8 xf = *(const LAS bf16x8*)(T1 + (tt * 16 + j) * TROW + (ks * 32 + 8 * q) * 2);
#pragma unroll
                for (int d = 0; d < 2; ++d) acc[d][tt] = mma16(gwf[ks][d], xf, acc[d][tt]); }
        }
#pragma unroll
        for (int d = 0; d < 2; ++d) {
            const int col0 = (wave * 2 + d) * 16 + 4 * q;
            const f32x4 gb = gb_[d];
#pragma unroll
            for (int tt = 0; tt < 4; ++tt) {
                const v2u yw = *(const LAS v2u*)(T1 + (tt * 16 + j) * TROW + col0 * 2);
                const f32x4 s = acc[d][tt] + gb;
                v2u w; w.x = pk2(__uint_as_float(yw.x << 16) * sigmoidf_(s.x), __uint_as_float(yw.x & 0xffff0000u) * sigmoidf_(s.y));
                w.y = pk2(__uint_as_float(yw.y << 16) * sigmoidf_(s.z), __uint_as_float(yw.y & 0xffff0000u) * sigmoidf_(s.w));
                *(v2u*)(A.ys + (t0 + tt * 16 + j) * 1024 + 512 + col0) = w;
            }
        }
    }
    __syncthreads();
    if (cdo) conv_finish(cd, cv, lds + wave * 8192, lane);
}

__device__ __forceinline__ void router_phase(Frame& F, const bf16_t* h, const float* g2, const float* Wp, const float* rgb, const float* reb,
                                             bf16_t* xn, unsigned* cnt, int* buf_ts, float* buf_w) {
    LAS float* part = (LAS float*)(F.lds);
    LAS float* lg = (LAS float*)(F.lds + 98304);
    LAS float* rs = (LAS float*)(F.lds + 98304 + 12288);
    const int lane = F.lane, wave = F.wave, tid = F.tid, j = lane & 15, q = lane >> 4;
    LAS float* rebs = (LAS float*)(F.lds + 98304 + 12288 + 256 + 256);
    if (tid < 32) rebs[tid] = reb[tid]; else if (tid < 36) rebs[tid] = rgb[tid - 32];
    for (int blk = blockIdx.x; blk < T / 64; blk += F.G) {
        const int m0 = blk * 64;
        f32x4 v[8][4];
#pragma unroll
        for (int i = 0; i < 8; ++i)
#pragma unroll
            for (int jj = 0; jj < 4; ++jj) { const uint2 hv = *(const uint2*)(h + (size_t)(m0 + wave * 8 + i) * D + 4 * lane + 256 * jj);
                v[i][jj] = (f32x4){__uint_as_float(hv.x << 16), __uint_as_float(hv.x & 0xffff0000u), __uint_as_float(hv.y << 16), __uint_as_float(hv.y & 0xffff0000u)}; }
        {
            f32x4 gg[4];
#pragma unroll
            for (int jj = 0; jj < 4; ++jj) gg[jj] = *(const f32x4*)(g2 + 4 * lane + 256 * jj);
            __builtin_amdgcn_sched_barrier(0);
#pragma unroll
            for (int i = 0; i < 8; ++i) {
                float s = 0.f;
#pragma unroll
                for (int jj = 0; jj < 4; ++jj) s += v[i][jj].x * v[i][jj].x + v[i][jj].y * v[i][jj].y + v[i][jj].z * v[i][jj].z + v[i][jj].w * v[i][jj].w;
#pragma unroll
                for (int o = 1; o < 64; o <<= 1) s += __shfl_xor(s, o);
                const float rstd = rsqrtf(s * (1.0f / D) + EPS);
                if (lane == 0) rs[wave * 8 + i] = rstd;
#pragma unroll
                for (int jj = 0; jj < 4; ++jj) {
                    const f32x4 o = v[i][jj] * rstd * gg[jj];
                    *(unsigned*)((unsigned char*)xn + (size_t)(m0 + wave * 8 + i) * D + 4 * lane + 256 * jj) = pk4_fp8(o.x, o.y, o.z, o.w);
                }
            }
        }
        STAMP(48);
        f32x4 acc[3][4];
#pragma unroll
        for (int ot = 0; ot < 3; ++ot)
#pragma unroll
            for (int tt = 0; tt < 4; ++tt) acc[ot][tt] = (f32x4){0.f, 0.f, 0.f, 0.f};
        LAS float* xq = (LAS float*)(F.lds);
        const bf16_t* WH = (const bf16_t*)Wp; const bf16_t* WL = WH + 49152;
        bf16x8 wh[3], wl[3], whn[3], wln[3];
#pragma unroll
        for (int ot = 0; ot < 3; ++ot) { wh[ot] = *(const bf16x8*)(WH + (size_t)(ot * 16 + j) * 1024 + wave * 32 + 8 * q); wl[ot] = *(const bf16x8*)(WL + (size_t)(ot * 16 + j) * 1024 + wave * 32 + 8 * q); }
#pragma unroll
        for (int kq = 0; kq < 4; ++kq) {
            if (kq) {
#pragma unroll
                for (int ot = 0; ot < 3; ++ot) { wh[ot] = whn[ot]; wl[ot] = wln[ot]; }
                __syncthreads();
            }
#pragma unroll
            for (int i = 0; i < 8; ++i) *(LAS f32x4*)(xq + (wave * 8 + i) * 260 + 4 * lane) = v[i][kq];
            __builtin_amdgcn_sched_barrier(0);
            __syncthreads();
            if (kq < 3) {
#pragma unroll
                for (int ot = 0; ot < 3; ++ot) { whn[ot] = *(const bf16x8*)(WH + (size_t)(ot * 16 + j) * 1024 + (kq + 1) * 256 + wave * 32 + 8 * q); wln[ot] = *(const bf16x8*)(WL + (size_t)(ot * 16 + j) * 1024 + (kq + 1) * 256 + wave * 32 + 8 * q); }
            }
#pragma unroll
            for (int tt = 0; tt < 4; ++tt) {
                const f32x4 x0 = *(const LAS f32x4*)(xq + (tt * 16 + j) * 260 + wave * 32 + 8 * q), x1 = *(const LAS f32x4*)(xq + (tt * 16 + j) * 260 + wave * 32 + 8 * q + 4);
                const float xv[8] = {x0.x, x0.y, x0.z, x0.w, x1.x, x1.y, x1.z, x1.w};
                unsigned hp[4];
#pragma unroll
                for (int p = 0; p < 4; ++p) hp[p] = (__float_as_uint(xv[2 * p]) >> 16) | (__float_as_uint(xv[2 * p + 1]) & 0xffff0000u);
                const bf16x8 xh = __builtin_bit_cast(bf16x8, (v4u){hp[0], hp[1], hp[2], hp[3]});
#pragma unroll
                for (int ot = 0; ot < 3; ++ot) { acc[ot][tt] = mma16(wh[ot], xh, acc[ot][tt]); acc[ot][tt] = mma16(wl[ot], xh, acc[ot][tt]); }
            }
        }
        __syncthreads();
#pragma unroll
        for (int ot = 0; ot < 3; ++ot)
#pragma unroll
            for (int tt = 0; tt < 4; ++tt) *(LAS f32x4*)(part + ((wave * 12 + ot * 4 + tt) * 64 + lane) * 4) = acc[ot][tt];
        STAMP(49);
        __syncthreads();
        STAMP(50);
        for (int idx = tid; idx < 12 * 256; idx += 512) {
            const int tile = idx >> 8, ln = (idx >> 2) & 63, r = idx & 3, ot = tile >> 2, tt = tile & 3;
            float s = 0.f;
#pragma unroll
            for (int w = 0; w < 8; ++w) s += part[(w * 12 + tile) * 256 + (idx & 255)];
            const int tok = tt * 16 + (ln & 15), o = ot * 16 + 4 * (ln >> 4) + r;
            lg[tok * 48 + o] = s * rs[tok];
        }
        __syncthreads();
        STAMP(51);
        if (tid < 64) {
            const int m = m0 + tid;
            float gl[4], mx = -1e30f; int gi = 0;
#pragma unroll
            for (int i = 0; i < 4; ++i) { gl[i] = lg[tid * 48 + i] + rebs[32 + i]; if (gl[i] > mx) { mx = gl[i]; gi = i; } }
            float den = 0.f;
#pragma unroll
            for (int i = 0; i < 4; ++i) den += __expf(gl[i] - mx);
            const float gval = 1.0f / den;
            float v1 = -1e30f, v2 = -1e30f; int i1 = 0, i2 = 0;
            for (int i = 0; i < 8; ++i) { const float el = lg[tid * 48 + 4 + gi * 8 + i] + rebs[gi * 8 + i]; if (el > v1) { v2 = v1; i2 = i1; v1 = el; i1 = i; } else if (el > v2) { v2 = el; i2 = i; } }
            const float e2 = __expf(v2 - v1), w1 = gval / (1.0f + e2), w2 = gval * e2 / (1.0f + e2);
            const int ex1 = gi * 8 + i1, ex2 = gi * 8 + i2;
            LAS unsigned* lcnt = (LAS unsigned*)(F.lds + 98304 + 12288 + 256); LAS unsigned* lbase = lcnt + 32;
            if (tid < 32) lcnt[tid] = 0u;
            LDS_WAIT();
            const unsigned l1 = __hip_atomic_fetch_add(lcnt + ex1, 1u, __ATOMIC_RELAXED, __HIP_MEMORY_SCOPE_WORKGROUP);
            const unsigned l2 = __hip_atomic_fetch_add(lcnt + ex2, 1u, __ATOMIC_RELAXED, __HIP_MEMORY_SCOPE_WORKGROUP);
            LDS_WAIT();
            if (tid < 32) { const unsigned nloc = lcnt[tid]; lbase[tid] = nloc ? atomicAdd(&cnt[tid * 64], nloc) : 0u; }
            LDS_WAIT();
            const unsigned r1 = lbase[ex1] + l1, r2 = lbase[ex2] + l2;
            buf_ts[ex1 * CAP + r1] = m * 2 + 0; buf_w[ex1 * CAP + r1] = w1;
            buf_ts[ex2 * CAP + r2] = m * 2 + 1; buf_w[ex2 * CAP + r2] = w2;
        }
        __syncthreads();
    }
}

__device__ __forceinline__ void build_plan(Frame& F, const unsigned* cnt) {
    LAS int* plan = (LAS int*)(F.lds + PLAN_OFF);
    if (F.tid < 64) {
        const int e = F.tid & 31;
        const int ce = (int)__hip_atomic_load(cnt + e * 64, RLX_AGENT);
        const int nf = ce >> 8, rem = ce & 255, big = rem > 128 ? 1 : 0, sml = (rem > 0 && rem <= 128) ? 1 : 0;
        int pf = nf, pb = big, ps = sml;
#pragma unroll
        for (int o = 1; o < 32; o <<= 1) { const int a = __shfl_up(pf, o, 32), b = __shfl_up(pb, o, 32), c = __shfl_up(ps, o, 32); if (e >= o) { pf += a; pb += b; ps += c; } }
        const int NF = __shfl(pf, 31, 32), NB = __shfl(pb, 31, 32), NS = __shfl(ps, 31, 32);
        if (F.tid < 32) {
            plan[321 + e] = ce;
            for (int jb = 0; jb < nf; ++jb) { const int p = pf - nf + jb; if (p < MAXBLK) { plan[1 + p] = e; plan[1 + MAXBLK + p] = jb; } }
            if (big) { const int p = NF + pb - 1; if (p < MAXBLK) { plan[1 + p] = e; plan[1 + MAXBLK + p] = nf; } }
            if (sml) { const int p = NF + NB + ps - 1; if (p < MAXBLK) { plan[1 + p] = e; plan[1 + MAXBLK + p] = nf; } }
            if (e == 0) { const int tot = NF + NB + NS; plan[0] = tot < MAXBLK ? tot : MAXBLK; }
        }
    }
    __syncthreads();
}

struct DenseSched {
    static constexpr bool GATHER = false, HALF = false, WAITS = false, PUBLISHES = false;
    pg8::StaticOrder ord; const char* A; const char* Bt; int lda, K; int a_sh, a_cs; int es;
    int pair_mode = 0, pair0 = 0, pairG = 1, npair = 0;
    __device__ __forceinline__ bool next(int i, pg8::Unit& u) const {
        if (pair_mode == 0) return ord.next(i, u);
        const int p = pair0 + (i >> 2) * pairG; if (p >= npair) return false;
        u.pm = p >> 2; u.pn = pair_mode == 1 ? 4 * (i & 3) + (p & 3) : 4 * (p & 3) + (i & 3); return true;
    }
    __device__ __forceinline__ const char* a_base(const pg8::Unit& u) const { return A + (size_t)u.pm * 256 * lda * es + (size_t)((u.pn >> a_sh) * a_cs); }
    __device__ __forceinline__ const char* b_base(const pg8::Unit& u) const { return Bt + (size_t)u.pn * 256 * K * es; }
    __device__ __forceinline__ unsigned gather_off(const pg8::Unit&, int) const { return 0u; }
    __device__ __forceinline__ bool half_only(const pg8::Unit&) const { return false; }
};
struct Moe1Sched {
    static constexpr bool GATHER = true, HALF = true, WAITS = false, PUBLISHES = false;
    const char* xn; const char* w13; const LAS int* plan; const int* buf_ts; int G, c, lda; unsigned* ready;
    __device__ __forceinline__ void done(const pg8::Unit& u) const { asm volatile("s_waitcnt vmcnt(0)" ::: "memory"); if ((threadIdx.x & 63) == 0) __hip_atomic_fetch_add(ready + 16 * u.pm, 1u, RLX_AGENT); }
    __device__ __forceinline__ bool next(int i, pg8::Unit& u) const { const int L = i * G + c; if (L >= 4 * plan[0]) return false; u.pm = L >> 2; u.pn = L & 3; return true; }
    __device__ __forceinline__ const char* a_base(const pg8::Unit&) const { return xn; }
    __device__ __forceinline__ const char* b_base(const pg8::Unit& u) const { return w13 + (size_t)plan[1 + u.pm] * (1024 * 1024) + (size_t)u.pn * (256 * 1024); }
    __device__ __forceinline__ unsigned gather_off(const pg8::Unit& u, int r) const {
        const int e = plan[1 + u.pm], lb = plan[1 + MAXBLK + u.pm], ce = plan[321 + e];
        int pos = lb * 256 + r; pos = pos < ce ? pos : ce - 1;
        return (unsigned)(buf_ts[e * CAP + pos] >> 1) * (unsigned)D;
    }
    __device__ __forceinline__ bool half_only(const pg8::Unit& u) const { const int e = plan[1 + u.pm], lb = plan[1 + MAXBLK + u.pm]; return plan[321 + e] - lb * 256 <= 128; }
};
struct Moe2Sched {
    static constexpr bool GATHER = false, HALF = true, WAITS = false, PUBLISHES = false;
    const char* hbuf; const char* w2t; const LAS int* plan; int G, c, lda; const unsigned* ready; unsigned* tmo;
    __device__ __forceinline__ void a_ready(const pg8::Unit& u) const {
        if (threadIdx.x < 64) {
            const unsigned long long t0 = __builtin_amdgcn_s_memrealtime(); unsigned polls = 0;
            while ((unsigned)__builtin_amdgcn_readfirstlane(__hip_atomic_load(ready + 16 * u.pm, RLX_AGENT)) < 32u) {
                if ((++polls & 255u) == 0u && __builtin_amdgcn_readfirstlane(__hip_atomic_load(tmo, RLX_AGENT)) != 0u) break;
                if (__builtin_amdgcn_s_memrealtime() - t0 > 2000000ull) { if (threadIdx.x == 0) __hip_atomic_store(tmo, 1u, RLX_AGENT); break; }
                __builtin_amdgcn_s_sleep(2); }
            __builtin_amdgcn_fence(__ATOMIC_ACQUIRE, "agent");
            asm volatile("s_waitcnt vmcnt(0)" ::: "memory");
        }
        asm volatile("" ::: "memory"); __builtin_amdgcn_s_barrier(); asm volatile("" ::: "memory");
    }
    __device__ __forceinline__ bool next(int i, pg8::Unit& u) const { const int L = i * G + c; if (L >= 4 * plan[0]) return false; u.pm = L >> 2; u.pn = L & 3; return true; }
    __device__ __forceinline__ const char* a_base(const pg8::Unit& u) const { return hbuf + (size_t)u.pm * 256 * DEXP; }
    __device__ __forceinline__ const char* b_base(const pg8::Unit& u) const { return w2t + (size_t)plan[1 + u.pm] * (1024 * 512) + (size_t)u.pn * (256 * 512); }
    __device__ __forceinline__ unsigned gather_off(const pg8::Unit&, int) const { return 0u; }
    __device__ __forceinline__ bool half_only(const pg8::Unit& u) const { const int e = plan[1 + u.pm], lb = plan[1 + MAXBLK + u.pm]; return plan[321 + e] - lb * 256 <= 128; }
};

using pg8::f32x4; using pg8::u32x4; using pg8::u32x2; using pg8::cvt_pk_bf16; using pg8::Unit; using pg8::HALF; using pg8::BM;
struct EpiStoreBf16 {
    static constexpr bool PERM = true;
    bf16_t* O; int ldc;
    __device__ __forceinline__ void operator()(const f32x4 (&acc)[2][2][4][2], const Unit& u, int wr, int wc, int fr, int fq) const {
        const int row0 = u.pm * BM + wr * 64 + fr, col0 = u.pn * BM + wc * 32 + 8 * fq;
#pragma unroll
        for (int ai = 0; ai < 2; ++ai)
#pragma unroll
            for (int m = 0; m < 4; ++m) { bf16_t* rowp = O + (size_t)(row0 + ai * HALF + m * 16) * ldc + col0;
#pragma unroll
                for (int bj = 0; bj < 2; ++bj) { const f32x4 v0 = acc[ai][bj][m][0], v1 = acc[ai][bj][m][1];
                    u32x4 w; w.x = cvt_pk_bf16(v0[0], v0[1]); w.y = cvt_pk_bf16(v0[2], v0[3]); w.z = cvt_pk_bf16(v1[0], v1[1]); w.w = cvt_pk_bf16(v1[2], v1[3]);
                    *(u32x4*)(rowp + bj * HALF) = w; } }
    }
};
struct EpiGateMerge {
    static constexpr bool PERM = false;
    const float* bias; const bf16_t* br; bf16_t* merged;
    __device__ __forceinline__ void operator()(const f32x4 (&acc)[2][2][4][2], const Unit& u, int wr, int wc, int fr, int fq) const {
        const int row0 = u.pm * BM + wr * 64 + fr, d0 = u.pn * 64 + wc * 16 + 4 * fq;
        f32x4 bv[4];
#pragma unroll
        for (int k4 = 0; k4 < 4; ++k4) bv[k4] = *(const f32x4*)(bias + k4 * 1024 + d0) * -1.4426950408889634f;
#pragma unroll
        for (int ai = 0; ai < 2; ++ai)
#pragma unroll
            for (int m = 0; m < 4; ++m) {
                const size_t row = (size_t)(row0 + ai * HALF + m * 16);
                f32x4 s = (f32x4){0.f, 0.f, 0.f, 0.f};
#pragma unroll
                for (int k4 = 0; k4 < 4; ++k4) {
                    const u32x2 b2 = *(const u32x2*)(br + row * 4096 + k4 * 1024 + d0);
                    const f32x4 a = acc[ai][k4 >> 1][m][k4 & 1] * (-1.4426950408889634f / MG_SCALE) + bv[k4];
                    s[0] += __builtin_amdgcn_rcpf(1.0f + __builtin_amdgcn_exp2f(a[0])) * __uint_as_float(b2.x << 16);
                    s[1] += __builtin_amdgcn_rcpf(1.0f + __builtin_amdgcn_exp2f(a[1])) * __uint_as_float(b2.x & 0xffff0000u);
                    s[2] += __builtin_amdgcn_rcpf(1.0f + __builtin_amdgcn_exp2f(a[2])) * __uint_as_float(b2.y << 16);
                    s[3] += __builtin_amdgcn_rcpf(1.0f + __builtin_amdgcn_exp2f(a[3])) * __uint_as_float(b2.y & 0xffff0000u);
                }
                u32x2 w; w.x = cvt_pk_bf16(s[0], s[1]); w.y = cvt_pk_bf16(s[2], s[3]);
                *(u32x2*)(merged + row * D + d0) = w;
            }
    }
};
template <bool SRC_F32>
struct EpiAddH {
    static constexpr bool PERM = true;
    const void* hsrc; bf16_t* hdst;
    __device__ __forceinline__ void operator()(const f32x4 (&acc)[2][2][4][2], const Unit& u, int wr, int wc, int fr, int fq) const {
        const int row0 = u.pm * BM + wr * 64 + fr, col0 = u.pn * BM + wc * 32 + 8 * fq;
#pragma unroll
        for (int ai = 0; ai < 2; ++ai)
#pragma unroll
            for (int m = 0; m < 4; ++m) { const size_t ro = (size_t)(row0 + ai * HALF + m * 16) * D + col0;
#pragma unroll
                for (int bj = 0; bj < 2; ++bj) {
                    f32x4 r0, r1;
                    if (SRC_F32) { r0 = *(const f32x4*)((const float*)hsrc + ro + bj * HALF); r1 = *(const f32x4*)((const float*)hsrc + ro + bj * HALF + 4); }
                    else { const u32x4 hv = *(const u32x4*)((const bf16_t*)hsrc + ro + bj * HALF);
                        r0 = (f32x4){__uint_as_float(hv.x << 16), __uint_as_float(hv.x & 0xffff0000u), __uint_as_float(hv.y << 16), __uint_as_float(hv.y & 0xffff0000u)};
                        r1 = (f32x4){__uint_as_float(hv.z << 16), __uint_as_float(hv.z & 0xffff0000u), __uint_as_float(hv.w << 16), __uint_as_float(hv.w & 0xffff0000u)}; }
                    const f32x4 v0 = acc[ai][bj][m][0] + r0, v1 = acc[ai][bj][m][1] + r1;
                    u32x4 w; w.x = cvt_pk_bf16(v0[0], v0[1]); w.y = cvt_pk_bf16(v0[2], v0[3]); w.z = cvt_pk_bf16(v1[0], v1[1]); w.w = cvt_pk_bf16(v1[2], v1[3]);
                    *(u32x4*)(hdst + ro + bj * HALF) = w; } }
    }
};
struct EpiMoe1 {
    static constexpr bool PERM = false;
    unsigned char* hbuf;
    __device__ __forceinline__ void operator()(const f32x4 (&acc)[2][2][4][2], const Unit& u, int wr, int wc, int fr, int fq) const {
        const int row0 = u.pm * BM + wr * 64 + fr, h0 = u.pn * 128 + wc * 16 + 4 * fq;
        const float si = 1.0f / W13_SCALE;
#pragma unroll
        for (int ai = 0; ai < 2; ++ai)
#pragma unroll
            for (int m = 0; m < 4; ++m) { unsigned char* rowp = hbuf + (size_t)(row0 + ai * HALF + m * 16) * DEXP + h0;
#pragma unroll
                for (int bj = 0; bj < 2; ++bj) { const f32x4 a1 = acc[ai][bj][m][0] * si, a3 = acc[ai][bj][m][1] * (si * H_SCALE);
                    const unsigned w = pk4_fp8(a1[0] * sigmoidf_(a1[0]) * a3[0], a1[1] * sigmoidf_(a1[1]) * a3[1], a1[2] * sigmoidf_(a1[2]) * a3[2], a1[3] * sigmoidf_(a1[3]) * a3[3]);
                    *(unsigned*)(rowp + bj * 64) = w; } }
    }
};
struct EpiMoe2 {
    static constexpr bool PERM = true;
    bf16_t* ymoe; const LAS int* plan; const int* buf_ts; const float* buf_w;
    __device__ __forceinline__ void operator()(const f32x4 (&acc)[2][2][4][2], const Unit& u, int wr, int wc, int fr, int fq) const {
        const int e = plan[1 + u.pm], lb = plan[1 + MAXBLK + u.pm], ce = plan[321 + e];
        const int col0 = u.pn * BM + wc * 32 + 8 * fq;
        int ts[2][4]; float wt[2][4];
#pragma unroll
        for (int ai = 0; ai < 2; ++ai)
#pragma unroll
            for (int m = 0; m < 4; ++m) {
                const int pos = lb * 256 + ai * HALF + wr * 64 + m * 16 + fr; const int pc = pos < ce ? pos : ce - 1;
                ts[ai][m] = buf_ts[e * CAP + pc]; wt[ai][m] = buf_w[e * CAP + pc] * (1.0f / (W2_SCALE * H_SCALE));
                if (pos >= ce) ts[ai][m] = -1;
            }
        __builtin_amdgcn_sched_barrier(0);
#pragma unroll
        for (int ai = 0; ai < 2; ++ai)
#pragma unroll
            for (int m = 0; m < 4; ++m) {
                if (ts[ai][m] >= 0) {
                    bf16_t* rowp = ymoe + (size_t)ts[ai][m] * D + col0; const float w_ = wt[ai][m];
#pragma unroll
                    for (int bj = 0; bj < 2; ++bj) { const f32x4 v0 = acc[ai][bj][m][0] * w_, v1 = acc[ai][bj][m][1] * w_;
                        u32x4 w; w.x = cvt_pk_bf16(v0[0], v0[1]); w.y = cvt_pk_bf16(v0[2], v0[3]); w.z = cvt_pk_bf16(v1[0], v1[1]); w.w = cvt_pk_bf16(v1[2], v1[3]);
                        *(u32x4*)(rowp + bj * HALF) = w; }
                }
            }
    }
};

__device__ __forceinline__ void make_mix_args(MixArgs& A, const Args& args, unsigned char* ws, int l) {
    A.proj = (const bf16_t*)(ws + WS_PROJ); A.ys = (bf16_t*)(ws + WS_YS); A.tab = (const float*)(ws + WS_TAB + (size_t)l * MiB); A.sm = ws + WS_TAB + (size_t)l * MiB + SM_OFF; A.ws = ws;
    A.s5st = (float2*)(ws + WS_S5ST); A.lruS = (float2*)(ws + WS_LRUS); A.lrup = (unsigned*)(ws + WS_LRUA);
    A.conv_a_w = args.in[3] + (size_t)l * 3 * W; A.pool_b = args.in[5] + (size_t)l * W; A.pool_scale = args.in[6] + (size_t)l * W;
    A.s5_d = args.in[14] + (size_t)l * W; A.glu_b = args.in[16] + (size_t)l * W;
    A.cw1 = args.in[33]; A.cw3 = args.in[34]; A.cw2 = args.in[35]; A.cl = l; A.cbase = -1;
    A.lconv_w = args.in[17] + (size_t)l * 4 * W; A.lconv_b = args.in[18] + (size_t)l * W; A.ba = args.in[20] + (size_t)l * W; A.bx = args.in[22] + (size_t)l * W;
}

__global__ void __launch_bounds__(NWAVES * 64, 2) mk_fwd(Args args) {
    extern __shared__ __attribute__((aligned(16))) unsigned char lds[];
    Frame F;
    F.lds = (LAS unsigned char*)lds; F.smem = lds;
    F.MISC = (volatile LAS unsigned*)(F.lds + MISC_OFF);
    F.tid = threadIdx.x; F.lane = F.tid & 63; F.wave = __builtin_amdgcn_readfirstlane(F.tid >> 6);
    F.G = gridDim.x; { const int bx = blockIdx.x; F.vcu = (F.G % 8 == 0) ? (bx % 8) * (F.G / 8) + bx / 8 : bx; }
    F.ws = args.ws; F.ctl = (unsigned*)(args.ws + WS_CTL);
    unsigned char* ws = args.ws; unsigned char* const args_ws_ = args.ws; (void)args_ws_;
    for (int u = F.tid; u < (LDS_BYTES - LDSCTL_OFF) / 4; u += NWAVES * 64) ((LAS unsigned*)(F.lds + LDSCTL_OFF))[u] = 0u;
    __syncthreads();
    XcdBarrier bar; bar.bar = F.ctl + CW_BAR; bar.x = 0; bar.st = nullptr;
    if (N_LAUNCHES == 1) bar = xcd_barrier_post(F.ctl + CW_BAR, F.MISC + 8);
    const int lo = args.ph_lo, hi = args.ph_hi;
    bf16_t* h = (bf16_t*)(ws + WS_H); bf16_t* xn = (bf16_t*)(ws + WS_XN); bf16_t* proj = (bf16_t*)(ws + WS_PROJ); bf16_t* ys = (bf16_t*)(ws + WS_YS);
    bf16_t* br = (bf16_t*)(ws + WS_R1); bf16_t* hbuf = (bf16_t*)(ws + WS_HBUF); bf16_t* ymoe = (bf16_t*)(ws + WS_YMOE); bf16_t* merged = (bf16_t*)(ws + WS_MERGED);
    int* buf_ts = (int*)(ws + WS_BUFTS); float* buf_w = (float*)(ws + WS_BUFW);

#ifndef KIND_MASK
#define KIND_MASK 0x7ff
#endif
#define PH_BEGIN(k, kind) if (lo <= (k) && (k) < hi && ((KIND_MASK >> (kind)) & 1)) { \
        { int t_ = threadIdx.x; asm volatile("" : "+v"(t_)); F.tid = t_; F.lane = t_ & 63; F.wave = __builtin_amdgcn_readfirstlane(t_ >> 6); } STAMP(2 * (k));
#ifdef PROBE_A
#define PH_END(k) __syncthreads(); STAMP(2 * (k) + 1); if ((k) + 1 < hi) xcd_barrier(bar); }
#else
#define PH_END(k) if ((k) + 1 < hi) xcd_barrier(bar); }
#endif

    PH_BEGIN(0, 0)
        prep_tables(F, args);
        STAMP(62);
        conv_mixer_weights(F, args, 0, F.vcu * NWAVES + F.wave, F.G * NWAVES);
        STAMP(63);
        { const int nm0 = F.G == 256 ? CONV_NM : 0; conv_expert_range(F, args, 0, CONV_NA + nm0, CONV_ITEMS - CONV_NA - nm0, F.vcu * NWAVES + F.wave, F.G * NWAVES); }
        STAMP(61);
        norm_phase<false>(F, args.in[0], nullptr, args.in[1], nullptr, xn, nullptr, 0.0f, ws + WS_XN8);
    PH_END(0)

#ifdef PROBE_A
#ifndef PROBE_MODE
#define PROBE_MODE 0
#endif
#ifndef PROBE_SCALE
#define PROBE_SCALE 300
#endif
#ifndef PROBE_SHIFT
#define PROBE_SHIFT 0.0f
#endif
#define PROBE_REDUCE() { xcd_barrier(bar); \
        if (blockIdx.x == 0) { LAS float* red = (LAS float*)F.lds; const unsigned long long* dd = (const unsigned long long*)(g_dbg); \
            if (F.tid < 256) { const unsigned long long ta = __hip_atomic_load(dd + (size_t)F.tid * 64 + (PROBE_A), RLX_AGENT), tb = __hip_atomic_load(dd + (size_t)F.tid * 64 + (PROBE_B), RLX_AGENT), t00 = __hip_atomic_load(dd + (PROBE_A), RLX_AGENT); \
                red[F.tid] = (float)(long long)(tb - ta) * 0.01f; red[256 + F.tid] = (float)(long long)(ta - t00) * 0.01f; red[512 + F.tid] = (float)(long long)(tb - t00) * 0.01f; } \
            __syncthreads(); \
            if (F.tid == 0) { float sum = 0.f, mx = -1e30f, mna = 1e30f, mxb = -1e30f, mxa = -1e30f, mnb = 1e30f; for (int i = 0; i < 256; ++i) { sum += red[i]; mx = fmaxf(mx, red[i]); mna = fminf(mna, red[256 + i]); mxb = fmaxf(mxb, red[512 + i]); mxa = fmaxf(mxa, red[256 + i]); mnb = fminf(mnb, red[512 + i]); } \
                const float val = PROBE_MODE == 0 ? sum * (1.0f / 256.0f) : (PROBE_MODE == 1 ? mx : (PROBE_MODE == 2 ? mxb - mna : mnb - mxa)); \
                const float vq = val; \
                __hip_atomic_store((float*)((unsigned long long*)(g_dbg) + 256 * 64), vq, RLX_AGENT); } \
            __syncthreads(); } \
        xcd_barrier(bar); \
        oscale_ = __hip_atomic_load((float*)((unsigned long long*)(g_dbg) + 256 * 64), RLX_AGENT) * (1.0f / (float)(PROBE_SCALE)); }
#else
#define PROBE_REDUCE()
#endif
#define LAYER(l) { \
    const int pb = 1 + PH_PER_LAYER * (l); \
    const float* tab = (const float*)(ws + WS_TAB + (size_t)(l) * MiB); \
    const unsigned char* wmix = ws + WS_WMIX + (size_t)(l) * WMIX_STRIDE; \
    unsigned* cnt = F.ctl + CW_CNT + 2048 * (l); \
    PH_BEGIN(pb + 0, 1)   \
        DenseSched S; S.ord.init(T, IN_COLS, F.G, (int)blockIdx.x); S.A = (const char*)xn; S.Bt = (const char*)(wmix + WMIX_IN); S.lda = D; S.K = D; S.a_sh = 0; S.a_cs = 0; S.es = 2; \
        EpiStoreBf16 E{proj, IN_COLS}; \
        pg8::gemm_phase<EpiStoreBf16, DenseSched, true, true>(F.lds, F.tid, D, S, E); \
        if (F.G == 256 && (int)blockIdx.x >= 192) conv_expert_range(F, args, (l), 0, CONV_NA, ((int)blockIdx.x - 192) * NWAVES + F.wave, 64 * NWAVES); \
        else if (F.G != 256 && (int)blockIdx.x == 0) conv_expert_range(F, args, (l), 0, CONV_NA, F.wave, NWAVES);     \
    PH_END(pb + 0) \
    PH_BEGIN(pb + 1, 2)   \
        MixArgs A; make_mix_args(A, args, ws, (l)); if (F.G == 256) A.cbase = CONV_NA; \
        for (int u = blockIdx.x; u < BATCH * NCHUNK; u += F.G) { int t_ = F.tid; asm volatile("" : "+v"(t_)); mix_unit<1>(A, F.lds, u, t_); } \
    PH_END(pb + 1) \
    PH_BEGIN(pb + 2, 3)   \
        MixArgs A; make_mix_args(A, args, ws, (l)); if (F.G == 256) A.cbase = CONV_NA + CONV_NM / 2; \
        for (int u = blockIdx.x; u < BATCH * NCHUNK; u += F.G) { int t_ = F.tid; asm volatile("" : "+v"(t_)); mix_unit<2>(A, F.lds, u, t_); } \
    PH_END(pb + 2) \
    PH_BEGIN(pb + 3, 4)   \
        { DenseSched S; S.ord.init(T, 4096, F.G, (int)blockIdx.x); S.A = (const char*)ys; S.Bt = (const char*)(wmix + WMIX_BR); S.lda = 1024; S.K = 256; S.a_sh = 2; S.a_cs = 512; S.es = 2; \
          S.pair_mode = 1; S.pair0 = F.vcu; S.pairG = F.G; S.npair = (T / 256) * 4; \
          EpiStoreBf16 E{br, 4096}; \
          pg8::gemm_phase<EpiStoreBf16, DenseSched, true, true>(F.lds, F.tid, 256, S, E); } \
        asm volatile("s_waitcnt vmcnt(0)" ::: "memory"); __syncthreads();     \
        { DenseSched S; S.ord.init(T, 4096, F.G, (int)blockIdx.x); S.A = (const char*)(ws + WS_XN8); S.Bt = (const char*)(wmix + WMIX_MG); S.lda = D; S.K = D; S.a_sh = 0; S.a_cs = 0; S.es = 1; \
          S.pair_mode = 2; S.pair0 = F.vcu; S.pairG = F.G; S.npair = (T / 256) * 4; \
          EpiGateMerge E{args.in[25] + (size_t)(l) * 4096, br, merged}; \
          pg8::gemm_phase<EpiGateMerge, DenseSched, true, true, true>(F.lds, F.tid, D, S, E); } \
    PH_END(pb + 3) \
    PH_BEGIN(pb + 4, 6)   \
        DenseSched S; S.ord.init(T, D, F.G, (int)blockIdx.x); S.A = (const char*)merged; S.Bt = (const char*)(wmix + WMIX_OUT); S.lda = D; S.K = D; S.a_sh = 0; S.a_cs = 0; S.es = 2; \
        bf16_t* hd_ = (args.flags & 1) ? (bf16_t*)(ws + WS_R1) : h; \
        if ((l) == 0) { EpiAddH<true> E{args.in[0], hd_}; pg8::gemm_phase<EpiAddH<true>, DenseSched, true, true>(F.lds, F.tid, D, S, E); } \
        else { EpiAddH<false> E{h, hd_}; pg8::gemm_phase<EpiAddH<false>, DenseSched, true, true>(F.lds, F.tid, D, S, E); } \
    PH_END(pb + 4) \
    PH_BEGIN(pb + 5, 7)   \
        if (args.flags & 1) router_phase(F, h, args.in[28] + (size_t)(l) * D, tab + TB_RW, args.in[30] + (size_t)(l) * 4, args.in[32] + (size_t)(l) * 32, xn, F.ctl + 16384, (int*)(ws + WS_END), (float*)(ws + WS_END + 2 * MiB)); \
        else router_phase(F, h, args.in[28] + (size_t)(l) * D, tab + TB_RW, args.in[30] + (size_t)(l) * 4, args.in[32] + (size_t)(l) * 32, xn, cnt, buf_ts, buf_w); \
    PH_END(pb + 5) \
    PH_BEGIN(pb + 6, 8)   \
        build_plan(F, cnt); \
        unsigned* rdy = F.ctl + CW_RDY + 4096 * (l); \
        { Moe1Sched S{(const char*)xn, (const char*)(ws + WS_WEXP + (size_t)(l) * WEXP_LAYER), (const LAS int*)(F.lds + PLAN_OFF), buf_ts, F.G, F.vcu, D, rdy}; \
          EpiMoe1 E{(unsigned char*)hbuf}; \
          pg8::gemm_phase<EpiMoe1, Moe1Sched, true, true, true>(F.lds, F.tid, D, S, E); } \
        STAMP(44); \
        if ((l) + 1 < DEPTH) { if (F.G == 256 && F.vcu >= 128) { conv_mixer_weights(F, args, (l) + 1, (F.vcu - 128) * NWAVES + F.wave, 128 * NWAVES); } \
            else if (F.G != 256 && F.vcu == 0) { conv_expert_range(F, args, (l) + 1, CONV_NA, CONV_NB, F.wave, NWAVES); conv_mixer_weights(F, args, (l) + 1, F.wave, NWAVES); } } \
        xcd_barrier(bar);     \
        STAMP(45); \
        { Moe2Sched S{(const char*)hbuf, (const char*)(ws + WS_WEXP + (size_t)(l) * WEXP_LAYER + WEXP_W2), (const LAS int*)(F.lds + PLAN_OFF), F.G, F.G - 1 - F.vcu, DEXP, rdy, F.ctl + CW_TMO}; \
          EpiMoe2 E{ymoe, (const LAS int*)(F.lds + PLAN_OFF), buf_ts, buf_w}; \
          pg8::gemm_phase<EpiMoe2, Moe2Sched, true, true, true>(F.lds, F.tid, DEXP, S, E); } \
        if ((l) + 1 < DEPTH) { if (F.G == 256) { if (F.vcu < 128) conv_expert_range(F, args, (l) + 1, CONV_NA + CONV_NM, CONV_ITEMS - CONV_NA - CONV_NM, F.vcu * NWAVES + F.wave, 128 * NWAVES); }     \
            else if (F.G != 256 && F.vcu == 0) conv_expert_range(F, args, (l) + 1, CONV_NA + CONV_NB, CONV_NC, F.wave, NWAVES); } \
    PH_END(pb + 6) \
    PH_BEGIN(pb + 7, 9)   \
        if ((l) + 1 < DEPTH) { \
            if (F.G != 256) conv_expert_range(F, args, (l) + 1, CONV_NA + CONV_NB + CONV_NC, CONV_ITEMS - (CONV_NA + CONV_NB + CONV_NC), F.vcu * NWAVES + F.wave, F.G * NWAVES); \
            norm_phase<true>(F, h, ymoe, args.in[1] + (size_t)((l) + 1) * D, (args.flags & 1) ? nullptr : h, xn, nullptr, 0.0f, ws + WS_XN8); \
        } else { \
            float oscale_ = 0.0f; \
            PROBE_REDUCE() \
            norm_phase<true>(F, h, ymoe, args.in[36], nullptr, nullptr, args.out, oscale_); \
        } \
    PH_END(pb + 7) \
}
    LAYER(0)
    LAYER(1)
#undef LAYER
#undef PH_BEGIN
#undef PH_END
}
}

extern "C" void kernel_launch(void* const* d_in, const int* in_sizes, int n_in, void* d_out, int out_size, void* d_ws, size_t ws_size, hipStream_t stream) {
    static int grid = 0;
    if (grid == 0) {
        if (n_in != 37 || ws_size < WS_END) { fprintf(stderr, "kernel_launch: unexpected n_in %d or ws %zu\n", n_in, ws_size); grid = -1; return; }
        int dev = 0, cus = 0;
        if (hipGetDevice(&dev) != hipSuccess || hipDeviceGetAttribute(&cus, hipDeviceAttributeMultiprocessorCount, dev) != hipSuccess) { grid = -1; return; }
        if (hipFuncSetAttribute((const void*)mk_fwd, hipFuncAttributeMaxDynamicSharedMemorySize, LDS_BYTES) != hipSuccess) { fprintf(stderr, "kernel_launch: hipFuncSetAttribute failed\n"); grid = -1; return; }
        grid = cus;
    }
    if (grid < 0) return;
    (void)hipMemsetAsync((char*)d_ws + WS_CTL, 0, 1 * MiB, stream);
    Args a{};
    for (int i = 0; i < 37; ++i) a.in[i] = (const float*)d_in[i];
    a.out = (float*)d_out; a.ws = (unsigned char*)d_ws;
    if (N_LAUNCHES == 1) {
        a.ph_lo = 0; a.ph_hi = N_PHASES;
        hipLaunchKernelGGL(mk_fwd, dim3(grid), dim3(NWAVES * 64), LDS_BYTES, stream, a);
    } else {
#ifndef REP_MASK
#define REP_MASK 0
#endif
#ifndef REP_N
#define REP_N 2
#endif
        for (int p = 0; p < N_PHASES; ++p) { a.ph_lo = p; a.ph_hi = p + 1; const int kind = p == 0 ? 0 : 1 + (p - 1) % PH_PER_LAYER; const int nrep = ((REP_MASK >> kind) & 1) ? REP_N : 1;
            for (int r = 0; r < nrep; ++r) { a.flags = (r + 1 < nrep) ? 1 : 0; hipLaunchKernelGGL(mk_fwd, dim3(grid), dim3(NWAVES * 64), LDS_BYTES, stream, a); } }
    }
}
```
